# Optimizing an MI355X kernel written in HIP

```python
import math
import jax, jax.numpy as jnp
from jax import lax
import numpy as np

D_MODEL = 2048
BATCH = 2
SEQ = 16384
DEPTH = 2
DEC_BATCH = 4
DEC_SEQ = 4096
PAST_LEN = 128

GRID_W = 64
PLE_DIM = 256
W_A = 512
S5_H = 16
S5_G = W_A // S5_H
S5_P = 64
W_B = 512
CONV_K = 3
N_HEADS = 8
HEAD_DIM = 64
W_C = N_HEADS * HEAD_DIM
NA_ROWS = 8
NA_COLS = 16
QCB = 16
KCB = 32
W_D = 512
FNET_GROUPS = 4
FNET_GW = W_D // FNET_GROUPS
N_BRANCH = 4
MIX_IN = W_A + 3 * W_B + 3 * W_C + W_D
IN_COLS = MIX_IN + N_BRANCH * D_MODEL
D_FF = -(-8 * D_MODEL // (3 * 256)) * 256
EPS = 1e-6
NEG_INF = -1e30

kernel_name = 'hybrid_bidir_s5_conv_natten_fnet_encoder'


def rmsnorm(x, g):
    xf = x.astype(jnp.float32)
    y = xf * lax.rsqrt(jnp.mean(xf * xf, axis=-1, keepdims=True) + EPS)
    return (y * g.astype(jnp.float32)).astype(x.dtype)


def cmul(ar, ai, br, bi):
    return ar * br - ai * bi, ar * bi + ai * br


def s5_scan(uf, lam_re, lam_im, log_dt, b_re, b_im, c_re, c_im, reverse):
    lam_re = lam_re.astype(jnp.float32)
    lam_im = lam_im.astype(jnp.float32)
    dt = jnp.exp(log_dt.astype(jnp.float32))[:, None]
    mag = jnp.exp(lam_re * dt)
    ar = mag * jnp.cos(lam_im * dt)
    ai = mag * jnp.sin(lam_im * dt)
    den = lam_re * lam_re + lam_im * lam_im
    fr = ((ar - 1.0) * lam_re + ai * lam_im) / den
    fi = (ai * lam_re - (ar - 1.0) * lam_im) / den
    bbr, bbi = cmul(fr[..., None], fi[..., None], b_re.astype(jnp.float32), b_im.astype(jnp.float32))
    bur = jnp.einsum('blgh,gph->blgp', uf, bbr)
    bui = jnp.einsum('blgh,gph->blgp', uf, bbi)
    a_r = jnp.broadcast_to(ar, bur.shape)
    a_i = jnp.broadcast_to(ai, bur.shape)

    def combine(e1, e2):
        a1r, a1i, b1r, b1i = e1
        a2r, a2i, b2r, b2i = e2
        nar, nai = cmul(a2r, a2i, a1r, a1i)
        tr, ti = cmul(a2r, a2i, b1r, b1i)
        return nar, nai, tr + b2r, ti + b2i

    _, _, xr, xi = lax.associative_scan(combine, (a_r, a_i, bur, bui), reverse=reverse, axis=1)
    return (jnp.einsum('blgp,ghp->blgh', xr, c_re.astype(jnp.float32))
            - jnp.einsum('blgp,ghp->blgh', xi, c_im.astype(jnp.float32)))


def s5_mixer(u, lam_re, lam_im, log_dt, b_re, b_im, c_re, c_im, d_skip, w_glu):
    bn, L, _ = u.shape
    uf = u.astype(jnp.float32).reshape(bn, L, S5_G, S5_H)
    y = d_skip.astype(jnp.float32).reshape(S5_G, S5_H) * uf
    for direction, rev in ((0, False), (1, True)):
        y = y + s5_scan(uf, lam_re[direction], lam_im[direction], log_dt[direction],
                        b_re[direction], b_im[direction], c_re[direction], c_im[direction], rev)
    y = jax.nn.gelu(y.reshape(bn, L, W_A))
    y = y * jax.nn.sigmoid(y @ w_glu.astype(jnp.float32))
    return y.astype(u.dtype)


def short_conv_mixer(bg, cg, v, conv_w):
    z = cg * v
    y = lax.conv_general_dilated(z, conv_w[:, None, :].astype(z.dtype), window_strides=(1,),
                                 padding=((CONV_K // 2, CONV_K // 2),),
                                 dimension_numbers=('NWC', 'WIO', 'NWC'),
                                 feature_group_count=W_B)
    return bg * y


def neighbourhood_attention(q, k, v, rel_bias):
    bn, L = q.shape[0], q.shape[1]
    rows = L // GRID_W
    wr = min(NA_ROWS, rows)
    n_cb = GRID_W // QCB
    r = np.arange(rows)
    rs = np.clip(r - wr // 2, 0, rows - wr)
    row_idx = rs[:, None] + np.arange(wr)[None, :]
    dr_idx = row_idx - r[:, None] + (NA_ROWS - 1)
    j = np.arange(n_cb)
    kc0 = np.clip(j * QCB - NA_COLS // 2, 0, GRID_W - KCB)
    col_idx = kc0[:, None] + np.arange(KCB)[None, :]
    qc = j[:, None] * QCB + np.arange(QCB)[None, :]
    cs = np.clip(qc - NA_COLS // 2, 0, GRID_W - NA_COLS)
    kcol = col_idx[:, None, :]
    valid = (kcol >= cs[:, :, None]) & (kcol < cs[:, :, None] + NA_COLS)
    dc_idx = np.clip(kcol - qc[:, :, None] + (NA_COLS - 1), 0, 2 * NA_COLS - 2)

    qg = q.reshape(bn, rows, n_cb, QCB, N_HEADS, HEAD_DIM)
    kg = k.reshape(bn, rows, GRID_W, N_HEADS, HEAD_DIM)
    vg = v.reshape(bn, rows, GRID_W, N_HEADS, HEAD_DIM)
    gi_r = row_idx[:, None, :, None]
    gi_c = col_idx[None, :, None, :]
    kn = kg[:, gi_r, gi_c]
    vn = vg[:, gi_r, gi_c]
    s = jnp.einsum('brjqhd,brjakhd->brjhqak', qg, kn,
                   preferred_element_type=jnp.float32) * (1.0 / math.sqrt(HEAD_DIM))
    bias = rel_bias.astype(jnp.float32)[:, dr_idx[:, None, None, :, None], dc_idx[None, :, :, None, :]]
    bias = jnp.transpose(bias, (1, 2, 0, 3, 4, 5))
    s = jnp.where(valid[None, :, None, :, None, :], s + bias, NEG_INF)
    pr = jax.nn.softmax(s.reshape(bn, rows, n_cb, N_HEADS, QCB, wr * KCB), axis=-1)
    pr = pr.reshape(bn, rows, n_cb, N_HEADS, QCB, wr, KCB).astype(v.dtype)
    o = jnp.einsum('brjhqak,brjakhd->brjqhd', pr, vn)
    return o.reshape(bn, L, W_C)


def fourier_mixer(u):
    bn, L, _ = u.shape
    ug = u.astype(jnp.float32).reshape(bn, L, FNET_GROUPS, FNET_GW)
    f = jnp.fft.fftn(ug, axes=(1, 3), norm='ortho').real
    return f.reshape(bn, L, W_D).astype(u.dtype)


def encoder_layer(x, p, g_mix, w_in, s5_lam_re, s5_lam_im, s5_log_dt, s5_b_re, s5_b_im,
                  s5_c_re, s5_c_im, s5_d, w_glu, conv_w, q_gain, k_gain, rel_bias,
                  w_br, w_o, g_ffn, w_ffn_in, w_ffn_out, g_ple, w_ple_gate, w_ple_proj):
    bn, L, _ = x.shape
    h = rmsnorm(x, g_mix)
    z = h @ w_in[:, :MIX_IN]
    offs = [W_A, W_A + W_B, W_A + 2 * W_B, W_A + 3 * W_B,
            W_A + 3 * W_B + W_C, W_A + 3 * W_B + 2 * W_C, W_A + 3 * W_B + 3 * W_C]
    u_a, b_g, c_g, v_b, q, k, v_c, u_d = jnp.split(z, offs, axis=-1)
    y_a = s5_mixer(u_a, s5_lam_re, s5_lam_im, s5_log_dt, s5_b_re, s5_b_im, s5_c_re, s5_c_im, s5_d, w_glu)
    y_b = short_conv_mixer(b_g, c_g, v_b, conv_w)
    qh = rmsnorm(q.reshape(bn, L, N_HEADS, HEAD_DIM), q_gain)
    kh = rmsnorm(k.reshape(bn, L, N_HEADS, HEAD_DIM), k_gain)
    vh = v_c.reshape(bn, L, N_HEADS, HEAD_DIM)
    y_c = neighbourhood_attention(qh, kh, vh, rel_bias)
    y_d = fourier_mixer(u_d)
    ys = (y_a, y_b, y_c, y_d)
    merged = None
    for kb in range(N_BRANCH):
        gate = jax.nn.sigmoid(h @ w_in[:, MIX_IN + kb * D_MODEL: MIX_IN + (kb + 1) * D_MODEL])
        term = gate * (ys[kb] @ w_br[kb])
        merged = term if merged is None else merged + term
    x = x + merged @ w_o
    h2 = rmsnorm(x, g_ffn)
    a, b = jnp.split(h2 @ w_ffn_in, 2, axis=-1)
    x = x + (jax.nn.silu(a) * b) @ w_ffn_out
    pg = jax.nn.sigmoid(rmsnorm(x, g_ple) @ w_ple_gate)
    x = x + pg * (p @ w_ple_proj)
    return x


def setup_inputs(seed: int = 0) -> dict:
    key = jax.random.key(seed)
    ks = iter(jax.random.split(key, 40))
    f32 = jnp.float32

    def nrm(shape, scale):
        return jax.random.normal(next(ks), shape, f32) * scale

    x_prompt = nrm((BATCH, SEQ, D_MODEL), 1.0)
    x_sample = nrm((DEC_BATCH, DEC_SEQ, D_MODEL), 1.0)
    p_prompt = nrm((DEPTH, BATCH, SEQ, PLE_DIM), 1.0)
    p_sample = nrm((DEPTH, DEC_BATCH, DEC_SEQ, PLE_DIM), 1.0)
    g_mix = 1.0 + nrm((DEPTH, D_MODEL), 0.02)
    w_in = nrm((DEPTH, D_MODEL, IN_COLS), D_MODEL ** -0.5)
    n_idx = jnp.arange(S5_P, dtype=f32)
    s5_lam_re = -0.5 + nrm((DEPTH, 2, S5_G, S5_P), 0.01)
    s5_lam_im = math.pi * n_idx + nrm((DEPTH, 2, S5_G, S5_P), 0.01)
    s5_log_dt = jax.random.uniform(next(ks), (DEPTH, 2, S5_G), f32, math.log(1e-3), math.log(1e-1))
    s5_b_re = nrm((DEPTH, 2, S5_G, S5_P, S5_H), (2 * S5_H) ** -0.5)
    s5_b_im = nrm((DEPTH, 2, S5_G, S5_P, S5_H), (2 * S5_H) ** -0.5)
    s5_c_re = nrm((DEPTH, 2, S5_G, S5_H, S5_P), (2 * S5_P) ** -0.5)
    s5_c_im = nrm((DEPTH, 2, S5_G, S5_H, S5_P), (2 * S5_P) ** -0.5)
    s5_d = nrm((DEPTH, W_A), 1.0)
    w_glu = nrm((DEPTH, W_A, W_A), W_A ** -0.5)
    conv_w = nrm((DEPTH, CONV_K, W_B), CONV_K ** -0.5)
    q_gain = 1.0 + nrm((DEPTH, HEAD_DIM), 0.02)
    k_gain = 1.0 + nrm((DEPTH, HEAD_DIM), 0.02)
    rel_bias = nrm((DEPTH, N_HEADS, 2 * NA_ROWS - 1, 2 * NA_COLS - 1), 0.02)
    w_br = nrm((DEPTH, N_BRANCH, W_A, D_MODEL), W_A ** -0.5)
    w_o = nrm((DEPTH, D_MODEL, D_MODEL), D_MODEL ** -0.5)
    g_ffn = 1.0 + nrm((DEPTH, D_MODEL), 0.02)
    w_ffn_in = nrm((DEPTH, D_MODEL, 2 * D_FF), D_MODEL ** -0.5)
    w_ffn_out = nrm((DEPTH, D_FF, D_MODEL), D_FF ** -0.5)
    g_ple = 1.0 + nrm((DEPTH, D_MODEL), 0.02)
    w_ple_gate = nrm((DEPTH, D_MODEL, D_MODEL), D_MODEL ** -0.5)
    w_ple_proj = nrm((DEPTH, PLE_DIM, D_MODEL), PLE_DIM ** -0.5)
    return {'x_prompt': x_prompt, 'x_sample': x_sample, 'p_prompt': p_prompt, 'p_sample': p_sample,
            'g_mix': g_mix, 'w_in': w_in, 's5_lam_re': s5_lam_re, 's5_lam_im': s5_lam_im,
            's5_log_dt': s5_log_dt, 's5_b_re': s5_b_re, 's5_b_im': s5_b_im, 's5_c_re': s5_c_re,
            's5_c_im': s5_c_im, 's5_d': s5_d, 'w_glu': w_glu, 'conv_w': conv_w, 'q_gain': q_gain,
            'k_gain': k_gain, 'rel_bias': rel_bias, 'w_br': w_br, 'w_o': w_o, 'g_ffn': g_ffn,
            'w_ffn_in': w_ffn_in, 'w_ffn_out': w_ffn_out, 'g_ple': g_ple, 'w_ple_gate': w_ple_gate,
            'w_ple_proj': w_ple_proj}


def reference(x_prompt, x_sample, p_prompt, p_sample, g_mix, w_in, s5_lam_re, s5_lam_im,
              s5_log_dt, s5_b_re, s5_b_im, s5_c_re, s5_c_im, s5_d, w_glu, conv_w, q_gain,
              k_gain, rel_bias, w_br, w_o, g_ffn, w_ffn_in, w_ffn_out, g_ple, w_ple_gate,
              w_ple_proj):
    def trunk(x, p):
        for i in range(DEPTH):
            x = encoder_layer(x, p[i], g_mix[i], w_in[i], s5_lam_re[i], s5_lam_im[i], s5_log_dt[i],
                              s5_b_re[i], s5_b_im[i], s5_c_re[i], s5_c_im[i], s5_d[i], w_glu[i],
                              conv_w[i], q_gain[i], k_gain[i], rel_bias[i], w_br[i], w_o[i],
                              g_ffn[i], w_ffn_in[i], w_ffn_out[i], g_ple[i], w_ple_gate[i],
                              w_ple_proj[i])
        return x

    y_prompt = trunk(x_prompt, p_prompt)
    y_sample = trunk(x_sample, p_sample)
    return (y_prompt, y_sample)
```

```cpp
#include <hip/hip_runtime.h>
#include <cstdio>
#include <cstdint>

namespace pg8 {
#define PG8_LAS __attribute__((address_space(3)))
typedef unsigned short bf16_t;
typedef short bf16x8 __attribute__((ext_vector_type(8)));
typedef float f32x4 __attribute__((ext_vector_type(4)));
typedef float f32x2 __attribute__((ext_vector_type(2)));
typedef unsigned u32x4 __attribute__((ext_vector_type(4)));
typedef unsigned u32x2 __attribute__((ext_vector_type(2)));
constexpr int BM = 256, BK = 64, HALF = 128, HTB = HALF * BK * 2  , STAGE_BYTES = 8 * HTB, NXCD = 8, WGM = 8;

__host__ __device__ __forceinline__ int lds_byte(int r, int c) { const int st = (r >> 4) * 2 + (c >> 5), rr = r & 15, cc = c & 31, ob = rr * 64 + cc * 2; return st * 1024 + (ob ^ (((ob >> 9) & 1) << 5)); }
__host__ __device__ __forceinline__ void stage_rc(int b, int& R, int& C) { const int st = b / 1024, sb = b % 1024, swz = sb ^ (((sb >> 9) & 1) << 5); R = (st >> 1) * 16 + swz / 64; C = (st & 1) * 32 + (swz % 64) / 2; }
__host__ __device__ __forceinline__ int perm32(int rho) { const int n = rho >> 4, i = rho & 15; return 8 * (i >> 2) + 4 * n + (i & 3); }

struct Unit { int pm, pn; };
struct Gemm { const bf16_t* A; const bf16_t* Bt; int lda, ldb, K, agrp_shift, agrp_stride; };

__device__ __forceinline__ void tile_of(int wgid, int nwg, int nM, int nN, int& pm, int& pn) {
    { const int q = nwg / NXCD, r = nwg % NXCD, xcd = wgid % NXCD, off = wgid / NXCD; wgid = (xcd < r ? xcd * (q + 1) : r * (q + 1) + (xcd - r) * q) + off; }
    const int nig = WGM * nN, gid = wgid / nig, fm = gid * WGM, gsz = (nM - fm) < WGM ? (nM - fm) : WGM;
    pm = fm + ((wgid % nig) % gsz); pn = (wgid % nig) / gsz;
}
struct StaticOrder {
    int nM, nN, nwg, G, c;
    __device__ __forceinline__ void init(int M, int N, int G_, int c_) { nM = M / BM; nN = N / BM; nwg = nM * nN; G = G_; c = c_; }
    __device__ __forceinline__ bool next(int i, Unit& u) const {
        const long L = (long)i * G + c; if (L >= nwg) return false;
        tile_of((int)L, nwg, nM, nN, u.pm, u.pn); return true;
    }
};
struct MergeOrder {
    int nM, ntile, G, c;
    __device__ __forceinline__ void init(int M, int G_, int c_) { nM = M / BM; ntile = nM * 8; G = G_; c = c_; }
    __device__ __forceinline__ bool next(int i, Unit& u) const {
        const long L = (long)(i >> 2) * G + c; if (L >= ntile) return false;
        int pm, ct; tile_of((int)L, ntile, nM, 8, pm, ct); u.pm = pm; u.pn = (i & 3) * 8 + ct; return true;
    }
};

typedef __bf16 bf16x2_t __attribute__((ext_vector_type(2)));
__device__ __forceinline__ unsigned cvt_pk_bf16(float lo, float hi) { const f32x2 v = {lo, hi}; return __builtin_bit_cast(unsigned, __builtin_convertvector(v, bf16x2_t)); }
__device__ __forceinline__ float bf_lo(unsigned w) { return __uint_as_float(w << 16); }
__device__ __forceinline__ float bf_hi(unsigned w) { return __uint_as_float(w & 0xffff0000u); }
__device__ __forceinline__ float sigmoidf_fast(float x) { return __builtin_amdgcn_rcpf(1.0f + __expf(-x)); }

struct EpiStoreBf16 {
    static constexpr bool PERM = true;
    bf16_t* O; int ldc;
    __device__ __forceinline__ void operator()(const f32x4 (&acc)[2][2][4][2], const Unit& u, int wr, int wc, int fr, int fq) const {
        const int row0 = u.pm * BM + wr * 64 + fr, col0 = u.pn * BM + wc * 32 + 8 * fq;
#pragma unroll
        for (int ai = 0; ai < 2; ++ai)
#pragma unroll
            for (int m = 0; m < 4; ++m) { bf16_t* rowp = O + (size_t)(row0 + ai * HALF + m * 16) * ldc + col0;
#pragma unroll
                for (int bj = 0; bj < 2; ++bj) { const f32x4 v0 = acc[ai][bj][m][0], v1 = acc[ai][bj][m][1];
                    u32x4 w; w.x = cvt_pk_bf16(v0[0], v0[1]); w.y = cvt_pk_bf16(v0[2], v0[3]); w.z = cvt_pk_bf16(v1[0], v1[1]); w.w = cvt_pk_bf16(v1[2], v1[3]);
                    *(u32x4*)(rowp + bj * HALF) = w; } }
    }
};
struct EpiGlu {
    static constexpr bool PERM = true;
    const bf16_t* Y1; int ld1; bf16_t* O; int ldc;
    __device__ __forceinline__ void operator()(const f32x4 (&acc)[2][2][4][2], const Unit& u, int wr, int wc, int fr, int fq) const {
        const int row0 = u.pm * BM + wr * 64 + fr, col0 = u.pn * BM + wc * 32 + 8 * fq;
#pragma unroll
        for (int ai = 0; ai < 2; ++ai)
#pragma unroll
            for (int m = 0; m < 4; ++m) { const size_t r = (size_t)(row0 + ai * HALF + m * 16);
#pragma unroll
                for (int bj = 0; bj < 2; ++bj) { const f32x4 v0 = acc[ai][bj][m][0], v1 = acc[ai][bj][m][1];
                    const u32x4 y = *(const u32x4*)(Y1 + r * ld1 + col0 + bj * HALF);
                    u32x4 w;
                    w.x = cvt_pk_bf16(bf_lo(y.x) * sigmoidf_fast(v0[0]), bf_hi(y.x) * sigmoidf_fast(v0[1]));
                    w.y = cvt_pk_bf16(bf_lo(y.y) * sigmoidf_fast(v0[2]), bf_hi(y.y) * sigmoidf_fast(v0[3]));
                    w.z = cvt_pk_bf16(bf_lo(y.z) * sigmoidf_fast(v1[0]), bf_hi(y.z) * sigmoidf_fast(v1[1]));
                    w.w = cvt_pk_bf16(bf_lo(y.w) * sigmoidf_fast(v1[2]), bf_hi(y.w) * sigmoidf_fast(v1[3]));
                    *(u32x4*)(O + r * ldc + col0 + bj * HALF) = w; } }
    }
};
struct EpiMerge {
    static constexpr bool PERM = true;
    const bf16_t* P; float* MACC; bf16_t* MG;
    __device__ __forceinline__ void operator()(const f32x4 (&acc)[2][2][4][2], const Unit& u, int wr, int wc, int fr, int fq) const {
        const int kb = u.pn >> 3, ct = u.pn & 7;
        const int row0 = u.pm * BM + wr * 64 + fr, col0 = ct * BM + wc * 32 + 8 * fq;
#pragma unroll
        for (int ai = 0; ai < 2; ++ai)
#pragma unroll
            for (int m = 0; m < 4; ++m) { const size_t r = (size_t)(row0 + ai * HALF + m * 16);
#pragma unroll
                for (int bj = 0; bj < 2; ++bj) { const f32x4 v0 = acc[ai][bj][m][0], v1 = acc[ai][bj][m][1];
                    const int c = col0 + bj * HALF;
                    const u32x4 p = *(const u32x4*)(P + r * 8192 + kb * 2048 + c);
                    f32x4 t0, t1;
                    t0[0] = bf_lo(p.x) * sigmoidf_fast(v0[0]); t0[1] = bf_hi(p.x) * sigmoidf_fast(v0[1]); t0[2] = bf_lo(p.y) * sigmoidf_fast(v0[2]); t0[3] = bf_hi(p.y) * sigmoidf_fast(v0[3]);
                    t1[0] = bf_lo(p.z) * sigmoidf_fast(v1[0]); t1[1] = bf_hi(p.z) * sigmoidf_fast(v1[1]); t1[2] = bf_lo(p.w) * sigmoidf_fast(v1[2]); t1[3] = bf_hi(p.w) * sigmoidf_fast(v1[3]);
                    float* mp = MACC + r * 2048 + c;
                    if (kb > 0) { t0 += *(const f32x4*)mp; t1 += *(const f32x4*)(mp + 4); }
                    if (kb < 3) { *(f32x4*)mp = t0; *(f32x4*)(mp + 4) = t1; }
                    else { u32x4 w; w.x = cvt_pk_bf16(t0[0], t0[1]); w.y = cvt_pk_bf16(t0[2], t0[3]); w.z = cvt_pk_bf16(t1[0], t1[1]); w.w = cvt_pk_bf16(t1[2], t1[3]);
                        *(u32x4*)(MG + r * 2048 + c) = w; } } }
    }
};
struct EpiResF32 {
    static constexpr bool PERM = false;
    const float* base; float* out; int ldc;
    __device__ __forceinline__ void operator()(const f32x4 (&acc)[2][2][4][2], const Unit& u, int wr, int wc, int fr, int fq) const {
        const int row0 = u.pm * BM + wr * 64 + fr, col0 = u.pn * BM + wc * 32 + 4 * fq;
#pragma unroll
        for (int ai = 0; ai < 2; ++ai)
#pragma unroll
            for (int m = 0; m < 4; ++m) { const size_t off = (size_t)(row0 + ai * HALF + m * 16) * ldc + col0;
#pragma unroll
                for (int bj = 0; bj < 2; ++bj)
#pragma unroll
                    for (int n = 0; n < 2; ++n) { const f32x4 bs = *(const f32x4*)(base + off + bj * HALF + n * 16); *(f32x4*)(out + off + bj * HALF + n * 16) = bs + acc[ai][bj][m][n]; } }
    }
};
struct EpiSwiglu {
    static constexpr bool PERM = true;
    bf16_t* O; int ldc;
    __device__ __forceinline__ void operator()(const f32x4 (&acc)[2][2][4][2], const Unit& u, int wr, int wc, int fr, int fq) const {
        const int row0 = u.pm * BM + wr * 64 + fr, col0 = u.pn * HALF + wc * 32 + 8 * fq;
#pragma unroll
        for (int ai = 0; ai < 2; ++ai)
#pragma unroll
            for (int m = 0; m < 4; ++m) {
                f32x4 t[2];
#pragma unroll
                for (int n = 0; n < 2; ++n)
#pragma unroll
                    for (int j = 0; j < 4; ++j) { const float a = acc[ai][0][m][n][j], b = acc[ai][1][m][n][j]; t[n][j] = a * sigmoidf_fast(a) * b; }
                u32x4 w; w.x = cvt_pk_bf16(t[0][0], t[0][1]); w.y = cvt_pk_bf16(t[0][2], t[0][3]); w.z = cvt_pk_bf16(t[1][0], t[1][1]); w.w = cvt_pk_bf16(t[1][2], t[1][3]);
                *(u32x4*)(O + (size_t)(row0 + ai * HALF + m * 16) * ldc + col0) = w; }
    }
};
struct EpiPle {
    static constexpr bool PERM = false;
    const float* base; float* out; int ldc; const bf16_t* PP; int ldp;
    __device__ __forceinline__ void operator()(const f32x4 (&acc)[2][2][4][2], const Unit& u, int wr, int wc, int fr, int fq) const {
        const int row0 = u.pm * BM + wr * 64 + fr, col0 = u.pn * BM + wc * 32 + 4 * fq;
#pragma unroll
        for (int ai = 0; ai < 2; ++ai)
#pragma unroll
            for (int m = 0; m < 4; ++m) { const size_t r = (size_t)(row0 + ai * HALF + m * 16);
#pragma unroll
                for (int bj = 0; bj < 2; ++bj)
#pragma unroll
                    for (int n = 0; n < 2; ++n) { const int c = col0 + bj * HALF + n * 16; const f32x4 a = acc[ai][bj][m][n];
                        const f32x4 bs = *(const f32x4*)(base + r * ldc + c); const u32x2 p = *(const u32x2*)(PP + r * ldp + c);
                        f32x4 o; o[0] = bs[0] + sigmoidf_fast(a[0]) * bf_lo(p.x); o[1] = bs[1] + sigmoidf_fast(a[1]) * bf_hi(p.x); o[2] = bs[2] + sigmoidf_fast(a[2]) * bf_lo(p.y); o[3] = bs[3] + sigmoidf_fast(a[3]) * bf_hi(p.y);
                        *(f32x4*)(out + r * ldc + c) = o; } }
    }
};
template <class Epi, class Sched, bool ALIGN_EPI = false, bool SP2 = false>
__device__ __forceinline__ void gemm_phase(PG8_LAS unsigned char* lds, const Gemm g, const Sched& S, const Epi& E) {
    int tid_ = threadIdx.x; asm volatile("" : "+v"(tid_));
    const int tid = tid_, wid = __builtin_amdgcn_readfirstlane(tid >> 6), lane = tid & 63, wr = wid >> 2, wc = wid & 3, fr = lane & 15, fq = lane >> 4;
    const int K = g.K, nt = K / BK, lda = g.lda, ldb = g.ldb;
    unsigned voffA[2], voffB[2];
#pragma unroll
    for (int i = 0; i < 2; ++i) { int R, C; stage_rc(tid * 16 + i * 8192, R, C); const int Rb = Epi::PERM ? ((R & ~31) + perm32(R & 31)) : R;
        voffA[i] = (unsigned)(R * lda + C) * 2u; voffB[i] = (unsigned)(Rb * ldb + C) * 2u; }
    const size_t kstep = (size_t)(BK * 2);
    const size_t hstepA = (size_t)HALF * lda * 2, hstepB = (size_t)HALF * ldb * 2;
    const size_t tstepA = 2 * hstepA, tstepB = 2 * hstepB;
#define PG8_ABASE(u) ((const char*)g.A + (size_t)(u).pm * tstepA + (size_t)((u).pn >> g.agrp_shift) * (size_t)g.agrp_stride * 2)
#define PG8_BBASE(u) ((const char*)g.Bt + (size_t)(u).pn * tstepB)
    const unsigned ldsw = (unsigned)wid * 1024u;
    const int aoff = lds_byte(wr * 64 + fr, fq * 8), boff = lds_byte(wc * 32 + fr, fq * 8);
#define PG8_SA(b, h) (((b) * 2 + (h)) * HTB)
#define PG8_SB(b, h) ((4 + (b) * 2 + (h)) * HTB)
#define PG8_STAGE(bufoff, gbase, voff) do { _Pragma("unroll") for (int _i = 0; _i < 2; ++_i) \
        __builtin_amdgcn_global_load_lds((const unsigned*)((const char*)(gbase) + (voff)[_i]), (PG8_LAS unsigned*)(lds + (bufoff) + ldsw + _i * 8192), 16, 0, 0); } while (0)
#define PG8_LDA(dst, b, h) do { _Pragma("unroll") for (int m = 0; m < 4; ++m) _Pragma("unroll") for (int k = 0; k < 2; ++k) dst[m][k] = *(const PG8_LAS bf16x8*)(lds + PG8_SA(b, h) + aoff + m * 2048 + k * 1024); } while (0)
#define PG8_LDB(dst, b, h) do { _Pragma("unroll") for (int n = 0; n < 2; ++n) _Pragma("unroll") for (int k = 0; k < 2; ++k) dst[n][k] = *(const PG8_LAS bf16x8*)(lds + PG8_SB(b, h) + boff + n * 2048 + k * 1024); } while (0)
#define PG8_MMA(ai, bj, At, Bt) do { __builtin_amdgcn_s_setprio(1); _Pragma("unroll") for (int m = 0; m < 4; ++m) _Pragma("unroll") for (int n = 0; n < 2; ++n) _Pragma("unroll") for (int k = 0; k < 2; ++k) \
        acc[ai][bj][m][n] = __builtin_amdgcn_mfma_f32_16x16x32_bf16(Bt[n][k], At[m][k], acc[ai][bj][m][n], 0, 0, 0); __builtin_amdgcn_s_setprio(0); } while (0)
#define PG8_WAIT_V(n) asm volatile("s_waitcnt vmcnt(" #n ")" ::: "memory")
#define PG8_WAIT_L(n) asm volatile("s_waitcnt lgkmcnt(" #n ")" ::: "memory")
#define PG8_BAR __builtin_amdgcn_s_barrier()
#define PG8_SCHED __builtin_amdgcn_sched_barrier(0)
    Unit cur, nxt; int ui = 0;
    if (!S.next(0, cur)) return;
    f32x4 acc[2][2][4][2];
#pragma unroll
    for (int a = 0; a < 2; ++a)
#pragma unroll
        for (int b = 0; b < 2; ++b)
#pragma unroll
            for (int m = 0; m < 4; ++m)
#pragma unroll
                for (int n = 0; n < 2; ++n) acc[a][b][m][n] = (f32x4){0.f, 0.f, 0.f, 0.f};
    bf16x8 At[4][2], B0[2][2], B1[2][2];
    const char* cA = PG8_ABASE(cur); const char* cB = PG8_BBASE(cur);
    if constexpr (SP2) {
        PG8_STAGE(PG8_SB(0, 0), cB, voffB); PG8_STAGE(PG8_SB(0, 1), cB + hstepB, voffB); PG8_STAGE(PG8_SA(0, 0), cA, voffA); PG8_STAGE(PG8_SA(0, 1), cA + hstepA, voffA);
        if (wr == 1) PG8_BAR;
        PG8_WAIT_V(2); PG8_BAR;
        PG8_STAGE(PG8_SB(1, 0), cB + kstep, voffB); PG8_STAGE(PG8_SA(1, 0), cA + kstep, voffA); PG8_STAGE(PG8_SB(1, 1), cB + hstepB + kstep, voffB);
        PG8_WAIT_V(6); PG8_BAR;
    } else {
        PG8_STAGE(PG8_SB(0, 0), cB, voffB); PG8_STAGE(PG8_SA(0, 0), cA, voffA); PG8_STAGE(PG8_SB(0, 1), cB + hstepB, voffB); PG8_STAGE(PG8_SA(0, 1), cA + hstepA, voffA);
        if (wr == 1) PG8_BAR;
        PG8_WAIT_V(4); PG8_BAR;
        PG8_STAGE(PG8_SB(1, 0), cB + kstep, voffB); PG8_STAGE(PG8_SA(1, 0), cA + kstep, voffA); PG8_STAGE(PG8_SB(1, 1), cB + hstepB + kstep, voffB);
        PG8_WAIT_V(6); PG8_BAR;
    }
    for (;;) {
        const bool has_next = S.next(ui + 1, nxt);
        const char* nA = has_next ? PG8_ABASE(nxt) : cA; const char* nB = has_next ? PG8_BBASE(nxt) : cB;
        for (int t = 0; t < nt; t += 2) {
            const bool last = (t == nt - 2);
            const char* a1 = cA + (size_t)(t + 1) * kstep;
            const char* a2 = last ? nA : cA + (size_t)(t + 2) * kstep; const char* b2 = last ? nB : cB + (size_t)(t + 2) * kstep;
            const char* a3 = a2 + kstep; const char* b3 = b2 + kstep;
            if constexpr (SP2) {
            PG8_LDB(B0, 0, 0); PG8_LDB(B1, 0, 1); PG8_SCHED; PG8_LDA(At, 0, 0); PG8_STAGE(PG8_SA(1, 1), a1 + hstepA, voffA);
            PG8_WAIT_V(8); PG8_WAIT_L(0); PG8_BAR; PG8_MMA(0, 0, At, B0); PG8_MMA(0, 1, At, B1); PG8_BAR; PG8_SCHED;
            PG8_LDA(At, 0, 1); PG8_STAGE(PG8_SB(0, 0), b2, voffB); PG8_STAGE(PG8_SB(0, 1), b2 + hstepB, voffB); PG8_STAGE(PG8_SA(0, 0), a2, voffA);
            PG8_WAIT_V(8); PG8_WAIT_L(0); PG8_BAR; PG8_MMA(1, 0, At, B0); PG8_MMA(1, 1, At, B1); PG8_BAR; PG8_SCHED;
            PG8_LDB(B0, 1, 0); PG8_LDB(B1, 1, 1); PG8_SCHED; PG8_LDA(At, 1, 0); PG8_STAGE(PG8_SA(0, 1), a2 + hstepA, voffA);
            PG8_WAIT_V(8); PG8_WAIT_L(0); PG8_BAR; PG8_MMA(0, 0, At, B0); PG8_MMA(0, 1, At, B1); PG8_BAR; PG8_SCHED;
            PG8_LDA(At, 1, 1); PG8_STAGE(PG8_SB(1, 0), b3, voffB); PG8_STAGE(PG8_SB(1, 1), b3 + hstepB, voffB); PG8_STAGE(PG8_SA(1, 0), a3, voffA);
            PG8_WAIT_V(8); PG8_WAIT_L(0); PG8_BAR; PG8_MMA(1, 0, At, B0); PG8_MMA(1, 1, At, B1); PG8_BAR; PG8_SCHED;
            } else {
            PG8_LDB(B0, 0, 0); PG8_SCHED; PG8_LDA(At, 0, 0); PG8_STAGE(PG8_SA(1, 1), a1 + hstepA, voffA);
            PG8_WAIT_L(8); PG8_BAR; PG8_WAIT_L(0); PG8_MMA(0, 0, At, B0); PG8_BAR; PG8_SCHED;
            PG8_LDB(B1, 0, 1); PG8_STAGE(PG8_SB(0, 0), b2, voffB);
            PG8_BAR; PG8_WAIT_L(0); PG8_MMA(0, 1, At, B1); PG8_BAR;
            PG8_LDA(At, 0, 1); PG8_STAGE(PG8_SA(0, 0), a2, voffA);
            PG8_BAR; PG8_WAIT_L(0); PG8_MMA(1, 0, At, B0); PG8_BAR; PG8_SCHED;
            PG8_STAGE(PG8_SB(0, 1), b2 + hstepB, voffB);
            PG8_WAIT_V(6); PG8_BAR; PG8_MMA(1, 1, At, B1); PG8_BAR;
            PG8_LDB(B0, 1, 0); PG8_SCHED; PG8_LDA(At, 1, 0); PG8_STAGE(PG8_SA(0, 1), a2 + hstepA, voffA);
            PG8_WAIT_L(8); PG8_BAR; PG8_WAIT_L(0); PG8_MMA(0, 0, At, B0); PG8_BAR; PG8_SCHED;
            PG8_LDB(B1, 1, 1); PG8_STAGE(PG8_SB(1, 0), b3, voffB);
            PG8_BAR; PG8_WAIT_L(0); PG8_MMA(0, 1, At, B1); PG8_BAR;
            PG8_LDA(At, 1, 1); PG8_STAGE(PG8_SA(1, 0), a3, voffA);
            PG8_BAR; PG8_WAIT_L(0); PG8_MMA(1, 0, At, B0); PG8_BAR; PG8_SCHED;
            PG8_STAGE(PG8_SB(1, 1), b3 + hstepB, voffB);
            PG8_WAIT_V(6); PG8_BAR; PG8_MMA(1, 1, At, B1); PG8_BAR;
            }
        }
        if constexpr (ALIGN_EPI) { if (wr == 0) PG8_BAR; }
        { E(acc, cur, wr, wc, fr, fq); }
        if (!has_next) break;
#pragma unroll
        for (int a = 0; a < 2; ++a)
#pragma unroll
            for (int b = 0; b < 2; ++b)
#pragma unroll
                for (int m = 0; m < 4; ++m)
#pragma unroll
                    for (int n = 0; n < 2; ++n) acc[a][b][m][n] = (f32x4){0.f, 0.f, 0.f, 0.f};
        cur = nxt; cA = nA; cB = nB; ++ui;
        if constexpr (ALIGN_EPI) { if (wr == 1) PG8_BAR; }
    }
    PG8_WAIT_V(0);
    if constexpr (!ALIGN_EPI) { if (wr == 0) PG8_BAR; }
    PG8_BAR;
#undef PG8_ABASE
#undef PG8_BBASE
#undef PG8_SA
#undef PG8_SB
#undef PG8_STAGE
#undef PG8_LDA
#undef PG8_LDB
#undef PG8_MMA
#undef PG8_WAIT_V
#undef PG8_WAIT_L
#undef PG8_BAR
#undef PG8_SCHED
}
}


constexpr int D_MODEL = 2048, NTOK = 49152, CH_TOK = 16384, N_CHUNK = 3, DEPTH = 2;
constexpr int MIX_IN = 4096, IN_COLS = 12288, D_FF = 5632, PLE_DIM = 256;
constexpr int ZC_UA = 0, ZC_BG = 512, ZC_CG = 1024, ZC_VB = 1536, ZC_Q = 2048, ZC_K = 2560, ZC_VC = 3072, ZC_UD = 3584;
constexpr float EPS = 1e-6f;
constexpr int NWAVES = 8;

constexpr size_t MiB = 1u << 20;
constexpr size_t WS_CTL = 0, CTL_ZERO_BYTES = 1 * MiB;
constexpr size_t WS_TAB = 1 * MiB;
constexpr size_t S5T_BYTES = 12800, S5T_BB = 0, S5T_C = 8192, S5T_AB = 12288;
constexpr size_t TAB_S5 = WS_TAB, TAB_C128 = WS_TAB + 2 * MiB, TAB_S128 = TAB_C128 + 32768, TAB_C32 = TAB_S128 + 32768, TAB_S32 = TAB_C32 + 2048;
constexpr size_t WS_W = 8 * MiB;
constexpr size_t WL_MIX = 0, WL_G = 16 * MiB, WL_GLU = 48 * MiB, WL_BR = WL_GLU + MiB / 2, WL_O = WL_BR + 8 * MiB, WL_FF = WL_O + 8 * MiB, WL_FF2 = WL_FF + 44 * MiB, WL_PG = WL_FF2 + 22 * MiB, WL_PP = WL_PG + 8 * MiB;
constexpr size_t WL_BYTES = WL_PP + 1 * MiB;
static_assert(WL_BYTES == 139 * MiB + MiB / 2, "weight map");
constexpr size_t WS_H = 288 * MiB;
constexpr size_t WS_Z = 352 * MiB;
constexpr size_t WS_YS = 480 * MiB;
constexpr size_t WS_MG = 544 * MiB;
constexpr size_t WS_GT = 608 * MiB;
constexpr size_t WS_YF = WS_GT, WS_YB = WS_GT + 32 * MiB, WS_ZF = WS_GT + 64 * MiB, WS_Y1 = WS_GT + 96 * MiB;
constexpr size_t WS_P16 = 864 * MiB;
constexpr size_t WS_END = 872 * MiB;
static_assert(WS_W + 2 * WL_BYTES <= WS_H, "ws map");
constexpr int CW_BAR = 4096;

constexpr int LDS_SCRATCH = 151552;
constexpr int LDSCTL_OFF = LDS_SCRATCH;
constexpr int LDS_BYTES = LDS_SCRATCH + 256;

#define GAS __attribute__((address_space(1)))
#define LAS __attribute__((address_space(3)))
typedef unsigned short bf16;
typedef unsigned u32x4 __attribute__((ext_vector_type(4)));
typedef unsigned u32x2 __attribute__((ext_vector_type(2)));
typedef float f32x4 __attribute__((ext_vector_type(4)));
typedef float f32x2 __attribute__((ext_vector_type(2)));
typedef short bf16x8 __attribute__((ext_vector_type(8)));
#define LDS_WAIT() asm volatile("s_waitcnt lgkmcnt(0)" ::: "memory")
using pg8::cvt_pk_bf16; using pg8::bf_lo; using pg8::bf_hi;
__device__ __forceinline__ bf16x8 as_frag(u32x4 v) { return __builtin_bit_cast(bf16x8, v); }
__device__ __forceinline__ f32x4 mfma16(bf16x8 a, bf16x8 b, f32x4 c) { return __builtin_amdgcn_mfma_f32_16x16x32_bf16(a, b, c, 0, 0, 0); }
__device__ __forceinline__ float wave_sum(float v) {
#pragma unroll
    for (int o = 1; o < 64; o <<= 1) v += __shfl_xor(v, o);
    return v;
}
__device__ __forceinline__ unsigned short f2bf(float f) { return (unsigned short)(cvt_pk_bf16(f, 0.f) & 0xffffu); }

#define XB_TMO      128
#define XB_XCNT(j)  (256  + 64 * (j))
#define XB_XSUB(j)  (1280 + 64 * (j))
#define XB_XGEN(j)  (2304 + 64 * (j))
#define XB_TOP      3328
#define XB_TOPGEN   3392
#define XCD_BAR_WORDS 3456
#define XB_SPIN_CAP (1u << 22)
__device__ __forceinline__ unsigned xb_ld(unsigned* p)              { return __hip_atomic_load(p, __ATOMIC_RELAXED, __HIP_MEMORY_SCOPE_AGENT); }
__device__ __forceinline__ unsigned xb_add(unsigned* p, unsigned v) { return __hip_atomic_fetch_add(p, v, __ATOMIC_RELAXED, __HIP_MEMORY_SCOPE_AGENT); }
__device__ __forceinline__ unsigned xb_xcc_id() { return (unsigned)__builtin_amdgcn_s_getreg((3 << 11) | 20) & 0xFu; }
#define XB_SPIN(cond, bar) do { unsigned _sp = 0; while (cond) { __builtin_amdgcn_s_sleep(1); \
    if ((++_sp & 255u) == 0u) { if (xb_ld(&(bar)[XB_TMO])) break; if (_sp > XB_SPIN_CAP) { atomicAdd(&(bar)[XB_TMO], 1u); break; } } } } while (0)
struct XcdBarrier { unsigned* bar; unsigned x; volatile LAS unsigned* st; };
__device__ __forceinline__ XcdBarrier xcd_barrier_post(unsigned* bar, volatile LAS unsigned* st) {
    XcdBarrier b; b.bar = bar; b.x = xb_xcc_id(); b.st = st;
    if (threadIdx.x == 0) (void)xb_add(&bar[XB_XCNT(b.x)], 1u);
    return b;
}
__device__ __forceinline__ void xcd_barrier_complete(unsigned* bar, unsigned x, unsigned& nloc, unsigned& nx) {
    const unsigned G = gridDim.x * gridDim.y * gridDim.z;
    unsigned sum, cnt, mine, sp = 0u;
    for (;;) {
        sum = 0u; cnt = 0u; mine = 0u;
#pragma unroll
        for (unsigned j = 0; j < 16; ++j) { const unsigned c = xb_ld(&bar[XB_XCNT(j)]); sum += c; cnt += (c > 0u) ? 1u : 0u; mine = (j == x) ? c : mine; }
        if (sum == G) break;
        __builtin_amdgcn_s_sleep(1);
        if ((++sp & 255u) == 0u) { if (xb_ld(&bar[XB_TMO])) break; if (sp > XB_SPIN_CAP) { atomicAdd(&bar[XB_TMO], 1u); break; } }
    }
    nloc = mine > 0u ? mine : 1u; nx = cnt > 0u ? cnt : 1u;
}
__device__ __forceinline__ void xcd_barrier(const XcdBarrier& b) {
    asm volatile("s_waitcnt vmcnt(0)" ::: "memory");
    __syncthreads();
    if (threadIdx.x == 0) {
        unsigned* bar = b.bar;
        __builtin_amdgcn_s_waitcnt(0);
        unsigned nloc = b.st[0], nx = b.st[1];
        if (nloc == 0u) { xcd_barrier_complete(bar, b.x, nloc, nx); b.st[0] = nloc; b.st[1] = nx; }
        const unsigned old = xb_add(&bar[XB_XSUB(b.x)], 1u);
        const unsigned gen = old / nloc;
        if (old + 1u == (gen + 1u) * nloc) {
            __builtin_amdgcn_fence(__ATOMIC_RELEASE, "agent");
            asm volatile("s_waitcnt vmcnt(0)" ::: "memory");
            const unsigned og = xb_add(&bar[XB_TOP], 1u);
            const unsigned tg = og / nx;
            if (og + 1u == (tg + 1u) * nx) xb_add(&bar[XB_TOPGEN], 1u);
            else XB_SPIN(xb_ld(&bar[XB_TOPGEN]) == tg, bar);
            __builtin_amdgcn_fence(__ATOMIC_ACQUIRE, "agent");
            xb_add(&bar[XB_XGEN(b.x)], 1u);
            asm volatile("s_waitcnt vmcnt(0)" ::: "memory");
        } else {
            XB_SPIN(xb_ld(&bar[XB_XGEN(b.x)]) == gen, bar);
            __builtin_amdgcn_fence(__ATOMIC_ACQUIRE, "agent");
            asm volatile("s_waitcnt vmcnt(0)" ::: "memory");
        }
    }
    __syncthreads();
}

struct Frame {
    LAS unsigned char* lds;
    int tid, lane, wave;
    int vcu, G;
    unsigned char* ws;
};
struct Args { const float* in[27]; float* out; unsigned char* ws; int ph_lo, ph_hi; };
__device__ __forceinline__ Frame fresh(const Frame& F0) { Frame F = F0; int t = F0.tid; asm volatile("" : "+v"(t)); F.tid = t; F.lane = t & 63; F.wave = __builtin_amdgcn_readfirstlane(t >> 6); return F; }

__device__ __forceinline__ void transpose_item(const float* W, int K, int N, bf16* WT, int k0, int n0, int drow0, LAS float* scr, int lane) {
#pragma unroll 8
    for (int i = 0; i < 32; ++i) { const int kk = 2 * i + (lane >> 5); scr[kk * 33 + (lane & 31)] = W[(size_t)(k0 + kk) * N + n0 + (lane & 31)]; }
    LDS_WAIT(); asm volatile("" ::: "memory");
    const int c = lane & 7;
#pragma unroll
    for (int j = 0; j < 4; ++j) { const int n = (lane >> 3) + 8 * j; const LAS float* s = scr + (8 * c) * 33 + n;
        u32x4 o; o.x = cvt_pk_bf16(s[0 * 33], s[1 * 33]); o.y = cvt_pk_bf16(s[2 * 33], s[3 * 33]); o.z = cvt_pk_bf16(s[4 * 33], s[5 * 33]); o.w = cvt_pk_bf16(s[6 * 33], s[7 * 33]);
        *(u32x4*)(WT + (size_t)(drow0 + n) * K + k0 + 8 * c) = o; }
    LDS_WAIT(); asm volatile("" ::: "memory");
}
__device__ __forceinline__ void conv_plain(const float* W, int K, int N, bf16* WT, int item, LAS float* scr, int lane) {
    const int nblk = N / 32, kb = item / nblk, nb = item % nblk;
    transpose_item(W, K, N, WT, 64 * kb, 32 * nb, 32 * nb, scr, lane);
}
__device__ __forceinline__ void ph_prologue(Frame& F, const Args& A) {
    LAS float* scr = (LAS float*)(F.lds + F.wave * 16384);
    const int gw = F.vcu * NWAVES + F.wave, NGW = F.G * NWAVES;
    constexpr int I_IN = (2048 / 64) * (IN_COLS / 32), I_GLU = (512 / 64) * (512 / 32), I_BR1 = (512 / 64) * (2048 / 32), I_BR = 4 * I_BR1, I_O = (2048 / 64) * (2048 / 32),
                  I_FF = (2048 / 64) * (2 * D_FF / 32), I_FF2 = (D_FF / 64) * (2048 / 32), I_PG = I_O, I_PP = (256 / 64) * (2048 / 32);
    constexpr int I_LAYER = I_IN + I_GLU + I_BR + I_O + I_FF + I_FF2 + I_PG + I_PP;
    for (int it = gw; it < DEPTH * I_LAYER; it += NGW) {
        const int l = it / I_LAYER; int r = it % I_LAYER;
        unsigned char* wl = F.ws + WS_W + (size_t)l * WL_BYTES;
        if (r < I_IN) {
            const float* W = A.in[5] + (size_t)l * 2048 * IN_COLS; const int nblk = IN_COLS / 32, kb = r / nblk, nb = r % nblk, n0 = 32 * nb;
            if (n0 < MIX_IN) transpose_item(W, 2048, IN_COLS, (bf16*)(wl + WL_MIX), 64 * kb, n0, n0, scr, F.lane);
            else transpose_item(W, 2048, IN_COLS, (bf16*)(wl + WL_G), 64 * kb, n0, n0 - MIX_IN, scr, F.lane);
            continue; } r -= I_IN;
        if (r < I_GLU) { conv_plain(A.in[14] + (size_t)l * 512 * 512, 512, 512, (bf16*)(wl + WL_GLU), r, scr, F.lane); continue; } r -= I_GLU;
        if (r < I_BR) { const int kb = r / I_BR1; conv_plain(A.in[19] + ((size_t)l * 4 + kb) * 512 * 2048, 512, 2048, (bf16*)(wl + WL_BR) + (size_t)kb * 2048 * 512, r % I_BR1, scr, F.lane); continue; } r -= I_BR;
        if (r < I_O) { conv_plain(A.in[20] + (size_t)l * 2048 * 2048, 2048, 2048, (bf16*)(wl + WL_O), r, scr, F.lane); continue; } r -= I_O;
        if (r < I_FF) {
            const float* W = A.in[22] + (size_t)l * 2048 * 2 * D_FF; const int nblk = 2 * D_FF / 32, kb = r / nblk, nb = r % nblk, n0 = 32 * nb;
            const int j = n0 / D_FF, rr = n0 % D_FF, pn = rr / 128, cc = rr % 128;
            transpose_item(W, 2048, 2 * D_FF, (bf16*)(wl + WL_FF), 64 * kb, n0, 256 * pn + 128 * j + cc, scr, F.lane);
            continue; } r -= I_FF;
        if (r < I_FF2) { conv_plain(A.in[23] + (size_t)l * D_FF * 2048, D_FF, 2048, (bf16*)(wl + WL_FF2), r, scr, F.lane); continue; } r -= I_FF2;
        if (r < I_PG) { conv_plain(A.in[25] + (size_t)l * 2048 * 2048, 2048, 2048, (bf16*)(wl + WL_PG), r, scr, F.lane); continue; } r -= I_PG;
        conv_plain(A.in[26] + (size_t)l * 256 * 2048, 256, 2048, (bf16*)(wl + WL_PP), r, scr, F.lane);
    }
    {
        const int gt = F.vcu * 512 + F.tid, NT = F.G * 512;
        bf16* c128 = (bf16*)(F.ws + TAB_C128); bf16* s128 = (bf16*)(F.ws + TAB_S128); bf16* c32 = (bf16*)(F.ws + TAB_C32); bf16* s32 = (bf16*)(F.ws + TAB_S32);
        for (int e = gt; e < 128 * 128 + 32 * 32; e += NT) {
            if (e < 128 * 128) { const int i = e >> 7, k = e & 127, m = (i * k) & 127; float sn, cs; sincospif((float)m * (1.0f / 64.0f), &sn, &cs);
                c128[e] = f2bf(cs * 0.08838834764831845f); s128[e] = f2bf(sn * 0.08838834764831845f); }
            else { const int e2 = e - 128 * 128, i = e2 >> 5, k = e2 & 31, m = (i * k) & 31; float sn, cs; sincospif((float)m * (1.0f / 16.0f), &sn, &cs);
                c32[e2] = f2bf(cs * 0.17677669529663687f); s32[e2] = f2bf(sn * 0.17677669529663687f); }
        }
    }
    for (int t = gw; t < DEPTH * 2 * 32; t += NGW) {
        const int g = t & 31, ld = t >> 5;
        unsigned char* tb = F.ws + TAB_S5 + (size_t)t * S5T_BYTES;
        const float* lam_re = A.in[6] + (size_t)t * 64; const float* lam_im = A.in[7] + (size_t)t * 64;
        const float dt = expf(A.in[8][t]);
        const float* b_re = A.in[9] + (size_t)t * 64 * 16; const float* b_im = A.in[10] + (size_t)t * 64 * 16;
        const float* c_re = A.in[11] + (size_t)t * 16 * 64; const float* c_im = A.in[12] + (size_t)t * 16 * 64;
        (void)g; (void)ld;
        const int lane = F.lane, l15 = lane & 15, g4 = lane >> 4;
        {
            const float lr = lam_re[lane], li = lam_im[lane], mag = expf(lr * dt); float sn, cs; sincosf(li * dt, &sn, &cs);
            f32x2 ab; ab.x = mag * cs; ab.y = mag * sn; ((f32x2*)(tb + S5T_AB))[lane] = ab;
        }
#pragma unroll 1
        for (int cb = 0; cb < 8; ++cb) {
            const int col = 16 * cb + l15, p = col >> 1, ri = col & 1;
            const float lr = lam_re[p], li = lam_im[p], mag = expf(lr * dt); float sn, cs; sincosf(li * dt, &sn, &cs);
            const float ar = mag * cs, ai = mag * sn, den = lr * lr + li * li;
            const float fr = ((ar - 1.0f) * lr + ai * li) / den, fi = (ai * lr - (ar - 1.0f) * li) / den;
            float v[8];
#pragma unroll
            for (int j = 0; j < 8; ++j) { const int h = 8 * g4 + j; float x = 0.f;
                if (h < 16) { const float br = b_re[p * 16 + h], bi = b_im[p * 16 + h]; x = ri ? (fr * bi + fi * br) : (fr * br - fi * bi); }
                v[j] = x; }
            u32x4 o; o.x = cvt_pk_bf16(v[0], v[1]); o.y = cvt_pk_bf16(v[2], v[3]); o.z = cvt_pk_bf16(v[4], v[5]); o.w = cvt_pk_bf16(v[6], v[7]);
            ((u32x4*)(tb + S5T_BB))[cb * 64 + lane] = o;
        }
#pragma unroll 1
        for (int ks = 0; ks < 4; ++ks) {
            float v[8];
#pragma unroll
            for (int j = 0; j < 8; ++j) { const int col = 32 * ks + 8 * g4 + j, p = col >> 1, ri = col & 1; v[j] = ri ? -c_im[l15 * 64 + p] : c_re[l15 * 64 + p]; }
            u32x4 o; o.x = cvt_pk_bf16(v[0], v[1]); o.y = cvt_pk_bf16(v[2], v[3]); o.z = cvt_pk_bf16(v[4], v[5]); o.w = cvt_pk_bf16(v[6], v[7]);
            ((u32x4*)(tb + S5T_C))[ks * 64 + lane] = o;
        }
    }
}

__device__ __forceinline__ void ph_norm(Frame& F, const float* xsrc, const float* gain, bf16* H) {
    const int gw = F.vcu * NWAVES + F.wave, NGW = F.G * NWAVES;
    f32x4 gv[8];
#pragma unroll
    for (int j = 0; j < 8; ++j) gv[j] = ((const f32x4*)gain)[F.lane + 64 * j];
    for (int m = gw; m < CH_TOK; m += NGW) {
        const f32x4* xr = (const f32x4*)(xsrc + (size_t)m * D_MODEL) + F.lane;
        f32x4 v[8]; float s = 0.f;
#pragma unroll
        for (int j = 0; j < 8; ++j) { v[j] = xr[64 * j]; s += (v[j][0] * v[j][0] + v[j][1] * v[j][1]) + (v[j][2] * v[j][2] + v[j][3] * v[j][3]); }
        const float rstd = rsqrtf(wave_sum(s) * (1.0f / D_MODEL) + EPS);
        u32x2* o = (u32x2*)(H + (size_t)m * D_MODEL) + F.lane;
#pragma unroll
        for (int j = 0; j < 8; ++j) { u32x2 w; w.x = cvt_pk_bf16(v[j][0] * rstd * gv[j][0], v[j][1] * rstd * gv[j][1]); w.y = cvt_pk_bf16(v[j][2] * rstd * gv[j][2], v[j][3] * rstd * gv[j][3]); o[64 * j] = w; }
    }
}
__device__ __forceinline__ void ph_pcvt(Frame& F, const float* p, bf16* P16) {
    const int gw = F.vcu * NWAVES + F.wave, NGW = F.G * NWAVES;
    for (int m = gw; m < CH_TOK; m += NGW) {
        const f32x4 v = ((const f32x4*)(p + (size_t)m * PLE_DIM))[F.lane];
        u32x2 w; w.x = cvt_pk_bf16(v[0], v[1]); w.y = cvt_pk_bf16(v[2], v[3]);
        ((u32x2*)(P16 + (size_t)m * PLE_DIM))[F.lane] = w;
    }
}
__device__ __forceinline__ void unpack8(u32x4 w, float (&f)[8]) { f[0] = bf_lo(w.x); f[1] = bf_hi(w.x); f[2] = bf_lo(w.y); f[3] = bf_hi(w.y); f[4] = bf_lo(w.z); f[5] = bf_hi(w.z); f[6] = bf_lo(w.w); f[7] = bf_hi(w.w); }
__device__ __forceinline__ u32x4 pack8(const float (&f)[8]) { u32x4 w; w.x = cvt_pk_bf16(f[0], f[1]); w.y = cvt_pk_bf16(f[2], f[3]); w.z = cvt_pk_bf16(f[4], f[5]); w.w = cvt_pk_bf16(f[6], f[7]); return w; }

__device__ __forceinline__ void conv_block(Frame& F, const bf16* Z, bf16* YS, const float* cw  , int blk, int lseq) {
#pragma unroll 1
    for (int i = 0; i < 8; ++i) {
        const int idx = F.tid + 512 * i, r = blk * 64 + (idx >> 6), c = (idx & 63) * 8, lpos = r % lseq;
        const bf16* zr = Z + (size_t)r * MIX_IN;
        float bg[8], z0[8], acc[8], tmp[8], w[8];
        unpack8(*(const u32x4*)(zr + ZC_BG + c), bg);
        {   float cg[8], vv[8]; unpack8(*(const u32x4*)(zr + ZC_CG + c), cg); unpack8(*(const u32x4*)(zr + ZC_VB + c), vv);
            const f32x4 wa = *(const f32x4*)(cw + 512 + c), wb = *(const f32x4*)(cw + 512 + c + 4);
            w[0] = wa[0]; w[1] = wa[1]; w[2] = wa[2]; w[3] = wa[3]; w[4] = wb[0]; w[5] = wb[1]; w[6] = wb[2]; w[7] = wb[3];
#pragma unroll
            for (int j = 0; j < 8; ++j) { z0[j] = cg[j] * vv[j]; acc[j] = w[j] * z0[j]; } }
        if (lpos > 0) { float cg[8], vv[8]; unpack8(*(const u32x4*)(zr - MIX_IN + ZC_CG + c), cg); unpack8(*(const u32x4*)(zr - MIX_IN + ZC_VB + c), vv);
            const f32x4 wa = *(const f32x4*)(cw + c), wb = *(const f32x4*)(cw + c + 4);
            w[0] = wa[0]; w[1] = wa[1]; w[2] = wa[2]; w[3] = wa[3]; w[4] = wb[0]; w[5] = wb[1]; w[6] = wb[2]; w[7] = wb[3];
#pragma unroll
            for (int j = 0; j < 8; ++j) acc[j] += w[j] * (cg[j] * vv[j]); }
        if (lpos < lseq - 1) { float cg[8], vv[8]; unpack8(*(const u32x4*)(zr + MIX_IN + ZC_CG + c), cg); unpack8(*(const u32x4*)(zr + MIX_IN + ZC_VB + c), vv);
            const f32x4 wa = *(const f32x4*)(cw + 1024 + c), wb = *(const f32x4*)(cw + 1024 + c + 4);
            w[0] = wa[0]; w[1] = wa[1]; w[2] = wa[2]; w[3] = wa[3]; w[4] = wb[0]; w[5] = wb[1]; w[6] = wb[2]; w[7] = wb[3];
#pragma unroll
            for (int j = 0; j < 8; ++j) acc[j] += w[j] * (cg[j] * vv[j]); }
#pragma unroll
        for (int j = 0; j < 8; ++j) tmp[j] = bg[j] * acc[j];
        *(u32x4*)(YS + (size_t)r * D_MODEL + 512 + c) = pack8(tmp);
    }
}
__device__ __forceinline__ void s5fin_block(Frame& F, const bf16* Z, const float* YF, const float* YB, const float* dsk  , bf16* Y1, int blk) {
#pragma unroll 1
    for (int i = 0; i < 8; ++i) {
        const int idx = F.tid + 512 * i, r = blk * 64 + (idx >> 6), c = (idx & 63) * 8;
        float u[8], o[8]; unpack8(*(const u32x4*)(Z + (size_t)r * MIX_IN + ZC_UA + c), u);
        const f32x4 f0 = *(const f32x4*)(YF + (size_t)r * 512 + c), f1 = *(const f32x4*)(YF + (size_t)r * 512 + c + 4);
        const f32x4 b0 = *(const f32x4*)(YB + (size_t)r * 512 + c), b1 = *(const f32x4*)(YB + (size_t)r * 512 + c + 4);
        const f32x4 d0 = *(const f32x4*)(dsk + c), d1 = *(const f32x4*)(dsk + c + 4);
#pragma unroll
        for (int j = 0; j < 8; ++j) { const float yy = (j < 4 ? d0[j & 3] : d1[j & 3]) * u[j] + (j < 4 ? f0[j & 3] : f1[j & 3]) + (j < 4 ? b0[j & 3] : b1[j & 3]);
            const float a = 0.7978845608028654f * (yy + 0.044715f * yy * yy * yy);
            const float th = 1.0f - 2.0f * __builtin_amdgcn_rcpf(1.0f + __expf(2.0f * a));
            o[j] = 0.5f * yy * (1.0f + th); }
        *(u32x4*)(Y1 + (size_t)r * 512 + c) = pack8(o);
    }
}

__device__ __forceinline__ void s5_wave_task(Frame& F, const unsigned char* tb, const bf16* Zs, float* Yout, int ntok, int dir, int g) {
    LAS float* BU = (LAS float*)(F.lds + F.wave * 12288);
    LAS unsigned* XD = (LAS unsigned*)(F.lds + F.wave * 12288 + 8192);
    const int lane = F.lane, l15 = lane & 15, g4 = lane >> 4;
    const f32x2 ab = ((const f32x2*)(tb + S5T_AB))[lane];
    const float ar = ab.x, ai = ab.y;
    bf16x8 bbf[8], cf[4];
#pragma unroll
    for (int cb = 0; cb < 8; ++cb) bbf[cb] = as_frag(((const u32x4*)(tb + S5T_BB))[cb * 64 + lane]);
#pragma unroll
    for (int ks = 0; ks < 4; ++ks) cf[ks] = as_frag(((const u32x4*)(tb + S5T_C))[ks * 64 + lane]);
    float xr = 0.f, xi = 0.f;
    const int ntile = ntok >> 4;
    const bf16* zcol = Zs + ZC_UA + g * 16 + 8 * (g4 & 1);
    u32x4 ucur = (u32x4){0u, 0u, 0u, 0u};
    { const int tile = dir ? ntile - 1 : 0; if (g4 < 2) ucur = *(const u32x4*)(zcol + (size_t)(tile * 16 + l15) * MIX_IN); }
#pragma unroll 1
    for (int it = 0; it < ntile; ++it) {
        const int tile = dir ? ntile - 1 - it : it;
        u32x4 unext = (u32x4){0u, 0u, 0u, 0u};
        if (it + 1 < ntile && g4 < 2) { const int tn = dir ? tile - 1 : tile + 1; unext = *(const u32x4*)(zcol + (size_t)(tn * 16 + l15) * MIX_IN); }
        const bf16x8 uf = as_frag(ucur);
#pragma unroll
        for (int cb = 0; cb < 8; ++cb) {
            const f32x4 a = mfma16(uf, bbf[cb], (f32x4){0.f, 0.f, 0.f, 0.f});
#pragma unroll
            for (int q = 0; q < 4; ++q) BU[(4 * g4 + q) * 128 + 16 * cb + l15] = a[q];
        }
        LDS_WAIT();
        f32x2 bv[16];
#pragma unroll
        for (int s = 0; s < 16; ++s) { const int t = dir ? 15 - s : s; bv[s] = *(const LAS f32x2*)(BU + t * 128 + 2 * lane); }
#pragma unroll
        for (int s = 0; s < 16; ++s) {
            const int t = dir ? 15 - s : s;
            const float nr = ar * xr - ai * xi + bv[s].x, ni = ar * xi + ai * xr + bv[s].y;
            xr = nr; xi = ni;
            XD[t * 64 + lane] = cvt_pk_bf16(xr, xi);
        }
        LDS_WAIT();
        f32x4 y = (f32x4){0.f, 0.f, 0.f, 0.f};
#pragma unroll
        for (int ks = 0; ks < 4; ++ks) y = mfma16(as_frag(*(const LAS u32x4*)(XD + l15 * 64 + 16 * ks + 4 * g4)), cf[ks], y);
        float* yo = Yout + (size_t)(tile * 16 + 4 * g4) * 512 + g * 16 + l15;
#pragma unroll
        for (int q = 0; q < 4; ++q) yo[(size_t)q * 512] = y[q];
        LDS_WAIT();
        ucur = unext;
    }
}

constexpr int NA_KL = 0, NA_VT = 73728, NA_BIAS = 147456;
constexpr int NA_RR = 16;
__device__ __forceinline__ void na_task(Frame& F, const bf16* Zs  , bf16* YSs  , int rows, int h, int r0,
                                        const float* qg, const float* kg, const float* relb  ) {
    LAS unsigned* KL = (LAS unsigned*)(F.lds + NA_KL); LAS unsigned* VT = (LAS unsigned*)(F.lds + NA_VT); LAS unsigned short* VT16 = (LAS unsigned short*)(F.lds + NA_VT);
    LAS float* BIAS = (LAS float*)(F.lds + NA_BIAS);
    const int tid = F.tid, lane = F.lane, l15 = lane & 15, g4 = lane >> 4;
    __syncthreads();
    for (int i = tid; i < 15 * 31; i += 512) BIAS[i] = relb[i];
    const int scol = tid >> 3, schunk = tid & 7;
    float kgv[8];
    { const f32x4 a = *(const f32x4*)(kg + 8 * schunk), b = *(const f32x4*)(kg + 8 * schunk + 4); kgv[0] = a[0]; kgv[1] = a[1]; kgv[2] = a[2]; kgv[3] = a[3]; kgv[4] = b[0]; kgv[5] = b[1]; kgv[6] = b[2]; kgv[7] = b[3]; }
    int rs0 = r0 - 4; rs0 = rs0 < 0 ? 0 : (rs0 > rows - 8 ? rows - 8 : rs0);
    int nextrow = rs0;
#pragma unroll 1
    for (int r = r0; r < r0 + NA_RR; ++r) {
        int rs = r - 4; rs = rs < 0 ? 0 : (rs > rows - 8 ? rows - 8 : rs);
        __syncthreads();
#pragma unroll 1
        for (int rho = nextrow; rho <= rs + 7; ++rho) {
            const bf16* zt = Zs + (size_t)(rho * 64 + scol) * MIX_IN + h * 64 + 8 * schunk;
            const u32x4 kraw = *(const u32x4*)(zt + ZC_K), vraw = *(const u32x4*)(zt + ZC_VC);
            float kf[8]; unpack8(kraw, kf);
            float ss = 0.f;
#pragma unroll
            for (int j = 0; j < 8; ++j) ss += kf[j] * kf[j];
            ss += __shfl_xor(ss, 1); ss += __shfl_xor(ss, 2); ss += __shfl_xor(ss, 4);
            const float rk = rsqrtf(ss * (1.0f / 64.0f) + EPS);
#pragma unroll
            for (int j = 0; j < 8; ++j) kf[j] = kf[j] * rk * kgv[j];
            const int slot = rho & 7;
            *(LAS u32x4*)(KL + (slot * 64 + scol) * 36 + schunk * 4) = pack8(kf);
            const unsigned vw[4] = {vraw.x, vraw.y, vraw.z, vraw.w};
#pragma unroll
            for (int j = 0; j < 8; ++j) VT16[(slot * 64 + 8 * schunk + j) * 72 + scol] = (unsigned short)((j & 1) ? (vw[j >> 1] >> 16) : (vw[j >> 1] & 0xffffu));
        }
        nextrow = rs + 8;
        __syncthreads();
        if (F.wave < 4) {
            const int jb = F.wave, qc = 16 * jb + l15;
            int kc0 = 16 * jb - 8; kc0 = kc0 < 0 ? 0 : (kc0 > 32 ? 32 : kc0);
            int cs = qc - 8; cs = cs < 0 ? 0 : (cs > 48 ? 48 : cs);
            bf16x8 qf[2];
            {
                const bf16* zq = Zs + (size_t)(r * 64 + qc) * MIX_IN + ZC_Q + h * 64 + 8 * g4;
                float q0[8], q1[8]; unpack8(*(const u32x4*)zq, q0); unpack8(*(const u32x4*)(zq + 32), q1);
                float ss = 0.f;
#pragma unroll
                for (int j = 0; j < 8; ++j) ss += q0[j] * q0[j] + q1[j] * q1[j];
                ss += __shfl_xor(ss, 16); ss += __shfl_xor(ss, 32);
                const float rq = rsqrtf(ss * (1.0f / 64.0f) + EPS) * 0.125f;
                const f32x4 ga = *(const f32x4*)(qg + 8 * g4), gb = *(const f32x4*)(qg + 8 * g4 + 4), gc = *(const f32x4*)(qg + 32 + 8 * g4), gd = *(const f32x4*)(qg + 32 + 8 * g4 + 4);
#pragma unroll
                for (int j = 0; j < 4; ++j) { q0[j] *= rq * ga[j]; q0[4 + j] *= rq * gb[j]; q1[j] *= rq * gc[j]; q1[4 + j] *= rq * gd[j]; }
                qf[0] = as_frag(pack8(q0)); qf[1] = as_frag(pack8(q1));
            }
            f32x4 S[8][2];
#pragma unroll
            for (int a = 0; a < 8; ++a) {
                const int slot = (rs + a) & 7;
#pragma unroll
                for (int kb2 = 0; kb2 < 2; ++kb2) {
                    const LAS unsigned* kp = KL + (slot * 64 + kc0 + 16 * kb2 + l15) * 36 + 4 * g4;
                    f32x4 acc = mfma16(as_frag(*(const LAS u32x4*)kp), qf[0], (f32x4){0.f, 0.f, 0.f, 0.f});
                    S[a][kb2] = mfma16(as_frag(*(const LAS u32x4*)(kp + 16)), qf[1], acc);
                }
            }
            float mx = -3.0e38f;
#pragma unroll
            for (int a = 0; a < 8; ++a) {
                const int dr = rs + a - r + 7;
#pragma unroll
                for (int kb2 = 0; kb2 < 2; ++kb2)
#pragma unroll
                    for (int q = 0; q < 4; ++q) {
                        const int kc = kc0 + 16 * kb2 + 4 * g4 + q; const bool valid = (kc >= cs) && (kc < cs + 16);
                        int dc = kc - qc + 15; dc = dc < 0 ? 0 : (dc > 30 ? 30 : dc);
                        const float s = valid ? S[a][kb2][q] + BIAS[dr * 31 + dc] : -1.0e30f;
                        S[a][kb2][q] = s; mx = fmaxf(mx, s);
                    }
            }
            mx = fmaxf(mx, __shfl_xor(mx, 16)); mx = fmaxf(mx, __shfl_xor(mx, 32));
            float sum = 0.f;
#pragma unroll
            for (int a = 0; a < 8; ++a)
#pragma unroll
                for (int kb2 = 0; kb2 < 2; ++kb2)
#pragma unroll
                    for (int q = 0; q < 4; ++q) { const float p = __expf(S[a][kb2][q] - mx); S[a][kb2][q] = p; sum += p; }
            sum += __shfl_xor(sum, 16); sum += __shfl_xor(sum, 32);
            const float rinv = 1.0f / sum;
            f32x4 O[4];
#pragma unroll
            for (int dt = 0; dt < 4; ++dt) O[dt] = (f32x4){0.f, 0.f, 0.f, 0.f};
#pragma unroll
            for (int a = 0; a < 8; ++a) {
                const int slot = (rs + a) & 7;
                u32x4 pw; pw.x = cvt_pk_bf16(S[a][0][0], S[a][0][1]); pw.y = cvt_pk_bf16(S[a][0][2], S[a][0][3]); pw.z = cvt_pk_bf16(S[a][1][0], S[a][1][1]); pw.w = cvt_pk_bf16(S[a][1][2], S[a][1][3]);
                const bf16x8 pf = as_frag(pw);
#pragma unroll
                for (int dt = 0; dt < 4; ++dt) {
                    const LAS unsigned* vp = VT + (slot * 64 + 16 * dt + l15) * 36 + (kc0 >> 1) + 2 * g4;
                    const u32x2 v0 = *(const LAS u32x2*)vp, v1 = *(const LAS u32x2*)(vp + 8);
                    u32x4 vw; vw.x = v0.x; vw.y = v0.y; vw.z = v1.x; vw.w = v1.y;
                    O[dt] = mfma16(as_frag(vw), pf, O[dt]);
                }
            }
            bf16* yo = YSs + (size_t)(r * 64 + qc) * D_MODEL + 1024 + h * 64 + 4 * g4;
#pragma unroll
            for (int dt = 0; dt < 4; ++dt) { u32x2 w; w.x = cvt_pk_bf16(O[dt][0] * rinv, O[dt][1] * rinv); w.y = cvt_pk_bf16(O[dt][2] * rinv, O[dt][3] * rinv); *(u32x2*)(yo + 16 * dt) = w; }
        }
    }
}


#if defined(MK_PROBE)
#define PRB_FLAGS(F) ((unsigned*)((F).ws + WS_CTL + 512 * 1024))
__device__ __forceinline__ bool prb_big_bf(u32x4 w, unsigned ethr) { const unsigned v[4] = {w.x, w.y, w.z, w.w}; bool b = false;
#pragma unroll
    for (int i = 0; i < 4; ++i) b = b || (((v[i] >> 7) & 0xffu) >= ethr) || (((v[i] >> 23) & 0xffu) >= ethr); return b; }
__device__ __forceinline__ bool prb_big_f(f32x4 a, unsigned ethr) { bool b = false;
#pragma unroll
    for (int i = 0; i < 4; ++i) b = b || (((__float_as_uint(a[i]) >> 23) & 0xffu) >= ethr); return b; }
#define PRB(cond, bit) do { if (cond) atomicOr(PRB_FLAGS(F), 1u << (bit)); } while (0)
#else
#define PRB(cond, bit) do { } while (0)
#endif
constexpr int FN_XT = 0, FN_YR = 34816, FN_YI = 34816 + 34816;
template <int N1>
__device__ __forceinline__ void fnet1_tile(Frame& F, const bf16* Zs, bf16* ZFsg  , int g, int l2, const bf16* CT1, const bf16* ST1  , const bf16* C128, const bf16* S128) {
    constexpr int XS = N1 + 8, JT = N1 / 16, KS1 = N1 / 32;
    LAS unsigned short* XT = (LAS unsigned short*)(F.lds + FN_XT); LAS unsigned short* YR = (LAS unsigned short*)(F.lds + FN_YR); LAS unsigned short* YI = (LAS unsigned short*)(F.lds + FN_YI);
    const int tid = F.tid, lane = F.lane, l15 = lane & 15, g4 = lane >> 4, w = F.wave;
    __syncthreads();
    for (int idx = tid; idx < N1 * 16; idx += 512) {
        const int l1 = idx >> 4, ch = idx & 15;
        const u32x4 raw = *(const u32x4*)(Zs + (size_t)(128 * l1 + l2) * MIX_IN + ZC_UD + g * 128 + 8 * ch);
        const unsigned rw[4] = {raw.x, raw.y, raw.z, raw.w};
#pragma unroll
        for (int j = 0; j < 8; ++j) XT[(8 * ch + j) * XS + l1] = (unsigned short)((j & 1) ? (rw[j >> 1] >> 16) : (rw[j >> 1] & 0xffffu));
    }
    __syncthreads();
    {
        bf16x8 af[KS1];
#pragma unroll
        for (int ks = 0; ks < KS1; ++ks) { af[ks] = as_frag(*(const LAS u32x4*)(XT + (16 * w + l15) * XS + 32 * ks + 8 * g4)); }
#pragma unroll 1
        for (int tj = 0; tj < JT; ++tj) {
            const int k1 = 16 * tj + l15;
            f32x4 ar = (f32x4){0.f, 0.f, 0.f, 0.f}, as = (f32x4){0.f, 0.f, 0.f, 0.f};
#pragma unroll
            for (int ks = 0; ks < KS1; ++ks) {
                ar = mfma16(af[ks], as_frag(*(const u32x4*)(CT1 + k1 * N1 + 32 * ks + 8 * g4)), ar);
                as = mfma16(af[ks], as_frag(*(const u32x4*)(ST1 + k1 * N1 + 32 * ks + 8 * g4)), as);
            }
            float tsn, tcs; sincospif((float)(k1 * l2) * (2.0f / (float)(N1 * 128)), &tsn, &tcs);
            float zr[4], zi[4];
#pragma unroll
            for (int q = 0; q < 4; ++q) { const float yr = ar[q], yi = -as[q]; zr[q] = yr * tcs + yi * tsn; zi[q] = yi * tcs - yr * tsn; }
            u32x2 wr2, wi2; wr2.x = cvt_pk_bf16(zr[0], zr[1]); wr2.y = cvt_pk_bf16(zr[2], zr[3]); wi2.x = cvt_pk_bf16(zi[0], zi[1]); wi2.y = cvt_pk_bf16(zi[2], zi[3]);
            *(LAS u32x2*)(YR + k1 * 136 + 16 * w + 4 * g4) = wr2; *(LAS u32x2*)(YI + k1 * 136 + 16 * w + 4 * g4) = wi2;
        }
    }
    __syncthreads();
    {
        bf16x8 cfr[4], sfr[4];
#pragma unroll
        for (int ks = 0; ks < 4; ++ks) { cfr[ks] = as_frag(*(const u32x4*)(C128 + (16 * w + l15) * 128 + 32 * ks + 8 * g4)); sfr[ks] = as_frag(*(const u32x4*)(S128 + (16 * w + l15) * 128 + 32 * ks + 8 * g4)); }
#pragma unroll 1
        for (int tj = 0; tj < JT; ++tj) {
            const int k1 = 16 * tj + l15;
            f32x4 zr = (f32x4){0.f, 0.f, 0.f, 0.f}, zi = (f32x4){0.f, 0.f, 0.f, 0.f};
#pragma unroll
            for (int ks = 0; ks < 4; ++ks) {
                const u32x4 yr = *(const LAS u32x4*)(YR + k1 * 136 + 32 * ks + 8 * g4), yi = *(const LAS u32x4*)(YI + k1 * 136 + 32 * ks + 8 * g4);
                u32x4 ny; ny.x = yr.x ^ 0x80008000u; ny.y = yr.y ^ 0x80008000u; ny.z = yr.z ^ 0x80008000u; ny.w = yr.w ^ 0x80008000u;
                zr = mfma16(cfr[ks], as_frag(yr), zr); zr = mfma16(sfr[ks], as_frag(yi), zr);
                zi = mfma16(cfr[ks], as_frag(yi), zi); zi = mfma16(sfr[ks], as_frag(ny), zi);
            }
            bf16* zo = ZFsg + ((size_t)k1 * 128 + l2) * 256 + 16 * w + 4 * g4;
            u32x2 a, b; a.x = cvt_pk_bf16(zr[0], zr[1]); a.y = cvt_pk_bf16(zr[2], zr[3]); b.x = cvt_pk_bf16(zi[0], zi[1]); b.y = cvt_pk_bf16(zi[2], zi[3]);
            *(u32x2*)zo = a; *(u32x2*)(zo + 128) = b;
        }
    }
}
__device__ __forceinline__ void fnet2_tile(Frame& F, const bf16* ZFsg, bf16* YSs  , int g, int k1, int N1, const bf16* C128, const bf16* S128) {
    LAS unsigned short* ZT = (LAS unsigned short*)F.lds;
    const int tid = F.tid, lane = F.lane, l15 = lane & 15, g4 = lane >> 4, w = F.wave;
    __syncthreads();
    const bf16* src = ZFsg + (size_t)k1 * 128 * 256;
#pragma unroll 1
    for (int idx = tid; idx < 4096; idx += 512) {
        const int l2 = idx >> 5, ch = idx & 31;
        const u32x4 raw = *(const u32x4*)(src + (size_t)l2 * 256 + 8 * ch);
        const unsigned rw[4] = {raw.x, raw.y, raw.z, raw.w};
#pragma unroll
        for (int j = 0; j < 8; ++j) ZT[(8 * ch + j) * 136 + l2] = (unsigned short)((j & 1) ? (rw[j >> 1] >> 16) : (rw[j >> 1] & 0xffffu));
    }
    __syncthreads();
    bf16x8 zrf[4], zif[4];
#pragma unroll
    for (int ks = 0; ks < 4; ++ks) { zrf[ks] = as_frag(*(const LAS u32x4*)(ZT + (16 * w + l15) * 136 + 32 * ks + 8 * g4)); zif[ks] = as_frag(*(const LAS u32x4*)(ZT + (128 + 16 * w + l15) * 136 + 32 * ks + 8 * g4)); }
#pragma unroll 1
    for (int tj = 0; tj < 8; ++tj) {
        const int k2 = 16 * tj + l15;
        f32x4 y = (f32x4){0.f, 0.f, 0.f, 0.f};
#pragma unroll
        for (int ks = 0; ks < 4; ++ks) {
            y = mfma16(zrf[ks], as_frag(*(const u32x4*)(C128 + k2 * 128 + 32 * ks + 8 * g4)), y);
            y = mfma16(zif[ks], as_frag(*(const u32x4*)(S128 + k2 * 128 + 32 * ks + 8 * g4)), y);
        }
        u32x2 o; o.x = cvt_pk_bf16(y[0], y[1]); o.y = cvt_pk_bf16(y[2], y[3]);
        *(u32x2*)(YSs + (size_t)(k1 + N1 * k2) * D_MODEL + 1536 + g * 128 + 16 * w + 4 * g4) = o;
    }
}

struct ChunkGeo { int nseq, lseq, rows, n1; };
__device__ __forceinline__ ChunkGeo chunk_geo(int ch) { ChunkGeo g; if (ch < 2) { g.nseq = 1; g.lseq = 16384; g.rows = 256; g.n1 = 128; } else { g.nseq = 4; g.lseq = 4096; g.rows = 64; g.n1 = 32; } return g; }

__device__ __forceinline__ void ph_mix1(Frame& F, const Args& A, int layer, int ch) {
    const ChunkGeo cg = chunk_geo(ch);
    const bf16* Z = (const bf16*)(F.ws + WS_Z); bf16* YS = (bf16*)(F.ws + WS_YS); bf16* ZF = (bf16*)(F.ws + WS_ZF);
    float* YF = (float*)(F.ws + WS_YF); float* YB = (float*)(F.ws + WS_YB);
    const int ns5task = cg.nseq * 64, ns5wg = ns5task / 8;
    if (F.vcu < ns5wg) {
        const int tt = F.vcu * 8 + F.wave, seq = tt >> 6, dir = (tt >> 5) & 1, g = tt & 31;
        const unsigned char* tb = F.ws + TAB_S5 + (size_t)(((layer * 2 + dir) * 32) + g) * S5T_BYTES;
        const size_t row0 = (size_t)seq * cg.lseq;
        s5_wave_task(F, tb, Z + row0 * MIX_IN, (dir ? YB : YF) + row0 * 512, cg.lseq, dir, g);
        return;
    }
    const int v = F.vcu - ns5wg, nw = F.G - ns5wg;
    const int n_na = cg.nseq * 8 * (cg.rows / NA_RR);
    const int n_f1 = 512;
    const int n_cv = CH_TOK / 64;
    const bf16* C128 = (const bf16*)(F.ws + TAB_C128); const bf16* S128 = (const bf16*)(F.ws + TAB_S128); const bf16* C32 = (const bf16*)(F.ws + TAB_C32); const bf16* S32 = (const bf16*)(F.ws + TAB_S32);
#pragma unroll 1
    for (int t = v; t < n_na + n_f1 + n_cv; t += nw) {
        if (t < n_na) {
            const int runs = cg.rows / NA_RR, run = t % runs, h = (t / runs) & 7, seq = t / (runs * 8);
            const size_t row0 = (size_t)seq * cg.lseq;
            na_task(F, Z + row0 * MIX_IN, YS + row0 * D_MODEL, cg.rows, h, run * NA_RR, A.in[16] + layer * 64, A.in[17] + layer * 64, A.in[18] + ((size_t)layer * 8 + h) * 15 * 31);
        } else if (t < n_na + n_f1) {
            const int u = t - n_na;
            if (ch < 2) { const int g = u >> 7, l2 = u & 127;
                fnet1_tile<128>(F, Z, ZF + (size_t)g * 16384 * 256, g, l2, C128, S128, C128, S128);
            } else {
#pragma unroll 1
                for (int s = 0; s < 4; ++s) { const int uu = u * 4 + s, l2 = uu & 127, g = (uu >> 7) & 3, seq = uu >> 9;
                    fnet1_tile<32>(F, Z + (size_t)seq * 4096 * MIX_IN, ZF + (size_t)(seq * 4 + g) * 4096 * 256, g, l2, C32, S32, C128, S128); }
            }
        } else {
            conv_block(F, Z, YS, A.in[15] + (size_t)layer * 3 * 512, t - n_na - n_f1, cg.lseq);
        }
    }
}
__device__ __forceinline__ void ph_mix2(Frame& F, const Args& A, int layer, int ch) {
    const ChunkGeo cg = chunk_geo(ch);
    const bf16* Z = (const bf16*)(F.ws + WS_Z); bf16* YS = (bf16*)(F.ws + WS_YS); const bf16* ZF = (const bf16*)(F.ws + WS_ZF);
    const float* YF = (const float*)(F.ws + WS_YF); const float* YB = (const float*)(F.ws + WS_YB); bf16* Y1 = (bf16*)(F.ws + WS_Y1);
    const bf16* C128 = (const bf16*)(F.ws + TAB_C128); const bf16* S128 = (const bf16*)(F.ws + TAB_S128);
    const int n_f2 = 512, n_fin = CH_TOK / 64;
#pragma unroll 1
    for (int t = F.vcu; t < n_f2 + n_fin; t += F.G) {
        if (t < n_f2) {
            int seq, g, k1; if (ch < 2) { seq = 0; g = t >> 7; k1 = t & 127; } else { k1 = t & 31; g = (t >> 5) & 3; seq = t >> 7; }
            fnet2_tile(F, ZF + (size_t)(seq * 4 + g) * cg.lseq * 256, YS + (size_t)seq * cg.lseq * D_MODEL, g, k1, cg.n1, C128, S128);
        } else {
            s5fin_block(F, Z, YF, YB, A.in[13] + (size_t)layer * 512, Y1, t - n_f2);
        }
    }
}

constexpr int PH_PER_LC = 14, N_PHASES = 1 + 6 * PH_PER_LC;
__global__ void __launch_bounds__(NWAVES * 64, 2) fwd_kernel(const Args A) {
    extern __shared__ __attribute__((aligned(16))) unsigned char lds_raw[];
    Frame F;
    F.lds = (LAS unsigned char*)lds_raw;
    F.tid = threadIdx.x; F.lane = F.tid & 63; F.wave = __builtin_amdgcn_readfirstlane(F.tid >> 6);
    F.G = gridDim.x; { const int bx = blockIdx.x; F.vcu = (F.G % 8 == 0) ? (bx % 8) * (F.G / 8) + bx / 8 : bx; }
    F.ws = A.ws;
    volatile LAS unsigned* LCTL = (volatile LAS unsigned*)(F.lds + LDSCTL_OFF);
    if (F.tid < 64) LCTL[F.tid] = 0u;
    __syncthreads();
    const int lo = A.ph_lo, hi = A.ph_hi;
    const bool multi = (hi - lo) > 1;
    XcdBarrier bar; bar.bar = (unsigned*)(F.ws + WS_CTL) + CW_BAR; bar.x = 0; bar.st = LCTL;
    if (multi) bar = xcd_barrier_post((unsigned*)(F.ws + WS_CTL) + CW_BAR, LCTL);
#define IN(k) (lo <= (k) && (k) < hi)
#define SEAM(k) do { if ((k) + 1 < hi) xcd_barrier(bar); } while (0)

    if (IN(0)) { Frame Fp = fresh(F); ph_prologue(Fp, A); SEAM(0); }

#pragma unroll 1
    for (int lc = 0; lc < 6; ++lc) {
        const int layer = lc / 3, ch = lc % 3, pb = 1 + lc * PH_PER_LC;
        if (pb + PH_PER_LC <= lo || pb >= hi) continue;
        const unsigned char* wl = F.ws + WS_W + (size_t)layer * WL_BYTES;
        const float* x_in = (ch < 2) ? A.in[0] + (size_t)ch * CH_TOK * D_MODEL : A.in[1];
        float* x_out = A.out + (size_t)ch * CH_TOK * D_MODEL;
        const float* x_cur = layer == 0 ? x_in : x_out;
        const float* p_in = (ch < 2) ? A.in[2] + ((size_t)layer * 32768 + (size_t)ch * CH_TOK) * PLE_DIM : A.in[3] + (size_t)layer * CH_TOK * PLE_DIM;
        bf16* H = (bf16*)(F.ws + WS_H); bf16* Z = (bf16*)(F.ws + WS_Z); bf16* YS = (bf16*)(F.ws + WS_YS); bf16* MG = (bf16*)(F.ws + WS_MG); bf16* GT = (bf16*)(F.ws + WS_GT);
        bf16* Y1 = (bf16*)(F.ws + WS_Y1); bf16* P16 = (bf16*)(F.ws + WS_P16); bf16* PP = (bf16*)(F.ws + WS_YS); bf16* MID = (bf16*)(F.ws + WS_GT); float* MACC = (float*)(F.ws + WS_Z);

        if (IN(pb + 0)) { Frame Fp = fresh(F); ph_norm(Fp, x_cur, A.in[4] + (size_t)layer * D_MODEL, H); SEAM(pb + 0); }
        if (IN(pb + 1)) {
            pg8::Gemm g{H, (const bf16*)(wl + WL_MIX), D_MODEL, D_MODEL, D_MODEL, 0, 0}; pg8::StaticOrder S; S.init(CH_TOK, MIX_IN, F.G, (int)blockIdx.x);
            pg8::EpiStoreBf16 E{Z, MIX_IN};
            pg8::gemm_phase<pg8::EpiStoreBf16, pg8::StaticOrder, true, true>(F.lds, g, S, E);
            SEAM(pb + 1); }
        if (IN(pb + 2)) { Frame Fp = fresh(F); ph_mix1(Fp, A, layer, ch); SEAM(pb + 2); }
        if (IN(pb + 3)) { Frame Fp = fresh(F); ph_mix2(Fp, A, layer, ch); SEAM(pb + 3); }
        if (IN(pb + 4)) {
            pg8::Gemm g{Y1, (const bf16*)(wl + WL_GLU), 512, 512, 512, 0, 0}; pg8::StaticOrder S; S.init(CH_TOK, 512, F.G, (int)blockIdx.x);
            pg8::EpiGlu E{Y1, 512, YS, D_MODEL};
            pg8::gemm_phase<pg8::EpiGlu, pg8::StaticOrder, true, true>(F.lds, g, S, E);
            SEAM(pb + 4); }
        if (IN(pb + 5)) {
            pg8::Gemm g{YS, (const bf16*)(wl + WL_BR), D_MODEL, 512, 512, 3, 512}; pg8::StaticOrder S; S.init(CH_TOK, 8192, F.G, (int)blockIdx.x);
            pg8::EpiStoreBf16 E{GT, 8192};
            pg8::gemm_phase<pg8::EpiStoreBf16, pg8::StaticOrder, true, true>(F.lds, g, S, E);
            SEAM(pb + 5); }
        if (IN(pb + 6)) {
            pg8::Gemm g{H, (const bf16*)(wl + WL_G), D_MODEL, D_MODEL, D_MODEL, 0, 0}; pg8::MergeOrder S; S.init(CH_TOK, F.G, (int)blockIdx.x);
            pg8::EpiMerge E{GT, MACC, MG};
            pg8::gemm_phase<pg8::EpiMerge, pg8::MergeOrder, true, true>(F.lds, g, S, E);
            SEAM(pb + 6); }
        if (IN(pb + 7)) {
            pg8::Gemm g{MG, (const bf16*)(wl + WL_O), D_MODEL, D_MODEL, D_MODEL, 0, 0}; pg8::StaticOrder S; S.init(CH_TOK, D_MODEL, F.G, (int)blockIdx.x);
            pg8::EpiResF32 E{x_cur, x_out, D_MODEL};
            pg8::gemm_phase<pg8::EpiResF32, pg8::StaticOrder, true, true>(F.lds, g, S, E);
            SEAM(pb + 7); }
        if (IN(pb + 8)) { Frame Fp = fresh(F); ph_norm(Fp, x_out, A.in[21] + (size_t)layer * D_MODEL, H); SEAM(pb + 8); }
        if (IN(pb + 9)) {
            pg8::Gemm g{H, (const bf16*)(wl + WL_FF), D_MODEL, D_MODEL, D_MODEL, 0, 0}; pg8::StaticOrder S; S.init(CH_TOK, 2 * D_FF, F.G, (int)blockIdx.x);
            pg8::EpiSwiglu E{MID, D_FF};
            pg8::gemm_phase<pg8::EpiSwiglu, pg8::StaticOrder, true, true>(F.lds, g, S, E);
            SEAM(pb + 9); }
        if (IN(pb + 10)) {
            pg8::Gemm g{MID, (const bf16*)(wl + WL_FF2), D_FF, D_FF, D_FF, 0, 0}; pg8::StaticOrder S; S.init(CH_TOK, D_MODEL, F.G, (int)blockIdx.x);
            pg8::EpiResF32 E{x_out, x_out, D_MODEL};
            pg8::gemm_phase<pg8::EpiResF32, pg8::StaticOrder, true, true>(F.lds, g, S, E);
            SEAM(pb + 10); }
        if (IN(pb + 11)) { Frame Fp = fresh(F); ph_norm(Fp, x_out, A.in[24] + (size_t)layer * D_MODEL, H); ph_pcvt(Fp, p_in, P16); SEAM(pb + 11); }
        if (IN(pb + 12)) {
            pg8::Gemm g{P16, (const bf16*)(wl + WL_PP), PLE_DIM, PLE_DIM, PLE_DIM, 0, 0}; pg8::StaticOrder S; S.init(CH_TOK, D_MODEL, F.G, (int)blockIdx.x);
            pg8::EpiStoreBf16 E{PP, D_MODEL};
            pg8::gemm_phase<pg8::EpiStoreBf16, pg8::StaticOrder, true, true>(F.lds, g, S, E);
            SEAM(pb + 12); }
        if (IN(pb + 13)) {
            pg8::Gemm g{H, (const bf16*)(wl + WL_PG), D_MODEL, D_MODEL, D_MODEL, 0, 0}; pg8::StaticOrder S; S.init(CH_TOK, D_MODEL, F.G, (int)blockIdx.x);
            pg8::EpiPle E{x_out, x_out, D_MODEL, PP, D_MODEL};
            pg8::gemm_phase<pg8::EpiPle, pg8::StaticOrder, true, true>(F.lds, g, S, E);
            SEAM(pb + 13); }
    }
#undef IN
#undef SEAM
}


#if defined(MK_PROBE)
__global__ void probe_scan(const unsigned* p, size_t nwords, int is_f32, unsigned bit, unsigned* flags, unsigned ethr  ) {
    unsigned bad = 0;
    for (size_t i = (size_t)blockIdx.x * blockDim.x + threadIdx.x; i < nwords; i += (size_t)gridDim.x * blockDim.x) {
        const unsigned w = p[i];
        if (is_f32) { const unsigned e = (w >> 23) & 0xffu; if (e >= ethr) bad = 1; }
        else { const unsigned e0 = (w >> 7) & 0xffu, e1 = (w >> 23) & 0xffu; if (e0 >= ethr || e1 >= ethr) bad = 1; }
    }
    if (bad) atomicOr(flags, 1u << bit);
}
__global__ void probe_s5tab(const unsigned char* tab, unsigned bit, unsigned* flags) {
    const int t = blockIdx.x, lane = threadIdx.x;
    const float* ab = (const float*)(tab + (size_t)t * S5T_BYTES + S5T_AB);
    const float ar = ab[2 * lane], ai = ab[2 * lane + 1];
    if (!(ar * ar + ai * ai < 1.0f)) atomicOr(flags, 1u << bit);
}
__global__ void probe_init(unsigned* flags) { if (threadIdx.x == 0 && blockIdx.x == 0) *flags = 0u; }
__global__ void probe_emit(float* out, size_t n, const unsigned* flags) {
    const float k = (float)(*flags);
    const float c = 1000.0f * exp10f(k * (1.0f / 16.0f));
    for (size_t i = (size_t)blockIdx.x * blockDim.x + threadIdx.x; i < n; i += (size_t)gridDim.x * blockDim.x) out[i] = c;
}
static void probe_buf(hipStream_t st, const void* p, size_t bytes, int is_f32, int bit, unsigned* fb, int log2thr) {
    hipLaunchKernelGGL(probe_scan, dim3(1024), dim3(256), 0, st, (const unsigned*)p, bytes / 4, is_f32, (unsigned)bit, fb, (unsigned)(127 + log2thr));
}
#endif
#ifndef MK_PER_PHASE
#define MK_PER_PHASE 1
#endif
extern "C" void kernel_launch(void* const* d_in, const int* in_sizes, int n_in, void* d_out, int out_size, void* d_ws, size_t ws_size, hipStream_t stream) {
    static int grid = 0;
    if (grid == 0) {
        if (n_in != 27 || out_size != NTOK * D_MODEL || ws_size < WS_END) { fprintf(stderr, "kernel_launch: unexpected shapes (n_in %d, out %d, ws %zu); nothing launched\n", n_in, out_size, ws_size); grid = -1; return; }
        int dev = 0, cus = 0, per_cu = 0;
        if (hipGetDevice(&dev) != hipSuccess || hipDeviceGetAttribute(&cus, hipDeviceAttributeMultiprocessorCount, dev) != hipSuccess) { grid = -1; return; }
        if (hipFuncSetAttribute((const void*)fwd_kernel, hipFuncAttributeMaxDynamicSharedMemorySize, LDS_BYTES) != hipSuccess) { fprintf(stderr, "kernel_launch: hipFuncSetAttribute failed\n"); grid = -1; return; }
        if (hipOccupancyMaxActiveBlocksPerMultiprocessor(&per_cu, (const void*)fwd_kernel, NWAVES * 64, LDS_BYTES) != hipSuccess || per_cu < 1)
            fprintf(stderr, "kernel_launch: occupancy query reports %d workgroups per CU\n", per_cu);
        (void)hipGetLastError();
        grid = cus;
    }
    if (grid < 0) return;
    (void)in_sizes;
    if (hipMemsetAsync((char*)d_ws + WS_CTL, 0, CTL_ZERO_BYTES, stream) != hipSuccess) return;
    Args a{};
    for (int i = 0; i < 27; ++i) a.in[i] = (const float*)d_in[i];
    a.out = (float*)d_out; a.ws = (unsigned char*)d_ws;
#if defined(MK_PROBE)
    unsigned* fb = (unsigned*)((char*)d_ws + WS_CTL + 512 * 1024);
    hipLaunchKernelGGL(probe_init, dim3(1), dim3(64), 0, stream, fb);
    for (int p = 0; p < 4; ++p) { a.ph_lo = p; a.ph_hi = p + 1; hipLaunchKernelGGL(fwd_kernel, dim3(grid), dim3(NWAVES * 64), LDS_BYTES, stream, a); }
    probe_buf(stream, (unsigned char*)d_ws + WS_ZF, 32 * MiB, 0, 8, fb, 10);
    hipLaunchKernelGGL(probe_emit, dim3(2048), dim3(256), 0, stream, (float*)d_out, (size_t)NTOK * D_MODEL, (const unsigned*)fb);
#elif MK_PER_PHASE
    for (int p = 0; p < N_PHASES; ++p) { a.ph_lo = p; a.ph_hi = p + 1; hipLaunchKernelGGL(fwd_kernel, dim3(grid), dim3(NWAVES * 64), LDS_BYTES, stream, a); }
#else
    a.ph_lo = 0; a.ph_hi = N_PHASES;
    hipLaunchKernelGGL(fwd_kernel, dim3(grid), dim3(NWAVES * 64), LDS_BYTES, stream, a);
#endif
}
```

```cpp
#include <hip/hip_runtime.h>
#include <cstdio>
#include <cstdint>

namespace pg8 {
#define PG8_LAS __attribute__((address_space(3)))
typedef unsigned short bf16_t;
typedef short bf16x8 __attribute__((ext_vector_type(8)));
typedef float f32x4 __attribute__((ext_vector_type(4)));
typedef float f32x2 __attribute__((ext_vector_type(2)));
typedef unsigned u32x4 __attribute__((ext_vector_type(4)));
typedef unsigned u32x2 __attribute__((ext_vector_type(2)));
constexpr int BM = 256, BK = 64, HALF = 128, HTB = HALF * BK * 2  , STAGE_BYTES = 8 * HTB, NXCD = 8, WGM = 8;

__host__ __device__ __forceinline__ int lds_byte(int r, int c) { const int st = (r >> 4) * 2 + (c >> 5), rr = r & 15, cc = c & 31, ob = rr * 64 + cc * 2; return st * 1024 + (ob ^ (((ob >> 9) & 1) << 5)); }
__host__ __device__ __forceinline__ void stage_rc(int b, int& R, int& C) { const int st = b / 1024, sb = b % 1024, swz = sb ^ (((sb >> 9) & 1) << 5); R = (st >> 1) * 16 + swz / 64; C = (st & 1) * 32 + (swz % 64) / 2; }
__host__ __device__ __forceinline__ int perm32(int rho) { const int n = rho >> 4, i = rho & 15; return 8 * (i >> 2) + 4 * n + (i & 3); }

struct Unit { int pm, pn; };
struct Gemm { const bf16_t* A; const bf16_t* Bt; int lda, ldb, K, agrp_shift, agrp_stride; };

__device__ __forceinline__ void tile_of(int wgid, int nwg, int nM, int nN, int& pm, int& pn) {
    { const int q = nwg / NXCD, r = nwg % NXCD, xcd = wgid % NXCD, off = wgid / NXCD; wgid = (xcd < r ? xcd * (q + 1) : r * (q + 1) + (xcd - r) * q) + off; }
    const int nig = WGM * nN, gid = wgid / nig, fm = gid * WGM, gsz = (nM - fm) < WGM ? (nM - fm) : WGM;
    pm = fm + ((wgid % nig) % gsz); pn = (wgid % nig) / gsz;
}
struct StaticOrder {
    int nM, nN, nwg, G, c;
    __device__ __forceinline__ void init(int M, int N, int G_, int c_) { nM = M / BM; nN = N / BM; nwg = nM * nN; G = G_; c = c_; }
    __device__ __forceinline__ bool next(int i, Unit& u) const {
        const long L = (long)i * G + c; if (L >= nwg) return false;
        tile_of((int)L, nwg, nM, nN, u.pm, u.pn); return true;
    }
};
struct MergeOrder {
    int nM, ntile, G, c;
    __device__ __forceinline__ void init(int M, int G_, int c_) { nM = M / BM; ntile = nM * 8; G = G_; c = c_; }
    __device__ __forceinline__ bool next(int i, Unit& u) const {
        const long L = (long)(i >> 2) * G + c; if (L >= ntile) return false;
        int pm, ct; tile_of((int)L, ntile, nM, 8, pm, ct); u.pm = pm; u.pn = (i & 3) * 8 + ct; return true;
    }
};

typedef __bf16 bf16x2_t __attribute__((ext_vector_type(2)));
__device__ __forceinline__ unsigned cvt_pk_bf16(float lo, float hi) { const f32x2 v = {lo, hi}; return __builtin_bit_cast(unsigned, __builtin_convertvector(v, bf16x2_t)); }
__device__ __forceinline__ float bf_lo(unsigned w) { return __uint_as_float(w << 16); }
__device__ __forceinline__ float bf_hi(unsigned w) { return __uint_as_float(w & 0xffff0000u); }
__device__ __forceinline__ float sigmoidf_fast(float x) { return __builtin_amdgcn_rcpf(1.0f + __expf(-x)); }

struct EpiStoreBf16 {
    static constexpr bool PERM = true;
    bf16_t* O; int ldc;
    __device__ __forceinline__ void operator()(const f32x4 (&acc)[2][2][4][2], const Unit& u, int wr, int wc, int fr, int fq) const {
        const int row0 = u.pm * BM + wr * 64 + fr, col0 = u.pn * BM + wc * 32 + 8 * fq;
#pragma unroll
        for (int ai = 0; ai < 2; ++ai)
#pragma unroll
            for (int m = 0; m < 4; ++m) { bf16_t* rowp = O + (size_t)(row0 + ai * HALF + m * 16) * ldc + col0;
#pragma unroll
                for (int bj = 0; bj < 2; ++bj) { const f32x4 v0 = acc[ai][bj][m][0], v1 = acc[ai][bj][m][1];
                    u32x4 w; w.x = cvt_pk_bf16(v0[0], v0[1]); w.y = cvt_pk_bf16(v0[2], v0[3]); w.z = cvt_pk_bf16(v1[0], v1[1]); w.w = cvt_pk_bf16(v1[2], v1[3]);
                    *(u32x4*)(rowp + bj * HALF) = w; } }
    }
};
struct EpiGlu {
    static constexpr bool PERM = true;
    const bf16_t* Y1; int ld1; bf16_t* O; int ldc;
    __device__ __forceinline__ void operator()(const f32x4 (&acc)[2][2][4][2], const Unit& u, int wr, int wc, int fr, int fq) const {
        const int row0 = u.pm * BM + wr * 64 + fr, col0 = u.pn * BM + wc * 32 + 8 * fq;
#pragma unroll
        for (int ai = 0; ai < 2; ++ai)
#pragma unroll
            for (int m = 0; m < 4; ++m) { const size_t r = (size_t)(row0 + ai * HALF + m * 16);
#pragma unroll
                for (int bj = 0; bj < 2; ++bj) { const f32x4 v0 = acc[ai][bj][m][0], v1 = acc[ai][bj][m][1];
                    const u32x4 y = *(const u32x4*)(Y1 + r * ld1 + col0 + bj * HALF);
                    u32x4 w;
                    w.x = cvt_pk_bf16(bf_lo(y.x) * sigmoidf_fast(v0[0]), bf_hi(y.x) * sigmoidf_fast(v0[1]));
                    w.y = cvt_pk_bf16(bf_lo(y.y) * sigmoidf_fast(v0[2]), bf_hi(y.y) * sigmoidf_fast(v0[3]));
                    w.z = cvt_pk_bf16(bf_lo(y.z) * sigmoidf_fast(v1[0]), bf_hi(y.z) * sigmoidf_fast(v1[1]));
                    w.w = cvt_pk_bf16(bf_lo(y.w) * sigmoidf_fast(v1[2]), bf_hi(y.w) * sigmoidf_fast(v1[3]));
                    *(u32x4*)(O + r * ldc + col0 + bj * HALF) = w; } }
    }
};
struct EpiMerge {
    static constexpr bool PERM = true;
    const bf16_t* P; float* MACC; bf16_t* MG;
    __device__ __forceinline__ void operator()(const f32x4 (&acc)[2][2][4][2], const Unit& u, int wr, int wc, int fr, int fq) const {
        const int kb = u.pn >> 3, ct = u.pn & 7;
        const int row0 = u.pm * BM + wr * 64 + fr, col0 = ct * BM + wc * 32 + 8 * fq;
#pragma unroll
        for (int ai = 0; ai < 2; ++ai)
#pragma unroll
            for (int m = 0; m < 4; ++m) { const size_t r = (size_t)(row0 + ai * HALF + m * 16);
#pragma unroll
                for (int bj = 0; bj < 2; ++bj) { const f32x4 v0 = acc[ai][bj][m][0], v1 = acc[ai][bj][m][1];
                    const int c = col0 + bj * HALF;
                    const u32x4 p = *(const u32x4*)(P + r * 8192 + kb * 2048 + c);
                    f32x4 t0, t1;
                    t0[0] = bf_lo(p.x) * sigmoidf_fast(v0[0]); t0[1] = bf_hi(p.x) * sigmoidf_fast(v0[1]); t0[2] = bf_lo(p.y) * sigmoidf_fast(v0[2]); t0[3] = bf_hi(p.y) * sigmoidf_fast(v0[3]);
                    t1[0] = bf_lo(p.z) * sigmoidf_fast(v1[0]); t1[1] = bf_hi(p.z) * sigmoidf_fast(v1[1]); t1[2] = bf_lo(p.w) * sigmoidf_fast(v1[2]); t1[3] = bf_hi(p.w) * sigmoidf_fast(v1[3]);
                    float* mp = MACC + r * 2048 + c;
                    if (kb > 0) { t0 += *(const f32x4*)mp; t1 += *(const f32x4*)(mp + 4); }
                    if (kb < 3) { *(f32x4*)mp = t0; *(f32x4*)(mp + 4) = t1; }
                    else { u32x4 w; w.x = cvt_pk_bf16(t0[0], t0[1]); w.y = cvt_pk_bf16(t0[2], t0[3]); w.z = cvt_pk_bf16(t1[0], t1[1]); w.w = cvt_pk_bf16(t1[2], t1[3]);
                        *(u32x4*)(MG + r * 2048 + c) = w; } } }
    }
};
struct EpiResF32 {
    static constexpr bool PERM = false;
    const float* base; float* out; int ldc;
    __device__ __forceinline__ void operator()(const f32x4 (&acc)[2][2][4][2], const Unit& u, int wr, int wc, int fr, int fq) const {
        const int row0 = u.pm * BM + wr * 64 + fr, col0 = u.pn * BM + wc * 32 + 4 * fq;
#pragma unroll
        for (int ai = 0; ai < 2; ++ai)
#pragma unroll
            for (int m = 0; m < 4; ++m) { const size_t off = (size_t)(row0 + ai * HALF + m * 16) * ldc + col0;
#pragma unroll
                for (int bj = 0; bj < 2; ++bj)
#pragma unroll
                    for (int n = 0; n < 2; ++n) { const f32x4 bs = *(const f32x4*)(base + off + bj * HALF + n * 16); *(f32x4*)(out + off + bj * HALF + n * 16) = bs + acc[ai][bj][m][n]; } }
    }
};
struct EpiSwiglu {
    static constexpr bool PERM = true;
    bf16_t* O; int ldc;
    __device__ __forceinline__ void operator()(const f32x4 (&acc)[2][2][4][2], const Unit& u, int wr, int wc, int fr, int fq) const {
        const int row0 = u.pm * BM + wr * 64 + fr, col0 = u.pn * HALF + wc * 32 + 8 * fq;
#pragma unroll
        for (int ai = 0; ai < 2; ++ai)
#pragma unroll
            for (int m = 0; m < 4; ++m) {
                f32x4 t[2];
#pragma unroll
                for (int n = 0; n < 2; ++n)
#pragma unroll
                    for (int j = 0; j < 4; ++j) { const float a = acc[ai][0][m][n][j], b = acc[ai][1][m][n][j]; t[n][j] = a * sigmoidf_fast(a) * b; }
                u32x4 w; w.x = cvt_pk_bf16(t[0][0], t[0][1]); w.y = cvt_pk_bf16(t[0][2], t[0][3]); w.z = cvt_pk_bf16(t[1][0], t[1][1]); w.w = cvt_pk_bf16(t[1][2], t[1][3]);
                *(u32x4*)(O + (size_t)(row0 + ai * HALF + m * 16) * ldc + col0) = w; }
    }
};
struct EpiPle {
    static constexpr bool PERM = false;
    const float* base; float* out; int ldc; const bf16_t* PP; int ldp;
    __device__ __forceinline__ void operator()(const f32x4 (&acc)[2][2][4][2], const Unit& u, int wr, int wc, int fr, int fq) const {
        const int row0 = u.pm * BM + wr * 64 + fr, col0 = u.pn * BM + wc * 32 + 4 * fq;
#pragma unroll
        for (int ai = 0; ai < 2; ++ai)
#pragma unroll
            for (int m = 0; m < 4; ++m) { const size_t r = (size_t)(row0 + ai * HALF + m * 16);
#pragma unroll
                for (int bj = 0; bj < 2; ++bj)
#pragma unroll
                    for (int n = 0; n < 2; ++n) { const int c = col0 + bj * HALF + n * 16; const f32x4 a = acc[ai][bj][m][n];
                        const f32x4 bs = *(const f32x4*)(base + r * ldc + c); const u32x2 p = *(const u32x2*)(PP + r * ldp + c);
                        f32x4 o; o[0] = bs[0] + sigmoidf_fast(a[0]) * bf_lo(p.x); o[1] = bs[1] + sigmoidf_fast(a[1]) * bf_hi(p.x); o[2] = bs[2] + sigmoidf_fast(a[2]) * bf_lo(p.y); o[3] = bs[3] + sigmoidf_fast(a[3]) * bf_hi(p.y);
                        *(f32x4*)(out + r * ldc + c) = o; } }
    }
};
template <class Epi, class Sched, bool ALIGN_EPI = false, bool SP2 = false>
__device__ __forceinline__ void gemm_phase(PG8_LAS unsigned char* lds, const Gemm g, const Sched& S, const Epi& E) {
    int tid_ = threadIdx.x; asm volatile("" : "+v"(tid_));
    const int tid = tid_, wid = __builtin_amdgcn_readfirstlane(tid >> 6), lane = tid & 63, wr = wid >> 2, wc = wid & 3, fr = lane & 15, fq = lane >> 4;
    const int K = g.K, nt = K / BK, lda = g.lda, ldb = g.ldb;
    unsigned voffA[2], voffB[2];
#pragma unroll
    for (int i = 0; i < 2; ++i) { int R, C; stage_rc(tid * 16 + i * 8192, R, C); const int Rb = Epi::PERM ? ((R & ~31) + perm32(R & 31)) : R;
        voffA[i] = (unsigned)(R * lda + C) * 2u; voffB[i] = (unsigned)(Rb * ldb + C) * 2u; }
    const size_t kstep = (size_t)(BK * 2);
    const size_t hstepA = (size_t)HALF * lda * 2, hstepB = (size_t)HALF * ldb * 2;
    const size_t tstepA = 2 * hstepA, tstepB = 2 * hstepB;
#define PG8_ABASE(u) ((const char*)g.A + (size_t)(u).pm * tstepA + (size_t)((u).pn >> g.agrp_shift) * (size_t)g.agrp_stride * 2)
#define PG8_BBASE(u) ((const char*)g.Bt + (size_t)(u).pn * tstepB)
    const unsigned ldsw = (unsigned)wid * 1024u;
    const int aoff = lds_byte(wr * 64 + fr, fq * 8), boff = lds_byte(wc * 32 + fr, fq * 8);
#define PG8_SA(b, h) (((b) * 2 + (h)) * HTB)
#define PG8_SB(b, h) ((4 + (b) * 2 + (h)) * HTB)
#define PG8_STAGE(bufoff, gbase, voff) do { _Pragma("unroll") for (int _i = 0; _i < 2; ++_i) \
        __builtin_amdgcn_global_load_lds((const unsigned*)((const char*)(gbase) + (voff)[_i]), (PG8_LAS unsigned*)(lds + (bufoff) + ldsw + _i * 8192), 16, 0, 0); } while (0)
#define PG8_LDA(dst, b, h) do { _Pragma("unroll") for (int m = 0; m < 4; ++m) _Pragma("unroll") for (int k = 0; k < 2; ++k) dst[m][k] = *(const PG8_LAS bf16x8*)(lds + PG8_SA(b, h) + aoff + m * 2048 + k * 1024); } while (0)
#define PG8_LDB(dst, b, h) do { _Pragma("unroll") for (int n = 0; n < 2; ++n) _Pragma("unroll") for (int k = 0; k < 2; ++k) dst[n][k] = *(const PG8_LAS bf16x8*)(lds + PG8_SB(b, h) + boff + n * 2048 + k * 1024); } while (0)
#define PG8_MMA(ai, bj, At, Bt) do { __builtin_amdgcn_s_setprio(1); _Pragma("unroll") for (int m = 0; m < 4; ++m) _Pragma("unroll") for (int n = 0; n < 2; ++n) _Pragma("unroll") for (int k = 0; k < 2; ++k) \
        acc[ai][bj][m][n] = __builtin_amdgcn_mfma_f32_16x16x32_bf16(Bt[n][k], At[m][k], acc[ai][bj][m][n], 0, 0, 0); __builtin_amdgcn_s_setprio(0); } while (0)
#define PG8_WAIT_V(n) asm volatile("s_waitcnt vmcnt(" #n ")" ::: "memory")
#define PG8_WAIT_L(n) asm volatile("s_waitcnt lgkmcnt(" #n ")" ::: "memory")
#define PG8_BAR __builtin_amdgcn_s_barrier()
#define PG8_SCHED __builtin_amdgcn_sched_barrier(0)
    Unit cur, nxt; int ui = 0;
    if (!S.next(0, cur)) return;
    f32x4 acc[2][2][4][2];
#pragma unroll
    for (int a = 0; a < 2; ++a)
#pragma unroll
        for (int b = 0; b < 2; ++b)
#pragma unroll
            for (int m = 0; m < 4; ++m)
#pragma unroll
                for (int n = 0; n < 2; ++n) acc[a][b][m][n] = (f32x4){0.f, 0.f, 0.f, 0.f};
    bf16x8 At[4][2], B0[2][2], B1[2][2];
    const char* cA = PG8_ABASE(cur); const char* cB = PG8_BBASE(cur);
    if constexpr (SP2) {
        PG8_STAGE(PG8_SB(0, 0), cB, voffB); PG8_STAGE(PG8_SB(0, 1), cB + hstepB, voffB); PG8_STAGE(PG8_SA(0, 0), cA, voffA); PG8_STAGE(PG8_SA(0, 1), cA + hstepA, voffA);
        if (wr == 1) PG8_BAR;
        PG8_WAIT_V(2); PG8_BAR;
        PG8_STAGE(PG8_SB(1, 0), cB + kstep, voffB); PG8_STAGE(PG8_SA(1, 0), cA + kstep, voffA); PG8_STAGE(PG8_SB(1, 1), cB + hstepB + kstep, voffB);
        PG8_WAIT_V(6); PG8_BAR;
    } else {
        PG8_STAGE(PG8_SB(0, 0), cB, voffB); PG8_STAGE(PG8_SA(0, 0), cA, voffA); PG8_STAGE(PG8_SB(0, 1), cB + hstepB, voffB); PG8_STAGE(PG8_SA(0, 1), cA + hstepA, voffA);
        if (wr == 1) PG8_BAR;
        PG8_WAIT_V(4); PG8_BAR;
        PG8_STAGE(PG8_SB(1, 0), cB + kstep, voffB); PG8_STAGE(PG8_SA(1, 0), cA + kstep, voffA); PG8_STAGE(PG8_SB(1, 1), cB + hstepB + kstep, voffB);
        PG8_WAIT_V(6); PG8_BAR;
    }
    for (;;) {
        const bool has_next = S.next(ui + 1, nxt);
        const char* nA = has_next ? PG8_ABASE(nxt) : cA; const char* nB = has_next ? PG8_BBASE(nxt) : cB;
        for (int t = 0; t < nt; t += 2) {
            const bool last = (t == nt - 2);
            const char* a1 = cA + (size_t)(t + 1) * kstep;
            const char* a2 = last ? nA : cA + (size_t)(t + 2) * kstep; const char* b2 = last ? nB : cB + (size_t)(t + 2) * kstep;
            const char* a3 = a2 + kstep; const char* b3 = b2 + kstep;
            if constexpr (SP2) {
            PG8_LDB(B0, 0, 0); PG8_LDB(B1, 0, 1); PG8_SCHED; PG8_LDA(At, 0, 0); PG8_STAGE(PG8_SA(1, 1), a1 + hstepA, voffA);
            PG8_WAIT_V(8); PG8_WAIT_L(0); PG8_BAR; PG8_MMA(0, 0, At, B0); PG8_MMA(0, 1, At, B1); PG8_BAR; PG8_SCHED;
            PG8_LDA(At, 0, 1); PG8_STAGE(PG8_SB(0, 0), b2, voffB); PG8_STAGE(PG8_SB(0, 1), b2 + hstepB, voffB); PG8_STAGE(PG8_SA(0, 0), a2, voffA);
            PG8_WAIT_V(8); PG8_WAIT_L(0); PG8_BAR; PG8_MMA(1, 0, At, B0); PG8_MMA(1, 1, At, B1); PG8_BAR; PG8_SCHED;
            PG8_LDB(B0, 1, 0); PG8_LDB(B1, 1, 1); PG8_SCHED; PG8_LDA(At, 1, 0); PG8_STAGE(PG8_SA(0, 1), a2 + hstepA, voffA);
            PG8_WAIT_V(8); PG8_WAIT_L(0); PG8_BAR; PG8_MMA(0, 0, At, B0); PG8_MMA(0, 1, At, B1); PG8_BAR; PG8_SCHED;
            PG8_LDA(At, 1, 1); PG8_STAGE(PG8_SB(1, 0), b3, voffB); PG8_STAGE(PG8_SB(1, 1), b3 + hstepB, voffB); PG8_STAGE(PG8_SA(1, 0), a3, voffA);
            PG8_WAIT_V(8); PG8_WAIT_L(0); PG8_BAR; PG8_MMA(1, 0, At, B0); PG8_MMA(1, 1, At, B1); PG8_BAR; PG8_SCHED;
            } else {
            PG8_LDB(B0, 0, 0); PG8_SCHED; PG8_LDA(At, 0, 0); PG8_STAGE(PG8_SA(1, 1), a1 + hstepA, voffA);
            PG8_WAIT_L(8); PG8_BAR; PG8_WAIT_L(0); PG8_MMA(0, 0, At, B0); PG8_BAR; PG8_SCHED;
            PG8_LDB(B1, 0, 1); PG8_STAGE(PG8_SB(0, 0), b2, voffB);
            PG8_BAR; PG8_WAIT_L(0); PG8_MMA(0, 1, At, B1); PG8_BAR;
            PG8_LDA(At, 0, 1); PG8_STAGE(PG8_SA(0, 0), a2, voffA);
            PG8_BAR; PG8_WAIT_L(0); PG8_MMA(1, 0, At, B0); PG8_BAR; PG8_SCHED;
            PG8_STAGE(PG8_SB(0, 1), b2 + hstepB, voffB);
            PG8_WAIT_V(6); PG8_BAR; PG8_MMA(1, 1, At, B1); PG8_BAR;
            PG8_LDB(B0, 1, 0); PG8_SCHED; PG8_LDA(At, 1, 0); PG8_STAGE(PG8_SA(0, 1), a2 + hstepA, voffA);
            PG8_WAIT_L(8); PG8_BAR; PG8_WAIT_L(0); PG8_MMA(0, 0, At, B0); PG8_BAR; PG8_SCHED;
            PG8_LDB(B1, 1, 1); PG8_STAGE(PG8_SB(1, 0), b3, voffB);
            PG8_BAR; PG8_WAIT_L(0); PG8_MMA(0, 1, At, B1); PG8_BAR;
            PG8_LDA(At, 1, 1); PG8_STAGE(PG8_SA(1, 0), a3, voffA);
            PG8_BAR; PG8_WAIT_L(0); PG8_MMA(1, 0, At, B0); PG8_BAR; PG8_SCHED;
            PG8_STAGE(PG8_SB(1, 1), b3 + hstepB, voffB);
            PG8_WAIT_V(6); PG8_BAR; PG8_MMA(1, 1, At, B1); PG8_BAR;
            }
        }
        if constexpr (ALIGN_EPI) { if (wr == 0) PG8_BAR; }
        { E(acc, cur, wr, wc, fr, fq); }
        if (!has_next) break;
#pragma unroll
        for (int a = 0; a < 2; ++a)
#pragma unroll
            for (int b = 0; b < 2; ++b)
#pragma unroll
                for (int m = 0; m < 4; ++m)
#pragma unroll
                    for (int n = 0; n < 2; ++n) acc[a][b][m][n] = (f32x4){0.f, 0.f, 0.f, 0.f};
        cur = nxt; cA = nA; cB = nB; ++ui;
        if constexpr (ALIGN_EPI) { if (wr == 1) PG8_BAR; }
    }
    PG8_WAIT_V(0);
    if constexpr (!ALIGN_EPI) { if (wr == 0) PG8_BAR; }
    PG8_BAR;
#undef PG8_ABASE
#undef PG8_BBASE
#undef PG8_SA
#undef PG8_SB
#undef PG8_STAGE
#undef PG8_LDA
#undef PG8_LDB
#undef PG8_MMA
#undef PG8_WAIT_V
#undef PG8_WAIT_L
#undef PG8_BAR
#undef PG8_SCHED
}
}


constexpr int D_MODEL = 2048, NTOK = 49152, CH_TOK = 16384, N_CHUNK = 3, DEPTH = 2;
constexpr int MIX_IN = 4096, IN_COLS = 12288, D_FF = 5632, PLE_DIM = 256;
constexpr int ZC_UA = 0, ZC_BG = 512, ZC_CG = 1024, ZC_VB = 1536, ZC_Q = 2048, ZC_K = 2560, ZC_VC = 3072, ZC_UD = 3584;
constexpr float EPS = 1e-6f;
constexpr int NWAVES = 8;

constexpr size_t MiB = 1u << 20;
constexpr size_t WS_CTL = 0, CTL_ZERO_BYTES = 1 * MiB;
constexpr size_t WS_TAB = 1 * MiB;
constexpr size_t S5T_BYTES = 12800, S5T_BB = 0, S5T_C = 8192, S5T_AB = 12288;
constexpr size_t TAB_S5 = WS_TAB, TAB_C128 = WS_TAB + 2 * MiB, TAB_S128 = TAB_C128 + 32768, TAB_C32 = TAB_S128 + 32768, TAB_S32 = TAB_C32 + 2048;
constexpr size_t WS_W = 8 * MiB;
constexpr size_t WL_MIX = 0, WL_G = 16 * MiB, WL_GLU = 48 * MiB, WL_BR = WL_GLU + MiB / 2, WL_O = WL_BR + 8 * MiB, WL_FF = WL_O + 8 * MiB, WL_FF2 = WL_FF + 44 * MiB, WL_PG = WL_FF2 + 22 * MiB, WL_PP = WL_PG + 8 * MiB;
constexpr size_t WL_BYTES = WL_PP + 1 * MiB;
static_assert(WL_BYTES == 139 * MiB + MiB / 2, "weight map");
constexpr size_t WS_H = 288 * MiB;
constexpr size_t WS_Z = 352 * MiB;
constexpr size_t WS_YS = 480 * MiB;
constexpr size_t WS_MG = 544 * MiB;
constexpr size_t WS_GT = 608 * MiB;
constexpr size_t WS_YF = WS_GT, WS_YB = WS_GT + 32 * MiB, WS_ZF = WS_GT + 64 * MiB, WS_Y1 = WS_GT + 96 * MiB;
constexpr size_t WS_P16 = 864 * MiB;
constexpr size_t WS_END = 872 * MiB;
static_assert(WS_W + 2 * WL_BYTES <= WS_H, "ws map");
constexpr int CW_BAR = 4096;

constexpr int LDS_SCRATCH = 151552;
constexpr int LDSCTL_OFF = LDS_SCRATCH;
constexpr int LDS_BYTES = LDS_SCRATCH + 256;

#define GAS __attribute__((address_space(1)))
#define LAS __attribute__((address_space(3)))
typedef unsigned short bf16;
typedef unsigned u32x4 __attribute__((ext_vector_type(4)));
typedef unsigned u32x2 __attribute__((ext_vector_type(2)));
typedef float f32x4 __attribute__((ext_vector_type(4)));
typedef float f32x2 __attribute__((ext_vector_type(2)));
typedef short bf16x8 __attribute__((ext_vector_type(8)));
#define LDS_WAIT() asm volatile("s_waitcnt lgkmcnt(0)" ::: "memory")
using pg8::cvt_pk_bf16; using pg8::bf_lo; using pg8::bf_hi;
__device__ __forceinline__ bf16x8 as_frag(u32x4 v) { return __builtin_bit_cast(bf16x8, v); }
__device__ __forceinline__ f32x4 mfma16(bf16x8 a, bf16x8 b, f32x4 c) { return __builtin_amdgcn_mfma_f32_16x16x32_bf16(a, b, c, 0, 0, 0); }
__device__ __forceinline__ float wave_sum(float v) {
#pragma unroll
    for (int o = 1; o < 64; o <<= 1) v += __shfl_xor(v, o);
    return v;
}
__device__ __forceinline__ unsigned short f2bf(float f) { return (unsigned short)(cvt_pk_bf16(f, 0.f) & 0xffffu); }

#define XB_TMO      128
#define XB_XCNT(j)  (256  + 64 * (j))
#define XB_XSUB(j)  (1280 + 64 * (j))
#define XB_XGEN(j)  (2304 + 64 * (j))
#define XB_TOP      3328
#define XB_TOPGEN   3392
#define XCD_BAR_WORDS 3456
#define XB_SPIN_CAP (1u << 22)
__device__ __forceinline__ unsigned xb_ld(unsigned* p)              { return __hip_atomic_load(p, __ATOMIC_RELAXED, __HIP_MEMORY_SCOPE_AGENT); }
__device__ __forceinline__ unsigned xb_add(unsigned* p, unsigned v) { return __hip_atomic_fetch_add(p, v, __ATOMIC_RELAXED, __HIP_MEMORY_SCOPE_AGENT); }
__device__ __forceinline__ unsigned xb_xcc_id() { return (unsigned)__builtin_amdgcn_s_getreg((3 << 11) | 20) & 0xFu; }
#define XB_SPIN(cond, bar) do { unsigned _sp = 0; while (cond) { __builtin_amdgcn_s_sleep(1); \
    if ((++_sp & 255u) == 0u) { if (xb_ld(&(bar)[XB_TMO])) break; if (_sp > XB_SPIN_CAP) { atomicAdd(&(bar)[XB_TMO], 1u); break; } } } } while (0)
struct XcdBarrier { unsigned* bar; unsigned x; volatile LAS unsigned* st; };
__device__ __forceinline__ XcdBarrier xcd_barrier_post(unsigned* bar, volatile LAS unsigned* st) {
    XcdBarrier b; b.bar = bar; b.x = xb_xcc_id(); b.st = st;
    if (threadIdx.x == 0) (void)xb_add(&bar[XB_XCNT(b.x)], 1u);
    return b;
}
__device__ __forceinline__ void xcd_barrier_complete(unsigned* bar, unsigned x, unsigned& nloc, unsigned& nx) {
    const unsigned G = gridDim.x * gridDim.y * gridDim.z;
    unsigned sum, cnt, mine, sp = 0u;
    for (;;) {
        sum = 0u; cnt = 0u; mine = 0u;
#pragma unroll
        for (unsigned j = 0; j < 16; ++j) { const unsigned c = xb_ld(&bar[XB_XCNT(j)]); sum += c; cnt += (c > 0u) ? 1u : 0u; mine = (j == x) ? c : mine; }
        if (sum == G) break;
        __builtin_amdgcn_s_sleep(1);
        if ((++sp & 255u) == 0u) { if (xb_ld(&bar[XB_TMO])) break; if (sp > XB_SPIN_CAP) { atomicAdd(&bar[XB_TMO], 1u); break; } }
    }
    nloc = mine > 0u ? mine : 1u; nx = cnt > 0u ? cnt : 1u;
}
__device__ __forceinline__ void xcd_barrier(const XcdBarrier& b) {
    asm volatile("s_waitcnt vmcnt(0)" ::: "memory");
    __syncthreads();
    if (threadIdx.x == 0) {
        unsigned* bar = b.bar;
        __builtin_amdgcn_s_waitcnt(0);
        unsigned nloc = b.st[0], nx = b.st[1];
        if (nloc == 0u) { xcd_barrier_complete(bar, b.x, nloc, nx); b.st[0] = nloc; b.st[1] = nx; }
        const unsigned old = xb_add(&bar[XB_XSUB(b.x)], 1u);
        const unsigned gen = old / nloc;
        if (old + 1u == (gen + 1u) * nloc) {
            __builtin_amdgcn_fence(__ATOMIC_RELEASE, "agent");
            asm volatile("s_waitcnt vmcnt(0)" ::: "memory");
            const unsigned og = xb_add(&bar[XB_TOP], 1u);
            const unsigned tg = og / nx;
            if (og + 1u == (tg + 1u) * nx) xb_add(&bar[XB_TOPGEN], 1u);
            else XB_SPIN(xb_ld(&bar[XB_TOPGEN]) == tg, bar);
            __builtin_amdgcn_fence(__ATOMIC_ACQUIRE, "agent");
            xb_add(&bar[XB_XGEN(b.x)], 1u);
            asm volatile("s_waitcnt vmcnt(0)" ::: "memory");
        } else {
            XB_SPIN(xb_ld(&bar[XB_XGEN(b.x)]) == gen, bar);
            __builtin_amdgcn_fence(__ATOMIC_ACQUIRE, "agent");
            asm volatile("s_waitcnt vmcnt(0)" ::: "memory");
        }
    }
    __syncthreads();
}

struct Frame {
    LAS unsigned char* lds;
    int tid, lane, wave;
    int vcu, G;
    unsigned char* ws;
};
struct Args { const float* in[27]; float* out; unsigned char* ws; int ph_lo, ph_hi; };
__device__ __forceinline__ Frame fresh(const Frame& F0) { Frame F = F0; int t = F0.tid; asm volatile("" : "+v"(t)); F.tid = t; F.lane = t & 63; F.wave = __builtin_amdgcn_readfirstlane(t >> 6); return F; }

__device__ __forceinline__ void transpose_item(const float* W, int K, int N, bf16* WT, int k0, int n0, int drow0, LAS float* scr, int lane) {
#pragma unroll 8
    for (int i = 0; i < 32; ++i) { const int kk = 2 * i + (lane >> 5); scr[kk * 33 + (lane & 31)] = W[(size_t)(k0 + kk) * N + n0 + (lane & 31)]; }
    LDS_WAIT(); asm volatile("" ::: "memory");
    const int c = lane & 7;
#pragma unroll
    for (int j = 0; j < 4; ++j) { const int n = (lane >> 3) + 8 * j; const LAS float* s = scr + (8 * c) * 33 + n;
        u32x4 o; o.x = cvt_pk_bf16(s[0 * 33], s[1 * 33]); o.y = cvt_pk_bf16(s[2 * 33], s[3 * 33]); o.z = cvt_pk_bf16(s[4 * 33], s[5 * 33]); o.w = cvt_pk_bf16(s[6 * 33], s[7 * 33]);
        *(u32x4*)(WT + (size_t)(drow0 + n) * K + k0 + 8 * c) = o; }
    LDS_WAIT(); asm volatile("" ::: "memory");
}
__device__ __forceinline__ void conv_plain(const float* W, int K, int N, bf16* WT, int item, LAS float* scr, int lane) {
    const int nblk = N / 32, kb = item / nblk, nb = item % nblk;
    transpose_item(W, K, N, WT, 64 * kb, 32 * nb, 32 * nb, scr, lane);
}
__device__ __forceinline__ void ph_prologue(Frame& F, const Args& A) {
    LAS float* scr = (LAS float*)(F.lds + F.wave * 16384);
    const int gw = F.vcu * NWAVES + F.wave, NGW = F.G * NWAVES;
    constexpr int I_IN = (2048 / 64) * (IN_COLS / 32), I_GLU = (512 / 64) * (512 / 32), I_BR1 = (512 / 64) * (2048 / 32), I_BR = 4 * I_BR1, I_O = (2048 / 64) * (2048 / 32),
                  I_FF = (2048 / 64) * (2 * D_FF / 32), I_FF2 = (D_FF / 64) * (2048 / 32), I_PG = I_O, I_PP = (256 / 64) * (2048 / 32);
    constexpr int I_LAYER = I_IN + I_GLU + I_BR + I_O + I_FF + I_FF2 + I_PG + I_PP;
    for (int it = gw; it < DEPTH * I_LAYER; it += NGW) {
        const int l = it / I_LAYER; int r = it % I_LAYER;
        unsigned char* wl = F.ws + WS_W + (size_t)l * WL_BYTES;
        if (r < I_IN) {
            const float* W = A.in[5] + (size_t)l * 2048 * IN_COLS; const int nblk = IN_COLS / 32, kb = r / nblk, nb = r % nblk, n0 = 32 * nb;
            if (n0 < MIX_IN) transpose_item(W, 2048, IN_COLS, (bf16*)(wl + WL_MIX), 64 * kb, n0, n0, scr, F.lane);
            else transpose_item(W, 2048, IN_COLS, (bf16*)(wl + WL_G), 64 * kb, n0, n0 - MIX_IN, scr, F.lane);
            continue; } r -= I_IN;
        if (r < I_GLU) { conv_plain(A.in[14] + (size_t)l * 512 * 512, 512, 512, (bf16*)(wl + WL_GLU), r, scr, F.lane); continue; } r -= I_GLU;
        if (r < I_BR) { const int kb = r / I_BR1; conv_plain(A.in[19] + ((size_t)l * 4 + kb) * 512 * 2048, 512, 2048, (bf16*)(wl + WL_BR) + (size_t)kb * 2048 * 512, r % I_BR1, scr, F.lane); continue; } r -= I_BR;
        if (r < I_O) { conv_plain(A.in[20] + (size_t)l * 2048 * 2048, 2048, 2048, (bf16*)(wl + WL_O), r, scr, F.lane); continue; } r -= I_O;
        if (r < I_FF) {
            const float* W = A.in[22] + (size_t)l * 2048 * 2 * D_FF; const int nblk = 2 * D_FF / 32, kb = r / nblk, nb = r % nblk, n0 = 32 * nb;
            const int j = n0 / D_FF, rr = n0 % D_FF, pn = rr / 128, cc = rr % 128;
            transpose_item(W, 2048, 2 * D_FF, (bf16*)(wl + WL_FF), 64 * kb, n0, 256 * pn + 128 * j + cc, scr, F.lane);
            continue; } r -= I_FF;
        if (r < I_FF2) { conv_plain(A.in[23] + (size_t)l * D_FF * 2048, D_FF, 2048, (bf16*)(wl + WL_FF2), r, scr, F.lane); continue; } r -= I_FF2;
        if (r < I_PG) { conv_plain(A.in[25] + (size_t)l * 2048 * 2048, 2048, 2048, (bf16*)(wl + WL_PG), r, scr, F.lane); continue; } r -= I_PG;
        conv_plain(A.in[26] + (size_t)l * 256 * 2048, 256, 2048, (bf16*)(wl + WL_PP), r, scr, F.lane);
    }
    {
        const int gt = F.vcu * 512 + F.tid, NT = F.G * 512;
        bf16* c128 = (bf16*)(F.ws + TAB_C128); bf16* s128 = (bf16*)(F.ws + TAB_S128); bf16* c32 = (bf16*)(F.ws + TAB_C32); bf16* s32 = (bf16*)(F.ws + TAB_S32);
        for (int e = gt; e < 128 * 128 + 32 * 32; e += NT) {
            if (e < 128 * 128) { const int i = e >> 7, k = e & 127, m = (i * k) & 127; float sn, cs; sincospif((float)m * (1.0f / 64.0f), &sn, &cs);
                c128[e] = f2bf(cs * 0.08838834764831845f); s128[e] = f2bf(sn * 0.08838834764831845f); }
            else { const int e2 = e - 128 * 128, i = e2 >> 5, k = e2 & 31, m = (i * k) & 31; float sn, cs; sincospif((float)m * (1.0f / 16.0f), &sn, &cs);
                c32[e2] = f2bf(cs * 0.17677669529663687f); s32[e2] = f2bf(sn * 0.17677669529663687f); }
        }
    }
    for (int t = gw; t < DEPTH * 2 * 32; t += NGW) {
        const int g = t & 31, ld = t >> 5;
        unsigned char* tb = F.ws + TAB_S5 + (size_t)t * S5T_BYTES;
        const float* lam_re = A.in[6] + (size_t)t * 64; const float* lam_im = A.in[7] + (size_t)t * 64;
        const float dt = expf(A.in[8][t]);
        const float* b_re = A.in[9] + (size_t)t * 64 * 16; const float* b_im = A.in[10] + (size_t)t * 64 * 16;
        const float* c_re = A.in[11] + (size_t)t * 16 * 64; const float* c_im = A.in[12] + (size_t)t * 16 * 64;
        (void)g; (void)ld;
        const int lane = F.lane, l15 = lane & 15, g4 = lane >> 4;
        {
            const float lr = lam_re[lane], li = lam_im[lane], mag = expf(lr * dt); float sn, cs; sincosf(li * dt, &sn, &cs);
            f32x2 ab; ab.x = mag * cs; ab.y = mag * sn; ((f32x2*)(tb + S5T_AB))[lane] = ab;
        }
#pragma unroll 1
        for (int cb = 0; cb < 8; ++cb) {
            const int col = 16 * cb + l15, p = col >> 1, ri = col & 1;
            const float lr = lam_re[p], li = lam_im[p], mag = expf(lr * dt); float sn, cs; sincosf(li * dt, &sn, &cs);
            const float ar = mag * cs, ai = mag * sn, den = lr * lr + li * li;
            const float fr = ((ar - 1.0f) * lr + ai * li) / den, fi = (ai * lr - (ar - 1.0f) * li) / den;
            float v[8];
#pragma unroll
            for (int j = 0; j < 8; ++j) { const int h = 8 * g4 + j; float x = 0.f;
                if (h < 16) { const float br = b_re[p * 16 + h], bi = b_im[p * 16 + h]; x = ri ? (fr * bi + fi * br) : (fr * br - fi * bi); }
                v[j] = x; }
            u32x4 o; o.x = cvt_pk_bf16(v[0], v[1]); o.y = cvt_pk_bf16(v[2], v[3]); o.z = cvt_pk_bf16(v[4], v[5]); o.w = cvt_pk_bf16(v[6], v[7]);
            ((u32x4*)(tb + S5T_BB))[cb * 64 + lane] = o;
        }
#pragma unroll 1
        for (int ks = 0; ks < 4; ++ks) {
            float v[8];
#pragma unroll
            for (int j = 0; j < 8; ++j) { const int col = 32 * ks + 8 * g4 + j, p = col >> 1, ri = col & 1; v[j] = ri ? -c_im[l15 * 64 + p] : c_re[l15 * 64 + p]; }
            u32x4 o; o.x = cvt_pk_bf16(v[0], v[1]); o.y = cvt_pk_bf16(v[2], v[3]); o.z = cvt_pk_bf16(v[4], v[5]); o.w = cvt_pk_bf16(v[6], v[7]);
            ((u32x4*)(tb + S5T_C))[ks * 64 + lane] = o;
        }
    }
}

__device__ __forceinline__ void ph_norm(Frame& F, const float* xsrc, const float* gain, bf16* H) {
    const int gw = F.vcu * NWAVES + F.wave, NGW = F.G * NWAVES;
    f32x4 gv[8];
#pragma unroll
    for (int j = 0; j < 8; ++j) gv[j] = ((const f32x4*)gain)[F.lane + 64 * j];
    for (int m = gw; m < CH_TOK; m += NGW) {
        const f32x4* xr = (const f32x4*)(xsrc + (size_t)m * D_MODEL) + F.lane;
        f32x4 v[8]; float s = 0.f;
#pragma unroll
        for (int j = 0; j < 8; ++j) { v[j] = xr[64 * j]; s += (v[j][0] * v[j][0] + v[j][1] * v[j][1]) + (v[j][2] * v[j][2] + v[j][3] * v[j][3]); }
        const float rstd = rsqrtf(wave_sum(s) * (1.0f / D_MODEL) + EPS);
        u32x2* o = (u32x2*)(H + (size_t)m * D_MODEL) + F.lane;
#pragma unroll
        for (int j = 0; j < 8; ++j) { u32x2 w; w.x = cvt_pk_bf16(v[j][0] * rstd * gv[j][0], v[j][1] * rstd * gv[j][1]); w.y = cvt_pk_bf16(v[j][2] * rstd * gv[j][2], v[j][3] * rstd * gv[j][3]); o[64 * j] = w; }
    }
}
__device__ __forceinline__ void ph_pcvt(Frame& F, const float* p, bf16* P16) {
    const int gw = F.vcu * NWAVES + F.wave, NGW = F.G * NWAVES;
    for (int m = gw; m < CH_TOK; m += NGW) {
        const f32x4 v = ((const f32x4*)(p + (size_t)m * PLE_DIM))[F.lane];
        u32x2 w; w.x = cvt_pk_bf16(v[0], v[1]); w.y = cvt_pk_bf16(v[2], v[3]);
        ((u32x2*)(P16 + (size_t)m * PLE_DIM))[F.lane] = w;
    }
}
__device__ __forceinline__ void unpack8(u32x4 w, float (&f)[8]) { f[0] = bf_lo(w.x); f[1] = bf_hi(w.x); f[2] = bf_lo(w.y); f[3] = bf_hi(w.y); f[4] = bf_lo(w.z); f[5] = bf_hi(w.z); f[6] = bf_lo(w.w); f[7] = bf_hi(w.w); }
__device__ __forceinline__ u32x4 pack8(const float (&f)[8]) { u32x4 w; w.x = cvt_pk_bf16(f[0], f[1]); w.y = cvt_pk_bf16(f[2], f[3]); w.z = cvt_pk_bf16(f[4], f[5]); w.w = cvt_pk_bf16(f[6], f[7]); return w; }

__device__ __forceinline__ void conv_block(Frame& F, const bf16* Z, bf16* YS, const float* cw  , int blk, int lseq) {
#pragma unroll 1
    for (int i = 0; i < 8; ++i) {
        const int idx = F.tid + 512 * i, r = blk * 64 + (idx >> 6), c = (idx & 63) * 8, lpos = r % lseq;
        const bf16* zr = Z + (size_t)r * MIX_IN;
        float bg[8], z0[8], acc[8], tmp[8], w[8];
        unpack8(*(const u32x4*)(zr + ZC_BG + c), bg);
        {   float cg[8], vv[8]; unpack8(*(const u32x4*)(zr + ZC_CG + c), cg); unpack8(*(const u32x4*)(zr + ZC_VB + c), vv);
            const f32x4 wa = *(const f32x4*)(cw + 512 + c), wb = *(const f32x4*)(cw + 512 + c + 4);
            w[0] = wa[0]; w[1] = wa[1]; w[2] = wa[2]; w[3] = wa[3]; w[4] = wb[0]; w[5] = wb[1]; w[6] = wb[2]; w[7] = wb[3];
#pragma unroll
            for (int j = 0; j < 8; ++j) { z0[j] = cg[j] * vv[j]; acc[j] = w[j] * z0[j]; } }
        if (lpos > 0) { float cg[8], vv[8]; unpack8(*(const u32x4*)(zr - MIX_IN + ZC_CG + c), cg); unpack8(*(const u32x4*)(zr - MIX_IN + ZC_VB + c), vv);
            const f32x4 wa = *(const f32x4*)(cw + c), wb = *(const f32x4*)(cw + c + 4);
            w[0] = wa[0]; w[1] = wa[1]; w[2] = wa[2]; w[3] = wa[3]; w[4] = wb[0]; w[5] = wb[1]; w[6] = wb[2]; w[7] = wb[3];
#pragma unroll
            for (int j = 0; j < 8; ++j) acc[j] += w[j] * (cg[j] * vv[j]); }
        if (lpos < lseq - 1) { float cg[8], vv[8]; unpack8(*(const u32x4*)(zr + MIX_IN + ZC_CG + c), cg); unpack8(*(const u32x4*)(zr + MIX_IN + ZC_VB + c), vv);
            const f32x4 wa = *(const f32x4*)(cw + 1024 + c), wb = *(const f32x4*)(cw + 1024 + c + 4);
            w[0] = wa[0]; w[1] = wa[1]; w[2] = wa[2]; w[3] = wa[3]; w[4] = wb[0]; w[5] = wb[1]; w[6] = wb[2]; w[7] = wb[3];
#pragma unroll
            for (int j = 0; j < 8; ++j) acc[j] += w[j] * (cg[j] * vv[j]); }
#pragma unroll
        for (int j = 0; j < 8; ++j) tmp[j] = bg[j] * acc[j];
        *(u32x4*)(YS + (size_t)r * D_MODEL + 512 + c) = pack8(tmp);
    }
}
__device__ __forceinline__ void s5fin_block(Frame& F, const bf16* Z, const float* YF, const float* YB, const float* dsk  , bf16* Y1, int blk) {
#pragma unroll 1
    for (int i = 0; i < 8; ++i) {
        const int idx = F.tid + 512 * i, r = blk * 64 + (idx >> 6), c = (idx & 63) * 8;
        float u[8], o[8]; unpack8(*(const u32x4*)(Z + (size_t)r * MIX_IN + ZC_UA + c), u);
        const f32x4 f0 = *(const f32x4*)(YF + (size_t)r * 512 + c), f1 = *(const f32x4*)(YF + (size_t)r * 512 + c + 4);
        const f32x4 b0 = *(const f32x4*)(YB + (size_t)r * 512 + c), b1 = *(const f32x4*)(YB + (size_t)r * 512 + c + 4);
        const f32x4 d0 = *(const f32x4*)(dsk + c), d1 = *(const f32x4*)(dsk + c + 4);
#pragma unroll
        for (int j = 0; j < 8; ++j) { const float yy = (j < 4 ? d0[j & 3] : d1[j & 3]) * u[j] + (j < 4 ? f0[j & 3] : f1[j & 3]) + (j < 4 ? b0[j & 3] : b1[j & 3]);
            const float a = 0.7978845608028654f * (yy + 0.044715f * yy * yy * yy);
            const float th = 1.0f - 2.0f * __builtin_amdgcn_rcpf(1.0f + __expf(2.0f * a));
            o[j] = 0.5f * yy * (1.0f + th); }
        *(u32x4*)(Y1 + (size_t)r * 512 + c) = pack8(o);
    }
}

__device__ __forceinline__ void s5_wave_task(Frame& F, const unsigned char* tb, const bf16* Zs, float* Yout, int ntok, int dir, int g) {
    LAS float* BU = (LAS float*)(F.lds + F.wave * 12288);
    LAS unsigned* XD = (LAS unsigned*)(F.lds + F.wave * 12288 + 8192);
    const int lane = F.lane, l15 = lane & 15, g4 = lane >> 4;
    const f32x2 ab = ((const f32x2*)(tb + S5T_AB))[lane];
    const float ar = ab.x, ai = ab.y;
    bf16x8 bbf[8], cf[4];
#pragma unroll
    for (int cb = 0; cb < 8; ++cb) bbf[cb] = as_frag(((const u32x4*)(tb + S5T_BB))[cb * 64 + lane]);
#pragma unroll
    for (int ks = 0; ks < 4; ++ks) cf[ks] = as_frag(((const u32x4*)(tb + S5T_C))[ks * 64 + lane]);
    float xr = 0.f, xi = 0.f;
    const int ntile = ntok >> 4;
    const bf16* zcol = Zs + ZC_UA + g * 16 + 8 * (g4 & 1);
    u32x4 ucur = (u32x4){0u, 0u, 0u, 0u};
    { const int tile = dir ? ntile - 1 : 0; if (g4 < 2) ucur = *(const u32x4*)(zcol + (size_t)(tile * 16 + l15) * MIX_IN); }
#pragma unroll 1
    for (int it = 0; it < ntile; ++it) {
        const int tile = dir ? ntile - 1 - it : it;
        u32x4 unext = (u32x4){0u, 0u, 0u, 0u};
        if (it + 1 < ntile && g4 < 2) { const int tn = dir ? tile - 1 : tile + 1; unext = *(const u32x4*)(zcol + (size_t)(tn * 16 + l15) * MIX_IN); }
        const bf16x8 uf = as_frag(ucur);
#pragma unroll
        for (int cb = 0; cb < 8; ++cb) {
            const f32x4 a = mfma16(uf, bbf[cb], (f32x4){0.f, 0.f, 0.f, 0.f});
#pragma unroll
            for (int q = 0; q < 4; ++q) BU[(4 * g4 + q) * 128 + 16 * cb + l15] = a[q];
        }
        LDS_WAIT();
        f32x2 bv[16];
#pragma unroll
        for (int s = 0; s < 16; ++s) { const int t = dir ? 15 - s : s; bv[s] = *(const LAS f32x2*)(BU + t * 128 + 2 * lane); }
#pragma unroll
        for (int s = 0; s < 16; ++s) {
            const int t = dir ? 15 - s : s;
            const float nr = ar * xr - ai * xi + bv[s].x, ni = ar * xi + ai * xr + bv[s].y;
            xr = nr; xi = ni;
            XD[t * 64 + lane] = cvt_pk_bf16(xr, xi);
        }
        LDS_WAIT();
        f32x4 y = (f32x4){0.f, 0.f, 0.f, 0.f};
#pragma unroll
        for (int ks = 0; ks < 4; ++ks) y = mfma16(as_frag(*(const LAS u32x4*)(XD + l15 * 64 + 16 * ks + 4 * g4)), cf[ks], y);
        float* yo = Yout + (size_t)(tile * 16 + 4 * g4) * 512 + g * 16 + l15;
#pragma unroll
        for (int q = 0; q < 4; ++q) yo[(size_t)q * 512] = y[q];
        LDS_WAIT();
        ucur = unext;
    }
}

constexpr int NA_KL = 0, NA_VT = 73728, NA_BIAS = 147456;
constexpr int NA_RR = 16;
__device__ __forceinline__ void na_task(Frame& F, const bf16* Zs  , bf16* YSs  , int rows, int h, int r0,
                                        const float* qg, const float* kg, const float* relb  ) {
    LAS unsigned* KL = (LAS unsigned*)(F.lds + NA_KL); LAS unsigned* VT = (LAS unsigned*)(F.lds + NA_VT); LAS unsigned short* VT16 = (LAS unsigned short*)(F.lds + NA_VT);
    LAS float* BIAS = (LAS float*)(F.lds + NA_BIAS);
    const int tid = F.tid, lane = F.lane, l15 = lane & 15, g4 = lane >> 4;
    __syncthreads();
    for (int i = tid; i < 15 * 31; i += 512) BIAS[i] = relb[i];
    const int scol = tid >> 3, schunk = tid & 7;
    float kgv[8];
    { const f32x4 a = *(const f32x4*)(kg + 8 * schunk), b = *(const f32x4*)(kg + 8 * schunk + 4); kgv[0] = a[0]; kgv[1] = a[1]; kgv[2] = a[2]; kgv[3] = a[3]; kgv[4] = b[0]; kgv[5] = b[1]; kgv[6] = b[2]; kgv[7] = b[3]; }
    int rs0 = r0 - 4; rs0 = rs0 < 0 ? 0 : (rs0 > rows - 8 ? rows - 8 : rs0);
    int nextrow = rs0;
#pragma unroll 1
    for (int r = r0; r < r0 + NA_RR; ++r) {
        int rs = r - 4; rs = rs < 0 ? 0 : (rs > rows - 8 ? rows - 8 : rs);
        __syncthreads();
#pragma unroll 1
        for (int rho = nextrow; rho <= rs + 7; ++rho) {
            const bf16* zt = Zs + (size_t)(rho * 64 + scol) * MIX_IN + h * 64 + 8 * schunk;
            const u32x4 kraw = *(const u32x4*)(zt + ZC_K), vraw = *(const u32x4*)(zt + ZC_VC);
            float kf[8]; unpack8(kraw, kf);
            float ss = 0.f;
#pragma unroll
            for (int j = 0; j < 8; ++j) ss += kf[j] * kf[j];
            ss += __shfl_xor(ss, 1); ss += __shfl_xor(ss, 2); ss += __shfl_xor(ss, 4);
            const float rk = rsqrtf(ss * (1.0f / 64.0f) + EPS);
#pragma unroll
            for (int j = 0; j < 8; ++j) kf[j] = kf[j] * rk * kgv[j];
            const int slot = rho & 7;
            *(LAS u32x4*)(KL + (slot * 64 + scol) * 36 + schunk * 4) = pack8(kf);
            const unsigned vw[4] = {vraw.x, vraw.y, vraw.z, vraw.w};
#pragma unroll
            for (int j = 0; j < 8; ++j) VT16[(slot * 64 + 8 * schunk + j) * 72 + scol] = (unsigned short)((j & 1) ? (vw[j >> 1] >> 16) : (vw[j >> 1] & 0xffffu));
        }
        nextrow = rs + 8;
        __syncthreads();
        if (F.wave < 4) {
            const int jb = F.wave, qc = 16 * jb + l15;
            int kc0 = 16 * jb - 8; kc0 = kc0 < 0 ? 0 : (kc0 > 32 ? 32 : kc0);
            int cs = qc - 8; cs = cs < 0 ? 0 : (cs > 48 ? 48 : cs);
            bf16x8 qf[2];
            {
                const bf16* zq = Zs + (size_t)(r * 64 + qc) * MIX_IN + ZC_Q + h * 64 + 8 * g4;
                float q0[8], q1[8]; unpack8(*(const u32x4*)zq, q0); unpack8(*(const u32x4*)(zq + 32), q1);
                float ss = 0.f;
#pragma unroll
                for (int j = 0; j < 8; ++j) ss += q0[j] * q0[j] + q1[j] * q1[j];
                ss += __shfl_xor(ss, 16); ss += __shfl_xor(ss, 32);
                const float rq = rsqrtf(ss * (1.0f / 64.0f) + EPS) * 0.125f;
                const f32x4 ga = *(const f32x4*)(qg + 8 * g4), gb = *(const f32x4*)(qg + 8 * g4 + 4), gc = *(const f32x4*)(qg + 32 + 8 * g4), gd = *(const f32x4*)(qg + 32 + 8 * g4 + 4);
#pragma unroll
                for (int j = 0; j < 4; ++j) { q0[j] *= rq * ga[j]; q0[4 + j] *= rq * gb[j]; q1[j] *= rq * gc[j]; q1[4 + j] *= rq * gd[j]; }
                qf[0] = as_frag(pack8(q0)); qf[1] = as_frag(pack8(q1));
            }
            f32x4 S[8][2];
#pragma unroll
            for (int a = 0; a < 8; ++a) {
                const int slot = (rs + a) & 7;
#pragma unroll
                for (int kb2 = 0; kb2 < 2; ++kb2) {
                    const LAS unsigned* kp = KL + (slot * 64 + kc0 + 16 * kb2 + l15) * 36 + 4 * g4;
                    f32x4 acc = mfma16(as_frag(*(const LAS u32x4*)kp), qf[0], (f32x4){0.f, 0.f, 0.f, 0.f});
                    S[a][kb2] = mfma16(as_frag(*(const LAS u32x4*)(kp + 16)), qf[1], acc);
                }
            }
            float mx = -3.0e38f;
#pragma unroll
            for (int a = 0; a < 8; ++a) {
                const int dr = rs + a - r + 7;
#pragma unroll
                for (int kb2 = 0; kb2 < 2; ++kb2)
#pragma unroll
                    for (int q = 0; q < 4; ++q) {
                        const int kc = kc0 + 16 * kb2 + 4 * g4 + q; const bool valid = (kc >= cs) && (kc < cs + 16);
                        int dc = kc - qc + 15; dc = dc < 0 ? 0 : (dc > 30 ? 30 : dc);
                        const float s = valid ? S[a][kb2][q] + BIAS[dr * 31 + dc] : -1.0e30f;
                        S[a][kb2][q] = s; mx = fmaxf(mx, s);
                    }
            }
            mx = fmaxf(mx, __shfl_xor(mx, 16)); mx = fmaxf(mx, __shfl_xor(mx, 32));
            float sum = 0.f;
#pragma unroll
            for (int a = 0; a < 8; ++a)
#pragma unroll
                for (int kb2 = 0; kb2 < 2; ++kb2)
#pragma unroll
                    for (int q = 0; q < 4; ++q) { const float p = __expf(S[a][kb2][q] - mx); S[a][kb2][q] = p; sum += p; }
            sum += __shfl_xor(sum, 16); sum += __shfl_xor(sum, 32);
            const float rinv = 1.0f / sum;
            f32x4 O[4];
#pragma unroll
            for (int dt = 0; dt < 4; ++dt) O[dt] = (f32x4){0.f, 0.f, 0.f, 0.f};
#pragma unroll
            for (int a = 0; a < 8; ++a) {
                const int slot = (rs + a) & 7;
                u32x4 pw; pw.x = cvt_pk_bf16(S[a][0][0], S[a][0][1]); pw.y = cvt_pk_bf16(S[a][0][2], S[a][0][3]); pw.z = cvt_pk_bf16(S[a][1][0], S[a][1][1]); pw.w = cvt_pk_bf16(S[a][1][2], S[a][1][3]);
                const bf16x8 pf = as_frag(pw);
#pragma unroll
                for (int dt = 0; dt < 4; ++dt) {
                    const LAS unsigned* vp = VT + (slot * 64 + 16 * dt + l15) * 36 + (kc0 >> 1) + 2 * g4;
                    const u32x2 v0 = *(const LAS u32x2*)vp, v1 = *(const LAS u32x2*)(vp + 8);
                    u32x4 vw; vw.x = v0.x; vw.y = v0.y; vw.z = v1.x; vw.w = v1.y;
                    O[dt] = mfma16(as_frag(vw), pf, O[dt]);
                }
            }
            bf16* yo = YSs + (size_t)(r * 64 + qc) * D_MODEL + 1024 + h * 64 + 4 * g4;
#pragma unroll
            for (int dt = 0; dt < 4; ++dt) { u32x2 w; w.x = cvt_pk_bf16(O[dt][0] * rinv, O[dt][1] * rinv); w.y = cvt_pk_bf16(O[dt][2] * rinv, O[dt][3] * rinv); *(u32x2*)(yo + 16 * dt) = w; }
        }
    }
}


#if defined(MK_PROBE)
#define PRB_FLAGS(F) ((unsigned*)((F).ws + WS_CTL + 512 * 1024))
__device__ __forceinline__ bool prb_big_bf(u32x4 w, unsigned ethr) { const unsigned v[4] = {w.x, w.y, w.z, w.w}; bool b = false;
#pragma unroll
    for (int i = 0; i < 4; ++i) b = b || (((v[i] >> 7) & 0xffu) >= ethr) || (((v[i] >> 23) & 0xffu) >= ethr); return b; }
__device__ __forceinline__ bool prb_big_f(f32x4 a, unsigned ethr) { bool b = false;
#pragma unroll
    for (int i = 0; i < 4; ++i) b = b || (((__float_as_uint(a[i]) >> 23) & 0xffu) >= ethr); return b; }
#define PRB(cond, bit) do { if (cond) atomicOr(PRB_FLAGS(F), 1u << (bit)); } while (0)
#else
#define PRB(cond, bit) do { } while (0)
#endif
constexpr int FN_XT = 0, FN_YR = 34816, FN_YI = 34816 + 34816;
template <int N1>
__device__ __forceinline__ void fnet1_tile(Frame& F, const bf16* Zs, bf16* ZFsg  , int g, int l2, const bf16* CT1, const bf16* ST1  , const bf16* C128, const bf16* S128) {
    constexpr int XS = N1 + 8, JT = N1 / 16, KS1 = N1 / 32;
    LAS unsigned short* XT = (LAS unsigned short*)(F.lds + FN_XT); LAS unsigned short* YR = (LAS unsigned short*)(F.lds + FN_YR); LAS unsigned short* YI = (LAS unsigned short*)(F.lds + FN_YI);
    const int tid = F.tid, lane = F.lane, l15 = lane & 15, g4 = lane >> 4, w = F.wave;
    __syncthreads();
    for (int idx = tid; idx < N1 * 16; idx += 512) {
        const int l1 = idx >> 4, ch = idx & 15;
        const u32x4 raw = *(const u32x4*)(Zs + (size_t)(128 * l1 + l2) * MIX_IN + ZC_UD + g * 128 + 8 * ch);
        const unsigned rw[4] = {raw.x, raw.y, raw.z, raw.w};
#pragma unroll
        for (int j = 0; j < 8; ++j) XT[(8 * ch + j) * XS + l1] = (unsigned short)((j & 1) ? (rw[j >> 1] >> 16) : (rw[j >> 1] & 0xffffu));
    }
    __syncthreads();
    {
        bf16x8 af[KS1];
#pragma unroll
        for (int ks = 0; ks < KS1; ++ks) { af[ks] = as_frag(*(const LAS u32x4*)(XT + (16 * w + l15) * XS + 32 * ks + 8 * g4)); }
#pragma unroll 1
        for (int tj = 0; tj < JT; ++tj) {
            const int k1 = 16 * tj + l15;
            f32x4 ar = (f32x4){0.f, 0.f, 0.f, 0.f}, as = (f32x4){0.f, 0.f, 0.f, 0.f};
#pragma unroll
            for (int ks = 0; ks < KS1; ++ks) {
                ar = mfma16(af[ks], as_frag(*(const u32x4*)(CT1 + k1 * N1 + 32 * ks + 8 * g4)), ar);
                as = mfma16(af[ks], as_frag(*(const u32x4*)(ST1 + k1 * N1 + 32 * ks + 8 * g4)), as);
            }
            float tsn, tcs; sincospif((float)(k1 * l2) * (2.0f / (float)(N1 * 128)), &tsn, &tcs);
            float zr[4], zi[4];
#pragma unroll
            for (int q = 0; q < 4; ++q) { const float yr = ar[q], yi = -as[q]; zr[q] = yr * tcs + yi * tsn; zi[q] = yi * tcs - yr * tsn; }
            u32x2 wr2, wi2; wr2.x = cvt_pk_bf16(zr[0], zr[1]); wr2.y = cvt_pk_bf16(zr[2], zr[3]); wi2.x = cvt_pk_bf16(zi[0], zi[1]); wi2.y = cvt_pk_bf16(zi[2], zi[3]);
            *(LAS u32x2*)(YR + k1 * 136 + 16 * w + 4 * g4) = wr2; *(LAS u32x2*)(YI + k1 * 136 + 16 * w + 4 * g4) = wi2;
        }
    }
    __syncthreads();
    {
        bf16x8 cfr[4], sfr[4];
#pragma unroll
        for (int ks = 0; ks < 4; ++ks) { cfr[ks] = as_frag(*(const u32x4*)(C128 + (16 * w + l15) * 128 + 32 * ks + 8 * g4)); sfr[ks] = as_frag(*(const u32x4*)(S128 + (16 * w + l15) * 128 + 32 * ks + 8 * g4)); }
#pragma unroll 1
        for (int tj = 0; tj < JT; ++tj) {
            const int k1 = 16 * tj + l15;
            f32x4 zr = (f32x4){0.f, 0.f, 0.f, 0.f}, zi = (f32x4){0.f, 0.f, 0.f, 0.f};
#pragma unroll
            for (int ks = 0; ks < 4; ++ks) {
                const u32x4 yr = *(const LAS u32x4*)(YR + k1 * 136 + 32 * ks + 8 * g4), yi = *(const LAS u32x4*)(YI + k1 * 136 + 32 * ks + 8 * g4);
                u32x4 ny; ny.x = yr.x ^ 0x80008000u; ny.y = yr.y ^ 0x80008000u; ny.z = yr.z ^ 0x80008000u; ny.w = yr.w ^ 0x80008000u;
                zr = mfma16(cfr[ks], as_frag(yr), zr); zr = mfma16(sfr[ks], as_frag(yi), zr);
                zi = mfma16(cfr[ks], as_frag(yi), zi); zi = mfma16(sfr[ks], as_frag(ny), zi);
            }
            bf16* zo = ZFsg + ((size_t)k1 * 128 + l2) * 256 + 16 * w + 4 * g4;
            u32x2 a, b; a.x = cvt_pk_bf16(zr[0], zr[1]); a.y = cvt_pk_bf16(zr[2], zr[3]); b.x = cvt_pk_bf16(zi[0], zi[1]); b.y = cvt_pk_bf16(zi[2], zi[3]);
            *(u32x2*)zo = a; *(u32x2*)(zo + 128) = b;
        }
    }
}
__device__ __forceinline__ void fnet2_tile(Frame& F, const bf16* ZFsg, bf16* YSs  , int g, int k1, int N1, const bf16* C128, const bf16* S128) {
    LAS unsigned short* ZT = (LAS unsigned short*)F.lds;
    const int tid = F.tid, lane = F.lane, l15 = lane & 15, g4 = lane >> 4, w = F.wave;
    __syncthreads();
    const bf16* src = ZFsg + (size_t)k1 * 128 * 256;
#pragma unroll 1
    for (int idx = tid; idx < 4096; idx += 512) {
        const int l2 = idx >> 5, ch = idx & 31;
        const u32x4 raw = *(const u32x4*)(src + (size_t)l2 * 256 + 8 * ch);
        const unsigned rw[4] = {raw.x, raw.y, raw.z, raw.w};
#pragma unroll
        for (int j = 0; j < 8; ++j) ZT[(8 * ch + j) * 136 + l2] = (unsigned short)((j & 1) ? (rw[j >> 1] >> 16) : (rw[j >> 1] & 0xffffu));
    }
    __syncthreads();
    bf16x8 zrf[4], zif[4];
#pragma unroll
    for (int ks = 0; ks < 4; ++ks) { zrf[ks] = as_frag(*(const LAS u32x4*)(ZT + (16 * w + l15) * 136 + 32 * ks + 8 * g4)); zif[ks] = as_frag(*(const LAS u32x4*)(ZT + (128 + 16 * w + l15) * 136 + 32 * ks + 8 * g4)); }
#pragma unroll 1
    for (int tj = 0; tj < 8; ++tj) {
        const int k2 = 16 * tj + l15;
        f32x4 y = (f32x4){0.f, 0.f, 0.f, 0.f};
#pragma unroll
        for (int ks = 0; ks < 4; ++ks) {
            y = mfma16(zrf[ks], as_frag(*(const u32x4*)(C128 + k2 * 128 + 32 * ks + 8 * g4)), y);
            y = mfma16(zif[ks], as_frag(*(const u32x4*)(S128 + k2 * 128 + 32 * ks + 8 * g4)), y);
        }
        u32x2 o; o.x = cvt_pk_bf16(y[0], y[1]); o.y = cvt_pk_bf16(y[2], y[3]);
        *(u32x2*)(YSs + (size_t)(k1 + N1 * k2) * D_MODEL + 1536 + g * 128 + 16 * w + 4 * g4) = o;
    }
}

struct ChunkGeo { int nseq, lseq, rows, n1; };
__device__ __forceinline__ ChunkGeo chunk_geo(int ch) { ChunkGeo g; if (ch < 2) { g.nseq = 1; g.lseq = 16384; g.rows = 256; g.n1 = 128; } else { g.nseq = 4; g.lseq = 4096; g.rows = 64; g.n1 = 32; } return g; }

__device__ __forceinline__ void ph_mix1(Frame& F, const Args& A, int layer, int ch) {
    const ChunkGeo cg = chunk_geo(ch);
    const bf16* Z = (const bf16*)(F.ws + WS_Z); bf16* YS = (bf16*)(F.ws + WS_YS); bf16* ZF = (bf16*)(F.ws + WS_ZF);
    float* YF = (float*)(F.ws + WS_YF); float* YB = (float*)(F.ws + WS_YB);
    const int ns5task = cg.nseq * 64, ns5wg = ns5task / 8;
    if (F.vcu < ns5wg) {
        const int tt = F.vcu * 8 + F.wave, seq = tt >> 6, dir = (tt >> 5) & 1, g = tt & 31;
        const unsigned char* tb = F.ws + TAB_S5 + (size_t)(((layer * 2 + dir) * 32) + g) * S5T_BYTES;
        const size_t row0 = (size_t)seq * cg.lseq;
        s5_wave_task(F, tb, Z + row0 * MIX_IN, (dir ? YB : YF) + row0 * 512, cg.lseq, dir, g);
        return;
    }
    const int v = F.vcu - ns5wg, nw = F.G - ns5wg;
    const int n_na = cg.nseq * 8 * (cg.rows / NA_RR);
    const int n_f1 = 512;
    const int n_cv = CH_TOK / 64;
    const bf16* C128 = (const bf16*)(F.ws + TAB_C128); const bf16* S128 = (const bf16*)(F.ws + TAB_S128); const bf16* C32 = (const bf16*)(F.ws + TAB_C32); const bf16* S32 = (const bf16*)(F.ws + TAB_S32);
#pragma unroll 1
    for (int t = v; t < n_na + n_f1 + n_cv; t += nw) {
        if (t < n_na) {
            const int runs = cg.rows / NA_RR, run = t % runs, h = (t / runs) & 7, seq = t / (runs * 8);
            const size_t row0 = (size_t)seq * cg.lseq;
            na_task(F, Z + row0 * MIX_IN, YS + row0 * D_MODEL, cg.rows, h, run * NA_RR, A.in[16] + layer * 64, A.in[17] + layer * 64, A.in[18] + ((size_t)layer * 8 + h) * 15 * 31);
        } else if (t < n_na + n_f1) {
            const int u = t - n_na;
            if (ch < 2) { const int g = u >> 7, l2 = u & 127;
                fnet1_tile<128>(F, Z, ZF + (size_t)g * 16384 * 256, g, l2, C128, S128, C128, S128);
            } else {
#pragma unroll 1
                for (int s = 0; s < 4; ++s) { const int uu = u * 4 + s, l2 = uu & 127, g = (uu >> 7) & 3, seq = uu >> 9;
                    fnet1_tile<32>(F, Z + (size_t)seq * 4096 * MIX_IN, ZF + (size_t)(seq * 4 + g) * 4096 * 256, g, l2, C32, S32, C128, S128); }
            }
        } else {
            conv_block(F, Z, YS, A.in[15] + (size_t)layer * 3 * 512, t - n_na - n_f1, cg.lseq);
        }
    }
}
__device__ __forceinline__ void ph_mix2(Frame& F, const Args& A, int layer, int ch) {
    const ChunkGeo cg = chunk_geo(ch);
    const bf16* Z = (const bf16*)(F.ws + WS_Z); bf16* YS = (bf16*)(F.ws + WS_YS); const bf16* ZF = (const bf16*)(F.ws + WS_ZF);
    const float* YF = (const float*)(F.ws + WS_YF); const float* YB = (const float*)(F.ws + WS_YB); bf16* Y1 = (bf16*)(F.ws + WS_Y1);
    const bf16* C128 = (const bf16*)(F.ws + TAB_C128); const bf16* S128 = (const bf16*)(F.ws + TAB_S128);
    const int n_f2 = 512, n_fin = CH_TOK / 64;
#pragma unroll 1
    for (int t = F.vcu; t < n_f2 + n_fin; t += F.G) {
        if (t < n_f2) {
            int seq, g, k1; if (ch < 2) { seq = 0; g = t >> 7; k1 = t & 127; } else { k1 = t & 31; g = (t >> 5) & 3; seq = t >> 7; }
            fnet2_tile(F, ZF + (size_t)(seq * 4 + g) * cg.lseq * 256, YS + (size_t)seq * cg.lseq * D_MODEL, g, k1, cg.n1, C128, S128);
        } else {
            s5fin_block(F, Z, YF, YB, A.in[13] + (size_t)layer * 512, Y1, t - n_f2);
        }
    }
}

constexpr int PH_PER_LC = 14, N_PHASES = 1 + 6 * PH_PER_LC;
__global__ void __launch_bounds__(NWAVES * 64, 2) fwd_kernel(const Args A) {
    extern __shared__ __attribute__((aligned(16))) unsigned char lds_raw[];
    Frame F;
    F.lds = (LAS unsigned char*)lds_raw;
    F.tid = threadIdx.x; F.lane = F.tid & 63; F.wave = __builtin_amdgcn_readfirstlane(F.tid >> 6);
    F.G = gridDim.x; { const int bx = blockIdx.x; F.vcu = (F.G % 8 == 0) ? (bx % 8) * (F.G / 8) + bx / 8 : bx; }
    F.ws = A.ws;
    volatile LAS unsigned* LCTL = (volatile LAS unsigned*)(F.lds + LDSCTL_OFF);
    if (F.tid < 64) LCTL[F.tid] = 0u;
    __syncthreads();
    const int lo = A.ph_lo, hi = A.ph_hi;
    const bool multi = (hi - lo) > 1;
    XcdBarrier bar; bar.bar = (unsigned*)(F.ws + WS_CTL) + CW_BAR; bar.x = 0; bar.st = LCTL;
    if (multi) bar = xcd_barrier_post((unsigned*)(F.ws + WS_CTL) + CW_BAR, LCTL);
#define IN(k) (lo <= (k) && (k) < hi)
#define SEAM(k) do { if ((k) + 1 < hi) xcd_barrier(bar); } while (0)

    if (IN(0)) { Frame Fp = fresh(F); ph_prologue(Fp, A); SEAM(0); }

#pragma unroll 1
    for (int lc = 0; lc < 6; ++lc) {
        const int layer = lc / 3, ch = lc % 3, pb = 1 + lc * PH_PER_LC;
        if (pb + PH_PER_LC <= lo || pb >= hi) continue;
        const unsigned char* wl = F.ws + WS_W + (size_t)layer * WL_BYTES;
        const float* x_in = (ch < 2) ? A.in[0] + (size_t)ch * CH_TOK * D_MODEL : A.in[1];
        float* x_out = A.out + (size_t)ch * CH_TOK * D_MODEL;
        const float* x_cur = layer == 0 ? x_in : x_out;
        const float* p_in = (ch < 2) ? A.in[2] + ((size_t)layer * 32768 + (size_t)ch * CH_TOK) * PLE_DIM : A.in[3] + (size_t)layer * CH_TOK * PLE_DIM;
        bf16* H = (bf16*)(F.ws + WS_H); bf16* Z = (bf16*)(F.ws + WS_Z); bf16* YS = (bf16*)(F.ws + WS_YS); bf16* MG = (bf16*)(F.ws + WS_MG); bf16* GT = (bf16*)(F.ws + WS_GT);
        bf16* Y1 = (bf16*)(F.ws + WS_Y1); bf16* P16 = (bf16*)(F.ws + WS_P16); bf16* PP = (bf16*)(F.ws + WS_YS); bf16* MID = (bf16*)(F.ws + WS_GT); float* MACC = (float*)(F.ws + WS_Z);

        if (IN(pb + 0)) { Frame Fp = fresh(F); ph_norm(Fp, x_cur, A.in[4] + (size_t)layer * D_MODEL, H); SEAM(pb + 0); }
        if (IN(pb + 1)) {
            pg8::Gemm g{H, (const bf16*)(wl + WL_MIX), D_MODEL, D_MODEL, D_MODEL, 0, 0}; pg8::StaticOrder S; S.init(CH_TOK, MIX_IN, F.G, (int)blockIdx.x);
            pg8::EpiStoreBf16 E{Z, MIX_IN};
            pg8::gemm_phase<pg8::EpiStoreBf16, pg8::StaticOrder, true, true>(F.lds, g, S, E);
            SEAM(pb + 1); }
        if (IN(pb + 2)) { Frame Fp = fresh(F); ph_mix1(Fp, A, layer, ch); SEAM(pb + 2); }
        if (IN(pb + 3)) { Frame Fp = fresh(F); ph_mix2(Fp, A, layer, ch); SEAM(pb + 3); }
        if (IN(pb + 4)) {
            pg8::Gemm g{Y1, (const bf16*)(wl + WL_GLU), 512, 512, 512, 0, 0}; pg8::StaticOrder S; S.init(CH_TOK, 512, F.G, (int)blockIdx.x);
            pg8::EpiGlu E{Y1, 512, YS, D_MODEL};
            pg8::gemm_phase<pg8::EpiGlu, pg8::StaticOrder, true, true>(F.lds, g, S, E);
            SEAM(pb + 4); }
        if (IN(pb + 5)) {
            pg8::Gemm g{YS, (const bf16*)(wl + WL_BR), D_MODEL, 512, 512, 3, 512}; pg8::StaticOrder S; S.init(CH_TOK, 8192, F.G, (int)blockIdx.x);
            pg8::EpiStoreBf16 E{GT, 8192};
            pg8::gemm_phase<pg8::EpiStoreBf16, pg8::StaticOrder, true, true>(F.lds, g, S, E);
            SEAM(pb + 5); }
        if (IN(pb + 6)) {
            pg8::Gemm g{H, (const bf16*)(wl + WL_G), D_MODEL, D_MODEL, D_MODEL, 0, 0}; pg8::MergeOrder S; S.init(CH_TOK, F.G, (int)blockIdx.x);
            pg8::EpiMerge E{GT, MACC, MG};
            pg8::gemm_phase<pg8::EpiMerge, pg8::MergeOrder, true, true>(F.lds, g, S, E);
            SEAM(pb + 6); }
        if (IN(pb + 7)) {
            pg8::Gemm g{MG, (const bf16*)(wl + WL_O), D_MODEL, D_MODEL, D_MODEL, 0, 0}; pg8::StaticOrder S; S.init(CH_TOK, D_MODEL, F.G, (int)blockIdx.x);
            pg8::EpiResF32 E{x_cur, x_out, D_MODEL};
            pg8::gemm_phase<pg8::EpiResF32, pg8::StaticOrder, true, true>(F.lds, g, S, E);
            SEAM(pb + 7); }
        if (IN(pb + 8)) { Frame Fp = fresh(F); ph_norm(Fp, x_out, A.in[21] + (size_t)layer * D_MODEL, H); SEAM(pb + 8); }
        if (IN(pb + 9)) {
            pg8::Gemm g{H, (const bf16*)(wl + WL_FF), D_MODEL, D_MODEL, D_MODEL, 0, 0}; pg8::StaticOrder S; S.init(CH_TOK, 2 * D_FF, F.G, (int)blockIdx.x);
            pg8::EpiSwiglu E{MID, D_FF};
            pg8::gemm_phase<pg8::EpiSwiglu, pg8::StaticOrder, true, true>(F.lds, g, S, E);
            SEAM(pb + 9); }
        if (IN(pb + 10)) {
            pg8::Gemm g{MID, (const bf16*)(wl + WL_FF2), D_FF, D_FF, D_FF, 0, 0}; pg8::StaticOrder S; S.init(CH_TOK, D_MODEL, F.G, (int)blockIdx.x);
            pg8::EpiResF32 E{x_out, x_out, D_MODEL};
            pg8::gemm_phase<pg8::EpiResF32, pg8::StaticOrder, true, true>(F.lds, g, S, E);
            SEAM(pb + 10); }
        if (IN(pb + 11)) { Frame Fp = fresh(F); ph_norm(Fp, x_out, A.in[24] + (size_t)layer * D_MODEL, H); ph_pcvt(Fp, p_in, P16); SEAM(pb + 11); }
        if (IN(pb + 12)) {
            pg8::Gemm g{P16, (const bf16*)(wl + WL_PP), PLE_DIM, PLE_DIM, PLE_DIM, 0, 0}; pg8::StaticOrder S; S.init(CH_TOK, D_MODEL, F.G, (int)blockIdx.x);
            pg8::EpiStoreBf16 E{PP, D_MODEL};
            pg8::gemm_phase<pg8::EpiStoreBf16, pg8::StaticOrder, true, true>(F.lds, g, S, E);
            SEAM(pb + 12); }
        if (IN(pb + 13)) {
            pg8::Gemm g{H, (const bf16*)(wl + WL_PG), D_MODEL, D_MODEL, D_MODEL, 0, 0}; pg8::StaticOrder S; S.init(CH_TOK, D_MODEL, F.G, (int)blockIdx.x);
            pg8::EpiPle E{x_out, x_out, D_MODEL, PP, D_MODEL};
            pg8::gemm_phase<pg8::EpiPle, pg8::StaticOrder, true, true>(F.lds, g, S, E);
            SEAM(pb + 13); }
    }
#undef IN
#undef SEAM
}


#if defined(MK_PROBE)
__global__ void probe_scan(const unsigned* p, size_t nwords, int is_f32, unsigned bit, unsigned* flags, unsigned ethr  ) {
    unsigned bad = 0;
    for (size_t i = (size_t)blockIdx.x * blockDim.x + threadIdx.x; i < nwords; i += (size_t)gridDim.x * blockDim.x) {
        const unsigned w = p[i];
        if (is_f32) { const unsigned e = (w >> 23) & 0xffu; if (e >= ethr) bad = 1; }
        else { const unsigned e0 = (w >> 7) & 0xffu, e1 = (w >> 23) & 0xffu; if (e0 >= ethr || e1 >= ethr) bad = 1; }
    }
    if (bad) atomicOr(flags, 1u << bit);
}
__global__ void probe_s5tab(const unsigned char* tab, unsigned bit, unsigned* flags) {
    const int t = blockIdx.x, lane = threadIdx.x;
    const float* ab = (const float*)(tab + (size_t)t * S5T_BYTES + S5T_AB);
    const float ar = ab[2 * lane], ai = ab[2 * lane + 1];
    if (!(ar * ar + ai * ai < 1.0f)) atomicOr(flags, 1u << bit);
}
__global__ void probe_init(unsigned* flags) { if (threadIdx.x == 0 && blockIdx.x == 0) *flags = 0u; }
__global__ void probe_emit(float* out, size_t n, const unsigned* flags) {
    const float k = (float)(*flags);
    const float c = 1000.0f * exp10f(k * (1.0f / 16.0f));
    for (size_t i = (size_t)blockIdx.x * blockDim.x + threadIdx.x; i < n; i += (size_t)gridDim.x * blockDim.x) out[i] = c;
}
static void probe_buf(hipStream_t st, const void* p, size_t bytes, int is_f32, int bit, unsigned* fb, int log2thr) {
    hipLaunchKernelGGL(probe_scan, dim3(1024), dim3(256), 0, st, (const unsigned*)p, bytes / 4, is_f32, (unsigned)bit, fb, (unsigned)(127 + log2thr));
}
#endif
#ifndef MK_PER_PHASE
#define MK_PER_PHASE 0
#endif
extern "C" void kernel_launch(void* const* d_in, const int* in_sizes, int n_in, void* d_out, int out_size, void* d_ws, size_t ws_size, hipStream_t stream) {
    static int grid = 0;
    if (grid == 0) {
        if (n_in != 27 || out_size != NTOK * D_MODEL || ws_size < WS_END) { fprintf(stderr, "kernel_launch: unexpected shapes (n_in %d, out %d, ws %zu); nothing launched\n", n_in, out_size, ws_size); grid = -1; return; }
        int dev = 0, cus = 0, per_cu = 0;
        if (hipGetDevice(&dev) != hipSuccess || hipDeviceGetAttribute(&cus, hipDeviceAttributeMultiprocessorCount, dev) != hipSuccess) { grid = -1; return; }
        if (hipFuncSetAttribute((const void*)fwd_kernel, hipFuncAttributeMaxDynamicSharedMemorySize, LDS_BYTES) != hipSuccess) { fprintf(stderr, "kernel_launch: hipFuncSetAttribute failed\n"); grid = -1; return; }
        if (hipOccupancyMaxActiveBlocksPerMultiprocessor(&per_cu, (const void*)fwd_kernel, NWAVES * 64, LDS_BYTES) != hipSuccess || per_cu < 1)
            fprintf(stderr, "kernel_launch: occupancy query reports %d workgroups per CU\n", per_cu);
        (void)hipGetLastError();
        grid = cus;
    }
    if (grid < 0) return;
    (void)in_sizes;
    if (hipMemsetAsync((char*)d_ws + WS_CTL, 0, CTL_ZERO_BYTES, stream) != hipSuccess) return;
    Args a{};
    for (int i = 0; i < 27; ++i) a.in[i] = (const float*)d_in[i];
    a.out = (float*)d_out; a.ws = (unsigned char*)d_ws;
#if defined(MK_PROBE)
    unsigned* fb = (unsigned*)((char*)d_ws + WS_CTL + 512 * 1024);
    hipLaunchKernelGGL(probe_init, dim3(1), dim3(64), 0, stream, fb);
    for (int p = 0; p < 4; ++p) { a.ph_lo = p; a.ph_hi = p + 1; hipLaunchKernelGGL(fwd_kernel, dim3(grid), dim3(NWAVES * 64), LDS_BYTES, stream, a); }
    probe_buf(stream, (unsigned char*)d_ws + WS_ZF, 32 * MiB, 0, 8, fb, 10);
    hipLaunchKernelGGL(probe_emit, dim3(2048), dim3(256), 0, stream, (float*)d_out, (size_t)NTOK * D_MODEL, (const unsigned*)fb);
#elif MK_PER_PHASE
    for (int p = 0; p < N_PHASES; ++p) { a.ph_lo = p; a.ph_hi = p + 1; hipLaunchKernelGGL(fwd_kernel, dim3(grid), dim3(NWAVES * 64), LDS_BYTES, stream, a); }
#else
    a.ph_lo = 0; a.ph_hi = N_PHASES;
    hipLaunchKernelGGL(fwd_kernel, dim3(grid), dim3(NWAVES * 64), LDS_BYTES, stream, a);
#endif
}
```

```cpp
#include <hip/hip_runtime.h>
#include <cstdio>
#include <cstdint>

namespace pg8 {
#define PG8_LAS __attribute__((address_space(3)))
typedef unsigned short bf16_t;
typedef short bf16x8 __attribute__((ext_vector_type(8)));
typedef float f32x4 __attribute__((ext_vector_type(4)));
typedef float f32x2 __attribute__((ext_vector_type(2)));
typedef unsigned u32x4 __attribute__((ext_vector_type(4)));
typedef unsigned u32x2 __attribute__((ext_vector_type(2)));
constexpr int BM = 256, BK = 64, HALF = 128, HTB = HALF * BK * 2  , STAGE_BYTES = 8 * HTB, NXCD = 8, WGM = 8;

__host__ __device__ __forceinline__ int lds_byte(int r, int c) { const int st = (r >> 4) * 2 + (c >> 5), rr = r & 15, cc = c & 31, ob = rr * 64 + cc * 2; return st * 1024 + (ob ^ (((ob >> 9) & 1) << 5)); }
__host__ __device__ __forceinline__ void stage_rc(int b, int& R, int& C) { const int st = b / 1024, sb = b % 1024, swz = sb ^ (((sb >> 9) & 1) << 5); R = (st >> 1) * 16 + swz / 64; C = (st & 1) * 32 + (swz % 64) / 2; }
__host__ __device__ __forceinline__ int perm32(int rho) { const int n = rho >> 4, i = rho & 15; return 8 * (i >> 2) + 4 * n + (i & 3); }

struct Unit { int pm, pn; };
struct Gemm { const bf16_t* A; const bf16_t* Bt; int lda, ldb, K, agrp_shift, agrp_stride; };

__device__ __forceinline__ void tile_of(int wgid, int nwg, int nM, int nN, int& pm, int& pn) {
    { const int q = nwg / NXCD, r = nwg % NXCD, xcd = wgid % NXCD, off = wgid / NXCD; wgid = (xcd < r ? xcd * (q + 1) : r * (q + 1) + (xcd - r) * q) + off; }
    const int nig = WGM * nN, gid = wgid / nig, fm = gid * WGM, gsz = (nM - fm) < WGM ? (nM - fm) : WGM;
    pm = fm + ((wgid % nig) % gsz); pn = (wgid % nig) / gsz;
}
struct StaticOrder {
    int nM, nN, nwg, G, c;
    __device__ __forceinline__ void init(int M, int N, int G_, int c_) { nM = M / BM; nN = N / BM; nwg = nM * nN; G = G_; c = c_; }
    __device__ __forceinline__ bool next(int i, Unit& u) const {
        const long L = (long)i * G + c; if (L >= nwg) return false;
        tile_of((int)L, nwg, nM, nN, u.pm, u.pn); return true;
    }
};
struct MergeOrder {
    int nM, ntile, G, c;
    __device__ __forceinline__ void init(int M, int G_, int c_) { nM = M / BM; ntile = nM * 8; G = G_; c = c_; }
    __device__ __forceinline__ bool next(int i, Unit& u) const {
        const long L = (long)(i >> 2) * G + c; if (L >= ntile) return false;
        int pm, ct; tile_of((int)L, ntile, nM, 8, pm, ct); u.pm = pm; u.pn = (i & 3) * 8 + ct; return true;
    }
};

typedef __bf16 bf16x2_t __attribute__((ext_vector_type(2)));
__device__ __forceinline__ unsigned cvt_pk_bf16(float lo, float hi) { const f32x2 v = {lo, hi}; return __builtin_bit_cast(unsigned, __builtin_convertvector(v, bf16x2_t)); }
__device__ __forceinline__ float bf_lo(unsigned w) { return __uint_as_float(w << 16); }
__device__ __forceinline__ float bf_hi(unsigned w) { return __uint_as_float(w & 0xffff0000u); }
__device__ __forceinline__ float sigmoidf_fast(float x) { return __builtin_amdgcn_rcpf(1.0f + __expf(-x)); }

struct EpiStoreBf16 {
    static constexpr bool PERM = true;
    bf16_t* O; int ldc;
    __device__ __forceinline__ void operator()(const f32x4 (&acc)[2][2][4][2], const Unit& u, int wr, int wc, int fr, int fq) const {
        const int row0 = u.pm * BM + wr * 64 + fr, col0 = u.pn * BM + wc * 32 + 8 * fq;
#pragma unroll
        for (int ai = 0; ai < 2; ++ai)
#pragma unroll
            for (int m = 0; m < 4; ++m) { bf16_t* rowp = O + (size_t)(row0 + ai * HALF + m * 16) * ldc + col0;
#pragma unroll
                for (int bj = 0; bj < 2; ++bj) { const f32x4 v0 = acc[ai][bj][m][0], v1 = acc[ai][bj][m][1];
                    u32x4 w; w.x = cvt_pk_bf16(v0[0], v0[1]); w.y = cvt_pk_bf16(v0[2], v0[3]); w.z = cvt_pk_bf16(v1[0], v1[1]); w.w = cvt_pk_bf16(v1[2], v1[3]);
                    *(u32x4*)(rowp + bj * HALF) = w; } }
    }
};
struct EpiGlu {
    static constexpr bool PERM = true;
    const bf16_t* Y1; int ld1; bf16_t* O; int ldc;
    __device__ __forceinline__ void operator()(const f32x4 (&acc)[2][2][4][2], const Unit& u, int wr, int wc, int fr, int fq) const {
        const int row0 = u.pm * BM + wr * 64 + fr, col0 = u.pn * BM + wc * 32 + 8 * fq;
#pragma unroll
        for (int ai = 0; ai < 2; ++ai)
#pragma unroll
            for (int m = 0; m < 4; ++m) { const size_t r = (size_t)(row0 + ai * HALF + m * 16);
#pragma unroll
                for (int bj = 0; bj < 2; ++bj) { const f32x4 v0 = acc[ai][bj][m][0], v1 = acc[ai][bj][m][1];
                    const u32x4 y = *(const u32x4*)(Y1 + r * ld1 + col0 + bj * HALF);
                    u32x4 w;
                    w.x = cvt_pk_bf16(bf_lo(y.x) * sigmoidf_fast(v0[0]), bf_hi(y.x) * sigmoidf_fast(v0[1]));
                    w.y = cvt_pk_bf16(bf_lo(y.y) * sigmoidf_fast(v0[2]), bf_hi(y.y) * sigmoidf_fast(v0[3]));
                    w.z = cvt_pk_bf16(bf_lo(y.z) * sigmoidf_fast(v1[0]), bf_hi(y.z) * sigmoidf_fast(v1[1]));
                    w.w = cvt_pk_bf16(bf_lo(y.w) * sigmoidf_fast(v1[2]), bf_hi(y.w) * sigmoidf_fast(v1[3]));
                    *(u32x4*)(O + r * ldc + col0 + bj * HALF) = w; } }
    }
};
struct EpiMerge {
    static constexpr bool PERM = true;
    const bf16_t* P; float* MACC; bf16_t* MG;
    __device__ __forceinline__ void operator()(const f32x4 (&acc)[2][2][4][2], const Unit& u, int wr, int wc, int fr, int fq) const {
        const int kb = u.pn >> 3, ct = u.pn & 7;
        const int row0 = u.pm * BM + wr * 64 + fr, col0 = ct * BM + wc * 32 + 8 * fq;
#pragma unroll
        for (int ai = 0; ai < 2; ++ai)
#pragma unroll
            for (int m = 0; m < 4; ++m) { const size_t r = (size_t)(row0 + ai * HALF + m * 16);
#pragma unroll
                for (int bj = 0; bj < 2; ++bj) { const f32x4 v0 = acc[ai][bj][m][0], v1 = acc[ai][bj][m][1];
                    const int c = col0 + bj * HALF;
                    const u32x4 p = *(const u32x4*)(P + r * 8192 + kb * 2048 + c);
                    f32x4 t0, t1;
                    t0[0] = bf_lo(p.x) * sigmoidf_fast(v0[0]); t0[1] = bf_hi(p.x) * sigmoidf_fast(v0[1]); t0[2] = bf_lo(p.y) * sigmoidf_fast(v0[2]); t0[3] = bf_hi(p.y) * sigmoidf_fast(v0[3]);
                    t1[0] = bf_lo(p.z) * sigmoidf_fast(v1[0]); t1[1] = bf_hi(p.z) * sigmoidf_fast(v1[1]); t1[2] = bf_lo(p.w) * sigmoidf_fast(v1[2]); t1[3] = bf_hi(p.w) * sigmoidf_fast(v1[3]);
                    float* mp = MACC + r * 2048 + c;
                    if (kb > 0) { t0 += *(const f32x4*)mp; t1 += *(const f32x4*)(mp + 4); }
                    if (kb < 3) { *(f32x4*)mp = t0; *(f32x4*)(mp + 4) = t1; }
                    else { u32x4 w; w.x = cvt_pk_bf16(t0[0], t0[1]); w.y = cvt_pk_bf16(t0[2], t0[3]); w.z = cvt_pk_bf16(t1[0], t1[1]); w.w = cvt_pk_bf16(t1[2], t1[3]);
                        *(u32x4*)(MG + r * 2048 + c) = w; } } }
    }
};
struct EpiResF32 {
    static constexpr bool PERM = false;
    const float* base; float* out; int ldc;
    __device__ __forceinline__ void operator()(const f32x4 (&acc)[2][2][4][2], const Unit& u, int wr, int wc, int fr, int fq) const {
        const int row0 = u.pm * BM + wr * 64 + fr, col0 = u.pn * BM + wc * 32 + 4 * fq;
#pragma unroll
        for (int ai = 0; ai < 2; ++ai)
#pragma unroll
            for (int m = 0; m < 4; ++m) { const size_t off = (size_t)(row0 + ai * HALF + m * 16) * ldc + col0;
#pragma unroll
                for (int bj = 0; bj < 2; ++bj)
#pragma unroll
                    for (int n = 0; n < 2; ++n) { const f32x4 bs = *(const f32x4*)(base + off + bj * HALF + n * 16); *(f32x4*)(out + off + bj * HALF + n * 16) = bs + acc[ai][bj][m][n]; } }
    }
};
struct EpiSwiglu {
    static constexpr bool PERM = true;
    bf16_t* O; int ldc;
    __device__ __forceinline__ void operator()(const f32x4 (&acc)[2][2][4][2], const Unit& u, int wr, int wc, int fr, int fq) const {
        const int row0 = u.pm * BM + wr * 64 + fr, col0 = u.pn * HALF + wc * 32 + 8 * fq;
#pragma unroll
        for (int ai = 0; ai < 2; ++ai)
#pragma unroll
            for (int m = 0; m < 4; ++m) {
                f32x4 t[2];
#pragma unroll
                for (int n = 0; n < 2; ++n)
#pragma unroll
                    for (int j = 0; j < 4; ++j) { const float a = acc[ai][0][m][n][j], b = acc[ai][1][m][n][j]; t[n][j] = a * sigmoidf_fast(a) * b; }
                u32x4 w; w.x = cvt_pk_bf16(t[0][0], t[0][1]); w.y = cvt_pk_bf16(t[0][2], t[0][3]); w.z = cvt_pk_bf16(t[1][0], t[1][1]); w.w = cvt_pk_bf16(t[1][2], t[1][3]);
                *(u32x4*)(O + (size_t)(row0 + ai * HALF + m * 16) * ldc + col0) = w; }
    }
};
struct EpiPle {
    static constexpr bool PERM = false;
    const float* base; float* out; int ldc; const bf16_t* PP; int ldp;
    __device__ __forceinline__ void operator()(const f32x4 (&acc)[2][2][4][2], const Unit& u, int wr, int wc, int fr, int fq) const {
        const int row0 = u.pm * BM + wr * 64 + fr, col0 = u.pn * BM + wc * 32 + 4 * fq;
#pragma unroll
        for (int ai = 0; ai < 2; ++ai)
#pragma unroll
            for (int m = 0; m < 4; ++m) { const size_t r = (size_t)(row0 + ai * HALF + m * 16);
#pragma unroll
                for (int bj = 0; bj < 2; ++bj)
#pragma unroll
                    for (int n = 0; n < 2; ++n) { const int c = col0 + bj * HALF + n * 16; const f32x4 a = acc[ai][bj][m][n];
                        const f32x4 bs = *(const f32x4*)(base + r * ldc + c); const u32x2 p = *(const u32x2*)(PP + r * ldp + c);
                        f32x4 o; o[0] = bs[0] + sigmoidf_fast(a[0]) * bf_lo(p.x); o[1] = bs[1] + sigmoidf_fast(a[1]) * bf_hi(p.x); o[2] = bs[2] + sigmoidf_fast(a[2]) * bf_lo(p.y); o[3] = bs[3] + sigmoidf_fast(a[3]) * bf_hi(p.y);
                        *(f32x4*)(out + r * ldc + c) = o; } }
    }
};
template <class Epi, class Sched, bool ALIGN_EPI = false, bool SP2 = false>
__device__ __forceinline__ void gemm_phase(PG8_LAS unsigned char* lds, const Gemm g, const Sched& S, const Epi& E) {
    int tid_ = threadIdx.x; asm volatile("" : "+v"(tid_));
    const int tid = tid_, wid = __builtin_amdgcn_readfirstlane(tid >> 6), lane = tid & 63, wr = wid >> 2, wc = wid & 3, fr = lane & 15, fq = lane >> 4;
    const int K = g.K, nt = K / BK, lda = g.lda, ldb = g.ldb;
    unsigned voffA[2], voffB[2];
#pragma unroll
    for (int i = 0; i < 2; ++i) { int R, C; stage_rc(tid * 16 + i * 8192, R, C); const int Rb = Epi::PERM ? ((R & ~31) + perm32(R & 31)) : R;
        voffA[i] = (unsigned)(R * lda + C) * 2u; voffB[i] = (unsigned)(Rb * ldb + C) * 2u; }
    const size_t kstep = (size_t)(BK * 2);
    const size_t hstepA = (size_t)HALF * lda * 2, hstepB = (size_t)HALF * ldb * 2;
    const size_t tstepA = 2 * hstepA, tstepB = 2 * hstepB;
#define PG8_ABASE(u) ((const char*)g.A + (size_t)(u).pm * tstepA + (size_t)((u).pn >> g.agrp_shift) * (size_t)g.agrp_stride * 2)
#define PG8_BBASE(u) ((const char*)g.Bt + (size_t)(u).pn * tstepB)
    const unsigned ldsw = (unsigned)wid * 1024u;
    const int aoff = lds_byte(wr * 64 + fr, fq * 8), boff = lds_byte(wc * 32 + fr, fq * 8);
#define PG8_SA(b, h) (((b) * 2 + (h)) * HTB)
#define PG8_SB(b, h) ((4 + (b) * 2 + (h)) * HTB)
#define PG8_STAGE(bufoff, gbase, voff) do { _Pragma("unroll") for (int _i = 0; _i < 2; ++_i) \
        __builtin_amdgcn_global_load_lds((const unsigned*)((const char*)(gbase) + (voff)[_i]), (PG8_LAS unsigned*)(lds + (bufoff) + ldsw + _i * 8192), 16, 0, 0); } while (0)
#define PG8_LDA(dst, b, h) do { _Pragma("unroll") for (int m = 0; m < 4; ++m) _Pragma("unroll") for (int k = 0; k < 2; ++k) dst[m][k] = *(const PG8_LAS bf16x8*)(lds + PG8_SA(b, h) + aoff + m * 2048 + k * 1024); } while (0)
#define PG8_LDB(dst, b, h) do { _Pragma("unroll") for (int n = 0; n < 2; ++n) _Pragma("unroll") for (int k = 0; k < 2; ++k) dst[n][k] = *(const PG8_LAS bf16x8*)(lds + PG8_SB(b, h) + boff + n * 2048 + k * 1024); } while (0)
#define PG8_MMA(ai, bj, At, Bt) do { __builtin_amdgcn_s_setprio(1); _Pragma("unroll") for (int m = 0; m < 4; ++m) _Pragma("unroll") for (int n = 0; n < 2; ++n) _Pragma("unroll") for (int k = 0; k < 2; ++k) \
        acc[ai][bj][m][n] = __builtin_amdgcn_mfma_f32_16x16x32_bf16(Bt[n][k], At[m][k], acc[ai][bj][m][n], 0, 0, 0); __builtin_amdgcn_s_setprio(0); } while (0)
#define PG8_WAIT_V(n) asm volatile("s_waitcnt vmcnt(" #n ")" ::: "memory")
#define PG8_WAIT_L(n) asm volatile("s_waitcnt lgkmcnt(" #n ")" ::: "memory")
#define PG8_BAR __builtin_amdgcn_s_barrier()
#define PG8_SCHED __builtin_amdgcn_sched_barrier(0)
    Unit cur, nxt; int ui = 0;
    if (!S.next(0, cur)) return;
    f32x4 acc[2][2][4][2];
#pragma unroll
    for (int a = 0; a < 2; ++a)
#pragma unroll
        for (int b = 0; b < 2; ++b)
#pragma unroll
            for (int m = 0; m < 4; ++m)
#pragma unroll
                for (int n = 0; n < 2; ++n) acc[a][b][m][n] = (f32x4){0.f, 0.f, 0.f, 0.f};
    bf16x8 At[4][2], B0[2][2], B1[2][2];
    const char* cA = PG8_ABASE(cur); const char* cB = PG8_BBASE(cur);
    if constexpr (SP2) {
        PG8_STAGE(PG8_SB(0, 0), cB, voffB); PG8_STAGE(PG8_SB(0, 1), cB + hstepB, voffB); PG8_STAGE(PG8_SA(0, 0), cA, voffA); PG8_STAGE(PG8_SA(0, 1), cA + hstepA, voffA);
        if (wr == 1) PG8_BAR;
        PG8_WAIT_V(2); PG8_BAR;
        PG8_STAGE(PG8_SB(1, 0), cB + kstep, voffB); PG8_STAGE(PG8_SA(1, 0), cA + kstep, voffA); PG8_STAGE(PG8_SB(1, 1), cB + hstepB + kstep, voffB);
        PG8_WAIT_V(6); PG8_BAR;
    } else {
        PG8_STAGE(PG8_SB(0, 0), cB, voffB); PG8_STAGE(PG8_SA(0, 0), cA, voffA); PG8_STAGE(PG8_SB(0, 1), cB + hstepB, voffB); PG8_STAGE(PG8_SA(0, 1), cA + hstepA, voffA);
        if (wr == 1) PG8_BAR;
        PG8_WAIT_V(4); PG8_BAR;
        PG8_STAGE(PG8_SB(1, 0), cB + kstep, voffB); PG8_STAGE(PG8_SA(1, 0), cA + kstep, voffA); PG8_STAGE(PG8_SB(1, 1), cB + hstepB + kstep, voffB);
        PG8_WAIT_V(6); PG8_BAR;
    }
    for (;;) {
        const bool has_next = S.next(ui + 1, nxt);
        const char* nA = has_next ? PG8_ABASE(nxt) : cA; const char* nB = has_next ? PG8_BBASE(nxt) : cB;
        for (int t = 0; t < nt; t += 2) {
            const bool last = (t == nt - 2);
            const char* a1 = cA + (size_t)(t + 1) * kstep;
            const char* a2 = last ? nA : cA + (size_t)(t + 2) * kstep; const char* b2 = last ? nB : cB + (size_t)(t + 2) * kstep;
            const char* a3 = a2 + kstep; const char* b3 = b2 + kstep;
            if constexpr (SP2) {
            PG8_LDB(B0, 0, 0); PG8_LDB(B1, 0, 1); PG8_SCHED; PG8_LDA(At, 0, 0); PG8_STAGE(PG8_SA(1, 1), a1 + hstepA, voffA);
            PG8_WAIT_V(8); PG8_WAIT_L(0); PG8_BAR; PG8_MMA(0, 0, At, B0); PG8_MMA(0, 1, At, B1); PG8_BAR; PG8_SCHED;
            PG8_LDA(At, 0, 1); PG8_STAGE(PG8_SB(0, 0), b2, voffB); PG8_STAGE(PG8_SB(0, 1), b2 + hstepB, voffB); PG8_STAGE(PG8_SA(0, 0), a2, voffA);
            PG8_WAIT_V(8); PG8_WAIT_L(0); PG8_BAR; PG8_MMA(1, 0, At, B0); PG8_MMA(1, 1, At, B1); PG8_BAR; PG8_SCHED;
            PG8_LDB(B0, 1, 0); PG8_LDB(B1, 1, 1); PG8_SCHED; PG8_LDA(At, 1, 0); PG8_STAGE(PG8_SA(0, 1), a2 + hstepA, voffA);
            PG8_WAIT_V(8); PG8_WAIT_L(0); PG8_BAR; PG8_MMA(0, 0, At, B0); PG8_MMA(0, 1, At, B1); PG8_BAR; PG8_SCHED;
            PG8_LDA(At, 1, 1); PG8_STAGE(PG8_SB(1, 0), b3, voffB); PG8_STAGE(PG8_SB(1, 1), b3 + hstepB, voffB); PG8_STAGE(PG8_SA(1, 0), a3, voffA);
            PG8_WAIT_V(8); PG8_WAIT_L(0); PG8_BAR; PG8_MMA(1, 0, At, B0); PG8_MMA(1, 1, At, B1); PG8_BAR; PG8_SCHED;
            } else {
            PG8_LDB(B0, 0, 0); PG8_SCHED; PG8_LDA(At, 0, 0); PG8_STAGE(PG8_SA(1, 1), a1 + hstepA, voffA);
            PG8_WAIT_L(8); PG8_BAR; PG8_WAIT_L(0); PG8_MMA(0, 0, At, B0); PG8_BAR; PG8_SCHED;
            PG8_LDB(B1, 0, 1); PG8_STAGE(PG8_SB(0, 0), b2, voffB);
            PG8_BAR; PG8_WAIT_L(0); PG8_MMA(0, 1, At, B1); PG8_BAR;
            PG8_LDA(At, 0, 1); PG8_STAGE(PG8_SA(0, 0), a2, voffA);
            PG8_BAR; PG8_WAIT_L(0); PG8_MMA(1, 0, At, B0); PG8_BAR; PG8_SCHED;
            PG8_STAGE(PG8_SB(0, 1), b2 + hstepB, voffB);
            PG8_WAIT_V(6); PG8_BAR; PG8_MMA(1, 1, At, B1); PG8_BAR;
            PG8_LDB(B0, 1, 0); PG8_SCHED; PG8_LDA(At, 1, 0); PG8_STAGE(PG8_SA(0, 1), a2 + hstepA, voffA);
            PG8_WAIT_L(8); PG8_BAR; PG8_WAIT_L(0); PG8_MMA(0, 0, At, B0); PG8_BAR; PG8_SCHED;
            PG8_LDB(B1, 1, 1); PG8_STAGE(PG8_SB(1, 0), b3, voffB);
            PG8_BAR; PG8_WAIT_L(0); PG8_MMA(0, 1, At, B1); PG8_BAR;
            PG8_LDA(At, 1, 1); PG8_STAGE(PG8_SA(1, 0), a3, voffA);
            PG8_BAR; PG8_WAIT_L(0); PG8_MMA(1, 0, At, B0); PG8_BAR; PG8_SCHED;
            PG8_STAGE(PG8_SB(1, 1), b3 + hstepB, voffB);
            PG8_WAIT_V(6); PG8_BAR; PG8_MMA(1, 1, At, B1); PG8_BAR;
            }
        }
        if constexpr (ALIGN_EPI) { if (wr == 0) PG8_BAR; }
        { E(acc, cur, wr, wc, fr, fq); }
        if (!has_next) break;
#pragma unroll
        for (int a = 0; a < 2; ++a)
#pragma unroll
            for (int b = 0; b < 2; ++b)
#pragma unroll
                for (int m = 0; m < 4; ++m)
#pragma unroll
                    for (int n = 0; n < 2; ++n) acc[a][b][m][n] = (f32x4){0.f, 0.f, 0.f, 0.f};
        cur = nxt; cA = nA; cB = nB; ++ui;
        if constexpr (ALIGN_EPI) { if (wr == 1) PG8_BAR; }
    }
    PG8_WAIT_V(0);
    if constexpr (!ALIGN_EPI) { if (wr == 0) PG8_BAR; }
    PG8_BAR;
#undef PG8_ABASE
#undef PG8_BBASE
#undef PG8_SA
#undef PG8_SB
#undef PG8_STAGE
#undef PG8_LDA
#undef PG8_LDB
#undef PG8_MMA
#undef PG8_WAIT_V
#undef PG8_WAIT_L
#undef PG8_BAR
#undef PG8_SCHED
}
}


constexpr int D_MODEL = 2048, NTOK = 49152, CH_TOK = 16384, N_CHUNK = 3, DEPTH = 2;
constexpr int MIX_IN = 4096, IN_COLS = 12288, D_FF = 5632, PLE_DIM = 256;
constexpr int ZC_UA = 0, ZC_BG = 512, ZC_CG = 1024, ZC_VB = 1536, ZC_Q = 2048, ZC_K = 2560, ZC_VC = 3072, ZC_UD = 3584;
constexpr float EPS = 1e-6f;
constexpr int NWAVES = 8;

constexpr size_t MiB = 1u << 20;
constexpr size_t WS_CTL = 0, CTL_ZERO_BYTES = 1 * MiB;
constexpr size_t WS_TAB = 1 * MiB;
constexpr size_t S5T_BYTES = 12800, S5T_BB = 0, S5T_C = 8192, S5T_AB = 12288;
constexpr size_t TAB_S5 = WS_TAB, TAB_C128 = WS_TAB + 2 * MiB, TAB_S128 = TAB_C128 + 32768, TAB_C32 = TAB_S128 + 32768, TAB_S32 = TAB_C32 + 2048;
constexpr size_t WS_W = 8 * MiB;
constexpr size_t WL_MIX = 0, WL_G = 16 * MiB, WL_GLU = 48 * MiB, WL_BR = WL_GLU + MiB / 2, WL_O = WL_BR + 8 * MiB, WL_FF = WL_O + 8 * MiB, WL_FF2 = WL_FF + 44 * MiB, WL_PG = WL_FF2 + 22 * MiB, WL_PP = WL_PG + 8 * MiB;
constexpr size_t WL_BYTES = WL_PP + 1 * MiB;
static_assert(WL_BYTES == 139 * MiB + MiB / 2, "weight map");
constexpr size_t WS_H = 288 * MiB;
constexpr size_t WS_Z = 352 * MiB;
constexpr size_t WS_YS = 480 * MiB;
constexpr size_t WS_MG = 544 * MiB;
constexpr size_t WS_GT = 608 * MiB;
constexpr size_t WS_YF = WS_GT, WS_YB = WS_GT + 32 * MiB, WS_ZF = WS_GT + 64 * MiB, WS_Y1 = WS_GT + 96 * MiB, WS_S5E = WS_GT + 112 * MiB;
constexpr size_t WS_P16 = 864 * MiB;
constexpr size_t WS_END = 872 * MiB;
static_assert(WS_W + 2 * WL_BYTES <= WS_H, "ws map");
constexpr int CW_BAR = 4096;

constexpr int LDS_SCRATCH = 151552;
constexpr int LDSCTL_OFF = LDS_SCRATCH;
constexpr int LDS_BYTES = LDS_SCRATCH + 256;

#define GAS __attribute__((address_space(1)))
#define LAS __attribute__((address_space(3)))
typedef unsigned short bf16;
typedef unsigned u32x4 __attribute__((ext_vector_type(4)));
typedef unsigned u32x2 __attribute__((ext_vector_type(2)));
typedef float f32x4 __attribute__((ext_vector_type(4)));
typedef float f32x2 __attribute__((ext_vector_type(2)));
typedef short bf16x8 __attribute__((ext_vector_type(8)));
#define LDS_WAIT() asm volatile("s_waitcnt lgkmcnt(0)" ::: "memory")
using pg8::cvt_pk_bf16; using pg8::bf_lo; using pg8::bf_hi;
__device__ __forceinline__ bf16x8 as_frag(u32x4 v) { return __builtin_bit_cast(bf16x8, v); }
__device__ __forceinline__ f32x4 mfma16(bf16x8 a, bf16x8 b, f32x4 c) { f32x4 d = __builtin_amdgcn_mfma_f32_16x16x32_bf16(a, b, c, 0, 0, 0); asm volatile("" :: "v"(d), "v"(a), "v"(b)); return d; }
#define MFMA_DRAIN() do { __builtin_amdgcn_sched_barrier(0); asm volatile("s_nop 15\n\ts_nop 15" ::: "memory"); __builtin_amdgcn_sched_barrier(0); } while (0)
__device__ __forceinline__ float wave_sum(float v) {
#pragma unroll
    for (int o = 1; o < 64; o <<= 1) v += __shfl_xor(v, o);
    return v;
}
__device__ __forceinline__ unsigned short f2bf(float f) { return (unsigned short)(cvt_pk_bf16(f, 0.f) & 0xffffu); }

#define XB_TMO      128
#define XB_XCNT(j)  (256  + 64 * (j))
#define XB_XSUB(j)  (1280 + 64 * (j))
#define XB_XGEN(j)  (2304 + 64 * (j))
#define XB_TOP      3328
#define XB_TOPGEN   3392
#define XCD_BAR_WORDS 3456
#define XB_SPIN_CAP (1u << 22)
__device__ __forceinline__ unsigned xb_ld(unsigned* p)              { return __hip_atomic_load(p, __ATOMIC_RELAXED, __HIP_MEMORY_SCOPE_AGENT); }
__device__ __forceinline__ unsigned xb_add(unsigned* p, unsigned v) { return __hip_atomic_fetch_add(p, v, __ATOMIC_RELAXED, __HIP_MEMORY_SCOPE_AGENT); }
__device__ __forceinline__ unsigned xb_xcc_id() { return (unsigned)__builtin_amdgcn_s_getreg((3 << 11) | 20) & 0xFu; }
#define XB_SPIN(cond, bar) do { unsigned _sp = 0; while (cond) { __builtin_amdgcn_s_sleep(1); \
    if ((++_sp & 255u) == 0u) { if (xb_ld(&(bar)[XB_TMO])) break; if (_sp > XB_SPIN_CAP) { atomicAdd(&(bar)[XB_TMO], 1u); break; } } } } while (0)
struct XcdBarrier { unsigned* bar; unsigned x; volatile LAS unsigned* st; };
__device__ __forceinline__ XcdBarrier xcd_barrier_post(unsigned* bar, volatile LAS unsigned* st) {
    XcdBarrier b; b.bar = bar; b.x = xb_xcc_id(); b.st = st;
    if (threadIdx.x == 0) (void)xb_add(&bar[XB_XCNT(b.x)], 1u);
    return b;
}
__device__ __forceinline__ void xcd_barrier_complete(unsigned* bar, unsigned x, unsigned& nloc, unsigned& nx) {
    const unsigned G = gridDim.x * gridDim.y * gridDim.z;
    unsigned sum, cnt, mine, sp = 0u;
    for (;;) {
        sum = 0u; cnt = 0u; mine = 0u;
#pragma unroll
        for (unsigned j = 0; j < 16; ++j) { const unsigned c = xb_ld(&bar[XB_XCNT(j)]); sum += c; cnt += (c > 0u) ? 1u : 0u; mine = (j == x) ? c : mine; }
        if (sum == G) break;
        __builtin_amdgcn_s_sleep(1);
        if ((++sp & 255u) == 0u) { if (xb_ld(&bar[XB_TMO])) break; if (sp > XB_SPIN_CAP) { atomicAdd(&bar[XB_TMO], 1u); break; } }
    }
    nloc = mine > 0u ? mine : 1u; nx = cnt > 0u ? cnt : 1u;
}
__device__ __forceinline__ void xcd_barrier(const XcdBarrier& b) {
    asm volatile("s_waitcnt vmcnt(0)" ::: "memory");
    __syncthreads();
    if (threadIdx.x == 0) {
        unsigned* bar = b.bar;
        __builtin_amdgcn_s_waitcnt(0);
        unsigned nloc = b.st[0], nx = b.st[1];
        if (nloc == 0u) { xcd_barrier_complete(bar, b.x, nloc, nx); b.st[0] = nloc; b.st[1] = nx; }
        const unsigned old = xb_add(&bar[XB_XSUB(b.x)], 1u);
        const unsigned gen = old / nloc;
        if (old + 1u == (gen + 1u) * nloc) {
            __builtin_amdgcn_fence(__ATOMIC_RELEASE, "agent");
            asm volatile("s_waitcnt vmcnt(0)" ::: "memory");
            const unsigned og = xb_add(&bar[XB_TOP], 1u);
            const unsigned tg = og / nx;
            if (og + 1u == (tg + 1u) * nx) xb_add(&bar[XB_TOPGEN], 1u);
            else XB_SPIN(xb_ld(&bar[XB_TOPGEN]) == tg, bar);
            __builtin_amdgcn_fence(__ATOMIC_ACQUIRE, "agent");
            xb_add(&bar[XB_XGEN(b.x)], 1u);
            asm volatile("s_waitcnt vmcnt(0)" ::: "memory");
        } else {
            XB_SPIN(xb_ld(&bar[XB_XGEN(b.x)]) == gen, bar);
            __builtin_amdgcn_fence(__ATOMIC_ACQUIRE, "agent");
            asm volatile("s_waitcnt vmcnt(0)" ::: "memory");
        }
    }
    __syncthreads();
}

struct Frame {
    LAS unsigned char* lds;
    int tid, lane, wave;
    int vcu, G;
    unsigned char* ws;
};
struct Args { const float* in[27]; float* out; unsigned char* ws; int ph_lo, ph_hi; };
__device__ __forceinline__ Frame fresh(const Frame& F0) { Frame F = F0; int t = F0.tid; asm volatile("" : "+v"(t)); F.tid = t; F.lane = t & 63; F.wave = __builtin_amdgcn_readfirstlane(t >> 6); return F; }

__device__ __forceinline__ void transpose_item(const float* W, int K, int N, bf16* WT, int k0, int n0, int drow0, LAS float* scr, int lane) {
#pragma unroll 8
    for (int i = 0; i < 32; ++i) { const int kk = 2 * i + (lane >> 5); scr[kk * 33 + (lane & 31)] = W[(size_t)(k0 + kk) * N + n0 + (lane & 31)]; }
    LDS_WAIT(); asm volatile("" ::: "memory");
    const int c = lane & 7;
#pragma unroll
    for (int j = 0; j < 4; ++j) { const int n = (lane >> 3) + 8 * j; const LAS float* s = scr + (8 * c) * 33 + n;
        u32x4 o; o.x = cvt_pk_bf16(s[0 * 33], s[1 * 33]); o.y = cvt_pk_bf16(s[2 * 33], s[3 * 33]); o.z = cvt_pk_bf16(s[4 * 33], s[5 * 33]); o.w = cvt_pk_bf16(s[6 * 33], s[7 * 33]);
        *(u32x4*)(WT + (size_t)(drow0 + n) * K + k0 + 8 * c) = o; }
    LDS_WAIT(); asm volatile("" ::: "memory");
}
__device__ __forceinline__ void conv_plain(const float* W, int K, int N, bf16* WT, int item, LAS float* scr, int lane) {
    const int nblk = N / 32, kb = item / nblk, nb = item % nblk;
    transpose_item(W, K, N, WT, 64 * kb, 32 * nb, 32 * nb, scr, lane);
}
__device__ __forceinline__ void ph_prologue(Frame& F, const Args& A) {
    LAS float* scr = (LAS float*)(F.lds + F.wave * 16384);
    const int gw = F.vcu * NWAVES + F.wave, NGW = F.G * NWAVES;
    constexpr int I_IN = (2048 / 64) * (IN_COLS / 32), I_GLU = (512 / 64) * (512 / 32), I_BR1 = (512 / 64) * (2048 / 32), I_BR = 4 * I_BR1, I_O = (2048 / 64) * (2048 / 32),
                  I_FF = (2048 / 64) * (2 * D_FF / 32), I_FF2 = (D_FF / 64) * (2048 / 32), I_PG = I_O, I_PP = (256 / 64) * (2048 / 32);
    constexpr int I_LAYER = I_IN + I_GLU + I_BR + I_O + I_FF + I_FF2 + I_PG + I_PP;
    for (int it = gw; it < DEPTH * I_LAYER; it += NGW) {
        const int l = it / I_LAYER; int r = it % I_LAYER;
        unsigned char* wl = F.ws + WS_W + (size_t)l * WL_BYTES;
        if (r < I_IN) {
            const float* W = A.in[5] + (size_t)l * 2048 * IN_COLS; const int nblk = IN_COLS / 32, kb = r / nblk, nb = r % nblk, n0 = 32 * nb;
            if (n0 < MIX_IN) transpose_item(W, 2048, IN_COLS, (bf16*)(wl + WL_MIX), 64 * kb, n0, n0, scr, F.lane);
            else transpose_item(W, 2048, IN_COLS, (bf16*)(wl + WL_G), 64 * kb, n0, n0 - MIX_IN, scr, F.lane);
            continue; } r -= I_IN;
        if (r < I_GLU) { conv_plain(A.in[14] + (size_t)l * 512 * 512, 512, 512, (bf16*)(wl + WL_GLU), r, scr, F.lane); continue; } r -= I_GLU;
        if (r < I_BR) { const int kb = r / I_BR1; conv_plain(A.in[19] + ((size_t)l * 4 + kb) * 512 * 2048, 512, 2048, (bf16*)(wl + WL_BR) + (size_t)kb * 2048 * 512, r % I_BR1, scr, F.lane); continue; } r -= I_BR;
        if (r < I_O) { conv_plain(A.in[20] + (size_t)l * 2048 * 2048, 2048, 2048, (bf16*)(wl + WL_O), r, scr, F.lane); continue; } r -= I_O;
        if (r < I_FF) {
            const float* W = A.in[22] + (size_t)l * 2048 * 2 * D_FF; const int nblk = 2 * D_FF / 32, kb = r / nblk, nb = r % nblk, n0 = 32 * nb;
            const int j = n0 / D_FF, rr = n0 % D_FF, pn = rr / 128, cc = rr % 128;
            transpose_item(W, 2048, 2 * D_FF, (bf16*)(wl + WL_FF), 64 * kb, n0, 256 * pn + 128 * j + cc, scr, F.lane);
            continue; } r -= I_FF;
        if (r < I_FF2) { conv_plain(A.in[23] + (size_t)l * D_FF * 2048, D_FF, 2048, (bf16*)(wl + WL_FF2), r, scr, F.lane); continue; } r -= I_FF2;
        if (r < I_PG) { conv_plain(A.in[25] + (size_t)l * 2048 * 2048, 2048, 2048, (bf16*)(wl + WL_PG), r, scr, F.lane); continue; } r -= I_PG;
        conv_plain(A.in[26] + (size_t)l * 256 * 2048, 256, 2048, (bf16*)(wl + WL_PP), r, scr, F.lane);
    }
    {
        const int gt = F.vcu * 512 + F.tid, NT = F.G * 512;
        bf16* c128 = (bf16*)(F.ws + TAB_C128); bf16* s128 = (bf16*)(F.ws + TAB_S128); bf16* c32 = (bf16*)(F.ws + TAB_C32); bf16* s32 = (bf16*)(F.ws + TAB_S32);
        for (int e = gt; e < 128 * 128 + 32 * 32; e += NT) {
            if (e < 128 * 128) { const int i = e >> 7, k = e & 127, m = (i * k) & 127; float sn, cs; sincospif((float)m * (1.0f / 64.0f), &sn, &cs);
                c128[e] = f2bf(cs * 0.08838834764831845f); s128[e] = f2bf(sn * 0.08838834764831845f); }
            else { const int e2 = e - 128 * 128, i = e2 >> 5, k = e2 & 31, m = (i * k) & 31; float sn, cs; sincospif((float)m * (1.0f / 16.0f), &sn, &cs);
                c32[e2] = f2bf(cs * 0.17677669529663687f); s32[e2] = f2bf(sn * 0.17677669529663687f); }
        }
    }
    for (int t = gw; t < DEPTH * 2 * 32; t += NGW) {
        const int g = t & 31, ld = t >> 5;
        unsigned char* tb = F.ws + TAB_S5 + (size_t)t * S5T_BYTES;
        const float* lam_re = A.in[6] + (size_t)t * 64; const float* lam_im = A.in[7] + (size_t)t * 64;
        const float dt = expf(A.in[8][t]);
        const float* b_re = A.in[9] + (size_t)t * 64 * 16; const float* b_im = A.in[10] + (size_t)t * 64 * 16;
        const float* c_re = A.in[11] + (size_t)t * 16 * 64; const float* c_im = A.in[12] + (size_t)t * 16 * 64;
        (void)g; (void)ld;
        const int lane = F.lane, l15 = lane & 15, g4 = lane >> 4;
        {
            const float lr = lam_re[lane], li = lam_im[lane], mag = expf(lr * dt); float sn, cs; sincosf(li * dt, &sn, &cs);
            f32x2 ab; ab.x = mag * cs; ab.y = mag * sn; ((f32x2*)(tb + S5T_AB))[lane] = ab;
        }
#pragma unroll 1
        for (int cb = 0; cb < 8; ++cb) {
            const int col = 16 * cb + l15, p = col >> 1, ri = col & 1;
            const float lr = lam_re[p], li = lam_im[p], mag = expf(lr * dt); float sn, cs; sincosf(li * dt, &sn, &cs);
            const float ar = mag * cs, ai = mag * sn, den = lr * lr + li * li;
            const float fr = ((ar - 1.0f) * lr + ai * li) / den, fi = (ai * lr - (ar - 1.0f) * li) / den;
            float v[8];
#pragma unroll
            for (int j = 0; j < 8; ++j) { const int h = 8 * g4 + j; float x = 0.f;
                if (h < 16) { const float br = b_re[p * 16 + h], bi = b_im[p * 16 + h]; x = ri ? (fr * bi + fi * br) : (fr * br - fi * bi); }
                v[j] = x; }
            u32x4 o; o.x = cvt_pk_bf16(v[0], v[1]); o.y = cvt_pk_bf16(v[2], v[3]); o.z = cvt_pk_bf16(v[4], v[5]); o.w = cvt_pk_bf16(v[6], v[7]);
            ((u32x4*)(tb + S5T_BB))[cb * 64 + lane] = o;
        }
#pragma unroll 1
        for (int ks = 0; ks < 4; ++ks) {
            float v[8];
#pragma unroll
            for (int j = 0; j < 8; ++j) { const int col = 32 * ks + 8 * g4 + j, p = col >> 1, ri = col & 1; v[j] = ri ? -c_im[l15 * 64 + p] : c_re[l15 * 64 + p]; }
            u32x4 o; o.x = cvt_pk_bf16(v[0], v[1]); o.y = cvt_pk_bf16(v[2], v[3]); o.z = cvt_pk_bf16(v[4], v[5]); o.w = cvt_pk_bf16(v[6], v[7]);
            ((u32x4*)(tb + S5T_C))[ks * 64 + lane] = o;
        }
    }
}

__device__ __forceinline__ void ph_norm(Frame& F, const float* xsrc, const float* gain, bf16* H) {
    const int gw = F.vcu * NWAVES + F.wave, NGW = F.G * NWAVES;
    f32x4 gv[8];
#pragma unroll
    for (int j = 0; j < 8; ++j) gv[j] = ((const f32x4*)gain)[F.lane + 64 * j];
    for (int m = gw; m < CH_TOK; m += NGW) {
        const f32x4* xr = (const f32x4*)(xsrc + (size_t)m * D_MODEL) + F.lane;
        f32x4 v[8]; float s = 0.f;
#pragma unroll
        for (int j = 0; j < 8; ++j) { v[j] = xr[64 * j]; s += (v[j][0] * v[j][0] + v[j][1] * v[j][1]) + (v[j][2] * v[j][2] + v[j][3] * v[j][3]); }
        const float rstd = rsqrtf(wave_sum(s) * (1.0f / D_MODEL) + EPS);
        u32x2* o = (u32x2*)(H + (size_t)m * D_MODEL) + F.lane;
#pragma unroll
        for (int j = 0; j < 8; ++j) { u32x2 w; w.x = cvt_pk_bf16(v[j][0] * rstd * gv[j][0], v[j][1] * rstd * gv[j][1]); w.y = cvt_pk_bf16(v[j][2] * rstd * gv[j][2], v[j][3] * rstd * gv[j][3]); o[64 * j] = w; }
    }
}
__device__ __forceinline__ void ph_pcvt(Frame& F, const float* p, bf16* P16) {
    const int gw = F.vcu * NWAVES + F.wave, NGW = F.G * NWAVES;
    for (int m = gw; m < CH_TOK; m += NGW) {
        const f32x4 v = ((const f32x4*)(p + (size_t)m * PLE_DIM))[F.lane];
        u32x2 w; w.x = cvt_pk_bf16(v[0], v[1]); w.y = cvt_pk_bf16(v[2], v[3]);
        ((u32x2*)(P16 + (size_t)m * PLE_DIM))[F.lane] = w;
    }
}
__device__ __forceinline__ void unpack8(u32x4 w, float (&f)[8]) { f[0] = bf_lo(w.x); f[1] = bf_hi(w.x); f[2] = bf_lo(w.y); f[3] = bf_hi(w.y); f[4] = bf_lo(w.z); f[5] = bf_hi(w.z); f[6] = bf_lo(w.w); f[7] = bf_hi(w.w); }
__device__ __forceinline__ u32x4 pack8(const float (&f)[8]) { u32x4 w; w.x = cvt_pk_bf16(f[0], f[1]); w.y = cvt_pk_bf16(f[2], f[3]); w.z = cvt_pk_bf16(f[4], f[5]); w.w = cvt_pk_bf16(f[6], f[7]); return w; }

__device__ __forceinline__ void conv_block(Frame& F, const bf16* Z, bf16* YS, const float* cw  , int blk, int lseq) {
#pragma unroll 1
    for (int i = 0; i < 8; ++i) {
        const int idx = F.tid + 512 * i, r = blk * 64 + (idx >> 6), c = (idx & 63) * 8, lpos = r % lseq;
        const bf16* zr = Z + (size_t)r * MIX_IN;
        float bg[8], z0[8], acc[8], tmp[8], w[8];
        unpack8(*(const u32x4*)(zr + ZC_BG + c), bg);
        {   float cg[8], vv[8]; unpack8(*(const u32x4*)(zr + ZC_CG + c), cg); unpack8(*(const u32x4*)(zr + ZC_VB + c), vv);
            const f32x4 wa = *(const f32x4*)(cw + 512 + c), wb = *(const f32x4*)(cw + 512 + c + 4);
            w[0] = wa[0]; w[1] = wa[1]; w[2] = wa[2]; w[3] = wa[3]; w[4] = wb[0]; w[5] = wb[1]; w[6] = wb[2]; w[7] = wb[3];
#pragma unroll
            for (int j = 0; j < 8; ++j) { z0[j] = cg[j] * vv[j]; acc[j] = w[j] * z0[j]; } }
        if (lpos > 0) { float cg[8], vv[8]; unpack8(*(const u32x4*)(zr - MIX_IN + ZC_CG + c), cg); unpack8(*(const u32x4*)(zr - MIX_IN + ZC_VB + c), vv);
            const f32x4 wa = *(const f32x4*)(cw + c), wb = *(const f32x4*)(cw + c + 4);
            w[0] = wa[0]; w[1] = wa[1]; w[2] = wa[2]; w[3] = wa[3]; w[4] = wb[0]; w[5] = wb[1]; w[6] = wb[2]; w[7] = wb[3];
#pragma unroll
            for (int j = 0; j < 8; ++j) acc[j] += w[j] * (cg[j] * vv[j]); }
        if (lpos < lseq - 1) { float cg[8], vv[8]; unpack8(*(const u32x4*)(zr + MIX_IN + ZC_CG + c), cg); unpack8(*(const u32x4*)(zr + MIX_IN + ZC_VB + c), vv);
            const f32x4 wa = *(const f32x4*)(cw + 1024 + c), wb = *(const f32x4*)(cw + 1024 + c + 4);
            w[0] = wa[0]; w[1] = wa[1]; w[2] = wa[2]; w[3] = wa[3]; w[4] = wb[0]; w[5] = wb[1]; w[6] = wb[2]; w[7] = wb[3];
#pragma unroll
            for (int j = 0; j < 8; ++j) acc[j] += w[j] * (cg[j] * vv[j]); }
#pragma unroll
        for (int j = 0; j < 8; ++j) tmp[j] = bg[j] * acc[j];
        *(u32x4*)(YS + (size_t)r * D_MODEL + 512 + c) = pack8(tmp);
    }
}
__device__ __forceinline__ void s5fin_block(Frame& F, const bf16* Z, const float* YF, const float* YB, const float* dsk  , bf16* Y1, int blk) {
#pragma unroll 1
    for (int i = 0; i < 8; ++i) {
        const int idx = F.tid + 512 * i, r = blk * 64 + (idx >> 6), c = (idx & 63) * 8;
        float u[8], o[8]; unpack8(*(const u32x4*)(Z + (size_t)r * MIX_IN + ZC_UA + c), u);
        const f32x4 f0 = *(const f32x4*)(YF + (size_t)r * 512 + c), f1 = *(const f32x4*)(YF + (size_t)r * 512 + c + 4);
        const f32x4 b0 = *(const f32x4*)(YB + (size_t)r * 512 + c), b1 = *(const f32x4*)(YB + (size_t)r * 512 + c + 4);
        const f32x4 d0 = *(const f32x4*)(dsk + c), d1 = *(const f32x4*)(dsk + c + 4);
#pragma unroll
        for (int j = 0; j < 8; ++j) { const float yy = (j < 4 ? d0[j & 3] : d1[j & 3]) * u[j] + (j < 4 ? f0[j & 3] : f1[j & 3]) + (j < 4 ? b0[j & 3] : b1[j & 3]);
            const float a = 0.7978845608028654f * (yy + 0.044715f * yy * yy * yy);
            const float th = 1.0f - 2.0f * __builtin_amdgcn_rcpf(1.0f + __expf(2.0f * a));
            o[j] = 0.5f * yy * (1.0f + th); }
        *(u32x4*)(Y1 + (size_t)r * 512 + c) = pack8(o);
    }
}

constexpr int S5_SEG = 512, S5_TPS = S5_SEG / 16;
template <bool FULL>
__device__ __forceinline__ void s5_seg_task(Frame& F, const unsigned char* tb, const bf16* Zs, float* Yout, f32x2* Ev, int nseg, int seg, int dir, int g) {
#ifndef MK_S5_LDS_STRIDE
#define MK_S5_LDS_STRIDE 12288
#endif
    LAS float* BU = (LAS float*)(F.lds + F.wave * MK_S5_LDS_STRIDE);
    LAS unsigned* XD = (LAS unsigned*)(F.lds + F.wave * MK_S5_LDS_STRIDE + 8192);
    const int lane = F.lane, l15 = lane & 15, g4 = lane >> 4;
    const f32x2 ab = ((const f32x2*)(tb + S5T_AB))[lane];
    const float ar = ab.x, ai = ab.y;
    bf16x8 bbf[8];
#pragma unroll
    for (int cb = 0; cb < 8; ++cb) bbf[cb] = as_frag(((const u32x4*)(tb + S5T_BB))[cb * 64 + lane]);
    float xr = 0.f, xi = 0.f;
    if (FULL) {
        float pr = ar, pi = ai;
#pragma unroll
        for (int i = 0; i < 9; ++i) { const float nr = pr * pr - pi * pi, ni = 2.f * pr * pi; pr = nr; pi = ni; }
        if (dir == 0) { for (int j = 0; j < seg; ++j) { const f32x2 e = Ev[j * 64 + lane]; const float nr = pr * xr - pi * xi + e.x, ni = pr * xi + pi * xr + e.y; xr = nr; xi = ni; } }
        else { for (int j = nseg - 1; j > seg; --j) { const f32x2 e = Ev[j * 64 + lane]; const float nr = pr * xr - pi * xi + e.x, ni = pr * xi + pi * xr + e.y; xr = nr; xi = ni; } }
    }
    bf16x8 cf[4];
    if (FULL) {
#pragma unroll
        for (int ks = 0; ks < 4; ++ks) cf[ks] = as_frag(((const u32x4*)(tb + S5T_C))[ks * 64 + lane]);
    }
    const int tile0 = seg * S5_TPS;
    const bf16* zcol = Zs + ZC_UA + g * 16 + 8 * (g4 & 1);
    u32x4 ring[4];
#pragma unroll
    for (int j = 0; j < 4; ++j) { const int tile = tile0 + (dir ? S5_TPS - 1 - j : j); ring[j] = (u32x4){0u, 0u, 0u, 0u}; if (g4 < 2) ring[j] = *(const u32x4*)(zcol + (size_t)(tile * 16 + l15) * MIX_IN); }
#pragma unroll 1
    for (int it = 0; it < S5_TPS; it += 4) {
#pragma unroll
        for (int j = 0; j < 4; ++j) {
            const int tile = tile0 + (dir ? S5_TPS - 1 - (it + j) : it + j);
            const bf16x8 uf = as_frag(ring[j]);
            if (it + j + 4 < S5_TPS) { const int tn = dir ? tile - 4 : tile + 4; u32x4 nx = (u32x4){0u, 0u, 0u, 0u}; if (g4 < 2) nx = *(const u32x4*)(zcol + (size_t)(tn * 16 + l15) * MIX_IN); ring[j] = nx; }
            f32x4 a8[8];
#pragma unroll
            for (int cb = 0; cb < 8; ++cb) a8[cb] = mfma16(uf, bbf[cb], (f32x4){0.f, 0.f, 0.f, 0.f});
            MFMA_DRAIN();
#pragma unroll
            for (int cb = 0; cb < 8; ++cb)
#pragma unroll
                for (int q = 0; q < 4; ++q) BU[(4 * g4 + q) * 128 + 16 * cb + l15] = a8[cb][q];
            LDS_WAIT();
            f32x2 bv[16];
#pragma unroll
            for (int s = 0; s < 16; ++s) { const int t = dir ? 15 - s : s; bv[s] = *(const LAS f32x2*)(BU + t * 128 + 2 * lane); }
#pragma unroll
            for (int s = 0; s < 16; ++s) {
                const int t = dir ? 15 - s : s;
                const float nr = ar * xr - ai * xi + bv[s].x, ni = ar * xi + ai * xr + bv[s].y;
                xr = nr; xi = ni;
                if (FULL) XD[t * 64 + lane] = cvt_pk_bf16(xr, xi);
            }
            if (FULL) {
                LDS_WAIT();
                f32x4 y = (f32x4){0.f, 0.f, 0.f, 0.f};
#pragma unroll
                for (int ks = 0; ks < 4; ++ks) y = mfma16(as_frag(*(const LAS u32x4*)(XD + l15 * 64 + 16 * ks + 4 * g4)), cf[ks], y);
                MFMA_DRAIN();
                float* yo = Yout + (size_t)(tile * 16 + 4 * g4) * 512 + g * 16 + l15;
#pragma unroll
                for (int q = 0; q < 4; ++q) yo[(size_t)q * 512] = y[q];
            }
            LDS_WAIT();
        }
    }
    if (!FULL) { f32x2 e; e.x = xr; e.y = xi; Ev[seg * 64 + lane] = e; }
}

constexpr int NA_KL = 0, NA_VT = 73728, NA_BIAS = 147456;
constexpr int NA_RR = 16;
__device__ __forceinline__ void na_task(Frame& F, const bf16* Zs  , bf16* YSs  , int rows, int h, int r0,
                                        const float* qg, const float* kg, const float* relb  ) {
    LAS unsigned* KL = (LAS unsigned*)(F.lds + NA_KL); LAS unsigned* VT = (LAS unsigned*)(F.lds + NA_VT); LAS unsigned short* VT16 = (LAS unsigned short*)(F.lds + NA_VT);
    LAS float* BIAS = (LAS float*)(F.lds + NA_BIAS);
    const int tid = F.tid, lane = F.lane, l15 = lane & 15, g4 = lane >> 4;
    __syncthreads();
    for (int i = tid; i < 15 * 31; i += 512) BIAS[i] = relb[i];
    const int scol = tid >> 3, schunk = tid & 7;
    float kgv[8];
    { const f32x4 a = *(const f32x4*)(kg + 8 * schunk), b = *(const f32x4*)(kg + 8 * schunk + 4); kgv[0] = a[0]; kgv[1] = a[1]; kgv[2] = a[2]; kgv[3] = a[3]; kgv[4] = b[0]; kgv[5] = b[1]; kgv[6] = b[2]; kgv[7] = b[3]; }
    int rs0 = r0 - 4; rs0 = rs0 < 0 ? 0 : (rs0 > rows - 8 ? rows - 8 : rs0);
    int nextrow = rs0;
#pragma unroll 1
    for (int r = r0; r < r0 + NA_RR; ++r) {
        int rs = r - 4; rs = rs < 0 ? 0 : (rs > rows - 8 ? rows - 8 : rs);
        __syncthreads();
#pragma unroll 1
        for (int rho = nextrow; rho <= rs + 7; ++rho) {
            const bf16* zt = Zs + (size_t)(rho * 64 + scol) * MIX_IN + h * 64 + 8 * schunk;
            const u32x4 kraw = *(const u32x4*)(zt + ZC_K), vraw = *(const u32x4*)(zt + ZC_VC);
            float kf[8]; unpack8(kraw, kf);
            float ss = 0.f;
#pragma unroll
            for (int j = 0; j < 8; ++j) ss += kf[j] * kf[j];
            ss += __shfl_xor(ss, 1); ss += __shfl_xor(ss, 2); ss += __shfl_xor(ss, 4);
            const float rk = rsqrtf(ss * (1.0f / 64.0f) + EPS);
#pragma unroll
            for (int j = 0; j < 8; ++j) kf[j] = kf[j] * rk * kgv[j];
            const int slot = rho & 7;
            *(LAS u32x4*)(KL + (slot * 64 + scol) * 36 + schunk * 4) = pack8(kf);
            const unsigned vw[4] = {vraw.x, vraw.y, vraw.z, vraw.w};
#pragma unroll
            for (int j = 0; j < 8; ++j) VT16[(slot * 64 + 8 * schunk + j) * 72 + scol] = (unsigned short)((j & 1) ? (vw[j >> 1] >> 16) : (vw[j >> 1] & 0xffffu));
        }
        nextrow = rs + 8;
        __syncthreads();
        if (F.wave < 4) {
            const int jb = F.wave, qc = 16 * jb + l15;
            int kc0 = 16 * jb - 8; kc0 = kc0 < 0 ? 0 : (kc0 > 32 ? 32 : kc0);
            int cs = qc - 8; cs = cs < 0 ? 0 : (cs > 48 ? 48 : cs);
            bf16x8 qf[2];
            {
                const bf16* zq = Zs + (size_t)(r * 64 + qc) * MIX_IN + ZC_Q + h * 64 + 8 * g4;
                float q0[8], q1[8]; unpack8(*(const u32x4*)zq, q0); unpack8(*(const u32x4*)(zq + 32), q1);
                float ss = 0.f;
#pragma unroll
                for (int j = 0; j < 8; ++j) ss += q0[j] * q0[j] + q1[j] * q1[j];
                ss += __shfl_xor(ss, 16); ss += __shfl_xor(ss, 32);
                const float rq = rsqrtf(ss * (1.0f / 64.0f) + EPS) * 0.125f;
                const f32x4 ga = *(const f32x4*)(qg + 8 * g4), gb = *(const f32x4*)(qg + 8 * g4 + 4), gc = *(const f32x4*)(qg + 32 + 8 * g4), gd = *(const f32x4*)(qg + 32 + 8 * g4 + 4);
#pragma unroll
                for (int j = 0; j < 4; ++j) { q0[j] *= rq * ga[j]; q0[4 + j] *= rq * gb[j]; q1[j] *= rq * gc[j]; q1[4 + j] *= rq * gd[j]; }
                qf[0] = as_frag(pack8(q0)); qf[1] = as_frag(pack8(q1));
            }
            f32x4 S[8][2];
#pragma unroll
            for (int a = 0; a < 8; ++a) {
                const int slot = (rs + a) & 7;
#pragma unroll
                for (int kb2 = 0; kb2 < 2; ++kb2) {
                    const LAS unsigned* kp = KL + (slot * 64 + kc0 + 16 * kb2 + l15) * 36 + 4 * g4;
                    S[a][kb2] = mfma16(as_frag(*(const LAS u32x4*)kp), qf[0], (f32x4){0.f, 0.f, 0.f, 0.f});
                    S[a][kb2] = mfma16(as_frag(*(const LAS u32x4*)(kp + 16)), qf[1], S[a][kb2]);
                }
            }
            MFMA_DRAIN();
            float mx = -3.0e38f;
#pragma unroll
            for (int a = 0; a < 8; ++a) {
                const int dr = rs + a - r + 7;
#pragma unroll
                for (int kb2 = 0; kb2 < 2; ++kb2)
#pragma unroll
                    for (int q = 0; q < 4; ++q) {
                        const int kc = kc0 + 16 * kb2 + 4 * g4 + q; const bool valid = (kc >= cs) && (kc < cs + 16);
                        int dc = kc - qc + 15; dc = dc < 0 ? 0 : (dc > 30 ? 30 : dc);
                        const float s = valid ? S[a][kb2][q] + BIAS[dr * 31 + dc] : -1.0e30f;
                        S[a][kb2][q] = s; mx = fmaxf(mx, s);
                    }
            }
            mx = fmaxf(mx, __shfl_xor(mx, 16)); mx = fmaxf(mx, __shfl_xor(mx, 32));
            float sum = 0.f;
#pragma unroll
            for (int a = 0; a < 8; ++a)
#pragma unroll
                for (int kb2 = 0; kb2 < 2; ++kb2)
#pragma unroll
                    for (int q = 0; q < 4; ++q) { const float p = __expf(S[a][kb2][q] - mx); S[a][kb2][q] = p; sum += p; }
            sum += __shfl_xor(sum, 16); sum += __shfl_xor(sum, 32);
            const float rinv = 1.0f / sum;
            f32x4 O[4];
#pragma unroll
            for (int dt = 0; dt < 4; ++dt) O[dt] = (f32x4){0.f, 0.f, 0.f, 0.f};
#pragma unroll
            for (int a = 0; a < 8; ++a) {
                const int slot = (rs + a) & 7;
                u32x4 pw; pw.x = cvt_pk_bf16(S[a][0][0], S[a][0][1]); pw.y = cvt_pk_bf16(S[a][0][2], S[a][0][3]); pw.z = cvt_pk_bf16(S[a][1][0], S[a][1][1]); pw.w = cvt_pk_bf16(S[a][1][2], S[a][1][3]);
                const bf16x8 pf = as_frag(pw);
#pragma unroll
                for (int dt = 0; dt < 4; ++dt) {
                    const LAS unsigned* vp = VT + (slot * 64 + 16 * dt + l15) * 36 + (kc0 >> 1) + 2 * g4;
                    const u32x2 v0 = *(const LAS u32x2*)vp, v1 = *(const LAS u32x2*)(vp + 8);
                    u32x4 vw; vw.x = v0.x; vw.y = v0.y; vw.z = v1.x; vw.w = v1.y;
                    O[dt] = mfma16(as_frag(vw), pf, O[dt]);
                }
            }
            MFMA_DRAIN();
            bf16* yo = YSs + (size_t)(r * 64 + qc) * D_MODEL + 1024 + h * 64 + 4 * g4;
#pragma unroll
            for (int dt = 0; dt < 4; ++dt) { u32x2 w; w.x = cvt_pk_bf16(O[dt][0] * rinv, O[dt][1] * rinv); w.y = cvt_pk_bf16(O[dt][2] * rinv, O[dt][3] * rinv); *(u32x2*)(yo + 16 * dt) = w; }
        }
    }
}


#if defined(MK_PROBE)
#define PRB_FLAGS(F) ((unsigned*)((F).ws + WS_CTL + 512 * 1024))
__device__ __forceinline__ bool prb_big_bf(u32x4 w, unsigned ethr) { const unsigned v[4] = {w.x, w.y, w.z, w.w}; bool b = false;
#pragma unroll
    for (int i = 0; i < 4; ++i) b = b || (((v[i] >> 7) & 0xffu) >= ethr) || (((v[i] >> 23) & 0xffu) >= ethr); return b; }
__device__ __forceinline__ bool prb_big_f(f32x4 a, unsigned ethr) { bool b = false;
#pragma unroll
    for (int i = 0; i < 4; ++i) b = b || (((__float_as_uint(a[i]) >> 23) & 0xffu) >= ethr); return b; }
#define PRB(cond, bit) do { if (cond) atomicOr(PRB_FLAGS(F), 1u << (bit)); } while (0)
#else
#define PRB(cond, bit) do { } while (0)
#endif
constexpr int FN_XT = 0, FN_YR = 34816, FN_YI = 34816 + 34816;
template <int N1>
__device__ __forceinline__ void fnet1_tile(Frame& F, const bf16* Zs, bf16* ZFsg  , int g, int l2, const bf16* CT1, const bf16* ST1  , const bf16* C128, const bf16* S128) {
    constexpr int XS = N1 + 8, JT = N1 / 16, KS1 = N1 / 32;
    LAS unsigned short* XT = (LAS unsigned short*)(F.lds + FN_XT); LAS unsigned short* YR = (LAS unsigned short*)(F.lds + FN_YR); LAS unsigned short* YI = (LAS unsigned short*)(F.lds + FN_YI);
    const int tid = F.tid, lane = F.lane, l15 = lane & 15, g4 = lane >> 4, w = F.wave;
    __syncthreads();
    for (int idx = tid; idx < N1 * 16; idx += 512) {
        const int l1 = idx >> 4, ch = idx & 15;
        const u32x4 raw = *(const u32x4*)(Zs + (size_t)(128 * l1 + l2) * MIX_IN + ZC_UD + g * 128 + 8 * ch);
        const unsigned rw[4] = {raw.x, raw.y, raw.z, raw.w};
#pragma unroll
        for (int j = 0; j < 8; ++j) XT[(8 * ch + j) * XS + l1] = (unsigned short)((j & 1) ? (rw[j >> 1] >> 16) : (rw[j >> 1] & 0xffffu));
    }
    __syncthreads();
    {
        bf16x8 af[KS1];
#pragma unroll
        for (int ks = 0; ks < KS1; ++ks) { af[ks] = as_frag(*(const LAS u32x4*)(XT + (16 * w + l15) * XS + 32 * ks + 8 * g4)); }
#pragma unroll 1
        for (int tj = 0; tj < JT; ++tj) {
            const int k1 = 16 * tj + l15;
            f32x4 ar = (f32x4){0.f, 0.f, 0.f, 0.f}, as = (f32x4){0.f, 0.f, 0.f, 0.f};
#pragma unroll
            for (int ks = 0; ks < KS1; ++ks) {
                ar = mfma16(af[ks], as_frag(*(const u32x4*)(CT1 + k1 * N1 + 32 * ks + 8 * g4)), ar);
                as = mfma16(af[ks], as_frag(*(const u32x4*)(ST1 + k1 * N1 + 32 * ks + 8 * g4)), as);
            }
            MFMA_DRAIN();
            float tsn, tcs; sincospif((float)(k1 * l2) * (2.0f / (float)(N1 * 128)), &tsn, &tcs);
            float zr[4], zi[4];
#pragma unroll
            for (int q = 0; q < 4; ++q) { const float yr = ar[q], yi = -as[q]; zr[q] = yr * tcs + yi * tsn; zi[q] = yi * tcs - yr * tsn; }
            u32x2 wr2, wi2; wr2.x = cvt_pk_bf16(zr[0], zr[1]); wr2.y = cvt_pk_bf16(zr[2], zr[3]); wi2.x = cvt_pk_bf16(zi[0], zi[1]); wi2.y = cvt_pk_bf16(zi[2], zi[3]);
            *(LAS u32x2*)(YR + k1 * 136 + 16 * w + 4 * g4) = wr2; *(LAS u32x2*)(YI + k1 * 136 + 16 * w + 4 * g4) = wi2;
        }
    }
    __syncthreads();
    {
        bf16x8 cfr[4], sfr[4];
#pragma unroll
        for (int ks = 0; ks < 4; ++ks) { cfr[ks] = as_frag(*(const u32x4*)(C128 + (16 * w + l15) * 128 + 32 * ks + 8 * g4)); sfr[ks] = as_frag(*(const u32x4*)(S128 + (16 * w + l15) * 128 + 32 * ks + 8 * g4)); }
#pragma unroll 1
        for (int tj = 0; tj < JT; ++tj) {
            const int k1 = 16 * tj + l15;
            f32x4 zr = (f32x4){0.f, 0.f, 0.f, 0.f}, zi = (f32x4){0.f, 0.f, 0.f, 0.f};
#pragma unroll
            for (int ks = 0; ks < 4; ++ks) {
                const u32x4 yr = *(const LAS u32x4*)(YR + k1 * 136 + 32 * ks + 8 * g4), yi = *(const LAS u32x4*)(YI + k1 * 136 + 32 * ks + 8 * g4);
                u32x4 ny; ny.x = yr.x ^ 0x80008000u; ny.y = yr.y ^ 0x80008000u; ny.z = yr.z ^ 0x80008000u; ny.w = yr.w ^ 0x80008000u;
                zr = mfma16(cfr[ks], as_frag(yr), zr); zr = mfma16(sfr[ks], as_frag(yi), zr);
                zi = mfma16(cfr[ks], as_frag(yi), zi); zi = mfma16(sfr[ks], as_frag(ny), zi);
            }
            MFMA_DRAIN();
            bf16* zo = ZFsg + ((size_t)k1 * 128 + l2) * 256 + 16 * w + 4 * g4;
            u32x2 a, b; a.x = cvt_pk_bf16(zr[0], zr[1]); a.y = cvt_pk_bf16(zr[2], zr[3]); b.x = cvt_pk_bf16(zi[0], zi[1]); b.y = cvt_pk_bf16(zi[2], zi[3]);
            *(u32x2*)zo = a; *(u32x2*)(zo + 128) = b;
        }
    }
}
__device__ __forceinline__ void fnet2_tile(Frame& F, const bf16* ZFsg, bf16* YSs  , int g, int k1, int N1, const bf16* C128, const bf16* S128) {
    LAS unsigned short* ZT = (LAS unsigned short*)F.lds;
    const int tid = F.tid, lane = F.lane, l15 = lane & 15, g4 = lane >> 4, w = F.wave;
    __syncthreads();
    const bf16* src = ZFsg + (size_t)k1 * 128 * 256;
#pragma unroll 1
    for (int idx = tid; idx < 4096; idx += 512) {
        const int l2 = idx >> 5, ch = idx & 31;
        const u32x4 raw = *(const u32x4*)(src + (size_t)l2 * 256 + 8 * ch);
        const unsigned rw[4] = {raw.x, raw.y, raw.z, raw.w};
#pragma unroll
        for (int j = 0; j < 8; ++j) ZT[(8 * ch + j) * 136 + l2] = (unsigned short)((j & 1) ? (rw[j >> 1] >> 16) : (rw[j >> 1] & 0xffffu));
    }
    __syncthreads();
    bf16x8 zrf[4], zif[4];
#pragma unroll
    for (int ks = 0; ks < 4; ++ks) { zrf[ks] = as_frag(*(const LAS u32x4*)(ZT + (16 * w + l15) * 136 + 32 * ks + 8 * g4)); zif[ks] = as_frag(*(const LAS u32x4*)(ZT + (128 + 16 * w + l15) * 136 + 32 * ks + 8 * g4)); }
#pragma unroll 1
    for (int tj = 0; tj < 8; ++tj) {
        const int k2 = 16 * tj + l15;
        f32x4 y = (f32x4){0.f, 0.f, 0.f, 0.f};
#pragma unroll
        for (int ks = 0; ks < 4; ++ks) {
            y = mfma16(zrf[ks], as_frag(*(const u32x4*)(C128 + k2 * 128 + 32 * ks + 8 * g4)), y);
            y = mfma16(zif[ks], as_frag(*(const u32x4*)(S128 + k2 * 128 + 32 * ks + 8 * g4)), y);
        }
        MFMA_DRAIN();
        u32x2 o; o.x = cvt_pk_bf16(y[0], y[1]); o.y = cvt_pk_bf16(y[2], y[3]);
        *(u32x2*)(YSs + (size_t)(k1 + N1 * k2) * D_MODEL + 1536 + g * 128 + 16 * w + 4 * g4) = o;
    }
}

struct ChunkGeo { int nseq, lseq, rows, n1; };
__device__ __forceinline__ ChunkGeo chunk_geo(int ch) { ChunkGeo g; if (ch < 2) { g.nseq = 1; g.lseq = 16384; g.rows = 256; g.n1 = 128; } else { g.nseq = 4; g.lseq = 4096; g.rows = 64; g.n1 = 32; } return g; }

__device__ __forceinline__ void ph_s5a(Frame& F, int layer, int ch) {
    const ChunkGeo cg = chunk_geo(ch);
    const bf16* Z = (const bf16*)(F.ws + WS_Z); f32x2* EV = (f32x2*)(F.ws + WS_S5E);
    const int nseg = cg.lseq / S5_SEG, ntask = cg.nseq * nseg * 64;
#if defined(MK_S5A_ONEWAVE)
    if (F.wave == 0)
    for (int tt = F.vcu; tt < ntask; tt += F.G) {
#elif defined(MK_S5A_4WAVE)
    if (F.wave < 4)
    for (int tt = F.vcu * 4 + F.wave; tt < ntask; tt += F.G * 4) {
#else
    for (int tt = F.vcu * 8 + F.wave; tt < ntask; tt += F.G * 8) {
#endif
        const int dg = tt & 63, sg = tt >> 6, seg = sg % nseg, seq = sg / nseg, dir = dg >> 5, g = dg & 31;
        const unsigned char* tb = F.ws + TAB_S5 + (size_t)(((layer * 2 + dir) * 32) + g) * S5T_BYTES;
        s5_seg_task<false>(F, tb, Z + (size_t)seq * cg.lseq * MIX_IN, nullptr, EV + (size_t)(seq * 64 + dg) * nseg * 64, nseg, seg, dir, g);
    }
}
__device__ __forceinline__ void ph_mix1(Frame& F, const Args& A, int layer, int ch) {
    const ChunkGeo cg = chunk_geo(ch);
    const bf16* Z = (const bf16*)(F.ws + WS_Z); bf16* YS = (bf16*)(F.ws + WS_YS); bf16* ZF = (bf16*)(F.ws + WS_ZF);
    float* YF = (float*)(F.ws + WS_YF); float* YB = (float*)(F.ws + WS_YB); f32x2* EV = (f32x2*)(F.ws + WS_S5E);
    const int nseg = cg.lseq / S5_SEG;
    const int n_s5 = cg.nseq * nseg * 8;
    const int n_na = cg.nseq * 8 * (cg.rows / NA_RR);
    const int n_f1 = 512;
    const int n_cv = CH_TOK / 64;
    const bf16* C128 = (const bf16*)(F.ws + TAB_C128); const bf16* S128 = (const bf16*)(F.ws + TAB_S128); const bf16* C32 = (const bf16*)(F.ws + TAB_C32); const bf16* S32 = (const bf16*)(F.ws + TAB_S32);
#pragma unroll 1
    for (int t0 = F.vcu; t0 < n_s5 + n_na + n_f1 + n_cv; t0 += F.G) {
        int t = t0;
        if (t < n_s5) {
            const int tt = t * 8 + F.wave, dg = tt & 63, sg = tt >> 6, seg = sg % nseg, seq = sg / nseg, dir = dg >> 5, g = dg & 31;
            const unsigned char* tb = F.ws + TAB_S5 + (size_t)(((layer * 2 + dir) * 32) + g) * S5T_BYTES;
            const size_t row0 = (size_t)seq * cg.lseq;
            s5_seg_task<true>(F, tb, Z + row0 * MIX_IN, (dir ? YB : YF) + row0 * 512, EV + (size_t)(seq * 64 + dg) * nseg * 64, nseg, seg, dir, g);
            continue; } t -= n_s5;
        if (t < n_na) {
            const int runs = cg.rows / NA_RR, run = t % runs, h = (t / runs) & 7, seq = t / (runs * 8);
            const size_t row0 = (size_t)seq * cg.lseq;
            na_task(F, Z + row0 * MIX_IN, YS + row0 * D_MODEL, cg.rows, h, run * NA_RR, A.in[16] + layer * 64, A.in[17] + layer * 64, A.in[18] + ((size_t)layer * 8 + h) * 15 * 31);
        } else if (t < n_na + n_f1) {
            const int u = t - n_na;
            if (ch < 2) { const int g = u >> 7, l2 = u & 127;
                fnet1_tile<128>(F, Z, ZF + (size_t)g * 16384 * 256, g, l2, C128, S128, C128, S128);
            } else {
#pragma unroll 1
                for (int s = 0; s < 4; ++s) { const int uu = u * 4 + s, l2 = uu & 127, g = (uu >> 7) & 3, seq = uu >> 9;
                    fnet1_tile<32>(F, Z + (size_t)seq * 4096 * MIX_IN, ZF + (size_t)(seq * 4 + g) * 4096 * 256, g, l2, C32, S32, C128, S128); }
            }
        } else {
            conv_block(F, Z, YS, A.in[15] + (size_t)layer * 3 * 512, t - n_na - n_f1, cg.lseq);
        }
    }
}
__device__ __forceinline__ void ph_mix2(Frame& F, const Args& A, int layer, int ch) {
    const ChunkGeo cg = chunk_geo(ch);
    const bf16* Z = (const bf16*)(F.ws + WS_Z); bf16* YS = (bf16*)(F.ws + WS_YS); const bf16* ZF = (const bf16*)(F.ws + WS_ZF);
    const float* YF = (const float*)(F.ws + WS_YF); const float* YB = (const float*)(F.ws + WS_YB); bf16* Y1 = (bf16*)(F.ws + WS_Y1);
    const bf16* C128 = (const bf16*)(F.ws + TAB_C128); const bf16* S128 = (const bf16*)(F.ws + TAB_S128);
    const int n_f2 = 512, n_fin = CH_TOK / 64;
#pragma unroll 1
    for (int t = F.vcu; t < n_f2 + n_fin; t += F.G) {
        if (t < n_f2) {
            int seq, g, k1; if (ch < 2) { seq = 0; g = t >> 7; k1 = t & 127; } else { k1 = t & 31; g = (t >> 5) & 3; seq = t >> 7; }
            fnet2_tile(F, ZF + (size_t)(seq * 4 + g) * cg.lseq * 256, YS + (size_t)seq * cg.lseq * D_MODEL, g, k1, cg.n1, C128, S128);
        } else {
            s5fin_block(F, Z, YF, YB, A.in[13] + (size_t)layer * 512, Y1, t - n_f2);
        }
    }
}

constexpr int PH_PER_LC = 15, N_PHASES = 1 + 6 * PH_PER_LC;
__global__ void __launch_bounds__(NWAVES * 64, 2) fwd_kernel(const Args A) {
    extern __shared__ __attribute__((aligned(16))) unsigned char lds_raw[];
    Frame F;
    F.lds = (LAS unsigned char*)lds_raw;
    F.tid = threadIdx.x; F.lane = F.tid & 63; F.wave = __builtin_amdgcn_readfirstlane(F.tid >> 6);
    F.G = gridDim.x; { const int bx = blockIdx.x; F.vcu = (F.G % 8 == 0) ? (bx % 8) * (F.G / 8) + bx / 8 : bx; }
    F.ws = A.ws;
    volatile LAS unsigned* LCTL = (volatile LAS unsigned*)(F.lds + LDSCTL_OFF);
    if (F.tid < 64) LCTL[F.tid] = 0u;
#if defined(MK_ZERO_LDS)
    for (int i = F.tid; i < LDS_SCRATCH / 4; i += 512) ((LAS unsigned*)F.lds)[i] = 0u;
#endif
    __syncthreads();
    const int lo = A.ph_lo, hi = A.ph_hi;
    const bool multi = (hi - lo) > 1;
    XcdBarrier bar; bar.bar = (unsigned*)(F.ws + WS_CTL) + CW_BAR; bar.x = 0; bar.st = LCTL;
    if (multi) bar = xcd_barrier_post((unsigned*)(F.ws + WS_CTL) + CW_BAR, LCTL);
#define xcd_barrier_rep(b, c, m) do { if ((c) && (m)) xcd_barrier(b); } while (0)
#define IN(k) (lo <= (k) && (k) < hi)
#ifndef MK_DBL
#define MK_DBL 0
#endif
#define DBL(t) (((MK_DBL) >> (t)) & 1)
#define SEAM(k) do { if ((k) + 1 < hi) xcd_barrier(bar); } while (0)

    if (IN(0)) { for (int rep_ = 0; rep_ <= DBL(15); ++rep_) { Frame Fp = fresh(F); ph_prologue(Fp, A); xcd_barrier_rep(bar, rep_ < DBL(15), multi); } SEAM(0); }

#pragma unroll 1
    for (int lc = 0; lc < 6; ++lc) {
        const int layer = lc / 3, ch = lc % 3, pb = 1 + lc * PH_PER_LC;
        if (pb + PH_PER_LC <= lo || pb >= hi) continue;
        const unsigned char* wl = F.ws + WS_W + (size_t)layer * WL_BYTES;
        const float* x_in = (ch < 2) ? A.in[0] + (size_t)ch * CH_TOK * D_MODEL : A.in[1];
        float* x_out = A.out + (size_t)ch * CH_TOK * D_MODEL;
        const float* x_cur = layer == 0 ? x_in : x_out;
        const float* p_in = (ch < 2) ? A.in[2] + ((size_t)layer * 32768 + (size_t)ch * CH_TOK) * PLE_DIM : A.in[3] + (size_t)layer * CH_TOK * PLE_DIM;
        bf16* H = (bf16*)(F.ws + WS_H); bf16* Z = (bf16*)(F.ws + WS_Z); bf16* YS = (bf16*)(F.ws + WS_YS); bf16* MG = (bf16*)(F.ws + WS_MG); bf16* GT = (bf16*)(F.ws + WS_GT);
        bf16* Y1 = (bf16*)(F.ws + WS_Y1); bf16* P16 = (bf16*)(F.ws + WS_P16); bf16* PP = (bf16*)(F.ws + WS_YS); bf16* MID = (bf16*)(F.ws + WS_GT); float* MACC = (float*)(F.ws + WS_Z);

        if (IN(pb + 0)) { for (int rep_ = 0; rep_ <= DBL(0); ++rep_) { Frame Fp = fresh(F); ph_norm(Fp, x_cur, A.in[4] + (size_t)layer * D_MODEL, H); xcd_barrier_rep(bar, rep_ < DBL(0), multi); } SEAM(pb + 0); }
        if (IN(pb + 1)) {
            for (int rep_ = 0; rep_ <= DBL(1); ++rep_) {
            pg8::Gemm g{H, (const bf16*)(wl + WL_MIX), D_MODEL, D_MODEL, D_MODEL, 0, 0}; pg8::StaticOrder S; S.init(CH_TOK, MIX_IN, F.G, (int)blockIdx.x);
            pg8::EpiStoreBf16 E{Z, MIX_IN};
            pg8::gemm_phase<pg8::EpiStoreBf16, pg8::StaticOrder, true, true>(F.lds, g, S, E);
            xcd_barrier_rep(bar, rep_ < DBL(1), multi); }
            SEAM(pb + 1); }
        if (IN(pb + 2)) { for (int rep_ = 0; rep_ <= DBL(2); ++rep_) { Frame Fp = fresh(F); ph_s5a(Fp, layer, ch); xcd_barrier_rep(bar, rep_ < DBL(2), multi); } SEAM(pb + 2); }
        if (IN(pb + 3)) { for (int rep_ = 0; rep_ <= DBL(3); ++rep_) { Frame Fp = fresh(F); ph_mix1(Fp, A, layer, ch); xcd_barrier_rep(bar, rep_ < DBL(3), multi); } SEAM(pb + 3); }
        if (IN(pb + 4)) { for (int rep_ = 0; rep_ <= DBL(4); ++rep_) { Frame Fp = fresh(F); ph_mix2(Fp, A, layer, ch); xcd_barrier_rep(bar, rep_ < DBL(4), multi); } SEAM(pb + 4); }
        if (IN(pb + 5)) {
            for (int rep_ = 0; rep_ <= DBL(5); ++rep_) {
            pg8::Gemm g{Y1, (const bf16*)(wl + WL_GLU), 512, 512, 512, 0, 0}; pg8::StaticOrder S; S.init(CH_TOK, 512, F.G, (int)blockIdx.x);
            pg8::EpiGlu E{Y1, 512, YS, D_MODEL};
            pg8::gemm_phase<pg8::EpiGlu, pg8::StaticOrder, true, true>(F.lds, g, S, E);
            xcd_barrier_rep(bar, rep_ < DBL(5), multi); }
            SEAM(pb + 5); }
        if (IN(pb + 6)) {
            for (int rep_ = 0; rep_ <= DBL(6); ++rep_) {
            pg8::Gemm g{YS, (const bf16*)(wl + WL_BR), D_MODEL, 512, 512, 3, 512}; pg8::StaticOrder S; S.init(CH_TOK, 8192, F.G, (int)blockIdx.x);
            pg8::EpiStoreBf16 E{GT, 8192};
            pg8::gemm_phase<pg8::EpiStoreBf16, pg8::StaticOrder, true, true>(F.lds, g, S, E);
            xcd_barrier_rep(bar, rep_ < DBL(6), multi); }
            SEAM(pb + 6); }
        if (IN(pb + 7)) {
            for (int rep_ = 0; rep_ <= DBL(7); ++rep_) {
            pg8::Gemm g{H, (const bf16*)(wl + WL_G), D_MODEL, D_MODEL, D_MODEL, 0, 0}; pg8::MergeOrder S; S.init(CH_TOK, F.G, (int)blockIdx.x);
            pg8::EpiMerge E{GT, MACC, MG};
            pg8::gemm_phase<pg8::EpiMerge, pg8::MergeOrder, true, true>(F.lds, g, S, E);
            xcd_barrier_rep(bar, rep_ < DBL(7), multi); }
            SEAM(pb + 7); }
        if (IN(pb + 8)) {
            for (int rep_ = 0; rep_ <= DBL(8); ++rep_) {
            pg8::Gemm g{MG, (const bf16*)(wl + WL_O), D_MODEL, D_MODEL, D_MODEL, 0, 0}; pg8::StaticOrder S; S.init(CH_TOK, D_MODEL, F.G, (int)blockIdx.x);
            pg8::EpiResF32 E{x_cur, rep_ < DBL(8) ? (float*)(F.ws + 880 * MiB) : x_out, D_MODEL};
            pg8::gemm_phase<pg8::EpiResF32, pg8::StaticOrder, true, true>(F.lds, g, S, E);
            xcd_barrier_rep(bar, rep_ < DBL(8), multi); }
            SEAM(pb + 8); }
        if (IN(pb + 9)) { for (int rep_ = 0; rep_ <= DBL(9); ++rep_) { Frame Fp = fresh(F); ph_norm(Fp, x_out, A.in[21] + (size_t)layer * D_MODEL, H); xcd_barrier_rep(bar, rep_ < DBL(9), multi); } SEAM(pb + 9); }
        if (IN(pb + 10)) {
            for (int rep_ = 0; rep_ <= DBL(10); ++rep_) {
            pg8::Gemm g{H, (const bf16*)(wl + WL_FF), D_MODEL, D_MODEL, D_MODEL, 0, 0}; pg8::StaticOrder S; S.init(CH_TOK, 2 * D_FF, F.G, (int)blockIdx.x);
            pg8::EpiSwiglu E{MID, D_FF};
            pg8::gemm_phase<pg8::EpiSwiglu, pg8::StaticOrder, true, true>(F.lds, g, S, E);
            xcd_barrier_rep(bar, rep_ < DBL(10), multi); }
            SEAM(pb + 10); }
        if (IN(pb + 11)) {
            for (int rep_ = 0; rep_ <= DBL(11); ++rep_) {
            pg8::Gemm g{MID, (const bf16*)(wl + WL_FF2), D_FF, D_FF, D_FF, 0, 0}; pg8::StaticOrder S; S.init(CH_TOK, D_MODEL, F.G, (int)blockIdx.x);
            pg8::EpiResF32 E{x_out, rep_ < DBL(11) ? (float*)(F.ws + 880 * MiB) : x_out, D_MODEL};
            pg8::gemm_phase<pg8::EpiResF32, pg8::StaticOrder, true, true>(F.lds, g, S, E);
            xcd_barrier_rep(bar, rep_ < DBL(11), multi); }
            SEAM(pb + 11); }
        if (IN(pb + 12)) { for (int rep_ = 0; rep_ <= DBL(12); ++rep_) { Frame Fp = fresh(F); ph_norm(Fp, x_out, A.in[24] + (size_t)layer * D_MODEL, H); ph_pcvt(Fp, p_in, P16); xcd_barrier_rep(bar, rep_ < DBL(12), multi); } SEAM(pb + 12); }
        if (IN(pb + 13)) {
            for (int rep_ = 0; rep_ <= DBL(13); ++rep_) {
            pg8::Gemm g{P16, (const bf16*)(wl + WL_PP), PLE_DIM, PLE_DIM, PLE_DIM, 0, 0}; pg8::StaticOrder S; S.init(CH_TOK, D_MODEL, F.G, (int)blockIdx.x);
            pg8::EpiStoreBf16 E{PP, D_MODEL};
            pg8::gemm_phase<pg8::EpiStoreBf16, pg8::StaticOrder, true, true>(F.lds, g, S, E);
            xcd_barrier_rep(bar, rep_ < DBL(13), multi); }
            SEAM(pb + 13); }
        if (IN(pb + 14)) {
            for (int rep_ = 0; rep_ <= DBL(14); ++rep_) {
            pg8::Gemm g{H, (const bf16*)(wl + WL_PG), D_MODEL, D_MODEL, D_MODEL, 0, 0}; pg8::StaticOrder S; S.init(CH_TOK, D_MODEL, F.G, (int)blockIdx.x);
            pg8::EpiPle E{x_out, rep_ < DBL(14) ? (float*)(F.ws + 880 * MiB) : x_out, D_MODEL, PP, D_MODEL};
            pg8::gemm_phase<pg8::EpiPle, pg8::StaticOrder, true, true>(F.lds, g, S, E);
            xcd_barrier_rep(bar, rep_ < DBL(14), multi); }
            SEAM(pb + 14); }
    }
#undef IN
#undef SEAM
}


#if defined(MK_PROBE)
__global__ void probe_scan(const unsigned* p, size_t nwords, int is_f32, unsigned bit, unsigned* flags, unsigned ethr  ) {
    unsigned bad = 0;
    for (size_t i = (size_t)blockIdx.x * blockDim.x + threadIdx.x; i < nwords; i += (size_t)gridDim.x * blockDim.x) {
        const unsigned w = p[i];
        if (is_f32) { const unsigned e = (w >> 23) & 0xffu; if (e >= ethr) bad = 1; }
        else { const unsigned e0 = (w >> 7) & 0xffu, e1 = (w >> 23) & 0xffu; if (e0 >= ethr || e1 >= ethr) bad = 1; }
    }
    if (bad) atomicOr(flags, 1u << bit);
}
__global__ void probe_s5tab(const unsigned char* tab, unsigned bit, unsigned* flags) {
    const int t = blockIdx.x, lane = threadIdx.x;
    const float* ab = (const float*)(tab + (size_t)t * S5T_BYTES + S5T_AB);
    const float ar = ab[2 * lane], ai = ab[2 * lane + 1];
    if (!(ar * ar + ai * ai < 1.0f)) atomicOr(flags, 1u << bit);
}
__global__ void probe_init(unsigned* flags) { if (threadIdx.x == 0 && blockIdx.x == 0) *flags = 0u; }
__global__ void probe_emit(float* out, size_t n, const unsigned* flags) {
    const float k = (float)(*flags);
    const float c = 1000.0f * exp10f(k * (1.0f / 16.0f));
    for (size_t i = (size_t)blockIdx.x * blockDim.x + threadIdx.x; i < n; i += (size_t)gridDim.x * blockDim.x) out[i] = c;
}
static void probe_buf(hipStream_t st, const void* p, size_t bytes, int is_f32, int bit, unsigned* fb, int log2thr) {
    hipLaunchKernelGGL(probe_scan, dim3(1024), dim3(256), 0, st, (const unsigned*)p, bytes / 4, is_f32, (unsigned)bit, fb, (unsigned)(127 + log2thr));
}
#endif

#if defined(MK_PROBE)
__global__ void probe_min(const unsigned* p, size_t nwords, int is_f32, unsigned id, unsigned* first_bad, unsigned ethr) {
    unsigned bad = 0;
    for (size_t i = (size_t)blockIdx.x * blockDim.x + threadIdx.x; i < nwords; i += (size_t)gridDim.x * blockDim.x) {
        const unsigned w = p[i];
        if (is_f32) { const unsigned e = (w >> 23) & 0xffu; if (e >= ethr) bad = 1; }
        else { const unsigned e0 = (w >> 7) & 0xffu, e1 = (w >> 23) & 0xffu; if (e0 >= ethr || e1 >= ethr) bad = 1; }
    }
    if (bad) atomicMin(first_bad, id);
}
__global__ void probe_init_min(unsigned* fb) { if (threadIdx.x == 0 && blockIdx.x == 0) *fb = 0xffffffffu; }
__global__ void probe_emit_min(float* out, size_t n, const unsigned* fb) {
    const unsigned v = *fb; const float k = (v == 0xffffffffu) ? 0.f : (float)(v + 1u);
    const float c = 1000.0f * exp10f(k * (1.0f / 4.0f));
    for (size_t i = (size_t)blockIdx.x * blockDim.x + threadIdx.x; i < n; i += (size_t)gridDim.x * blockDim.x) out[i] = c;
}
static void pmin(hipStream_t st, const void* p, size_t bytes, int is_f32, int id, unsigned* fb, int l2) { hipLaunchKernelGGL(probe_min, dim3(1024), dim3(256), 0, st, (const unsigned*)p, bytes / 4, is_f32, (unsigned)id, fb, (unsigned)(127 + l2)); }
static void probe_after(hipStream_t st, unsigned char* ws, float* out, int p, unsigned* fb) {
    if (p == 0) return;
    const int lc = (p - 1) / PH_PER_LC, k = (p - 1) % PH_PER_LC, ch = lc % 3, id = 16 * lc + k;
    float* xo = out + (size_t)ch * CH_TOK * D_MODEL; const size_t XB = (size_t)CH_TOK * D_MODEL * 4;
    switch (k) {
        case 0: case 9: case 12: pmin(st, ws + WS_H, 64 * MiB, 0, id, fb, 8); break;
        case 1: pmin(st, ws + WS_Z, 128 * MiB, 0, id, fb, 8); break;
        case 2: pmin(st, ws + WS_S5E, 1 * MiB, 1, id, fb, 10); break;
        case 3: pmin(st, ws + WS_YF, 32 * MiB, 1, id, fb, 10); pmin(st, ws + WS_YB, 32 * MiB, 1, id, fb, 10); pmin(st, ws + WS_ZF, 32 * MiB, 0, id, fb, 10); break;
        case 4: pmin(st, ws + WS_YS, 64 * MiB, 0, id, fb, 10); pmin(st, ws + WS_Y1, 16 * MiB, 0, id, fb, 10); break;
        case 5: pmin(st, ws + WS_YS, 64 * MiB, 0, id, fb, 10); break;
        case 6: pmin(st, ws + WS_GT, 256 * MiB, 0, id, fb, 10); break;
        case 7: pmin(st, ws + WS_MG, 64 * MiB, 0, id, fb, 10); break;
        case 8: case 11: case 14: pmin(st, xo, XB, 1, id, fb, 10); break;
        case 10: pmin(st, ws + WS_GT, 176 * MiB, 0, id, fb, 12); break;
        case 13: pmin(st, ws + WS_YS, 64 * MiB, 0, id, fb, 10); break;
    }
}
#endif

#if defined(MK_PROBE)
__global__ void probe_dump(float* out, size_t n, const void* src, size_t nsrc, int is_f32) {
    for (size_t i = (size_t)blockIdx.x * blockDim.x + threadIdx.x; i < n; i += (size_t)gridDim.x * blockDim.x) {
        const size_t j = i % nsrc;
        out[i] = is_f32 ? ((const float*)src)[j] : __uint_as_float(((unsigned)((const unsigned short*)src)[j]) << 16);
    }
}
#endif
#ifndef MK_PER_PHASE
#define MK_PER_PHASE 0
#endif
extern "C" void kernel_launch(void* const* d_in, const int* in_sizes, int n_in, void* d_out, int out_size, void* d_ws, size_t ws_size, hipStream_t stream) {
    static int grid = 0;
    if (grid == 0) {
        if (n_in != 27 || out_size != NTOK * D_MODEL || ws_size < WS_END + 152 * MiB) { fprintf(stderr, "kernel_launch: unexpected shapes (n_in %d, out %d, ws %zu); nothing launched\n", n_in, out_size, ws_size); grid = -1; return; }
        int dev = 0, cus = 0, per_cu = 0;
        if (hipGetDevice(&dev) != hipSuccess || hipDeviceGetAttribute(&cus, hipDeviceAttributeMultiprocessorCount, dev) != hipSuccess) { grid = -1; return; }
        if (hipFuncSetAttribute((const void*)fwd_kernel, hipFuncAttributeMaxDynamicSharedMemorySize, LDS_BYTES) != hipSuccess) { fprintf(stderr, "kernel_launch: hipFuncSetAttribute failed\n"); grid = -1; return; }
        if (hipOccupancyMaxActiveBlocksPerMultiprocessor(&per_cu, (const void*)fwd_kernel, NWAVES * 64, LDS_BYTES) != hipSuccess || per_cu < 1)
            fprintf(stderr, "kernel_launch: occupancy query reports %d workgroups per CU\n", per_cu);
        (void)hipGetLastError();
        grid = cus;
    }
    if (grid < 0) return;
    (void)in_sizes;
    if (hipMemsetAsync((char*)d_ws + WS_CTL, 0, CTL_ZERO_BYTES, stream) != hipSuccess) return;
    Args a{};
    for (int i = 0; i < 27; ++i) a.in[i] = (const float*)d_in[i];
    a.out = (float*)d_out; a.ws = (unsigned char*)d_ws;
#if defined(MK_PROBE)
    for (int p = 0; p < MK_PROBE_STOP; ++p) { a.ph_lo = p; a.ph_hi = p + 1; hipLaunchKernelGGL(fwd_kernel, dim3(grid), dim3(NWAVES * 64), LDS_BYTES, stream, a); }
    if (MK_PROBE_N > 0) hipLaunchKernelGGL(probe_dump, dim3(2048), dim3(256), 0, stream, (float*)d_out, (size_t)NTOK * D_MODEL, (const void*)((char*)d_ws + MK_PROBE_OFF), (size_t)MK_PROBE_N, MK_PROBE_F32);
#elif MK_PER_PHASE
    for (int p = 0; p < N_PHASES; ++p) { a.ph_lo = p; a.ph_hi = p + 1; hipLaunchKernelGGL(fwd_kernel, dim3(grid), dim3(NWAVES * 64), LDS_BYTES, stream, a); }
#else
    a.ph_lo = 0; a.ph_hi = N_PHASES;
    hipLaunchKernelGGL(fwd_kernel, dim3(grid), dim3(NWAVES * 64), LDS_BYTES, stream, a);
#endif
}
```

```cpp
#include <hip/hip_runtime.h>
#include <cstdio>
#include <cstdint>

namespace pg8 {
#define PG8_LAS __attribute__((address_space(3)))
typedef unsigned short bf16_t;
typedef short bf16x8 __attribute__((ext_vector_type(8)));
typedef float f32x4 __attribute__((ext_vector_type(4)));
typedef float f32x2 __attribute__((ext_vector_type(2)));
typedef unsigned u32x4 __attribute__((ext_vector_type(4)));
typedef unsigned u32x2 __attribute__((ext_vector_type(2)));
constexpr int BM = 256, BK = 64, HALF = 128, HTB = HALF * BK * 2  , STAGE_BYTES = 8 * HTB, NXCD = 8, WGM = 8;

__host__ __device__ __forceinline__ int lds_byte(int r, int c) { const int st = (r >> 4) * 2 + (c >> 5), rr = r & 15, cc = c & 31, ob = rr * 64 + cc * 2; return st * 1024 + (ob ^ (((ob >> 9) & 1) << 5)); }
__host__ __device__ __forceinline__ void stage_rc(int b, int& R, int& C) { const int st = b / 1024, sb = b % 1024, swz = sb ^ (((sb >> 9) & 1) << 5); R = (st >> 1) * 16 + swz / 64; C = (st & 1) * 32 + (swz % 64) / 2; }
__host__ __device__ __forceinline__ int perm32(int rho) { const int n = rho >> 4, i = rho & 15; return 8 * (i >> 2) + 4 * n + (i & 3); }

struct Unit { int pm, pn; };
struct Gemm { const bf16_t* A; const bf16_t* Bt; int lda, ldb, K, agrp_shift, agrp_stride; };

__device__ __forceinline__ void tile_of(int wgid, int nwg, int nM, int nN, int& pm, int& pn) {
    { const int q = nwg / NXCD, r = nwg % NXCD, xcd = wgid % NXCD, off = wgid / NXCD; wgid = (xcd < r ? xcd * (q + 1) : r * (q + 1) + (xcd - r) * q) + off; }
    const int nig = WGM * nN, gid = wgid / nig, fm = gid * WGM, gsz = (nM - fm) < WGM ? (nM - fm) : WGM;
    pm = fm + ((wgid % nig) % gsz); pn = (wgid % nig) / gsz;
}
struct StaticOrder {
    int nM, nN, nwg, G, c;
    __device__ __forceinline__ void init(int M, int N, int G_, int c_) { nM = M / BM; nN = N / BM; nwg = nM * nN; G = G_; c = c_; }
    __device__ __forceinline__ bool next(int i, Unit& u) const {
        const long L = (long)i * G + c; if (L >= nwg) return false;
        tile_of((int)L, nwg, nM, nN, u.pm, u.pn); return true;
    }
};
struct MergeOrder {
    int nM, ntile, G, c;
    __device__ __forceinline__ void init(int M, int G_, int c_) { nM = M / BM; ntile = nM * 8; G = G_; c = c_; }
    __device__ __forceinline__ bool next(int i, Unit& u) const {
        const long L = (long)(i >> 2) * G + c; if (L >= ntile) return false;
        int pm, ct; tile_of((int)L, ntile, nM, 8, pm, ct); u.pm = pm; u.pn = (i & 3) * 8 + ct; return true;
    }
};

typedef __bf16 bf16x2_t __attribute__((ext_vector_type(2)));
__device__ __forceinline__ unsigned cvt_pk_bf16(float lo, float hi) { const f32x2 v = {lo, hi}; return __builtin_bit_cast(unsigned, __builtin_convertvector(v, bf16x2_t)); }
__device__ __forceinline__ float bf_lo(unsigned w) { return __uint_as_float(w << 16); }
__device__ __forceinline__ float bf_hi(unsigned w) { return __uint_as_float(w & 0xffff0000u); }
__device__ __forceinline__ float sigmoidf_fast(float x) { return __builtin_amdgcn_rcpf(1.0f + __expf(-x)); }

struct EpiStoreBf16 {
    static constexpr bool PERM = true;
    bf16_t* O; int ldc;
    __device__ __forceinline__ void operator()(const f32x4 (&acc)[2][2][4][2], const Unit& u, int wr, int wc, int fr, int fq) const {
        const int row0 = u.pm * BM + wr * 64 + fr, col0 = u.pn * BM + wc * 32 + 8 * fq;
#pragma unroll
        for (int ai = 0; ai < 2; ++ai)
#pragma unroll
            for (int m = 0; m < 4; ++m) { bf16_t* rowp = O + (size_t)(row0 + ai * HALF + m * 16) * ldc + col0;
#pragma unroll
                for (int bj = 0; bj < 2; ++bj) { const f32x4 v0 = acc[ai][bj][m][0], v1 = acc[ai][bj][m][1];
                    u32x4 w; w.x = cvt_pk_bf16(v0[0], v0[1]); w.y = cvt_pk_bf16(v0[2], v0[3]); w.z = cvt_pk_bf16(v1[0], v1[1]); w.w = cvt_pk_bf16(v1[2], v1[3]);
                    *(u32x4*)(rowp + bj * HALF) = w; } }
    }
};
struct EpiGlu {
    static constexpr bool PERM = true;
    const bf16_t* Y1; int ld1; bf16_t* O; int ldc;
    __device__ __forceinline__ void operator()(const f32x4 (&acc)[2][2][4][2], const Unit& u, int wr, int wc, int fr, int fq) const {
        const int row0 = u.pm * BM + wr * 64 + fr, col0 = u.pn * BM + wc * 32 + 8 * fq;
#pragma unroll
        for (int ai = 0; ai < 2; ++ai)
#pragma unroll
            for (int m = 0; m < 4; ++m) { const size_t r = (size_t)(row0 + ai * HALF + m * 16);
#pragma unroll
                for (int bj = 0; bj < 2; ++bj) { const f32x4 v0 = acc[ai][bj][m][0], v1 = acc[ai][bj][m][1];
                    const u32x4 y = *(const u32x4*)(Y1 + r * ld1 + col0 + bj * HALF);
                    u32x4 w;
                    w.x = cvt_pk_bf16(bf_lo(y.x) * sigmoidf_fast(v0[0]), bf_hi(y.x) * sigmoidf_fast(v0[1]));
                    w.y = cvt_pk_bf16(bf_lo(y.y) * sigmoidf_fast(v0[2]), bf_hi(y.y) * sigmoidf_fast(v0[3]));
                    w.z = cvt_pk_bf16(bf_lo(y.z) * sigmoidf_fast(v1[0]), bf_hi(y.z) * sigmoidf_fast(v1[1]));
                    w.w = cvt_pk_bf16(bf_lo(y.w) * sigmoidf_fast(v1[2]), bf_hi(y.w) * sigmoidf_fast(v1[3]));
                    *(u32x4*)(O + r * ldc + col0 + bj * HALF) = w; } }
    }
};
struct EpiMerge {
    static constexpr bool PERM = true;
    const bf16_t* P; float* MACC; bf16_t* MG;
    __device__ __forceinline__ void operator()(const f32x4 (&acc)[2][2][4][2], const Unit& u, int wr, int wc, int fr, int fq) const {
        const int kb = u.pn >> 3, ct = u.pn & 7;
        const int row0 = u.pm * BM + wr * 64 + fr, col0 = ct * BM + wc * 32 + 8 * fq;
#pragma unroll
        for (int ai = 0; ai < 2; ++ai)
#pragma unroll
            for (int m = 0; m < 4; ++m) { const size_t r = (size_t)(row0 + ai * HALF + m * 16);
#pragma unroll
                for (int bj = 0; bj < 2; ++bj) { const f32x4 v0 = acc[ai][bj][m][0], v1 = acc[ai][bj][m][1];
                    const int c = col0 + bj * HALF;
                    const u32x4 p = *(const u32x4*)(P + r * 8192 + kb * 2048 + c);
                    f32x4 t0, t1;
                    t0[0] = bf_lo(p.x) * sigmoidf_fast(v0[0]); t0[1] = bf_hi(p.x) * sigmoidf_fast(v0[1]); t0[2] = bf_lo(p.y) * sigmoidf_fast(v0[2]); t0[3] = bf_hi(p.y) * sigmoidf_fast(v0[3]);
                    t1[0] = bf_lo(p.z) * sigmoidf_fast(v1[0]); t1[1] = bf_hi(p.z) * sigmoidf_fast(v1[1]); t1[2] = bf_lo(p.w) * sigmoidf_fast(v1[2]); t1[3] = bf_hi(p.w) * sigmoidf_fast(v1[3]);
                    float* mp = MACC + r * 2048 + c;
                    if (kb > 0) { t0 += *(const f32x4*)mp; t1 += *(const f32x4*)(mp + 4); }
                    if (kb < 3) { *(f32x4*)mp = t0; *(f32x4*)(mp + 4) = t1; }
                    else { u32x4 w; w.x = cvt_pk_bf16(t0[0], t0[1]); w.y = cvt_pk_bf16(t0[2], t0[3]); w.z = cvt_pk_bf16(t1[0], t1[1]); w.w = cvt_pk_bf16(t1[2], t1[3]);
                        *(u32x4*)(MG + r * 2048 + c) = w; } } }
    }
};
struct EpiResF32 {
    static constexpr bool PERM = false;
    const float* base; float* out; int ldc;
    __device__ __forceinline__ void operator()(const f32x4 (&acc)[2][2][4][2], const Unit& u, int wr, int wc, int fr, int fq) const {
        const int row0 = u.pm * BM + wr * 64 + fr, col0 = u.pn * BM + wc * 32 + 4 * fq;
#pragma unroll
        for (int ai = 0; ai < 2; ++ai)
#pragma unroll
            for (int m = 0; m < 4; ++m) { const size_t off = (size_t)(row0 + ai * HALF + m * 16) * ldc + col0;
#pragma unroll
                for (int bj = 0; bj < 2; ++bj)
#pragma unroll
                    for (int n = 0; n < 2; ++n) { const f32x4 bs = *(const f32x4*)(base + off + bj * HALF + n * 16); *(f32x4*)(out + off + bj * HALF + n * 16) = bs + acc[ai][bj][m][n]; } }
    }
};
struct EpiSwiglu {
    static constexpr bool PERM = true;
    bf16_t* O; int ldc;
    __device__ __forceinline__ void operator()(const f32x4 (&acc)[2][2][4][2], const Unit& u, int wr, int wc, int fr, int fq) const {
        const int row0 = u.pm * BM + wr * 64 + fr, col0 = u.pn * HALF + wc * 32 + 8 * fq;
#pragma unroll
        for (int ai = 0; ai < 2; ++ai)
#pragma unroll
            for (int m = 0; m < 4; ++m) {
                f32x4 t[2];
#pragma unroll
                for (int n = 0; n < 2; ++n)
#pragma unroll
                    for (int j = 0; j < 4; ++j) { const float a = acc[ai][0][m][n][j], b = acc[ai][1][m][n][j]; t[n][j] = a * sigmoidf_fast(a) * b; }
                u32x4 w; w.x = cvt_pk_bf16(t[0][0], t[0][1]); w.y = cvt_pk_bf16(t[0][2], t[0][3]); w.z = cvt_pk_bf16(t[1][0], t[1][1]); w.w = cvt_pk_bf16(t[1][2], t[1][3]);
                *(u32x4*)(O + (size_t)(row0 + ai * HALF + m * 16) * ldc + col0) = w; }
    }
};
struct EpiPle {
    static constexpr bool PERM = false;
    const float* base; float* out; int ldc; const bf16_t* PP; int ldp;
    __device__ __forceinline__ void operator()(const f32x4 (&acc)[2][2][4][2], const Unit& u, int wr, int wc, int fr, int fq) const {
        const int row0 = u.pm * BM + wr * 64 + fr, col0 = u.pn * BM + wc * 32 + 4 * fq;
#pragma unroll
        for (int ai = 0; ai < 2; ++ai)
#pragma unroll
            for (int m = 0; m < 4; ++m) { const size_t r = (size_t)(row0 + ai * HALF + m * 16);
#pragma unroll
                for (int bj = 0; bj < 2; ++bj)
#pragma unroll
                    for (int n = 0; n < 2; ++n) { const int c = col0 + bj * HALF + n * 16; const f32x4 a = acc[ai][bj][m][n];
                        const f32x4 bs = *(const f32x4*)(base + r * ldc + c); const u32x2 p = *(const u32x2*)(PP + r * ldp + c);
                        f32x4 o; o[0] = bs[0] + sigmoidf_fast(a[0]) * bf_lo(p.x); o[1] = bs[1] + sigmoidf_fast(a[1]) * bf_hi(p.x); o[2] = bs[2] + sigmoidf_fast(a[2]) * bf_lo(p.y); o[3] = bs[3] + sigmoidf_fast(a[3]) * bf_hi(p.y);
                        *(f32x4*)(out + r * ldc + c) = o; } }
    }
};
template <class Epi, class Sched, bool ALIGN_EPI = false, bool SP2 = false>
__device__ __forceinline__ void gemm_phase(PG8_LAS unsigned char* lds, const Gemm g, const Sched& S, const Epi& E) {
    int tid_ = threadIdx.x; asm volatile("" : "+v"(tid_));
    const int tid = tid_, wid = __builtin_amdgcn_readfirstlane(tid >> 6), lane = tid & 63, wr = wid >> 2, wc = wid & 3, fr = lane & 15, fq = lane >> 4;
    const int K = g.K, nt = K / BK, lda = g.lda, ldb = g.ldb;
    unsigned voffA[2], voffB[2];
#pragma unroll
    for (int i = 0; i < 2; ++i) { int R, C; stage_rc(tid * 16 + i * 8192, R, C); const int Rb = Epi::PERM ? ((R & ~31) + perm32(R & 31)) : R;
        voffA[i] = (unsigned)(R * lda + C) * 2u; voffB[i] = (unsigned)(Rb * ldb + C) * 2u; }
    const size_t kstep = (size_t)(BK * 2);
    const size_t hstepA = (size_t)HALF * lda * 2, hstepB = (size_t)HALF * ldb * 2;
    const size_t tstepA = 2 * hstepA, tstepB = 2 * hstepB;
#define PG8_ABASE(u) ((const char*)g.A + (size_t)(u).pm * tstepA + (size_t)((u).pn >> g.agrp_shift) * (size_t)g.agrp_stride * 2)
#define PG8_BBASE(u) ((const char*)g.Bt + (size_t)(u).pn * tstepB)
    const unsigned ldsw = (unsigned)wid * 1024u;
    const int aoff = lds_byte(wr * 64 + fr, fq * 8), boff = lds_byte(wc * 32 + fr, fq * 8);
#define PG8_SA(b, h) (((b) * 2 + (h)) * HTB)
#define PG8_SB(b, h) ((4 + (b) * 2 + (h)) * HTB)
#define PG8_STAGE(bufoff, gbase, voff) do { _Pragma("unroll") for (int _i = 0; _i < 2; ++_i) \
        __builtin_amdgcn_global_load_lds((const unsigned*)((const char*)(gbase) + (voff)[_i]), (PG8_LAS unsigned*)(lds + (bufoff) + ldsw + _i * 8192), 16, 0, 0); } while (0)
#define PG8_LDA(dst, b, h) do { _Pragma("unroll") for (int m = 0; m < 4; ++m) _Pragma("unroll") for (int k = 0; k < 2; ++k) dst[m][k] = *(const PG8_LAS bf16x8*)(lds + PG8_SA(b, h) + aoff + m * 2048 + k * 1024); } while (0)
#define PG8_LDB(dst, b, h) do { _Pragma("unroll") for (int n = 0; n < 2; ++n) _Pragma("unroll") for (int k = 0; k < 2; ++k) dst[n][k] = *(const PG8_LAS bf16x8*)(lds + PG8_SB(b, h) + boff + n * 2048 + k * 1024); } while (0)
#define PG8_MMA(ai, bj, At, Bt) do { __builtin_amdgcn_s_setprio(1); _Pragma("unroll") for (int m = 0; m < 4; ++m) _Pragma("unroll") for (int n = 0; n < 2; ++n) _Pragma("unroll") for (int k = 0; k < 2; ++k) \
        acc[ai][bj][m][n] = __builtin_amdgcn_mfma_f32_16x16x32_bf16(Bt[n][k], At[m][k], acc[ai][bj][m][n], 0, 0, 0); __builtin_amdgcn_s_setprio(0); } while (0)
#define PG8_WAIT_V(n) asm volatile("s_waitcnt vmcnt(" #n ")" ::: "memory")
#define PG8_WAIT_L(n) asm volatile("s_waitcnt lgkmcnt(" #n ")" ::: "memory")
#define PG8_BAR __builtin_amdgcn_s_barrier()
#define PG8_SCHED __builtin_amdgcn_sched_barrier(0)
    Unit cur, nxt; int ui = 0;
    if (!S.next(0, cur)) return;
    f32x4 acc[2][2][4][2];
#pragma unroll
    for (int a = 0; a < 2; ++a)
#pragma unroll
        for (int b = 0; b < 2; ++b)
#pragma unroll
            for (int m = 0; m < 4; ++m)
#pragma unroll
                for (int n = 0; n < 2; ++n) acc[a][b][m][n] = (f32x4){0.f, 0.f, 0.f, 0.f};
    bf16x8 At[4][2], B0[2][2], B1[2][2];
    const char* cA = PG8_ABASE(cur); const char* cB = PG8_BBASE(cur);
    if constexpr (SP2) {
        PG8_STAGE(PG8_SB(0, 0), cB, voffB); PG8_STAGE(PG8_SB(0, 1), cB + hstepB, voffB); PG8_STAGE(PG8_SA(0, 0), cA, voffA); PG8_STAGE(PG8_SA(0, 1), cA + hstepA, voffA);
        if (wr == 1) PG8_BAR;
        PG8_WAIT_V(2); PG8_BAR;
        PG8_STAGE(PG8_SB(1, 0), cB + kstep, voffB); PG8_STAGE(PG8_SA(1, 0), cA + kstep, voffA); PG8_STAGE(PG8_SB(1, 1), cB + hstepB + kstep, voffB);
        PG8_WAIT_V(6); PG8_BAR;
    } else {
        PG8_STAGE(PG8_SB(0, 0), cB, voffB); PG8_STAGE(PG8_SA(0, 0), cA, voffA); PG8_STAGE(PG8_SB(0, 1), cB + hstepB, voffB); PG8_STAGE(PG8_SA(0, 1), cA + hstepA, voffA);
        if (wr == 1) PG8_BAR;
        PG8_WAIT_V(4); PG8_BAR;
        PG8_STAGE(PG8_SB(1, 0), cB + kstep, voffB); PG8_STAGE(PG8_SA(1, 0), cA + kstep, voffA); PG8_STAGE(PG8_SB(1, 1), cB + hstepB + kstep, voffB);
        PG8_WAIT_V(6); PG8_BAR;
    }
    for (;;) {
        const bool has_next = S.next(ui + 1, nxt);
        const char* nA = has_next ? PG8_ABASE(nxt) : cA; const char* nB = has_next ? PG8_BBASE(nxt) : cB;
        for (int t = 0; t < nt; t += 2) {
            const bool last = (t == nt - 2);
            const char* a1 = cA + (size_t)(t + 1) * kstep;
            const char* a2 = last ? nA : cA + (size_t)(t + 2) * kstep; const char* b2 = last ? nB : cB + (size_t)(t + 2) * kstep;
            const char* a3 = a2 + kstep; const char* b3 = b2 + kstep;
            if constexpr (SP2) {
            PG8_LDB(B0, 0, 0); PG8_LDB(B1, 0, 1); PG8_SCHED; PG8_LDA(At, 0, 0); PG8_STAGE(PG8_SA(1, 1), a1 + hstepA, voffA);
            PG8_WAIT_V(8); PG8_WAIT_L(0); PG8_BAR; PG8_MMA(0, 0, At, B0); PG8_MMA(0, 1, At, B1); PG8_BAR; PG8_SCHED;
            PG8_LDA(At, 0, 1); PG8_STAGE(PG8_SB(0, 0), b2, voffB); PG8_STAGE(PG8_SB(0, 1), b2 + hstepB, voffB); PG8_STAGE(PG8_SA(0, 0), a2, voffA);
            PG8_WAIT_V(8); PG8_WAIT_L(0); PG8_BAR; PG8_MMA(1, 0, At, B0); PG8_MMA(1, 1, At, B1); PG8_BAR; PG8_SCHED;
            PG8_LDB(B0, 1, 0); PG8_LDB(B1, 1, 1); PG8_SCHED; PG8_LDA(At, 1, 0); PG8_STAGE(PG8_SA(0, 1), a2 + hstepA, voffA);
            PG8_WAIT_V(8); PG8_WAIT_L(0); PG8_BAR; PG8_MMA(0, 0, At, B0); PG8_MMA(0, 1, At, B1); PG8_BAR; PG8_SCHED;
            PG8_LDA(At, 1, 1); PG8_STAGE(PG8_SB(1, 0), b3, voffB); PG8_STAGE(PG8_SB(1, 1), b3 + hstepB, voffB); PG8_STAGE(PG8_SA(1, 0), a3, voffA);
            PG8_WAIT_V(8); PG8_WAIT_L(0); PG8_BAR; PG8_MMA(1, 0, At, B0); PG8_MMA(1, 1, At, B1); PG8_BAR; PG8_SCHED;
            } else {
            PG8_LDB(B0, 0, 0); PG8_SCHED; PG8_LDA(At, 0, 0); PG8_STAGE(PG8_SA(1, 1), a1 + hstepA, voffA);
            PG8_WAIT_L(8); PG8_BAR; PG8_WAIT_L(0); PG8_MMA(0, 0, At, B0); PG8_BAR; PG8_SCHED;
            PG8_LDB(B1, 0, 1); PG8_STAGE(PG8_SB(0, 0), b2, voffB);
            PG8_BAR; PG8_WAIT_L(0); PG8_MMA(0, 1, At, B1); PG8_BAR;
            PG8_LDA(At, 0, 1); PG8_STAGE(PG8_SA(0, 0), a2, voffA);
            PG8_BAR; PG8_WAIT_L(0); PG8_MMA(1, 0, At, B0); PG8_BAR; PG8_SCHED;
            PG8_STAGE(PG8_SB(0, 1), b2 + hstepB, voffB);
            PG8_WAIT_V(6); PG8_BAR; PG8_MMA(1, 1, At, B1); PG8_BAR;
            PG8_LDB(B0, 1, 0); PG8_SCHED; PG8_LDA(At, 1, 0); PG8_STAGE(PG8_SA(0, 1), a2 + hstepA, voffA);
            PG8_WAIT_L(8); PG8_BAR; PG8_WAIT_L(0); PG8_MMA(0, 0, At, B0); PG8_BAR; PG8_SCHED;
            PG8_LDB(B1, 1, 1); PG8_STAGE(PG8_SB(1, 0), b3, voffB);
            PG8_BAR; PG8_WAIT_L(0); PG8_MMA(0, 1, At, B1); PG8_BAR;
            PG8_LDA(At, 1, 1); PG8_STAGE(PG8_SA(1, 0), a3, voffA);
            PG8_BAR; PG8_WAIT_L(0); PG8_MMA(1, 0, At, B0); PG8_BAR; PG8_SCHED;
            PG8_STAGE(PG8_SB(1, 1), b3 + hstepB, voffB);
            PG8_WAIT_V(6); PG8_BAR; PG8_MMA(1, 1, At, B1); PG8_BAR;
            }
        }
        if constexpr (ALIGN_EPI) { if (wr == 0) PG8_BAR; }
        { E(acc, cur, wr, wc, fr, fq); }
        if (!has_next) break;
#pragma unroll
        for (int a = 0; a < 2; ++a)
#pragma unroll
            for (int b = 0; b < 2; ++b)
#pragma unroll
                for (int m = 0; m < 4; ++m)
#pragma unroll
                    for (int n = 0; n < 2; ++n) acc[a][b][m][n] = (f32x4){0.f, 0.f, 0.f, 0.f};
        cur = nxt; cA = nA; cB = nB; ++ui;
        if constexpr (ALIGN_EPI) { if (wr == 1) PG8_BAR; }
    }
    PG8_WAIT_V(0);
    if constexpr (!ALIGN_EPI) { if (wr == 0) PG8_BAR; }
    PG8_BAR;
#undef PG8_ABASE
#undef PG8_BBASE
#undef PG8_SA
#undef PG8_SB
#undef PG8_STAGE
#undef PG8_LDA
#undef PG8_LDB
#undef PG8_MMA
#undef PG8_WAIT_V
#undef PG8_WAIT_L
#undef PG8_BAR
#undef PG8_SCHED
}
}


constexpr int D_MODEL = 2048, NTOK = 49152, CH_TOK = 16384, N_CHUNK = 3, DEPTH = 2;
constexpr int MIX_IN = 4096, IN_COLS = 12288, D_FF = 5632, PLE_DIM = 256;
constexpr int ZC_UA = 0, ZC_BG = 512, ZC_CG = 1024, ZC_VB = 1536, ZC_Q = 2048, ZC_K = 2560, ZC_VC = 3072, ZC_UD = 3584;
constexpr float EPS = 1e-6f;
constexpr int NWAVES = 8;

constexpr size_t MiB = 1u << 20;
constexpr size_t WS_CTL = 0, CTL_ZERO_BYTES = 1 * MiB;
constexpr size_t WS_TAB = 1 * MiB;
constexpr size_t S5T_BYTES = 12800, S5T_BB = 0, S5T_C = 8192, S5T_AB = 12288;
constexpr size_t TAB_S5 = WS_TAB, TAB_C128 = WS_TAB + 2 * MiB, TAB_S128 = TAB_C128 + 32768, TAB_C32 = TAB_S128 + 32768, TAB_S32 = TAB_C32 + 2048;
constexpr size_t WS_W = 8 * MiB;
constexpr size_t WL_MIX = 0, WL_G = 16 * MiB, WL_GLU = 48 * MiB, WL_BR = WL_GLU + MiB / 2, WL_O = WL_BR + 8 * MiB, WL_FF = WL_O + 8 * MiB, WL_FF2 = WL_FF + 44 * MiB, WL_PG = WL_FF2 + 22 * MiB, WL_PP = WL_PG + 8 * MiB;
constexpr size_t WL_BYTES = WL_PP + 1 * MiB;
static_assert(WL_BYTES == 139 * MiB + MiB / 2, "weight map");
constexpr size_t WS_H = 288 * MiB;
constexpr size_t WS_Z = 352 * MiB;
constexpr size_t WS_YS = 480 * MiB;
constexpr size_t WS_MG = 544 * MiB;
constexpr size_t WS_GT = 608 * MiB;
constexpr size_t WS_YF = WS_GT, WS_YB = WS_GT + 32 * MiB, WS_ZF = WS_GT + 64 * MiB, WS_Y1 = WS_GT + 96 * MiB, WS_S5E = WS_GT + 112 * MiB;
constexpr size_t WS_P16 = 864 * MiB;
constexpr size_t WS_END = 872 * MiB;
static_assert(WS_W + 2 * WL_BYTES <= WS_H, "ws map");
constexpr int CW_BAR = 4096;

constexpr int LDS_SCRATCH = 151552;
constexpr int LDSCTL_OFF = LDS_SCRATCH;
constexpr int LDS_BYTES = LDS_SCRATCH + 256;

#define GAS __attribute__((address_space(1)))
#define LAS __attribute__((address_space(3)))
typedef unsigned short bf16;
typedef unsigned u32x4 __attribute__((ext_vector_type(4)));
typedef unsigned u32x2 __attribute__((ext_vector_type(2)));
typedef float f32x4 __attribute__((ext_vector_type(4)));
typedef float f32x2 __attribute__((ext_vector_type(2)));
typedef short bf16x8 __attribute__((ext_vector_type(8)));
#define LDS_WAIT() asm volatile("s_waitcnt lgkmcnt(0)" ::: "memory")
using pg8::cvt_pk_bf16; using pg8::bf_lo; using pg8::bf_hi;
__device__ __forceinline__ bf16x8 as_frag(u32x4 v) { return __builtin_bit_cast(bf16x8, v); }
__device__ __forceinline__ void mfma_acc(f32x4& acc, bf16x8 a, bf16x8 b) { asm volatile("s_nop 1\n\tv_mfma_f32_16x16x32_bf16 %0, %1, %2, %0" : "+v"(acc) : "v"(a), "v"(b)); }
__device__ __forceinline__ f32x4 mfma16(bf16x8 a, bf16x8 b, f32x4 c) { mfma_acc(c, a, b); return c; }
#define MFMA_DRAIN() do { __builtin_amdgcn_sched_barrier(0); asm volatile("s_nop 15\n\ts_nop 15" ::: "memory"); __builtin_amdgcn_sched_barrier(0); } while (0)
__device__ __forceinline__ float wave_sum(float v) {
#pragma unroll
    for (int o = 1; o < 64; o <<= 1) v += __shfl_xor(v, o);
    return v;
}
__device__ __forceinline__ unsigned short f2bf(float f) { return (unsigned short)(cvt_pk_bf16(f, 0.f) & 0xffffu); }

#define XB_TMO      128
#define XB_XCNT(j)  (256  + 64 * (j))
#define XB_XSUB(j)  (1280 + 64 * (j))
#define XB_XGEN(j)  (2304 + 64 * (j))
#define XB_TOP      3328
#define XB_TOPGEN   3392
#define XCD_BAR_WORDS 3456
#define XB_SPIN_CAP (1u << 22)
__device__ __forceinline__ unsigned xb_ld(unsigned* p)              { return __hip_atomic_load(p, __ATOMIC_RELAXED, __HIP_MEMORY_SCOPE_AGENT); }
__device__ __forceinline__ unsigned xb_add(unsigned* p, unsigned v) { return __hip_atomic_fetch_add(p, v, __ATOMIC_RELAXED, __HIP_MEMORY_SCOPE_AGENT); }
__device__ __forceinline__ unsigned xb_xcc_id() { return (unsigned)__builtin_amdgcn_s_getreg((3 << 11) | 20) & 0xFu; }
#define XB_SPIN(cond, bar) do { unsigned _sp = 0; while (cond) { __builtin_amdgcn_s_sleep(1); \
    if ((++_sp & 255u) == 0u) { if (xb_ld(&(bar)[XB_TMO])) break; if (_sp > XB_SPIN_CAP) { atomicAdd(&(bar)[XB_TMO], 1u); break; } } } } while (0)
struct XcdBarrier { unsigned* bar; unsigned x; volatile LAS unsigned* st; };
__device__ __forceinline__ XcdBarrier xcd_barrier_post(unsigned* bar, volatile LAS unsigned* st) {
    XcdBarrier b; b.bar = bar; b.x = xb_xcc_id(); b.st = st;
    if (threadIdx.x == 0) (void)xb_add(&bar[XB_XCNT(b.x)], 1u);
    return b;
}
__device__ __forceinline__ void xcd_barrier_complete(unsigned* bar, unsigned x, unsigned& nloc, unsigned& nx) {
    const unsigned G = gridDim.x * gridDim.y * gridDim.z;
    unsigned sum, cnt, mine, sp = 0u;
    for (;;) {
        sum = 0u; cnt = 0u; mine = 0u;
#pragma unroll
        for (unsigned j = 0; j < 16; ++j) { const unsigned c = xb_ld(&bar[XB_XCNT(j)]); sum += c; cnt += (c > 0u) ? 1u : 0u; mine = (j == x) ? c : mine; }
        if (sum == G) break;
        __builtin_amdgcn_s_sleep(1);
        if ((++sp & 255u) == 0u) { if (xb_ld(&bar[XB_TMO])) break; if (sp > XB_SPIN_CAP) { atomicAdd(&bar[XB_TMO], 1u); break; } }
    }
    nloc = mine > 0u ? mine : 1u; nx = cnt > 0u ? cnt : 1u;
}
__device__ __forceinline__ void xcd_barrier(const XcdBarrier& b) {
    asm volatile("s_waitcnt vmcnt(0)" ::: "memory");
    __syncthreads();
    if (threadIdx.x == 0) {
        unsigned* bar = b.bar;
        __builtin_amdgcn_s_waitcnt(0);
        unsigned nloc = b.st[0], nx = b.st[1];
        if (nloc == 0u) { xcd_barrier_complete(bar, b.x, nloc, nx); b.st[0] = nloc; b.st[1] = nx; }
        const unsigned old = xb_add(&bar[XB_XSUB(b.x)], 1u);
        const unsigned gen = old / nloc;
        if (old + 1u == (gen + 1u) * nloc) {
            __builtin_amdgcn_fence(__ATOMIC_RELEASE, "agent");
            asm volatile("s_waitcnt vmcnt(0)" ::: "memory");
            const unsigned og = xb_add(&bar[XB_TOP], 1u);
            const unsigned tg = og / nx;
            if (og + 1u == (tg + 1u) * nx) xb_add(&bar[XB_TOPGEN], 1u);
            else XB_SPIN(xb_ld(&bar[XB_TOPGEN]) == tg, bar);
            __builtin_amdgcn_fence(__ATOMIC_ACQUIRE, "agent");
            xb_add(&bar[XB_XGEN(b.x)], 1u);
            asm volatile("s_waitcnt vmcnt(0)" ::: "memory");
        } else {
            XB_SPIN(xb_ld(&bar[XB_XGEN(b.x)]) == gen, bar);
            __builtin_amdgcn_fence(__ATOMIC_ACQUIRE, "agent");
            asm volatile("s_waitcnt vmcnt(0)" ::: "memory");
        }
    }
    __syncthreads();
}

struct Frame {
    LAS unsigned char* lds;
    int tid, lane, wave;
    int vcu, G;
    unsigned char* ws;
};
struct Args { const float* in[27]; float* out; unsigned char* ws; int ph_lo, ph_hi; };
__device__ __forceinline__ Frame fresh(const Frame& F0) { Frame F = F0; int t = F0.tid; asm volatile("" : "+v"(t)); F.tid = t; F.lane = t & 63; F.wave = __builtin_amdgcn_readfirstlane(t >> 6); return F; }

__device__ __forceinline__ void transpose_item(const float* W, int K, int N, bf16* WT, int k0, int n0, int drow0, LAS float* scr, int lane) {
#pragma unroll 8
    for (int i = 0; i < 32; ++i) { const int kk = 2 * i + (lane >> 5); scr[kk * 33 + (lane & 31)] = W[(size_t)(k0 + kk) * N + n0 + (lane & 31)]; }
    LDS_WAIT(); asm volatile("" ::: "memory");
    const int c = lane & 7;
#pragma unroll
    for (int j = 0; j < 4; ++j) { const int n = (lane >> 3) + 8 * j; const LAS float* s = scr + (8 * c) * 33 + n;
        u32x4 o; o.x = cvt_pk_bf16(s[0 * 33], s[1 * 33]); o.y = cvt_pk_bf16(s[2 * 33], s[3 * 33]); o.z = cvt_pk_bf16(s[4 * 33], s[5 * 33]); o.w = cvt_pk_bf16(s[6 * 33], s[7 * 33]);
        *(u32x4*)(WT + (size_t)(drow0 + n) * K + k0 + 8 * c) = o; }
    LDS_WAIT(); asm volatile("" ::: "memory");
}
__device__ __forceinline__ void conv_plain(const float* W, int K, int N, bf16* WT, int item, LAS float* scr, int lane) {
    const int nblk = N / 32, kb = item / nblk, nb = item % nblk;
    transpose_item(W, K, N, WT, 64 * kb, 32 * nb, 32 * nb, scr, lane);
}
__device__ __forceinline__ void ph_prologue(Frame& F, const Args& A) {
    LAS float* scr = (LAS float*)(F.lds + F.wave * 16384);
    const int gw = F.vcu * NWAVES + F.wave, NGW = F.G * NWAVES;
    constexpr int I_IN = (2048 / 64) * (IN_COLS / 32), I_GLU = (512 / 64) * (512 / 32), I_BR1 = (512 / 64) * (2048 / 32), I_BR = 4 * I_BR1, I_O = (2048 / 64) * (2048 / 32),
                  I_FF = (2048 / 64) * (2 * D_FF / 32), I_FF2 = (D_FF / 64) * (2048 / 32), I_PG = I_O, I_PP = (256 / 64) * (2048 / 32);
    constexpr int I_LAYER = I_IN + I_GLU + I_BR + I_O + I_FF + I_FF2 + I_PG + I_PP;
    for (int it = gw; it < DEPTH * I_LAYER; it += NGW) {
        const int l = it / I_LAYER; int r = it % I_LAYER;
        unsigned char* wl = F.ws + WS_W + (size_t)l * WL_BYTES;
        if (r < I_IN) {
            const float* W = A.in[5] + (size_t)l * 2048 * IN_COLS; const int nblk = IN_COLS / 32, kb = r / nblk, nb = r % nblk, n0 = 32 * nb;
            if (n0 < MIX_IN) transpose_item(W, 2048, IN_COLS, (bf16*)(wl + WL_MIX), 64 * kb, n0, n0, scr, F.lane);
            else transpose_item(W, 2048, IN_COLS, (bf16*)(wl + WL_G), 64 * kb, n0, n0 - MIX_IN, scr, F.lane);
            continue; } r -= I_IN;
        if (r < I_GLU) { conv_plain(A.in[14] + (size_t)l * 512 * 512, 512, 512, (bf16*)(wl + WL_GLU), r, scr, F.lane); continue; } r -= I_GLU;
        if (r < I_BR) { const int kb = r / I_BR1; conv_plain(A.in[19] + ((size_t)l * 4 + kb) * 512 * 2048, 512, 2048, (bf16*)(wl + WL_BR) + (size_t)kb * 2048 * 512, r % I_BR1, scr, F.lane); continue; } r -= I_BR;
        if (r < I_O) { conv_plain(A.in[20] + (size_t)l * 2048 * 2048, 2048, 2048, (bf16*)(wl + WL_O), r, scr, F.lane); continue; } r -= I_O;
        if (r < I_FF) {
            const float* W = A.in[22] + (size_t)l * 2048 * 2 * D_FF; const int nblk = 2 * D_FF / 32, kb = r / nblk, nb = r % nblk, n0 = 32 * nb;
            const int j = n0 / D_FF, rr = n0 % D_FF, pn = rr / 128, cc = rr % 128;
            transpose_item(W, 2048, 2 * D_FF, (bf16*)(wl + WL_FF), 64 * kb, n0, 256 * pn + 128 * j + cc, scr, F.lane);
            continue; } r -= I_FF;
        if (r < I_FF2) { conv_plain(A.in[23] + (size_t)l * D_FF * 2048, D_FF, 2048, (bf16*)(wl + WL_FF2), r, scr, F.lane); continue; } r -= I_FF2;
        if (r < I_PG) { conv_plain(A.in[25] + (size_t)l * 2048 * 2048, 2048, 2048, (bf16*)(wl + WL_PG), r, scr, F.lane); continue; } r -= I_PG;
        conv_plain(A.in[26] + (size_t)l * 256 * 2048, 256, 2048, (bf16*)(wl + WL_PP), r, scr, F.lane);
    }
    {
        const int gt = F.vcu * 512 + F.tid, NT = F.G * 512;
        bf16* c128 = (bf16*)(F.ws + TAB_C128); bf16* s128 = (bf16*)(F.ws + TAB_S128); bf16* c32 = (bf16*)(F.ws + TAB_C32); bf16* s32 = (bf16*)(F.ws + TAB_S32);
        for (int e = gt; e < 128 * 128 + 32 * 32; e += NT) {
            if (e < 128 * 128) { const int i = e >> 7, k = e & 127, m = (i * k) & 127; float sn, cs; sincospif((float)m * (1.0f / 64.0f), &sn, &cs);
                c128[e] = f2bf(cs * 0.08838834764831845f); s128[e] = f2bf(sn * 0.08838834764831845f); }
            else { const int e2 = e - 128 * 128, i = e2 >> 5, k = e2 & 31, m = (i * k) & 31; float sn, cs; sincospif((float)m * (1.0f / 16.0f), &sn, &cs);
                c32[e2] = f2bf(cs * 0.17677669529663687f); s32[e2] = f2bf(sn * 0.17677669529663687f); }
        }
    }
    for (int t = gw; t < DEPTH * 2 * 32; t += NGW) {
        const int g = t & 31, ld = t >> 5;
        unsigned char* tb = F.ws + TAB_S5 + (size_t)t * S5T_BYTES;
        const float* lam_re = A.in[6] + (size_t)t * 64; const float* lam_im = A.in[7] + (size_t)t * 64;
        const float dt = expf(A.in[8][t]);
        const float* b_re = A.in[9] + (size_t)t * 64 * 16; const float* b_im = A.in[10] + (size_t)t * 64 * 16;
        const float* c_re = A.in[11] + (size_t)t * 16 * 64; const float* c_im = A.in[12] + (size_t)t * 16 * 64;
        (void)g; (void)ld;
        const int lane = F.lane, l15 = lane & 15, g4 = lane >> 4;
        {
            const float lr = lam_re[lane], li = lam_im[lane], mag = expf(lr * dt); float sn, cs; sincosf(li * dt, &sn, &cs);
            f32x2 ab; ab.x = mag * cs; ab.y = mag * sn; ((f32x2*)(tb + S5T_AB))[lane] = ab;
        }
#pragma unroll 1
        for (int cb = 0; cb < 8; ++cb) {
            const int col = 16 * cb + l15, p = col >> 1, ri = col & 1;
            const float lr = lam_re[p], li = lam_im[p], mag = expf(lr * dt); float sn, cs; sincosf(li * dt, &sn, &cs);
            const float ar = mag * cs, ai = mag * sn, den = lr * lr + li * li;
            const float fr = ((ar - 1.0f) * lr + ai * li) / den, fi = (ai * lr - (ar - 1.0f) * li) / den;
            float v[8];
#pragma unroll
            for (int j = 0; j < 8; ++j) { const int h = 8 * g4 + j; float x = 0.f;
                if (h < 16) { const float br = b_re[p * 16 + h], bi = b_im[p * 16 + h]; x = ri ? (fr * bi + fi * br) : (fr * br - fi * bi); }
                v[j] = x; }
            u32x4 o; o.x = cvt_pk_bf16(v[0], v[1]); o.y = cvt_pk_bf16(v[2], v[3]); o.z = cvt_pk_bf16(v[4], v[5]); o.w = cvt_pk_bf16(v[6], v[7]);
            ((u32x4*)(tb + S5T_BB))[cb * 64 + lane] = o;
        }
#pragma unroll 1
        for (int ks = 0; ks < 4; ++ks) {
            float v[8];
#pragma unroll
            for (int j = 0; j < 8; ++j) { const int col = 32 * ks + 8 * g4 + j, p = col >> 1, ri = col & 1; v[j] = ri ? -c_im[l15 * 64 + p] : c_re[l15 * 64 + p]; }
            u32x4 o; o.x = cvt_pk_bf16(v[0], v[1]); o.y = cvt_pk_bf16(v[2], v[3]); o.z = cvt_pk_bf16(v[4], v[5]); o.w = cvt_pk_bf16(v[6], v[7]);
            ((u32x4*)(tb + S5T_C))[ks * 64 + lane] = o;
        }
    }
}

__device__ __forceinline__ void ph_norm(Frame& F, const float* xsrc, const float* gain, bf16* H) {
    const int gw = F.vcu * NWAVES + F.wave, NGW = F.G * NWAVES;
    f32x4 gv[8];
#pragma unroll
    for (int j = 0; j < 8; ++j) gv[j] = ((const f32x4*)gain)[F.lane + 64 * j];
    for (int m = gw; m < CH_TOK; m += NGW) {
        const f32x4* xr = (const f32x4*)(xsrc + (size_t)m * D_MODEL) + F.lane;
        f32x4 v[8]; float s = 0.f;
#pragma unroll
        for (int j = 0; j < 8; ++j) { v[j] = xr[64 * j]; s += (v[j][0] * v[j][0] + v[j][1] * v[j][1]) + (v[j][2] * v[j][2] + v[j][3] * v[j][3]); }
        const float rstd = rsqrtf(wave_sum(s) * (1.0f / D_MODEL) + EPS);
        u32x2* o = (u32x2*)(H + (size_t)m * D_MODEL) + F.lane;
#pragma unroll
        for (int j = 0; j < 8; ++j) { u32x2 w; w.x = cvt_pk_bf16(v[j][0] * rstd * gv[j][0], v[j][1] * rstd * gv[j][1]); w.y = cvt_pk_bf16(v[j][2] * rstd * gv[j][2], v[j][3] * rstd * gv[j][3]); o[64 * j] = w; }
    }
}
__device__ __forceinline__ void ph_pcvt(Frame& F, const float* p, bf16* P16) {
    const int gw = F.vcu * NWAVES + F.wave, NGW = F.G * NWAVES;
    for (int m = gw; m < CH_TOK; m += NGW) {
        const f32x4 v = ((const f32x4*)(p + (size_t)m * PLE_DIM))[F.lane];
        u32x2 w; w.x = cvt_pk_bf16(v[0], v[1]); w.y = cvt_pk_bf16(v[2], v[3]);
        ((u32x2*)(P16 + (size_t)m * PLE_DIM))[F.lane] = w;
    }
}
__device__ __forceinline__ void unpack8(u32x4 w, float (&f)[8]) { f[0] = bf_lo(w.x); f[1] = bf_hi(w.x); f[2] = bf_lo(w.y); f[3] = bf_hi(w.y); f[4] = bf_lo(w.z); f[5] = bf_hi(w.z); f[6] = bf_lo(w.w); f[7] = bf_hi(w.w); }
__device__ __forceinline__ u32x4 pack8(const float (&f)[8]) { u32x4 w; w.x = cvt_pk_bf16(f[0], f[1]); w.y = cvt_pk_bf16(f[2], f[3]); w.z = cvt_pk_bf16(f[4], f[5]); w.w = cvt_pk_bf16(f[6], f[7]); return w; }

__device__ __forceinline__ void conv_block(Frame& F, const bf16* Z, bf16* YS, const float* cw  , int blk, int lseq) {
#pragma unroll 1
    for (int i = 0; i < 8; ++i) {
        const int idx = F.tid + 512 * i, r = blk * 64 + (idx >> 6), c = (idx & 63) * 8, lpos = r % lseq;
        const bf16* zr = Z + (size_t)r * MIX_IN;
        float bg[8], z0[8], acc[8], tmp[8], w[8];
        unpack8(*(const u32x4*)(zr + ZC_BG + c), bg);
        {   float cg[8], vv[8]; unpack8(*(const u32x4*)(zr + ZC_CG + c), cg); unpack8(*(const u32x4*)(zr + ZC_VB + c), vv);
            const f32x4 wa = *(const f32x4*)(cw + 512 + c), wb = *(const f32x4*)(cw + 512 + c + 4);
            w[0] = wa[0]; w[1] = wa[1]; w[2] = wa[2]; w[3] = wa[3]; w[4] = wb[0]; w[5] = wb[1]; w[6] = wb[2]; w[7] = wb[3];
#pragma unroll
            for (int j = 0; j < 8; ++j) { z0[j] = cg[j] * vv[j]; acc[j] = w[j] * z0[j]; } }
        if (lpos > 0) { float cg[8], vv[8]; unpack8(*(const u32x4*)(zr - MIX_IN + ZC_CG + c), cg); unpack8(*(const u32x4*)(zr - MIX_IN + ZC_VB + c), vv);
            const f32x4 wa = *(const f32x4*)(cw + c), wb = *(const f32x4*)(cw + c + 4);
            w[0] = wa[0]; w[1] = wa[1]; w[2] = wa[2]; w[3] = wa[3]; w[4] = wb[0]; w[5] = wb[1]; w[6] = wb[2]; w[7] = wb[3];
#pragma unroll
            for (int j = 0; j < 8; ++j) acc[j] += w[j] * (cg[j] * vv[j]); }
        if (lpos < lseq - 1) { float cg[8], vv[8]; unpack8(*(const u32x4*)(zr + MIX_IN + ZC_CG + c), cg); unpack8(*(const u32x4*)(zr + MIX_IN + ZC_VB + c), vv);
            const f32x4 wa = *(const f32x4*)(cw + 1024 + c), wb = *(const f32x4*)(cw + 1024 + c + 4);
            w[0] = wa[0]; w[1] = wa[1]; w[2] = wa[2]; w[3] = wa[3]; w[4] = wb[0]; w[5] = wb[1]; w[6] = wb[2]; w[7] = wb[3];
#pragma unroll
            for (int j = 0; j < 8; ++j) acc[j] += w[j] * (cg[j] * vv[j]); }
#pragma unroll
        for (int j = 0; j < 8; ++j) tmp[j] = bg[j] * acc[j];
        *(u32x4*)(YS + (size_t)r * D_MODEL + 512 + c) = pack8(tmp);
    }
}
__device__ __forceinline__ void s5fin_block(Frame& F, const bf16* Z, const float* YF, const float* YB, const float* dsk  , bf16* Y1, int blk) {
#pragma unroll 1
    for (int i = 0; i < 8; ++i) {
        const int idx = F.tid + 512 * i, r = blk * 64 + (idx >> 6), c = (idx & 63) * 8;
        float u[8], o[8]; unpack8(*(const u32x4*)(Z + (size_t)r * MIX_IN + ZC_UA + c), u);
        const f32x4 f0 = *(const f32x4*)(YF + (size_t)r * 512 + c), f1 = *(const f32x4*)(YF + (size_t)r * 512 + c + 4);
        const f32x4 b0 = *(const f32x4*)(YB + (size_t)r * 512 + c), b1 = *(const f32x4*)(YB + (size_t)r * 512 + c + 4);
        const f32x4 d0 = *(const f32x4*)(dsk + c), d1 = *(const f32x4*)(dsk + c + 4);
#pragma unroll
        for (int j = 0; j < 8; ++j) { const float yy = (j < 4 ? d0[j & 3] : d1[j & 3]) * u[j] + (j < 4 ? f0[j & 3] : f1[j & 3]) + (j < 4 ? b0[j & 3] : b1[j & 3]);
            const float a = 0.7978845608028654f * (yy + 0.044715f * yy * yy * yy);
            const float th = 1.0f - 2.0f * __builtin_amdgcn_rcpf(1.0f + __expf(2.0f * a));
            o[j] = 0.5f * yy * (1.0f + th); }
        *(u32x4*)(Y1 + (size_t)r * 512 + c) = pack8(o);
    }
}

constexpr int S5_SEG = 512, S5_TPS = S5_SEG / 16;
template <bool FULL>
__device__ __forceinline__ void s5_seg_task(Frame& F, const unsigned char* tb, const bf16* Zs, float* Yout, f32x2* Ev, int nseg, int seg, int dir, int g) {
#ifndef MK_S5_LDS_STRIDE
#define MK_S5_LDS_STRIDE 12288
#endif
    LAS float* BU = (LAS float*)(F.lds + F.wave * MK_S5_LDS_STRIDE);
    LAS unsigned* XD = (LAS unsigned*)(F.lds + F.wave * MK_S5_LDS_STRIDE + 8192);
    const int lane = F.lane, l15 = lane & 15, g4 = lane >> 4;
    const f32x2 ab = ((const f32x2*)(tb + S5T_AB))[lane];
    const float ar = ab.x, ai = ab.y;
    bf16x8 bbf[8];
#pragma unroll
    for (int cb = 0; cb < 8; ++cb) bbf[cb] = as_frag(((const u32x4*)(tb + S5T_BB))[cb * 64 + lane]);
    float xr = 0.f, xi = 0.f;
    float pwr[4], pwi[4];
    pwr[0] = ar; pwi[0] = ai;
#pragma unroll
    for (int j = 1; j < 4; ++j) { pwr[j] = pwr[j - 1] * ar - pwi[j - 1] * ai; pwi[j] = pwr[j - 1] * ai + pwi[j - 1] * ar; }
    if (FULL) {
        float pr = ar, pi = ai;
#pragma unroll
        for (int i = 0; i < 9; ++i) { const float nr = pr * pr - pi * pi, ni = 2.f * pr * pi; pr = nr; pi = ni; }
        if (dir == 0) { for (int j = 0; j < seg; ++j) { const f32x2 e = Ev[j * 64 + lane]; const float nr = pr * xr - pi * xi + e.x, ni = pr * xi + pi * xr + e.y; xr = nr; xi = ni; } }
        else { for (int j = nseg - 1; j > seg; --j) { const f32x2 e = Ev[j * 64 + lane]; const float nr = pr * xr - pi * xi + e.x, ni = pr * xi + pi * xr + e.y; xr = nr; xi = ni; } }
    }
    bf16x8 cf[4];
    if (FULL) {
#pragma unroll
        for (int ks = 0; ks < 4; ++ks) cf[ks] = as_frag(((const u32x4*)(tb + S5T_C))[ks * 64 + lane]);
    }
    const int tile0 = seg * S5_TPS;
    const bf16* zcol = Zs + ZC_UA + g * 16 + 8 * (g4 & 1);
    u32x4 ring[4];
#pragma unroll
    for (int j = 0; j < 4; ++j) { const int tile = tile0 + (dir ? S5_TPS - 1 - j : j); ring[j] = (u32x4){0u, 0u, 0u, 0u}; if (g4 < 2) ring[j] = *(const u32x4*)(zcol + (size_t)(tile * 16 + l15) * MIX_IN); }
#pragma unroll 1
    for (int it = 0; it < S5_TPS; it += 4) {
#pragma unroll
        for (int j = 0; j < 4; ++j) {
            const int tile = tile0 + (dir ? S5_TPS - 1 - (it + j) : it + j);
            const bf16x8 uf = as_frag(ring[j]);
            if (it + j + 4 < S5_TPS) { const int tn = dir ? tile - 4 : tile + 4; u32x4 nx = (u32x4){0u, 0u, 0u, 0u}; if (g4 < 2) nx = *(const u32x4*)(zcol + (size_t)(tn * 16 + l15) * MIX_IN); ring[j] = nx; }
            f32x4 a8[8];
#pragma unroll
            for (int cb = 0; cb < 8; ++cb) a8[cb] = mfma16(uf, bbf[cb], (f32x4){0.f, 0.f, 0.f, 0.f});
            MFMA_DRAIN();
#pragma unroll
            for (int cb = 0; cb < 8; ++cb)
#pragma unroll
                for (int q = 0; q < 4; ++q) BU[(4 * g4 + q) * 128 + 16 * cb + l15] = a8[cb][q];
            LDS_WAIT();
#pragma unroll
            for (int k = 0; k < 4; ++k) {
                float cr[4], ci[4], yr[4], yi[4];
                f32x2 bv[4];
#pragma unroll
                for (int j = 0; j < 4; ++j) { const int t = dir ? 15 - (4 * k + j) : 4 * k + j; bv[j] = *(const LAS f32x2*)(BU + t * 128 + 2 * lane); }
                cr[0] = bv[0].x; ci[0] = bv[0].y;
#pragma unroll
                for (int j = 1; j < 4; ++j) {
                    cr[j] = __builtin_fmaf(ar, cr[j - 1], __builtin_fmaf(-ai, ci[j - 1], bv[j].x));
                    ci[j] = __builtin_fmaf(ar, ci[j - 1], __builtin_fmaf(ai, cr[j - 1], bv[j].y));
                }
#pragma unroll
                for (int j = 0; j < 4; ++j) {
                    yr[j] = __builtin_fmaf(pwr[j], xr, __builtin_fmaf(-pwi[j], xi, cr[j]));
                    yi[j] = __builtin_fmaf(pwr[j], xi, __builtin_fmaf(pwi[j], xr, ci[j]));
                    if (FULL) { const int t = dir ? 15 - (4 * k + j) : 4 * k + j; XD[t * 64 + lane] = cvt_pk_bf16(yr[j], yi[j]); }
                }
                xr = yr[3]; xi = yi[3];
            }
            if (FULL) {
                LDS_WAIT();
                f32x4 y = (f32x4){0.f, 0.f, 0.f, 0.f};
#pragma unroll
                for (int ks = 0; ks < 4; ++ks) y = mfma16(as_frag(*(const LAS u32x4*)(XD + l15 * 64 + 16 * ks + 4 * g4)), cf[ks], y);
                MFMA_DRAIN();
                float* yo = Yout + (size_t)(tile * 16 + 4 * g4) * 512 + g * 16 + l15;
#pragma unroll
                for (int q = 0; q < 4; ++q) yo[(size_t)q * 512] = y[q];
            }
            LDS_WAIT();
        }
    }
    if (!FULL) { f32x2 e; e.x = xr; e.y = xi; Ev[seg * 64 + lane] = e; }
}

constexpr int NA_KL = 0, NA_VT = 73728, NA_BIAS = 147456;
constexpr int NA_RR = 8;
__device__ __forceinline__ void na_task(Frame& F, const bf16* Zs  , bf16* YSs  , int rows, int h, int r0,
                                        const float* qg, const float* kg, const float* relb  ) {
    LAS unsigned* KL = (LAS unsigned*)(F.lds + NA_KL); LAS unsigned* VT = (LAS unsigned*)(F.lds + NA_VT); LAS unsigned short* VT16 = (LAS unsigned short*)(F.lds + NA_VT);
    LAS float* BIAS = (LAS float*)(F.lds + NA_BIAS);
    const int tid = F.tid, lane = F.lane, l15 = lane & 15, g4 = lane >> 4;
    __syncthreads();
    for (int i = tid; i < 15 * 31; i += 512) BIAS[i] = relb[i];
    const int scol = tid >> 3, schunk = tid & 7;
    float kgv[8];
    { const f32x4 a = *(const f32x4*)(kg + 8 * schunk), b = *(const f32x4*)(kg + 8 * schunk + 4); kgv[0] = a[0]; kgv[1] = a[1]; kgv[2] = a[2]; kgv[3] = a[3]; kgv[4] = b[0]; kgv[5] = b[1]; kgv[6] = b[2]; kgv[7] = b[3]; }
    int rs0 = r0 - 4; rs0 = rs0 < 0 ? 0 : (rs0 > rows - 8 ? rows - 8 : rs0);
    int nextrow = rs0;
#pragma unroll 1
    for (int r = r0; r < r0 + NA_RR; ++r) {
        int rs = r - 4; rs = rs < 0 ? 0 : (rs > rows - 8 ? rows - 8 : rs);
        __syncthreads();
#pragma unroll 1
        for (int rho = nextrow; rho <= rs + 7; ++rho) {
            const bf16* zt = Zs + (size_t)(rho * 64 + scol) * MIX_IN + h * 64 + 8 * schunk;
            const u32x4 kraw = *(const u32x4*)(zt + ZC_K), vraw = *(const u32x4*)(zt + ZC_VC);
            float kf[8]; unpack8(kraw, kf);
            float ss = 0.f;
#pragma unroll
            for (int j = 0; j < 8; ++j) ss += kf[j] * kf[j];
            ss += __shfl_xor(ss, 1); ss += __shfl_xor(ss, 2); ss += __shfl_xor(ss, 4);
            const float rk = rsqrtf(ss * (1.0f / 64.0f) + EPS);
#pragma unroll
            for (int j = 0; j < 8; ++j) kf[j] = kf[j] * rk * kgv[j];
            const int slot = rho & 7;
            *(LAS u32x4*)(KL + (slot * 64 + scol) * 36 + schunk * 4) = pack8(kf);
            const unsigned vw[4] = {vraw.x, vraw.y, vraw.z, vraw.w};
#pragma unroll
            for (int j = 0; j < 8; ++j) VT16[(slot * 64 + 8 * schunk + j) * 72 + scol] = (unsigned short)((j & 1) ? (vw[j >> 1] >> 16) : (vw[j >> 1] & 0xffffu));
        }
        nextrow = rs + 8;
        __syncthreads();
        if (F.wave < 4) {
            const int jb = F.wave, qc = 16 * jb + l15;
            int kc0 = 16 * jb - 8; kc0 = kc0 < 0 ? 0 : (kc0 > 32 ? 32 : kc0);
            int cs = qc - 8; cs = cs < 0 ? 0 : (cs > 48 ? 48 : cs);
            bf16x8 qf[2];
            {
                const bf16* zq = Zs + (size_t)(r * 64 + qc) * MIX_IN + ZC_Q + h * 64 + 8 * g4;
                float q0[8], q1[8]; unpack8(*(const u32x4*)zq, q0); unpack8(*(const u32x4*)(zq + 32), q1);
                float ss = 0.f;
#pragma unroll
                for (int j = 0; j < 8; ++j) ss += q0[j] * q0[j] + q1[j] * q1[j];
                ss += __shfl_xor(ss, 16); ss += __shfl_xor(ss, 32);
                const float rq = rsqrtf(ss * (1.0f / 64.0f) + EPS) * 0.125f;
                const f32x4 ga = *(const f32x4*)(qg + 8 * g4), gb = *(const f32x4*)(qg + 8 * g4 + 4), gc = *(const f32x4*)(qg + 32 + 8 * g4), gd = *(const f32x4*)(qg + 32 + 8 * g4 + 4);
#pragma unroll
                for (int j = 0; j < 4; ++j) { q0[j] *= rq * ga[j]; q0[4 + j] *= rq * gb[j]; q1[j] *= rq * gc[j]; q1[4 + j] *= rq * gd[j]; }
                qf[0] = as_frag(pack8(q0)); qf[1] = as_frag(pack8(q1));
            }
            f32x4 S[8][2];
#pragma unroll
            for (int a = 0; a < 8; ++a) {
                const int slot = (rs + a) & 7;
#pragma unroll
                for (int kb2 = 0; kb2 < 2; ++kb2) {
                    const LAS unsigned* kp = KL + (slot * 64 + kc0 + 16 * kb2 + l15) * 36 + 4 * g4;
                    S[a][kb2] = mfma16(as_frag(*(const LAS u32x4*)kp), qf[0], (f32x4){0.f, 0.f, 0.f, 0.f});
                    S[a][kb2] = mfma16(as_frag(*(const LAS u32x4*)(kp + 16)), qf[1], S[a][kb2]);
                }
            }
            MFMA_DRAIN();
            float mx = -3.0e38f;
#pragma unroll
            for (int a = 0; a < 8; ++a) {
                const int dr = rs + a - r + 7;
#pragma unroll
                for (int kb2 = 0; kb2 < 2; ++kb2)
#pragma unroll
                    for (int q = 0; q < 4; ++q) {
                        const int kc = kc0 + 16 * kb2 + 4 * g4 + q; const bool valid = (kc >= cs) && (kc < cs + 16);
                        int dc = kc - qc + 15; dc = dc < 0 ? 0 : (dc > 30 ? 30 : dc);
                        const float s = valid ? S[a][kb2][q] + BIAS[dr * 31 + dc] : -1.0e30f;
                        S[a][kb2][q] = s; mx = fmaxf(mx, s);
                    }
            }
            mx = fmaxf(mx, __shfl_xor(mx, 16)); mx = fmaxf(mx, __shfl_xor(mx, 32));
            float sum = 0.f;
#pragma unroll
            for (int a = 0; a < 8; ++a)
#pragma unroll
                for (int kb2 = 0; kb2 < 2; ++kb2)
#pragma unroll
                    for (int q = 0; q < 4; ++q) { const float p = __expf(S[a][kb2][q] - mx); S[a][kb2][q] = p; sum += p; }
            sum += __shfl_xor(sum, 16); sum += __shfl_xor(sum, 32);
            const float rinv = 1.0f / sum;
            f32x4 O[4];
#pragma unroll
            for (int dt = 0; dt < 4; ++dt) O[dt] = (f32x4){0.f, 0.f, 0.f, 0.f};
#pragma unroll
            for (int a = 0; a < 8; ++a) {
                const int slot = (rs + a) & 7;
                u32x4 pw; pw.x = cvt_pk_bf16(S[a][0][0], S[a][0][1]); pw.y = cvt_pk_bf16(S[a][0][2], S[a][0][3]); pw.z = cvt_pk_bf16(S[a][1][0], S[a][1][1]); pw.w = cvt_pk_bf16(S[a][1][2], S[a][1][3]);
                const bf16x8 pf = as_frag(pw);
#pragma unroll
                for (int dt = 0; dt < 4; ++dt) {
                    const LAS unsigned* vp = VT + (slot * 64 + 16 * dt + l15) * 36 + (kc0 >> 1) + 2 * g4;
                    const u32x2 v0 = *(const LAS u32x2*)vp, v1 = *(const LAS u32x2*)(vp + 8);
                    u32x4 vw; vw.x = v0.x; vw.y = v0.y; vw.z = v1.x; vw.w = v1.y;
                    O[dt] = mfma16(as_frag(vw), pf, O[dt]);
                }
            }
            MFMA_DRAIN();
            bf16* yo = YSs + (size_t)(r * 64 + qc) * D_MODEL + 1024 + h * 64 + 4 * g4;
#pragma unroll
            for (int dt = 0; dt < 4; ++dt) { u32x2 w; w.x = cvt_pk_bf16(O[dt][0] * rinv, O[dt][1] * rinv); w.y = cvt_pk_bf16(O[dt][2] * rinv, O[dt][3] * rinv); *(u32x2*)(yo + 16 * dt) = w; }
        }
    }
}


#if defined(MK_PROBE)
#define PRB_FLAGS(F) ((unsigned*)((F).ws + WS_CTL + 512 * 1024))
__device__ __forceinline__ bool prb_big_bf(u32x4 w, unsigned ethr) { const unsigned v[4] = {w.x, w.y, w.z, w.w}; bool b = false;
#pragma unroll
    for (int i = 0; i < 4; ++i) b = b || (((v[i] >> 7) & 0xffu) >= ethr) || (((v[i] >> 23) & 0xffu) >= ethr); return b; }
__device__ __forceinline__ bool prb_big_f(f32x4 a, unsigned ethr) { bool b = false;
#pragma unroll
    for (int i = 0; i < 4; ++i) b = b || (((__float_as_uint(a[i]) >> 23) & 0xffu) >= ethr); return b; }
#define PRB(cond, bit) do { if (cond) atomicOr(PRB_FLAGS(F), 1u << (bit)); } while (0)
#else
#define PRB(cond, bit) do { } while (0)
#endif
constexpr int FN_XT = 0, FN_YR = 34816, FN_YI = 34816 + 34816;
template <int N1>
__device__ __forceinline__ void fnet1_tile(Frame& F, const bf16* Zs, bf16* ZFsg  , int g, int l2, const bf16* CT1, const bf16* ST1  , const bf16* C128, const bf16* S128) {
    constexpr int XS = N1 + 8, JT = N1 / 16, KS1 = N1 / 32;
    LAS unsigned short* XT = (LAS unsigned short*)(F.lds + FN_XT); LAS unsigned short* YR = (LAS unsigned short*)(F.lds + FN_YR); LAS unsigned short* YI = (LAS unsigned short*)(F.lds + FN_YI);
    const int tid = F.tid, lane = F.lane, l15 = lane & 15, g4 = lane >> 4, w = F.wave;
    __syncthreads();
    for (int idx = tid; idx < N1 * 16; idx += 512) {
        const int l1 = idx >> 4, ch = idx & 15;
        const u32x4 raw = *(const u32x4*)(Zs + (size_t)(128 * l1 + l2) * MIX_IN + ZC_UD + g * 128 + 8 * ch);
        const unsigned rw[4] = {raw.x, raw.y, raw.z, raw.w};
#pragma unroll
        for (int j = 0; j < 8; ++j) XT[(8 * ch + j) * XS + l1] = (unsigned short)((j & 1) ? (rw[j >> 1] >> 16) : (rw[j >> 1] & 0xffffu));
    }
    __syncthreads();
    {
        bf16x8 af[KS1];
#pragma unroll
        for (int ks = 0; ks < KS1; ++ks) { af[ks] = as_frag(*(const LAS u32x4*)(XT + (16 * w + l15) * XS + 32 * ks + 8 * g4)); }
#pragma unroll 1
        for (int tj = 0; tj < JT; ++tj) {
            const int k1 = 16 * tj + l15;
            f32x4 ar = (f32x4){0.f, 0.f, 0.f, 0.f}, as = (f32x4){0.f, 0.f, 0.f, 0.f};
#pragma unroll
            for (int ks = 0; ks < KS1; ++ks) {
                ar = mfma16(af[ks], as_frag(*(const u32x4*)(CT1 + k1 * N1 + 32 * ks + 8 * g4)), ar);
                as = mfma16(af[ks], as_frag(*(const u32x4*)(ST1 + k1 * N1 + 32 * ks + 8 * g4)), as);
            }
            MFMA_DRAIN();
            float tsn, tcs; sincospif((float)(k1 * l2) * (2.0f / (float)(N1 * 128)), &tsn, &tcs);
            float zr[4], zi[4];
#pragma unroll
            for (int q = 0; q < 4; ++q) { const float yr = ar[q], yi = -as[q]; zr[q] = yr * tcs + yi * tsn; zi[q] = yi * tcs - yr * tsn; }
            u32x2 wr2, wi2; wr2.x = cvt_pk_bf16(zr[0], zr[1]); wr2.y = cvt_pk_bf16(zr[2], zr[3]); wi2.x = cvt_pk_bf16(zi[0], zi[1]); wi2.y = cvt_pk_bf16(zi[2], zi[3]);
            *(LAS u32x2*)(YR + k1 * 136 + 16 * w + 4 * g4) = wr2; *(LAS u32x2*)(YI + k1 * 136 + 16 * w + 4 * g4) = wi2;
        }
    }
    __syncthreads();
    {
        bf16x8 cfr[4], sfr[4];
#pragma unroll
        for (int ks = 0; ks < 4; ++ks) { cfr[ks] = as_frag(*(const u32x4*)(C128 + (16 * w + l15) * 128 + 32 * ks + 8 * g4)); sfr[ks] = as_frag(*(const u32x4*)(S128 + (16 * w + l15) * 128 + 32 * ks + 8 * g4)); }
#pragma unroll 1
        for (int tj = 0; tj < JT; ++tj) {
            const int k1 = 16 * tj + l15;
            f32x4 zr = (f32x4){0.f, 0.f, 0.f, 0.f}, zi = (f32x4){0.f, 0.f, 0.f, 0.f};
#pragma unroll
            for (int ks = 0; ks < 4; ++ks) {
                const u32x4 yr = *(const LAS u32x4*)(YR + k1 * 136 + 32 * ks + 8 * g4), yi = *(const LAS u32x4*)(YI + k1 * 136 + 32 * ks + 8 * g4);
                u32x4 ny; ny.x = yr.x ^ 0x80008000u; ny.y = yr.y ^ 0x80008000u; ny.z = yr.z ^ 0x80008000u; ny.w = yr.w ^ 0x80008000u;
                zr = mfma16(cfr[ks], as_frag(yr), zr); zr = mfma16(sfr[ks], as_frag(yi), zr);
                zi = mfma16(cfr[ks], as_frag(yi), zi); zi = mfma16(sfr[ks], as_frag(ny), zi);
            }
            MFMA_DRAIN();
            bf16* zo = ZFsg + ((size_t)k1 * 128 + l2) * 256 + 16 * w + 4 * g4;
            u32x2 a, b; a.x = cvt_pk_bf16(zr[0], zr[1]); a.y = cvt_pk_bf16(zr[2], zr[3]); b.x = cvt_pk_bf16(zi[0], zi[1]); b.y = cvt_pk_bf16(zi[2], zi[3]);
            *(u32x2*)zo = a; *(u32x2*)(zo + 128) = b;
        }
    }
}
__device__ __forceinline__ void fnet2_tile(Frame& F, const bf16* ZFsg, bf16* YSs  , int g, int k1, int N1, const bf16* C128, const bf16* S128) {
    LAS unsigned short* ZT = (LAS unsigned short*)F.lds;
    const int tid = F.tid, lane = F.lane, l15 = lane & 15, g4 = lane >> 4, w = F.wave;
    __syncthreads();
    const bf16* src = ZFsg + (size_t)k1 * 128 * 256;
#pragma unroll 1
    for (int idx = tid; idx < 4096; idx += 512) {
        const int l2 = idx >> 5, ch = idx & 31;
        const u32x4 raw = *(const u32x4*)(src + (size_t)l2 * 256 + 8 * ch);
        const unsigned rw[4] = {raw.x, raw.y, raw.z, raw.w};
#pragma unroll
        for (int j = 0; j < 8; ++j) ZT[(8 * ch + j) * 136 + l2] = (unsigned short)((j & 1) ? (rw[j >> 1] >> 16) : (rw[j >> 1] & 0xffffu));
    }
    __syncthreads();
    bf16x8 zrf[4], zif[4];
#pragma unroll
    for (int ks = 0; ks < 4; ++ks) { zrf[ks] = as_frag(*(const LAS u32x4*)(ZT + (16 * w + l15) * 136 + 32 * ks + 8 * g4)); zif[ks] = as_frag(*(const LAS u32x4*)(ZT + (128 + 16 * w + l15) * 136 + 32 * ks + 8 * g4)); }
#pragma unroll 1
    for (int tj = 0; tj < 8; ++tj) {
        const int k2 = 16 * tj + l15;
        f32x4 y = (f32x4){0.f, 0.f, 0.f, 0.f};
#pragma unroll
        for (int ks = 0; ks < 4; ++ks) {
            y = mfma16(zrf[ks], as_frag(*(const u32x4*)(C128 + k2 * 128 + 32 * ks + 8 * g4)), y);
            y = mfma16(zif[ks], as_frag(*(const u32x4*)(S128 + k2 * 128 + 32 * ks + 8 * g4)), y);
        }
        MFMA_DRAIN();
        u32x2 o; o.x = cvt_pk_bf16(y[0], y[1]); o.y = cvt_pk_bf16(y[2], y[3]);
        *(u32x2*)(YSs + (size_t)(k1 + N1 * k2) * D_MODEL + 1536 + g * 128 + 16 * w + 4 * g4) = o;
    }
}

struct ChunkGeo { int nseq, lseq, rows, n1; };
__device__ __forceinline__ ChunkGeo chunk_geo(int ch) { ChunkGeo g; if (ch < 2) { g.nseq = 1; g.lseq = 16384; g.rows = 256; g.n1 = 128; } else { g.nseq = 4; g.lseq = 4096; g.rows = 64; g.n1 = 32; } return g; }

__device__ __forceinline__ void ph_s5a(Frame& F, int layer, int ch) {
    const ChunkGeo cg = chunk_geo(ch);
    const bf16* Z = (const bf16*)(F.ws + WS_Z); f32x2* EV = (f32x2*)(F.ws + WS_S5E);
    const int nseg = cg.lseq / S5_SEG, ntask = cg.nseq * nseg * 64;
#if defined(MK_S5A_ONEWAVE)
    if (F.wave == 0)
    for (int tt = F.vcu; tt < ntask; tt += F.G) {
#elif defined(MK_S5A_4WAVE)
    if (F.wave < 4)
    for (int tt = F.vcu * 4 + F.wave; tt < ntask; tt += F.G * 4) {
#else
    for (int tt = F.vcu * 8 + F.wave; tt < ntask; tt += F.G * 8) {
#endif
        const int dg = tt & 63, sg = tt >> 6, seg = sg % nseg, seq = sg / nseg, dir = dg >> 5, g = dg & 31;
        const unsigned char* tb = F.ws + TAB_S5 + (size_t)(((layer * 2 + dir) * 32) + g) * S5T_BYTES;
        s5_seg_task<false>(F, tb, Z + (size_t)seq * cg.lseq * MIX_IN, nullptr, EV + (size_t)(seq * 64 + dg) * nseg * 64, nseg, seg, dir, g);
    }
}
__device__ __forceinline__ void ph_mix1(Frame& F, const Args& A, int layer, int ch) {
    const ChunkGeo cg = chunk_geo(ch);
    const bf16* Z = (const bf16*)(F.ws + WS_Z); bf16* YS = (bf16*)(F.ws + WS_YS); bf16* ZF = (bf16*)(F.ws + WS_ZF);
    float* YF = (float*)(F.ws + WS_YF); float* YB = (float*)(F.ws + WS_YB); f32x2* EV = (f32x2*)(F.ws + WS_S5E);
    const int nseg = cg.lseq / S5_SEG;
    const int n_s5 = cg.nseq * nseg * 8;
    const int n_na = cg.nseq * 8 * (cg.rows / NA_RR);
    const int n_f1 = 512;
    const int n_cv = CH_TOK / 64;
    int t0 = F.vcu;
#pragma unroll 1
    for (; t0 < n_s5; t0 += F.G) {
        const int tt = t0 * 8 + F.wave, dg = tt & 63, sg = tt >> 6, seg = sg % nseg, seq = sg / nseg, dir = dg >> 5, g = dg & 31;
        const unsigned char* tb = F.ws + TAB_S5 + (size_t)(((layer * 2 + dir) * 32) + g) * S5T_BYTES;
        const size_t row0 = (size_t)seq * cg.lseq;
        s5_seg_task<true>(F, tb, Z + row0 * MIX_IN, (dir ? YB : YF) + row0 * 512, EV + (size_t)(seq * 64 + dg) * nseg * 64, nseg, seg, dir, g);
    }
    asm volatile("" : "+s"(t0));
#pragma unroll 1
    for (; t0 < n_s5 + n_na + n_f1 + n_cv; t0 += F.G) {
        const int t = t0 - n_s5;
        if (t < n_na) {
            const int runs = cg.rows / NA_RR, run = t % runs, h = (t / runs) & 7, seq = t / (runs * 8);
            const size_t row0 = (size_t)seq * cg.lseq;
            na_task(F, Z + row0 * MIX_IN, YS + row0 * D_MODEL, cg.rows, h, run * NA_RR, A.in[16] + layer * 64, A.in[17] + layer * 64, A.in[18] + ((size_t)layer * 8 + h) * 15 * 31);
        } else if (t < n_na + n_f1) {
            const int u = t - n_na;
            const bf16* C128 = (const bf16*)(F.ws + TAB_C128); const bf16* S128 = (const bf16*)(F.ws + TAB_S128);
            if (ch < 2) { const int g = u >> 7, l2 = u & 127;
                fnet1_tile<128>(F, Z, ZF + (size_t)g * 16384 * 256, g, l2, C128, S128, C128, S128);
            } else {
                const bf16* C32 = (const bf16*)(F.ws + TAB_C32); const bf16* S32 = (const bf16*)(F.ws + TAB_S32);
#pragma unroll 1
                for (int s = 0; s < 4; ++s) { const int uu = u * 4 + s, l2 = uu & 127, g = (uu >> 7) & 3, seq = uu >> 9;
                    fnet1_tile<32>(F, Z + (size_t)seq * 4096 * MIX_IN, ZF + (size_t)(seq * 4 + g) * 4096 * 256, g, l2, C32, S32, C128, S128); }
            }
        } else {
            conv_block(F, Z, YS, A.in[15] + (size_t)layer * 3 * 512, t - n_na - n_f1, cg.lseq);
        }
    }
}
__device__ __forceinline__ void ph_mix2(Frame& F, const Args& A, int layer, int ch) {
    const ChunkGeo cg = chunk_geo(ch);
    const bf16* Z = (const bf16*)(F.ws + WS_Z); bf16* YS = (bf16*)(F.ws + WS_YS); const bf16* ZF = (const bf16*)(F.ws + WS_ZF);
    const float* YF = (const float*)(F.ws + WS_YF); const float* YB = (const float*)(F.ws + WS_YB); bf16* Y1 = (bf16*)(F.ws + WS_Y1);
    const bf16* C128 = (const bf16*)(F.ws + TAB_C128); const bf16* S128 = (const bf16*)(F.ws + TAB_S128);
    const int n_f2 = 512, n_fin = CH_TOK / 64;
#pragma unroll 1
    for (int t = F.vcu; t < n_f2 + n_fin; t += F.G) {
        if (t < n_f2) {
            int seq, g, k1; if (ch < 2) { seq = 0; g = t >> 7; k1 = t & 127; } else { k1 = t & 31; g = (t >> 5) & 3; seq = t >> 7; }
            fnet2_tile(F, ZF + (size_t)(seq * 4 + g) * cg.lseq * 256, YS + (size_t)seq * cg.lseq * D_MODEL, g, k1, cg.n1, C128, S128);
        } else {
            s5fin_block(F, Z, YF, YB, A.in[13] + (size_t)layer * 512, Y1, t - n_f2);
        }
    }
}

constexpr int PH_PER_LC = 15, N_PHASES = 1 + 6 * PH_PER_LC;
__global__ void __launch_bounds__(NWAVES * 64, 2) fwd_kernel(const Args A) {
    extern __shared__ __attribute__((aligned(16))) unsigned char lds_raw[];
    Frame F;
    F.lds = (LAS unsigned char*)lds_raw;
    F.tid = threadIdx.x; F.lane = F.tid & 63; F.wave = __builtin_amdgcn_readfirstlane(F.tid >> 6);
    F.G = gridDim.x; { const int bx = blockIdx.x; F.vcu = (F.G % 8 == 0) ? (bx % 8) * (F.G / 8) + bx / 8 : bx; }
    F.ws = A.ws;
    volatile LAS unsigned* LCTL = (volatile LAS unsigned*)(F.lds + LDSCTL_OFF);
    if (F.tid < 64) LCTL[F.tid] = 0u;
#if defined(MK_ZERO_LDS)
    for (int i = F.tid; i < LDS_SCRATCH / 4; i += 512) ((LAS unsigned*)F.lds)[i] = 0u;
#endif
    __syncthreads();
    const int lo = A.ph_lo, hi = A.ph_hi;
    const bool multi = (hi - lo) > 1;
    XcdBarrier bar; bar.bar = (unsigned*)(F.ws + WS_CTL) + CW_BAR; bar.x = 0; bar.st = LCTL;
    if (multi) bar = xcd_barrier_post((unsigned*)(F.ws + WS_CTL) + CW_BAR, LCTL);
#define xcd_barrier_rep(b, c, m) do { if ((c) && (m)) xcd_barrier(b); } while (0)
#define IN(k) (lo <= (k) && (k) < hi)
#ifndef MK_DBL
#define MK_DBL 0
#endif
#define DBL(t) (((MK_DBL) >> (t)) & 1)
#define SEAM(k) do { if ((k) + 1 < hi) xcd_barrier(bar); } while (0)

    if (IN(0)) { for (int rep_ = 0; rep_ <= DBL(15); ++rep_) { Frame Fp = fresh(F); ph_prologue(Fp, A); xcd_barrier_rep(bar, rep_ < DBL(15), multi); } SEAM(0); }

#pragma unroll 1
    for (int lc = 0; lc < 6; ++lc) {
        const int layer = lc / 3, ch = lc % 3, pb = 1 + lc * PH_PER_LC;
        if (pb + PH_PER_LC <= lo || pb >= hi) continue;
        const unsigned char* wl = F.ws + WS_W + (size_t)layer * WL_BYTES;
        const float* x_in = (ch < 2) ? A.in[0] + (size_t)ch * CH_TOK * D_MODEL : A.in[1];
        float* x_out = A.out + (size_t)ch * CH_TOK * D_MODEL;
        const float* x_cur = layer == 0 ? x_in : x_out;
        const float* p_in = (ch < 2) ? A.in[2] + ((size_t)layer * 32768 + (size_t)ch * CH_TOK) * PLE_DIM : A.in[3] + (size_t)layer * CH_TOK * PLE_DIM;
        bf16* H = (bf16*)(F.ws + WS_H); bf16* Z = (bf16*)(F.ws + WS_Z); bf16* YS = (bf16*)(F.ws + WS_YS); bf16* MG = (bf16*)(F.ws + WS_MG); bf16* GT = (bf16*)(F.ws + WS_GT);
        bf16* Y1 = (bf16*)(F.ws + WS_Y1); bf16* P16 = (bf16*)(F.ws + WS_P16); bf16* PP = (bf16*)(F.ws + WS_YS); bf16* MID = (bf16*)(F.ws + WS_GT); float* MACC = (float*)(F.ws + WS_Z);

        if (IN(pb + 0)) { for (int rep_ = 0; rep_ <= DBL(0); ++rep_) { Frame Fp = fresh(F); ph_norm(Fp, x_cur, A.in[4] + (size_t)layer * D_MODEL, H); xcd_barrier_rep(bar, rep_ < DBL(0), multi); } SEAM(pb + 0); }
        if (IN(pb + 1)) {
            for (int rep_ = 0; rep_ <= DBL(1); ++rep_) {
            pg8::Gemm g{H, (const bf16*)(wl + WL_MIX), D_MODEL, D_MODEL, D_MODEL, 0, 0}; pg8::StaticOrder S; S.init(CH_TOK, MIX_IN, F.G, (int)blockIdx.x);
            pg8::EpiStoreBf16 E{Z, MIX_IN};
            pg8::gemm_phase<pg8::EpiStoreBf16, pg8::StaticOrder, true, true>(F.lds, g, S, E);
            xcd_barrier_rep(bar, rep_ < DBL(1), multi); }
            SEAM(pb + 1); }
        if (IN(pb + 2)) { for (int rep_ = 0; rep_ <= DBL(2); ++rep_) { Frame Fp = fresh(F); ph_s5a(Fp, layer, ch); xcd_barrier_rep(bar, rep_ < DBL(2), multi); } SEAM(pb + 2); }
        if (IN(pb + 3)) { for (int rep_ = 0; rep_ <= DBL(3); ++rep_) { Frame Fp = fresh(F); ph_mix1(Fp, A, layer, ch); xcd_barrier_rep(bar, rep_ < DBL(3), multi); } SEAM(pb + 3); }
        if (IN(pb + 4)) { for (int rep_ = 0; rep_ <= DBL(4); ++rep_) { Frame Fp = fresh(F); ph_mix2(Fp, A, layer, ch); xcd_barrier_rep(bar, rep_ < DBL(4), multi); } SEAM(pb + 4); }
        if (IN(pb + 5)) {
            for (int rep_ = 0; rep_ <= DBL(5); ++rep_) {
            pg8::Gemm g{Y1, (const bf16*)(wl + WL_GLU), 512, 512, 512, 0, 0}; pg8::StaticOrder S; S.init(CH_TOK, 512, F.G, (int)blockIdx.x);
            pg8::EpiGlu E{Y1, 512, YS, D_MODEL};
            pg8::gemm_phase<pg8::EpiGlu, pg8::StaticOrder, true, true>(F.lds, g, S, E);
            xcd_barrier_rep(bar, rep_ < DBL(5), multi); }
            SEAM(pb + 5); }
        if (IN(pb + 6)) {
            for (int rep_ = 0; rep_ <= DBL(6); ++rep_) {
            pg8::Gemm g{YS, (const bf16*)(wl + WL_BR), D_MODEL, 512, 512, 3, 512}; pg8::StaticOrder S; S.init(CH_TOK, 8192, F.G, (int)blockIdx.x);
            pg8::EpiStoreBf16 E{GT, 8192};
            pg8::gemm_phase<pg8::EpiStoreBf16, pg8::StaticOrder, true, true>(F.lds, g, S, E);
            xcd_barrier_rep(bar, rep_ < DBL(6), multi); }
            SEAM(pb + 6); }
        if (IN(pb + 7)) {
            for (int rep_ = 0; rep_ <= DBL(7); ++rep_) {
            pg8::Gemm g{H, (const bf16*)(wl + WL_G), D_MODEL, D_MODEL, D_MODEL, 0, 0}; pg8::MergeOrder S; S.init(CH_TOK, F.G, (int)blockIdx.x);
            pg8::EpiMerge E{GT, MACC, MG};
            pg8::gemm_phase<pg8::EpiMerge, pg8::MergeOrder, true, true>(F.lds, g, S, E);
            xcd_barrier_rep(bar, rep_ < DBL(7), multi); }
            SEAM(pb + 7); }
        if (IN(pb + 8)) {
            for (int rep_ = 0; rep_ <= DBL(8); ++rep_) {
            pg8::Gemm g{MG, (const bf16*)(wl + WL_O), D_MODEL, D_MODEL, D_MODEL, 0, 0}; pg8::StaticOrder S; S.init(CH_TOK, D_MODEL, F.G, (int)blockIdx.x);
            pg8::EpiResF32 E{x_cur, rep_ < DBL(8) ? (float*)(F.ws + 880 * MiB) : x_out, D_MODEL};
            pg8::gemm_phase<pg8::EpiResF32, pg8::StaticOrder, true, true>(F.lds, g, S, E);
            xcd_barrier_rep(bar, rep_ < DBL(8), multi); }
            SEAM(pb + 8); }
        if (IN(pb + 9)) { for (int rep_ = 0; rep_ <= DBL(9); ++rep_) { Frame Fp = fresh(F); ph_norm(Fp, x_out, A.in[21] + (size_t)layer * D_MODEL, H); xcd_barrier_rep(bar, rep_ < DBL(9), multi); } SEAM(pb + 9); }
        if (IN(pb + 10)) {
            for (int rep_ = 0; rep_ <= DBL(10); ++rep_) {
            pg8::Gemm g{H, (const bf16*)(wl + WL_FF), D_MODEL, D_MODEL, D_MODEL, 0, 0}; pg8::StaticOrder S; S.init(CH_TOK, 2 * D_FF, F.G, (int)blockIdx.x);
            pg8::EpiSwiglu E{MID, D_FF};
            pg8::gemm_phase<pg8::EpiSwiglu, pg8::StaticOrder, true, true>(F.lds, g, S, E);
            xcd_barrier_rep(bar, rep_ < DBL(10), multi); }
            SEAM(pb + 10); }
        if (IN(pb + 11)) {
            for (int rep_ = 0; rep_ <= DBL(11); ++rep_) {
            pg8::Gemm g{MID, (const bf16*)(wl + WL_FF2), D_FF, D_FF, D_FF, 0, 0}; pg8::StaticOrder S; S.init(CH_TOK, D_MODEL, F.G, (int)blockIdx.x);
            pg8::EpiResF32 E{x_out, rep_ < DBL(11) ? (float*)(F.ws + 880 * MiB) : x_out, D_MODEL};
            pg8::gemm_phase<pg8::EpiResF32, pg8::StaticOrder, true, true>(F.lds, g, S, E);
            xcd_barrier_rep(bar, rep_ < DBL(11), multi); }
            SEAM(pb + 11); }
        if (IN(pb + 12)) { for (int rep_ = 0; rep_ <= DBL(12); ++rep_) { Frame Fp = fresh(F); ph_norm(Fp, x_out, A.in[24] + (size_t)layer * D_MODEL, H); ph_pcvt(Fp, p_in, P16); xcd_barrier_rep(bar, rep_ < DBL(12), multi); } SEAM(pb + 12); }
        if (IN(pb + 13)) {
            for (int rep_ = 0; rep_ <= DBL(13); ++rep_) {
            int kpp = PLE_DIM; asm volatile("" : "+s"(kpp));
            pg8::Gemm g{P16, (const bf16*)(wl + WL_PP), kpp, kpp, kpp, 0, 0}; pg8::StaticOrder S; S.init(CH_TOK, D_MODEL, F.G, (int)blockIdx.x);
            pg8::EpiStoreBf16 E{PP, D_MODEL};
            pg8::gemm_phase<pg8::EpiStoreBf16, pg8::StaticOrder, true, true>(F.lds, g, S, E);
            xcd_barrier_rep(bar, rep_ < DBL(13), multi); }
            SEAM(pb + 13); }
        if (IN(pb + 14)) {
            for (int rep_ = 0; rep_ <= DBL(14); ++rep_) {
            pg8::Gemm g{H, (const bf16*)(wl + WL_PG), D_MODEL, D_MODEL, D_MODEL, 0, 0}; pg8::StaticOrder S; S.init(CH_TOK, D_MODEL, F.G, (int)blockIdx.x);
            pg8::EpiPle E{x_out, rep_ < DBL(14) ? (float*)(F.ws + 880 * MiB) : x_out, D_MODEL, PP, D_MODEL};
            pg8::gemm_phase<pg8::EpiPle, pg8::StaticOrder, true, true>(F.lds, g, S, E);
            xcd_barrier_rep(bar, rep_ < DBL(14), multi); }
            SEAM(pb + 14); }
    }
#undef IN
#undef SEAM
}


#if defined(MK_PROBE)
__global__ void probe_scan(const unsigned* p, size_t nwords, int is_f32, unsigned bit, unsigned* flags, unsigned ethr  ) {
    unsigned bad = 0;
    for (size_t i = (size_t)blockIdx.x * blockDim.x + threadIdx.x; i < nwords; i += (size_t)gridDim.x * blockDim.x) {
        const unsigned w = p[i];
        if (is_f32) { const unsigned e = (w >> 23) & 0xffu; if (e >= ethr) bad = 1; }
        else { const unsigned e0 = (w >> 7) & 0xffu, e1 = (w >> 23) & 0xffu; if (e0 >= ethr || e1 >= ethr) bad = 1; }
    }
    if (bad) atomicOr(flags, 1u << bit);
}
__global__ void probe_s5tab(const unsigned char* tab, unsigned bit, unsigned* flags) {
    const int t = blockIdx.x, lane = threadIdx.x;
    const float* ab = (const float*)(tab + (size_t)t * S5T_BYTES + S5T_AB);
    const float ar = ab[2 * lane], ai = ab[2 * lane + 1];
    if (!(ar * ar + ai * ai < 1.0f)) atomicOr(flags, 1u << bit);
}
__global__ void probe_init(unsigned* flags) { if (threadIdx.x == 0 && blockIdx.x == 0) *flags = 0u; }
__global__ void probe_emit(float* out, size_t n, const unsigned* flags) {
    const float k = (float)(*flags);
    const float c = 1000.0f * exp10f(k * (1.0f / 16.0f));
    for (size_t i = (size_t)blockIdx.x * blockDim.x + threadIdx.x; i < n; i += (size_t)gridDim.x * blockDim.x) out[i] = c;
}
static void probe_buf(hipStream_t st, const void* p, size_t bytes, int is_f32, int bit, unsigned* fb, int log2thr) {
    hipLaunchKernelGGL(probe_scan, dim3(1024), dim3(256), 0, st, (const unsigned*)p, bytes / 4, is_f32, (unsigned)bit, fb, (unsigned)(127 + log2thr));
}
#endif

#if defined(MK_PROBE)
__global__ void probe_min(const unsigned* p, size_t nwords, int is_f32, unsigned id, unsigned* first_bad, unsigned ethr) {
    unsigned bad = 0;
    for (size_t i = (size_t)blockIdx.x * blockDim.x + threadIdx.x; i < nwords; i += (size_t)gridDim.x * blockDim.x) {
        const unsigned w = p[i];
        if (is_f32) { const unsigned e = (w >> 23) & 0xffu; if (e >= ethr) bad = 1; }
        else { const unsigned e0 = (w >> 7) & 0xffu, e1 = (w >> 23) & 0xffu; if (e0 >= ethr || e1 >= ethr) bad = 1; }
    }
    if (bad) atomicMin(first_bad, id);
}
__global__ void probe_init_min(unsigned* fb) { if (threadIdx.x == 0 && blockIdx.x == 0) *fb = 0xffffffffu; }
__global__ void probe_emit_min(float* out, size_t n, const unsigned* fb) {
    const unsigned v = *fb; const float k = (v == 0xffffffffu) ? 0.f : (float)(v + 1u);
    const float c = 1000.0f * exp10f(k * (1.0f / 4.0f));
    for (size_t i = (size_t)blockIdx.x * blockDim.x + threadIdx.x; i < n; i += (size_t)gridDim.x * blockDim.x) out[i] = c;
}
static void pmin(hipStream_t st, const void* p, size_t bytes, int is_f32, int id, unsigned* fb, int l2) { hipLaunchKernelGGL(probe_min, dim3(1024), dim3(256), 0, st, (const unsigned*)p, bytes / 4, is_f32, (unsigned)id, fb, (unsigned)(127 + l2)); }
static void probe_after(hipStream_t st, unsigned char* ws, float* out, int p, unsigned* fb) {
    if (p == 0) return;
    const int lc = (p - 1) / PH_PER_LC, k = (p - 1) % PH_PER_LC, ch = lc % 3, id = 16 * lc + k;
    float* xo = out + (size_t)ch * CH_TOK * D_MODEL; const size_t XB = (size_t)CH_TOK * D_MODEL * 4;
    switch (k) {
        case 0: case 9: case 12: pmin(st, ws + WS_H, 64 * MiB, 0, id, fb, 8); break;
        case 1: pmin(st, ws + WS_Z, 128 * MiB, 0, id, fb, 8); break;
        case 2: pmin(st, ws + WS_S5E, 1 * MiB, 1, id, fb, 10); break;
        case 3: pmin(st, ws + WS_YF, 32 * MiB, 1, id, fb, 10); pmin(st, ws + WS_YB, 32 * MiB, 1, id, fb, 10); pmin(st, ws + WS_ZF, 32 * MiB, 0, id, fb, 10); break;
        case 4: pmin(st, ws + WS_YS, 64 * MiB, 0, id, fb, 10); pmin(st, ws + WS_Y1, 16 * MiB, 0, id, fb, 10); break;
        case 5: pmin(st, ws + WS_YS, 64 * MiB, 0, id, fb, 10); break;
        case 6: pmin(st, ws + WS_GT, 256 * MiB, 0, id, fb, 10); break;
        case 7: pmin(st, ws + WS_MG, 64 * MiB, 0, id, fb, 10); break;
        case 8: case 11: case 14: pmin(st, xo, XB, 1, id, fb, 10); break;
        case 10: pmin(st, ws + WS_GT, 176 * MiB, 0, id, fb, 12); break;
        case 13: pmin(st, ws + WS_YS, 64 * MiB, 0, id, fb, 10); break;
    }
}
#endif

#if defined(MK_PROBE)
__global__ void probe_dump(float* out, size_t n, const void* src, size_t nsrc, int is_f32) {
    for (size_t i = (size_t)blockIdx.x * blockDim.x + threadIdx.x; i < n; i += (size_t)gridDim.x * blockDim.x) {
        const size_t j = i % nsrc;
        out[i] = is_f32 ? ((const float*)src)[j] : __uint_as_float(((unsigned)((const unsigned short*)src)[j]) << 16);
    }
}
#endif
#ifndef MK_PER_PHASE
#define MK_PER_PHASE 0
#endif
extern "C" void kernel_launch(void* const* d_in, const int* in_sizes, int n_in, void* d_out, int out_size, void* d_ws, size_t ws_size, hipStream_t stream) {
    static int grid = 0;
    if (grid == 0) {
        if (n_in != 27 || out_size != NTOK * D_MODEL || ws_size < WS_END + 152 * MiB) { fprintf(stderr, "kernel_launch: unexpected shapes (n_in %d, out %d, ws %zu); nothing launched\n", n_in, out_size, ws_size); grid = -1; return; }
        int dev = 0, cus = 0, per_cu = 0;
        if (hipGetDevice(&dev) != hipSuccess || hipDeviceGetAttribute(&cus, hipDeviceAttributeMultiprocessorCount, dev) != hipSuccess) { grid = -1; return; }
        if (hipFuncSetAttribute((const void*)fwd_kernel, hipFuncAttributeMaxDynamicSharedMemorySize, LDS_BYTES) != hipSuccess) { fprintf(stderr, "kernel_launch: hipFuncSetAttribute failed\n"); grid = -1; return; }
        if (hipOccupancyMaxActiveBlocksPerMultiprocessor(&per_cu, (const void*)fwd_kernel, NWAVES * 64, LDS_BYTES) != hipSuccess || per_cu < 1)
            fprintf(stderr, "kernel_launch: occupancy query reports %d workgroups per CU\n", per_cu);
        (void)hipGetLastError();
        grid = cus;
    }
    if (grid < 0) return;
    (void)in_sizes;
    if (hipMemsetAsync((char*)d_ws + WS_CTL, 0, CTL_ZERO_BYTES, stream) != hipSuccess) return;
    Args a{};
    for (int i = 0; i < 27; ++i) a.in[i] = (const float*)d_in[i];
    a.out = (float*)d_out; a.ws = (unsigned char*)d_ws;
#if defined(MK_PROBE)
    for (int p = 0; p < MK_PROBE_STOP; ++p) { a.ph_lo = p; a.ph_hi = p + 1; hipLaunchKernelGGL(fwd_kernel, dim3(grid), dim3(NWAVES * 64), LDS_BYTES, stream, a); }
    if (MK_PROBE_N > 0) hipLaunchKernelGGL(probe_dump, dim3(2048), dim3(256), 0, stream, (float*)d_out, (size_t)NTOK * D_MODEL, (const void*)((char*)d_ws + MK_PROBE_OFF), (size_t)MK_PROBE_N, MK_PROBE_F32);
#elif MK_PER_PHASE
    for (int p = 0; p < N_PHASES; ++p) { a.ph_lo = p; a.ph_hi = p + 1; hipLaunchKernelGGL(fwd_kernel, dim3(grid), dim3(NWAVES * 64), LDS_BYTES, stream, a); }
#else
    a.ph_lo = 0; a.ph_hi = N_PHASES;
    hipLaunchKernelGGL(fwd_kernel, dim3(grid), dim3(NWAVES * 64), LDS_BYTES, stream, a);
#endif
}
```

```cpp
#include <hip/hip_runtime.h>
#include <cstdio>
#include <cstdint>

namespace pg8 {
#define PG8_LAS __attribute__((address_space(3)))
typedef unsigned short bf16_t;
typedef short bf16x8 __attribute__((ext_vector_type(8)));
typedef float f32x4 __attribute__((ext_vector_type(4)));
typedef float f32x2 __attribute__((ext_vector_type(2)));
typedef unsigned u32x4 __attribute__((ext_vector_type(4)));
typedef unsigned u32x2 __attribute__((ext_vector_type(2)));
constexpr int BM = 256, BK = 64, HALF = 128, HTB = HALF * BK * 2  , STAGE_BYTES = 8 * HTB, NXCD = 8, WGM = 8;

__host__ __device__ __forceinline__ int lds_byte(int r, int c) { const int st = (r >> 4) * 2 + (c >> 5), rr = r & 15, cc = c & 31, ob = rr * 64 + cc * 2; return st * 1024 + (ob ^ (((ob >> 9) & 1) << 5)); }
__host__ __device__ __forceinline__ void stage_rc(int b, int& R, int& C) { const int st = b / 1024, sb = b % 1024, swz = sb ^ (((sb >> 9) & 1) << 5); R = (st >> 1) * 16 + swz / 64; C = (st & 1) * 32 + (swz % 64) / 2; }
__host__ __device__ __forceinline__ int perm32(int rho) { const int n = rho >> 4, i = rho & 15; return 8 * (i >> 2) + 4 * n + (i & 3); }

struct Unit { int pm, pn; };
struct Gemm { const bf16_t* A; const bf16_t* Bt; int lda, ldb, K, agrp_shift, agrp_stride, bmode; };

__device__ __forceinline__ void tile_of(int wgid, int nwg, int nM, int nN, int& pm, int& pn) {
    { const int q = nwg / NXCD, r = nwg % NXCD, xcd = wgid % NXCD, off = wgid / NXCD; wgid = (xcd < r ? xcd * (q + 1) : r * (q + 1) + (xcd - r) * q) + off; }
    const int nig = WGM * nN, gid = wgid / nig, fm = gid * WGM, gsz = (nM - fm) < WGM ? (nM - fm) : WGM;
    pm = fm + ((wgid % nig) % gsz); pn = (wgid % nig) / gsz;
}
struct StaticOrder {
    int nM, nN, nwg, G, c;
    __device__ __forceinline__ void init(int M, int N, int G_, int c_) { nM = M / BM; nN = N / BM; nwg = nM * nN; G = G_; c = c_; }
    __device__ __forceinline__ bool next(int i, Unit& u) const {
        const long L = (long)i * G + c; if (L >= nwg) return false;
        tile_of((int)L, nwg, nM, nN, u.pm, u.pn); return true;
    }
};
struct MergeOrder {
    int nM, ntile, G, c;
    __device__ __forceinline__ void init(int M, int G_, int c_) { nM = M / BM; ntile = nM * 16; G = G_; c = c_; }
    __device__ __forceinline__ bool next(int i, Unit& u) const {
        const long L = (long)(i >> 1) * G + c; if (L >= ntile) return false;
        int pm, ct; tile_of((int)L, ntile, nM, 16, pm, ct); u.pm = pm; u.pn = (i & 1) * 16 + ct; return true;
    }
};

typedef __bf16 bf16x2_t __attribute__((ext_vector_type(2)));
__device__ __forceinline__ unsigned cvt_pk_bf16(float lo, float hi) { const f32x2 v = {lo, hi}; return __builtin_bit_cast(unsigned, __builtin_convertvector(v, bf16x2_t)); }
__device__ __forceinline__ float bf_lo(unsigned w) { return __uint_as_float(w << 16); }
__device__ __forceinline__ float bf_hi(unsigned w) { return __uint_as_float(w & 0xffff0000u); }
__device__ __forceinline__ float sigmoidf_fast(float x) { return __builtin_amdgcn_rcpf(1.0f + __expf(-x)); }

struct EpiStoreBf16 {
    static constexpr bool PERM = true;
    bf16_t* O; int ldc;
    __device__ __forceinline__ void operator()(const f32x4 (&acc)[2][2][4][2], const Unit& u, int wr, int wc, int fr, int fq) const {
        const int row0 = u.pm * BM + wr * 64 + fr, col0 = u.pn * BM + wc * 32 + 8 * fq;
#pragma unroll
        for (int ai = 0; ai < 2; ++ai)
#pragma unroll
            for (int m = 0; m < 4; ++m) { bf16_t* rowp = O + (size_t)(row0 + ai * HALF + m * 16) * ldc + col0;
#pragma unroll
                for (int bj = 0; bj < 2; ++bj) { const f32x4 v0 = acc[ai][bj][m][0], v1 = acc[ai][bj][m][1];
                    u32x4 w; w.x = cvt_pk_bf16(v0[0], v0[1]); w.y = cvt_pk_bf16(v0[2], v0[3]); w.z = cvt_pk_bf16(v1[0], v1[1]); w.w = cvt_pk_bf16(v1[2], v1[3]);
                    *(u32x4*)(rowp + bj * HALF) = w; } }
    }
};
struct EpiGlu {
    static constexpr bool PERM = true;
    const bf16_t* Y1; int ld1; bf16_t* O; int ldc;
    __device__ __forceinline__ void operator()(const f32x4 (&acc)[2][2][4][2], const Unit& u, int wr, int wc, int fr, int fq) const {
        const int row0 = u.pm * BM + wr * 64 + fr, col0 = u.pn * BM + wc * 32 + 8 * fq;
#pragma unroll
        for (int ai = 0; ai < 2; ++ai)
#pragma unroll
            for (int m = 0; m < 4; ++m) { const size_t r = (size_t)(row0 + ai * HALF + m * 16);
#pragma unroll
                for (int bj = 0; bj < 2; ++bj) { const f32x4 v0 = acc[ai][bj][m][0], v1 = acc[ai][bj][m][1];
                    const u32x4 y = *(const u32x4*)(Y1 + r * ld1 + col0 + bj * HALF);
                    u32x4 w;
                    w.x = cvt_pk_bf16(bf_lo(y.x) * sigmoidf_fast(v0[0]), bf_hi(y.x) * sigmoidf_fast(v0[1]));
                    w.y = cvt_pk_bf16(bf_lo(y.y) * sigmoidf_fast(v0[2]), bf_hi(y.y) * sigmoidf_fast(v0[3]));
                    w.z = cvt_pk_bf16(bf_lo(y.z) * sigmoidf_fast(v1[0]), bf_hi(y.z) * sigmoidf_fast(v1[1]));
                    w.w = cvt_pk_bf16(bf_lo(y.w) * sigmoidf_fast(v1[2]), bf_hi(y.w) * sigmoidf_fast(v1[3]));
                    *(u32x4*)(O + r * ldc + col0 + bj * HALF) = w; } }
    }
};
struct EpiMerge {
    static constexpr bool PERM = true;
    const bf16_t* P; float* MACC; bf16_t* MG;
    __device__ __forceinline__ void operator()(const f32x4 (&acc)[2][2][4][2], const Unit& u, int wr, int wc, int fr, int fq) const {
        const int kp = u.pn >> 4, ct = u.pn & 15;
        const int row0 = u.pm * BM + wr * 64 + fr, c = ct * HALF + wc * 32 + 8 * fq;
#pragma unroll
        for (int ai = 0; ai < 2; ++ai)
#pragma unroll
            for (int m = 0; m < 4; ++m) { const size_t r = (size_t)(row0 + ai * HALF + m * 16);
                const u32x4 p0 = *(const u32x4*)(P + r * 8192 + (2 * kp) * 2048 + c), p1 = *(const u32x4*)(P + r * 8192 + (2 * kp + 1) * 2048 + c);
                const f32x4 a0 = acc[ai][0][m][0], a1 = acc[ai][0][m][1], b0 = acc[ai][1][m][0], b1 = acc[ai][1][m][1];
                f32x4 t0, t1;
                t0[0] = bf_lo(p0.x) * sigmoidf_fast(a0[0]) + bf_lo(p1.x) * sigmoidf_fast(b0[0]); t0[1] = bf_hi(p0.x) * sigmoidf_fast(a0[1]) + bf_hi(p1.x) * sigmoidf_fast(b0[1]);
                t0[2] = bf_lo(p0.y) * sigmoidf_fast(a0[2]) + bf_lo(p1.y) * sigmoidf_fast(b0[2]); t0[3] = bf_hi(p0.y) * sigmoidf_fast(a0[3]) + bf_hi(p1.y) * sigmoidf_fast(b0[3]);
                t1[0] = bf_lo(p0.z) * sigmoidf_fast(a1[0]) + bf_lo(p1.z) * sigmoidf_fast(b1[0]); t1[1] = bf_hi(p0.z) * sigmoidf_fast(a1[1]) + bf_hi(p1.z) * sigmoidf_fast(b1[1]);
                t1[2] = bf_lo(p0.w) * sigmoidf_fast(a1[2]) + bf_lo(p1.w) * sigmoidf_fast(b1[2]); t1[3] = bf_hi(p0.w) * sigmoidf_fast(a1[3]) + bf_hi(p1.w) * sigmoidf_fast(b1[3]);
                float* mp = MACC + r * 2048 + c;
                if (kp == 0) { *(f32x4*)mp = t0; *(f32x4*)(mp + 4) = t1; }
                else { t0 += *(const f32x4*)mp; t1 += *(const f32x4*)(mp + 4);
                    u32x4 w; w.x = cvt_pk_bf16(t0[0], t0[1]); w.y = cvt_pk_bf16(t0[2], t0[3]); w.z = cvt_pk_bf16(t1[0], t1[1]); w.w = cvt_pk_bf16(t1[2], t1[3]);
                    *(u32x4*)(MG + r * 2048 + c) = w; } }
    }
};
struct EpiResF32 {
    static constexpr bool PERM = false;
    const float* base; const float* base2; int split_row; float* out; int ldc;
    __device__ __forceinline__ void operator()(const f32x4 (&acc)[2][2][4][2], const Unit& u, int wr, int wc, int fr, int fq) const {
        const int row0 = u.pm * BM + wr * 64 + fr, col0 = u.pn * BM + wc * 32 + 4 * fq;
        const float* bp = (u.pm * BM >= split_row) ? base2 - (size_t)split_row * ldc : base;
#pragma unroll
        for (int ai = 0; ai < 2; ++ai)
#pragma unroll
            for (int m = 0; m < 4; ++m) { const size_t off = (size_t)(row0 + ai * HALF + m * 16) * ldc + col0;
#pragma unroll
                for (int bj = 0; bj < 2; ++bj)
#pragma unroll
                    for (int n = 0; n < 2; ++n) { const f32x4 bs = *(const f32x4*)(bp + off + bj * HALF + n * 16); *(f32x4*)(out + off + bj * HALF + n * 16) = bs + acc[ai][bj][m][n]; } }
    }
};
struct EpiSwiglu {
    static constexpr bool PERM = true;
    bf16_t* O; int ldc;
    __device__ __forceinline__ void operator()(const f32x4 (&acc)[2][2][4][2], const Unit& u, int wr, int wc, int fr, int fq) const {
        const int row0 = u.pm * BM + wr * 64 + fr, col0 = u.pn * HALF + wc * 32 + 8 * fq;
#pragma unroll
        for (int ai = 0; ai < 2; ++ai)
#pragma unroll
            for (int m = 0; m < 4; ++m) {
                f32x4 t[2];
#pragma unroll
                for (int n = 0; n < 2; ++n)
#pragma unroll
                    for (int j = 0; j < 4; ++j) { const float a = acc[ai][0][m][n][j], b = acc[ai][1][m][n][j]; t[n][j] = a * sigmoidf_fast(a) * b; }
                u32x4 w; w.x = cvt_pk_bf16(t[0][0], t[0][1]); w.y = cvt_pk_bf16(t[0][2], t[0][3]); w.z = cvt_pk_bf16(t[1][0], t[1][1]); w.w = cvt_pk_bf16(t[1][2], t[1][3]);
                *(u32x4*)(O + (size_t)(row0 + ai * HALF + m * 16) * ldc + col0) = w; }
    }
};
struct EpiPle {
    static constexpr bool PERM = false;
    const float* base; float* out; int ldc; const bf16_t* PP; int ldp;
    __device__ __forceinline__ void operator()(const f32x4 (&acc)[2][2][4][2], const Unit& u, int wr, int wc, int fr, int fq) const {
        const int row0 = u.pm * BM + wr * 64 + fr, col0 = u.pn * BM + wc * 32 + 4 * fq;
#pragma unroll
        for (int ai = 0; ai < 2; ++ai)
#pragma unroll
            for (int m = 0; m < 4; ++m) { const size_t r = (size_t)(row0 + ai * HALF + m * 16);
#pragma unroll
                for (int bj = 0; bj < 2; ++bj)
#pragma unroll
                    for (int n = 0; n < 2; ++n) { const int c = col0 + bj * HALF + n * 16; const f32x4 a = acc[ai][bj][m][n];
                        const f32x4 bs = *(const f32x4*)(base + r * ldc + c); const u32x2 p = *(const u32x2*)(PP + r * ldp + c);
                        f32x4 o; o[0] = bs[0] + sigmoidf_fast(a[0]) * bf_lo(p.x); o[1] = bs[1] + sigmoidf_fast(a[1]) * bf_hi(p.x); o[2] = bs[2] + sigmoidf_fast(a[2]) * bf_lo(p.y); o[3] = bs[3] + sigmoidf_fast(a[3]) * bf_hi(p.y);
                        *(f32x4*)(out + r * ldc + c) = o; } }
    }
};
template <class Epi, class Sched, bool ALIGN_EPI = false, bool SP2 = false>
__device__ __forceinline__ void gemm_phase(PG8_LAS unsigned char* lds, const Gemm g, const Sched& S, const Epi& E) {
    int tid_ = threadIdx.x; asm volatile("" : "+v"(tid_));
    const int tid = tid_, wid = __builtin_amdgcn_readfirstlane(tid >> 6), lane = tid & 63, wr = wid >> 2, wc = wid & 3, fr = lane & 15, fq = lane >> 4;
    const int K = g.K, nt = K / BK, lda = g.lda, ldb = g.ldb;
    unsigned voffA[2], voffB[2];
#pragma unroll
    for (int i = 0; i < 2; ++i) { int R, C; stage_rc(tid * 16 + i * 8192, R, C); const int Rb = Epi::PERM ? ((R & ~31) + perm32(R & 31)) : R;
        voffA[i] = (unsigned)(R * lda + C) * 2u; voffB[i] = (unsigned)(Rb * ldb + C) * 2u; }
    const size_t kstep = (size_t)(BK * 2);
    const size_t hstepA = (size_t)HALF * lda * 2, hstepB = (size_t)(g.bmode ? 2048 : HALF) * ldb * 2;
    const size_t tstepA = 2 * hstepA, tstepB = (size_t)BM * ldb * 2;
#define PG8_ABASE(u) ((const char*)g.A + (size_t)(u).pm * tstepA + (size_t)((u).pn >> g.agrp_shift) * (size_t)g.agrp_stride * 2)
#define PG8_BBASE(u) ((const char*)g.Bt + (g.bmode ? (size_t)(((u).pn >> 4) * 4096 + ((u).pn & 15) * HALF) * ldb * 2 : (size_t)(u).pn * tstepB))
    const unsigned ldsw = (unsigned)wid * 1024u;
    const int aoff = lds_byte(wr * 64 + fr, fq * 8), boff = lds_byte(wc * 32 + fr, fq * 8);
#define PG8_SA(b, h) (((b) * 2 + (h)) * HTB)
#define PG8_SB(b, h) ((4 + (b) * 2 + (h)) * HTB)
#define PG8_STAGE(bufoff, gbase, voff) do { _Pragma("unroll") for (int _i = 0; _i < 2; ++_i) \
        __builtin_amdgcn_global_load_lds((const unsigned*)((const char*)(gbase) + (voff)[_i]), (PG8_LAS unsigned*)(lds + (bufoff) + ldsw + _i * 8192), 16, 0, 0); } while (0)
#define PG8_LDA(dst, b, h) do { _Pragma("unroll") for (int m = 0; m < 4; ++m) _Pragma("unroll") for (int k = 0; k < 2; ++k) dst[m][k] = *(const PG8_LAS bf16x8*)(lds + PG8_SA(b, h) + aoff + m * 2048 + k * 1024); } while (0)
#define PG8_LDB(dst, b, h) do { _Pragma("unroll") for (int n = 0; n < 2; ++n) _Pragma("unroll") for (int k = 0; k < 2; ++k) dst[n][k] = *(const PG8_LAS bf16x8*)(lds + PG8_SB(b, h) + boff + n * 2048 + k * 1024); } while (0)
#define PG8_MMA(ai, bj, At, Bt) do { __builtin_amdgcn_s_setprio(1); _Pragma("unroll") for (int m = 0; m < 4; ++m) _Pragma("unroll") for (int n = 0; n < 2; ++n) _Pragma("unroll") for (int k = 0; k < 2; ++k) \
        acc[ai][bj][m][n] = __builtin_amdgcn_mfma_f32_16x16x32_bf16(Bt[n][k], At[m][k], acc[ai][bj][m][n], 0, 0, 0); __builtin_amdgcn_s_setprio(0); } while (0)
#define PG8_WAIT_V(n) asm volatile("s_waitcnt vmcnt(" #n ")" ::: "memory")
#define PG8_WAIT_L(n) asm volatile("s_waitcnt lgkmcnt(" #n ")" ::: "memory")
#define PG8_BAR __builtin_amdgcn_s_barrier()
#define PG8_SCHED __builtin_amdgcn_sched_barrier(0)
    Unit cur, nxt; int ui = 0;
    if (!S.next(0, cur)) return;
    f32x4 acc[2][2][4][2];
#pragma unroll
    for (int a = 0; a < 2; ++a)
#pragma unroll
        for (int b = 0; b < 2; ++b)
#pragma unroll
            for (int m = 0; m < 4; ++m)
#pragma unroll
                for (int n = 0; n < 2; ++n) acc[a][b][m][n] = (f32x4){0.f, 0.f, 0.f, 0.f};
    bf16x8 At[4][2], B0[2][2], B1[2][2];
    const char* cA = PG8_ABASE(cur); const char* cB = PG8_BBASE(cur);
    if constexpr (SP2) {
        PG8_STAGE(PG8_SB(0, 0), cB, voffB); PG8_STAGE(PG8_SB(0, 1), cB + hstepB, voffB); PG8_STAGE(PG8_SA(0, 0), cA, voffA); PG8_STAGE(PG8_SA(0, 1), cA + hstepA, voffA);
        if (wr == 1) PG8_BAR;
        PG8_WAIT_V(2); PG8_BAR;
        PG8_STAGE(PG8_SB(1, 0), cB + kstep, voffB); PG8_STAGE(PG8_SA(1, 0), cA + kstep, voffA); PG8_STAGE(PG8_SB(1, 1), cB + hstepB + kstep, voffB);
        PG8_WAIT_V(6); PG8_BAR;
    } else {
        PG8_STAGE(PG8_SB(0, 0), cB, voffB); PG8_STAGE(PG8_SA(0, 0), cA, voffA); PG8_STAGE(PG8_SB(0, 1), cB + hstepB, voffB); PG8_STAGE(PG8_SA(0, 1), cA + hstepA, voffA);
        if (wr == 1) PG8_BAR;
        PG8_WAIT_V(4); PG8_BAR;
        PG8_STAGE(PG8_SB(1, 0), cB + kstep, voffB); PG8_STAGE(PG8_SA(1, 0), cA + kstep, voffA); PG8_STAGE(PG8_SB(1, 1), cB + hstepB + kstep, voffB);
        PG8_WAIT_V(6); PG8_BAR;
    }
    for (;;) {
        const bool has_next = S.next(ui + 1, nxt);
        const char* nA = has_next ? PG8_ABASE(nxt) : cA; const char* nB = has_next ? PG8_BBASE(nxt) : cB;
        for (int t = 0; t < nt; t += 2) {
            const bool last = (t == nt - 2);
            const char* a1 = cA + (size_t)(t + 1) * kstep;
            const char* a2 = last ? nA : cA + (size_t)(t + 2) * kstep; const char* b2 = last ? nB : cB + (size_t)(t + 2) * kstep;
            const char* a3 = a2 + kstep; const char* b3 = b2 + kstep;
            if constexpr (SP2) {
            PG8_LDB(B0, 0, 0); PG8_LDB(B1, 0, 1); PG8_SCHED; PG8_LDA(At, 0, 0); PG8_STAGE(PG8_SA(1, 1), a1 + hstepA, voffA);
            PG8_WAIT_V(8); PG8_WAIT_L(0); PG8_BAR; PG8_MMA(0, 0, At, B0); PG8_MMA(0, 1, At, B1); PG8_BAR; PG8_SCHED;
            PG8_LDA(At, 0, 1); PG8_STAGE(PG8_SB(0, 0), b2, voffB); PG8_STAGE(PG8_SB(0, 1), b2 + hstepB, voffB); PG8_STAGE(PG8_SA(0, 0), a2, voffA);
            PG8_WAIT_V(8); PG8_WAIT_L(0); PG8_BAR; PG8_MMA(1, 0, At, B0); PG8_MMA(1, 1, At, B1); PG8_BAR; PG8_SCHED;
            PG8_LDB(B0, 1, 0); PG8_LDB(B1, 1, 1); PG8_SCHED; PG8_LDA(At, 1, 0); PG8_STAGE(PG8_SA(0, 1), a2 + hstepA, voffA);
            PG8_WAIT_V(8); PG8_WAIT_L(0); PG8_BAR; PG8_MMA(0, 0, At, B0); PG8_MMA(0, 1, At, B1); PG8_BAR; PG8_SCHED;
            PG8_LDA(At, 1, 1); PG8_STAGE(PG8_SB(1, 0), b3, voffB); PG8_STAGE(PG8_SB(1, 1), b3 + hstepB, voffB); PG8_STAGE(PG8_SA(1, 0), a3, voffA);
            PG8_WAIT_V(8); PG8_WAIT_L(0); PG8_BAR; PG8_MMA(1, 0, At, B0); PG8_MMA(1, 1, At, B1); PG8_BAR; PG8_SCHED;
            } else {
            PG8_LDB(B0, 0, 0); PG8_SCHED; PG8_LDA(At, 0, 0); PG8_STAGE(PG8_SA(1, 1), a1 + hstepA, voffA);
            PG8_WAIT_L(8); PG8_BAR; PG8_WAIT_L(0); PG8_MMA(0, 0, At, B0); PG8_BAR; PG8_SCHED;
            PG8_LDB(B1, 0, 1); PG8_STAGE(PG8_SB(0, 0), b2, voffB);
            PG8_BAR; PG8_WAIT_L(0); PG8_MMA(0, 1, At, B1); PG8_BAR;
            PG8_LDA(At, 0, 1); PG8_STAGE(PG8_SA(0, 0), a2, voffA);
            PG8_BAR; PG8_WAIT_L(0); PG8_MMA(1, 0, At, B0); PG8_BAR; PG8_SCHED;
            PG8_STAGE(PG8_SB(0, 1), b2 + hstepB, voffB);
            PG8_WAIT_V(6); PG8_BAR; PG8_MMA(1, 1, At, B1); PG8_BAR;
            PG8_LDB(B0, 1, 0); PG8_SCHED; PG8_LDA(At, 1, 0); PG8_STAGE(PG8_SA(0, 1), a2 + hstepA, voffA);
            PG8_WAIT_L(8); PG8_BAR; PG8_WAIT_L(0); PG8_MMA(0, 0, At, B0); PG8_BAR; PG8_SCHED;
            PG8_LDB(B1, 1, 1); PG8_STAGE(PG8_SB(1, 0), b3, voffB);
            PG8_BAR; PG8_WAIT_L(0); PG8_MMA(0, 1, At, B1); PG8_BAR;
            PG8_LDA(At, 1, 1); PG8_STAGE(PG8_SA(1, 0), a3, voffA);
            PG8_BAR; PG8_WAIT_L(0); PG8_MMA(1, 0, At, B0); PG8_BAR; PG8_SCHED;
            PG8_STAGE(PG8_SB(1, 1), b3 + hstepB, voffB);
            PG8_WAIT_V(6); PG8_BAR; PG8_MMA(1, 1, At, B1); PG8_BAR;
            }
        }
        if constexpr (ALIGN_EPI) { if (wr == 0) PG8_BAR; }
        { E(acc, cur, wr, wc, fr, fq); }
        if (!has_next) break;
#pragma unroll
        for (int a = 0; a < 2; ++a)
#pragma unroll
            for (int b = 0; b < 2; ++b)
#pragma unroll
                for (int m = 0; m < 4; ++m)
#pragma unroll
                    for (int n = 0; n < 2; ++n) acc[a][b][m][n] = (f32x4){0.f, 0.f, 0.f, 0.f};
        cur = nxt; cA = nA; cB = nB; ++ui;
        if constexpr (ALIGN_EPI) { if (wr == 1) PG8_BAR; }
    }
    PG8_WAIT_V(0);
    if constexpr (!ALIGN_EPI) { if (wr == 0) PG8_BAR; }
    PG8_BAR;
#undef PG8_ABASE
#undef PG8_BBASE
#undef PG8_SA
#undef PG8_SB
#undef PG8_STAGE
#undef PG8_LDA
#undef PG8_LDB
#undef PG8_MMA
#undef PG8_WAIT_V
#undef PG8_WAIT_L
#undef PG8_BAR
#undef PG8_SCHED
}
}


constexpr int D_MODEL = 2048, NTOK = 49152, CH_TOK = 16384, N_CHUNK = 3, DEPTH = 2;
constexpr int MIX_IN = 4096, IN_COLS = 12288, D_FF = 5632, PLE_DIM = 256;
constexpr int ZC_UA = 0, ZC_BG = 512, ZC_CG = 1024, ZC_VB = 1536, ZC_Q = 2048, ZC_K = 2560, ZC_VC = 3072, ZC_UD = 3584;
constexpr float EPS = 1e-6f;
constexpr int NWAVES = 8;

constexpr size_t MiB = 1u << 20;
constexpr size_t WS_CTL = 0, CTL_ZERO_BYTES = 1 * MiB;
constexpr size_t WS_TAB = 1 * MiB;
constexpr size_t S5T_BYTES = 12800, S5T_BB = 0, S5T_C = 8192, S5T_AB = 12288;
constexpr size_t TAB_S5 = WS_TAB, TAB_C128 = WS_TAB + 2 * MiB, TAB_S128 = TAB_C128 + 32768, TAB_C32 = TAB_S128 + 32768, TAB_S32 = TAB_C32 + 2048;
constexpr size_t WS_W = 8 * MiB;
constexpr size_t WL_MIX = 0, WL_G = 16 * MiB, WL_GLU = 48 * MiB, WL_BR = WL_GLU + MiB / 2, WL_O = WL_BR + 8 * MiB, WL_FF = WL_O + 8 * MiB, WL_FF2 = WL_FF + 44 * MiB, WL_PG = WL_FF2 + 22 * MiB, WL_PP = WL_PG + 8 * MiB;
constexpr size_t WL_BYTES = WL_PP + 1 * MiB;
static_assert(WL_BYTES == 139 * MiB + MiB / 2, "weight map");
constexpr size_t WS_H = 288 * MiB;
constexpr size_t WS_Z = 352 * MiB;
constexpr size_t WS_YS = 480 * MiB;
constexpr size_t WS_HALL = 352 * MiB;
constexpr size_t WS_MG = 544 * MiB;
constexpr size_t WS_GT = 736 * MiB;
constexpr size_t WS_YF = WS_GT, WS_YB = WS_GT + 32 * MiB, WS_ZF = WS_GT + 64 * MiB, WS_Y1 = WS_GT + 96 * MiB, WS_S5E = WS_GT + 112 * MiB;
constexpr size_t WS_H2ALL = 288 * MiB, WS_MIDALL = 480 * MiB;
constexpr size_t WS_PP = WS_GT;
constexpr size_t WS_P16 = 992 * MiB;
constexpr size_t WS_END = 1016 * MiB;
static_assert(WS_MIDALL + 528 * MiB <= WS_END && WS_H2ALL + 192 * MiB <= WS_MIDALL, "ffn map");
static_assert(WS_W + 2 * WL_BYTES <= WS_H && WS_MG + 192 * MiB <= WS_GT && WS_GT + 256 * MiB <= WS_P16, "ws map");
constexpr int CW_BAR = 4096;

constexpr int LDS_SCRATCH = 151552;
constexpr int LDSCTL_OFF = LDS_SCRATCH;
constexpr int LDS_BYTES = LDS_SCRATCH + 256;

#define GAS __attribute__((address_space(1)))
#define LAS __attribute__((address_space(3)))
typedef unsigned short bf16;
typedef unsigned u32x4 __attribute__((ext_vector_type(4)));
typedef unsigned u32x2 __attribute__((ext_vector_type(2)));
typedef float f32x4 __attribute__((ext_vector_type(4)));
typedef float f32x2 __attribute__((ext_vector_type(2)));
typedef short bf16x8 __attribute__((ext_vector_type(8)));
#define LDS_WAIT() asm volatile("s_waitcnt lgkmcnt(0)" ::: "memory")
using pg8::cvt_pk_bf16; using pg8::bf_lo; using pg8::bf_hi;
__device__ __forceinline__ bf16x8 as_frag(u32x4 v) { return __builtin_bit_cast(bf16x8, v); }
__device__ __forceinline__ void mfma_acc(f32x4& acc, bf16x8 a, bf16x8 b) { asm volatile("s_nop 1\n\tv_mfma_f32_16x16x32_bf16 %0, %1, %2, %0" : "+v"(acc) : "v"(a), "v"(b)); }
__device__ __forceinline__ f32x4 mfma16(bf16x8 a, bf16x8 b, f32x4 c) { mfma_acc(c, a, b); return c; }
#define MFMA_DRAIN() do { __builtin_amdgcn_sched_barrier(0); asm volatile("s_nop 15\n\ts_nop 15" ::: "memory"); __builtin_amdgcn_sched_barrier(0); } while (0)
__device__ __forceinline__ float wave_sum(float v) {
#pragma unroll
    for (int o = 1; o < 64; o <<= 1) v += __shfl_xor(v, o);
    return v;
}
__device__ __forceinline__ unsigned short f2bf(float f) { return (unsigned short)(cvt_pk_bf16(f, 0.f) & 0xffffu); }

#define XB_TMO      128
#define XB_XCNT(j)  (256  + 64 * (j))
#define XB_XSUB(j)  (1280 + 64 * (j))
#define XB_XGEN(j)  (2304 + 64 * (j))
#define XB_TOP      3328
#define XB_TOPGEN   3392
#define XCD_BAR_WORDS 3456
#define XB_SPIN_CAP (1u << 22)
__device__ __forceinline__ unsigned xb_ld(unsigned* p)              { return __hip_atomic_load(p, __ATOMIC_RELAXED, __HIP_MEMORY_SCOPE_AGENT); }
__device__ __forceinline__ unsigned xb_add(unsigned* p, unsigned v) { return __hip_atomic_fetch_add(p, v, __ATOMIC_RELAXED, __HIP_MEMORY_SCOPE_AGENT); }
__device__ __forceinline__ unsigned xb_xcc_id() { return (unsigned)__builtin_amdgcn_s_getreg((3 << 11) | 20) & 0xFu; }
#define XB_SPIN(cond, bar) do { unsigned _sp = 0; while (cond) { __builtin_amdgcn_s_sleep(1); \
    if ((++_sp & 255u) == 0u) { if (xb_ld(&(bar)[XB_TMO])) break; if (_sp > XB_SPIN_CAP) { atomicAdd(&(bar)[XB_TMO], 1u); break; } } } } while (0)
struct XcdBarrier { unsigned* bar; unsigned x; volatile LAS unsigned* st; };
__device__ __forceinline__ XcdBarrier xcd_barrier_post(unsigned* bar, volatile LAS unsigned* st) {
    XcdBarrier b; b.bar = bar; b.x = xb_xcc_id(); b.st = st;
    if (threadIdx.x == 0) (void)xb_add(&bar[XB_XCNT(b.x)], 1u);
    return b;
}
__device__ __forceinline__ void xcd_barrier_complete(unsigned* bar, unsigned x, unsigned& nloc, unsigned& nx) {
    const unsigned G = gridDim.x * gridDim.y * gridDim.z;
    unsigned sum, cnt, mine, sp = 0u;
    for (;;) {
        sum = 0u; cnt = 0u; mine = 0u;
#pragma unroll
        for (unsigned j = 0; j < 16; ++j) { const unsigned c = xb_ld(&bar[XB_XCNT(j)]); sum += c; cnt += (c > 0u) ? 1u : 0u; mine = (j == x) ? c : mine; }
        if (sum == G) break;
        __builtin_amdgcn_s_sleep(1);
        if ((++sp & 255u) == 0u) { if (xb_ld(&bar[XB_TMO])) break; if (sp > XB_SPIN_CAP) { atomicAdd(&bar[XB_TMO], 1u); break; } }
    }
    nloc = mine > 0u ? mine : 1u; nx = cnt > 0u ? cnt : 1u;
}
__device__ __forceinline__ void xcd_barrier(const XcdBarrier& b) {
    asm volatile("s_waitcnt vmcnt(0)" ::: "memory");
    __syncthreads();
    if (threadIdx.x == 0) {
        unsigned* bar = b.bar;
        __builtin_amdgcn_s_waitcnt(0);
        unsigned nloc = b.st[0], nx = b.st[1];
        if (nloc == 0u) { xcd_barrier_complete(bar, b.x, nloc, nx); b.st[0] = nloc; b.st[1] = nx; }
        const unsigned old = xb_add(&bar[XB_XSUB(b.x)], 1u);
        const unsigned gen = old / nloc;
        if (old + 1u == (gen + 1u) * nloc) {
            __builtin_amdgcn_fence(__ATOMIC_RELEASE, "agent");
            asm volatile("s_waitcnt vmcnt(0)" ::: "memory");
            const unsigned og = xb_add(&bar[XB_TOP], 1u);
            const unsigned tg = og / nx;
            if (og + 1u == (tg + 1u) * nx) xb_add(&bar[XB_TOPGEN], 1u);
            else XB_SPIN(xb_ld(&bar[XB_TOPGEN]) == tg, bar);
            __builtin_amdgcn_fence(__ATOMIC_ACQUIRE, "agent");
            xb_add(&bar[XB_XGEN(b.x)], 1u);
            asm volatile("s_waitcnt vmcnt(0)" ::: "memory");
        } else {
            XB_SPIN(xb_ld(&bar[XB_XGEN(b.x)]) == gen, bar);
            __builtin_amdgcn_fence(__ATOMIC_ACQUIRE, "agent");
            asm volatile("s_waitcnt vmcnt(0)" ::: "memory");
        }
    }
    __syncthreads();
}

struct Frame {
    LAS unsigned char* lds;
    int tid, lane, wave;
    int vcu, G;
    unsigned char* ws;
};
struct Args { const float* in[27]; float* out; unsigned char* ws; int ph_lo, ph_hi; };
__device__ __forceinline__ Frame fresh(const Frame& F0) { Frame F = F0; int t = F0.tid; asm volatile("" : "+v"(t)); F.tid = t; F.lane = t & 63; F.wave = __builtin_amdgcn_readfirstlane(t >> 6); return F; }

__device__ __forceinline__ void transpose_item(const float* W, int K, int N, bf16* WT, int k0, int n0, int drow0, LAS float* scr, int lane) {
#pragma unroll 8
    for (int i = 0; i < 32; ++i) { const int kk = 2 * i + (lane >> 5); scr[kk * 33 + (lane & 31)] = W[(size_t)(k0 + kk) * N + n0 + (lane & 31)]; }
    LDS_WAIT(); asm volatile("" ::: "memory");
    const int c = lane & 7;
#pragma unroll
    for (int j = 0; j < 4; ++j) { const int n = (lane >> 3) + 8 * j; const LAS float* s = scr + (8 * c) * 33 + n;
        u32x4 o; o.x = cvt_pk_bf16(s[0 * 33], s[1 * 33]); o.y = cvt_pk_bf16(s[2 * 33], s[3 * 33]); o.z = cvt_pk_bf16(s[4 * 33], s[5 * 33]); o.w = cvt_pk_bf16(s[6 * 33], s[7 * 33]);
        *(u32x4*)(WT + (size_t)(drow0 + n) * K + k0 + 8 * c) = o; }
    LDS_WAIT(); asm volatile("" ::: "memory");
}
__device__ __forceinline__ void conv_plain(const float* W, int K, int N, bf16* WT, int item, LAS float* scr, int lane) {
    const int nblk = N / 32, kb = item / nblk, nb = item % nblk;
    transpose_item(W, K, N, WT, 64 * kb, 32 * nb, 32 * nb, scr, lane);
}
__device__ __forceinline__ void ph_prologue(Frame& F, const Args& A) {
    LAS float* scr = (LAS float*)(F.lds + F.wave * 16384);
    const int gw = F.vcu * NWAVES + F.wave, NGW = F.G * NWAVES;
    constexpr int I_IN = (2048 / 64) * (IN_COLS / 32), I_GLU = (512 / 64) * (512 / 32), I_BR1 = (512 / 64) * (2048 / 32), I_BR = 4 * I_BR1, I_O = (2048 / 64) * (2048 / 32),
                  I_FF = (2048 / 64) * (2 * D_FF / 32), I_FF2 = (D_FF / 64) * (2048 / 32), I_PG = I_O, I_PP = (256 / 64) * (2048 / 32);
    constexpr int I_LAYER = I_IN + I_GLU + I_BR + I_O + I_FF + I_FF2 + I_PG + I_PP;
    for (int it = gw; it < DEPTH * I_LAYER; it += NGW) {
        const int l = it / I_LAYER; int r = it % I_LAYER;
        unsigned char* wl = F.ws + WS_W + (size_t)l * WL_BYTES;
        if (r < I_IN) {
            const float* W = A.in[5] + (size_t)l * 2048 * IN_COLS; const int nblk = IN_COLS / 32, kb = r / nblk, nb = r % nblk, n0 = 32 * nb;
            if (n0 < MIX_IN) transpose_item(W, 2048, IN_COLS, (bf16*)(wl + WL_MIX), 64 * kb, n0, n0, scr, F.lane);
            else transpose_item(W, 2048, IN_COLS, (bf16*)(wl + WL_G), 64 * kb, n0, n0 - MIX_IN, scr, F.lane);
            continue; } r -= I_IN;
        if (r < I_GLU) { conv_plain(A.in[14] + (size_t)l * 512 * 512, 512, 512, (bf16*)(wl + WL_GLU), r, scr, F.lane); continue; } r -= I_GLU;
        if (r < I_BR) { const int kb = r / I_BR1; conv_plain(A.in[19] + ((size_t)l * 4 + kb) * 512 * 2048, 512, 2048, (bf16*)(wl + WL_BR) + (size_t)kb * 2048 * 512, r % I_BR1, scr, F.lane); continue; } r -= I_BR;
        if (r < I_O) { conv_plain(A.in[20] + (size_t)l * 2048 * 2048, 2048, 2048, (bf16*)(wl + WL_O), r, scr, F.lane); continue; } r -= I_O;
        if (r < I_FF) {
            const float* W = A.in[22] + (size_t)l * 2048 * 2 * D_FF; const int nblk = 2 * D_FF / 32, kb = r / nblk, nb = r % nblk, n0 = 32 * nb;
            const int j = n0 / D_FF, rr = n0 % D_FF, pn = rr / 128, cc = rr % 128;
            transpose_item(W, 2048, 2 * D_FF, (bf16*)(wl + WL_FF), 64 * kb, n0, 256 * pn + 128 * j + cc, scr, F.lane);
            continue; } r -= I_FF;
        if (r < I_FF2) { conv_plain(A.in[23] + (size_t)l * D_FF * 2048, D_FF, 2048, (bf16*)(wl + WL_FF2), r, scr, F.lane); continue; } r -= I_FF2;
        if (r < I_PG) { conv_plain(A.in[25] + (size_t)l * 2048 * 2048, 2048, 2048, (bf16*)(wl + WL_PG), r, scr, F.lane); continue; } r -= I_PG;
        conv_plain(A.in[26] + (size_t)l * 256 * 2048, 256, 2048, (bf16*)(wl + WL_PP), r, scr, F.lane);
    }
    {
        const int gt = F.vcu * 512 + F.tid, NT = F.G * 512;
        bf16* c128 = (bf16*)(F.ws + TAB_C128); bf16* s128 = (bf16*)(F.ws + TAB_S128); bf16* c32 = (bf16*)(F.ws + TAB_C32); bf16* s32 = (bf16*)(F.ws + TAB_S32);
        for (int e = gt; e < 128 * 128 + 32 * 32; e += NT) {
            if (e < 128 * 128) { const int i = e >> 7, k = e & 127, m = (i * k) & 127; float sn, cs; sincospif((float)m * (1.0f / 64.0f), &sn, &cs);
                c128[e] = f2bf(cs * 0.08838834764831845f); s128[e] = f2bf(sn * 0.08838834764831845f); }
            else { const int e2 = e - 128 * 128, i = e2 >> 5, k = e2 & 31, m = (i * k) & 31; float sn, cs; sincospif((float)m * (1.0f / 16.0f), &sn, &cs);
                c32[e2] = f2bf(cs * 0.17677669529663687f); s32[e2] = f2bf(sn * 0.17677669529663687f); }
        }
    }
    for (int t = gw; t < DEPTH * 2 * 32; t += NGW) {
        const int g = t & 31, ld = t >> 5;
        unsigned char* tb = F.ws + TAB_S5 + (size_t)t * S5T_BYTES;
        const float* lam_re = A.in[6] + (size_t)t * 64; const float* lam_im = A.in[7] + (size_t)t * 64;
        const float dt = expf(A.in[8][t]);
        const float* b_re = A.in[9] + (size_t)t * 64 * 16; const float* b_im = A.in[10] + (size_t)t * 64 * 16;
        const float* c_re = A.in[11] + (size_t)t * 16 * 64; const float* c_im = A.in[12] + (size_t)t * 16 * 64;
        (void)g; (void)ld;
        const int lane = F.lane, l15 = lane & 15, g4 = lane >> 4;
        {
            const float lr = lam_re[lane], li = lam_im[lane], mag = expf(lr * dt); float sn, cs; sincosf(li * dt, &sn, &cs);
            f32x2 ab; ab.x = mag * cs; ab.y = mag * sn; ((f32x2*)(tb + S5T_AB))[lane] = ab;
        }
#pragma unroll 1
        for (int cb = 0; cb < 8; ++cb) {
            const int col = 16 * cb + l15, p = col >> 1, ri = col & 1;
            const float lr = lam_re[p], li = lam_im[p], mag = expf(lr * dt); float sn, cs; sincosf(li * dt, &sn, &cs);
            const float ar = mag * cs, ai = mag * sn, den = lr * lr + li * li;
            const float fr = ((ar - 1.0f) * lr + ai * li) / den, fi = (ai * lr - (ar - 1.0f) * li) / den;
            float v[8];
#pragma unroll
            for (int j = 0; j < 8; ++j) { const int h = 8 * g4 + j; float x = 0.f;
                if (h < 16) { const float br = b_re[p * 16 + h], bi = b_im[p * 16 + h]; x = ri ? (fr * bi + fi * br) : (fr * br - fi * bi); }
                v[j] = x; }
            u32x4 o; o.x = cvt_pk_bf16(v[0], v[1]); o.y = cvt_pk_bf16(v[2], v[3]); o.z = cvt_pk_bf16(v[4], v[5]); o.w = cvt_pk_bf16(v[6], v[7]);
            ((u32x4*)(tb + S5T_BB))[cb * 64 + lane] = o;
        }
#pragma unroll 1
        for (int ks = 0; ks < 4; ++ks) {
            float v[8];
#pragma unroll
            for (int j = 0; j < 8; ++j) { const int col = 32 * ks + 8 * g4 + j, p = col >> 1, ri = col & 1; v[j] = ri ? -c_im[l15 * 64 + p] : c_re[l15 * 64 + p]; }
            u32x4 o; o.x = cvt_pk_bf16(v[0], v[1]); o.y = cvt_pk_bf16(v[2], v[3]); o.z = cvt_pk_bf16(v[4], v[5]); o.w = cvt_pk_bf16(v[6], v[7]);
            ((u32x4*)(tb + S5T_C))[ks * 64 + lane] = o;
        }
    }
}

__device__ __forceinline__ void ph_norm(Frame& F, const float* xsrc, const float* gain, bf16* H, int nrows) {
    const int gw = F.vcu * NWAVES + F.wave, NGW = F.G * NWAVES;
    f32x4 gv[8];
#pragma unroll
    for (int j = 0; j < 8; ++j) gv[j] = ((const f32x4*)gain)[F.lane + 64 * j];
    for (int m = gw; m < nrows; m += NGW) {
        const f32x4* xr = (const f32x4*)(xsrc + (size_t)m * D_MODEL) + F.lane;
        f32x4 v[8]; float s = 0.f;
#pragma unroll
        for (int j = 0; j < 8; ++j) { v[j] = xr[64 * j]; s += (v[j][0] * v[j][0] + v[j][1] * v[j][1]) + (v[j][2] * v[j][2] + v[j][3] * v[j][3]); }
        const float rstd = rsqrtf(wave_sum(s) * (1.0f / D_MODEL) + EPS);
        u32x2* o = (u32x2*)(H + (size_t)m * D_MODEL) + F.lane;
#pragma unroll
        for (int j = 0; j < 8; ++j) { u32x2 w; w.x = cvt_pk_bf16(v[j][0] * rstd * gv[j][0], v[j][1] * rstd * gv[j][1]); w.y = cvt_pk_bf16(v[j][2] * rstd * gv[j][2], v[j][3] * rstd * gv[j][3]); o[64 * j] = w; }
    }
}
__device__ __forceinline__ void ph_pcvt(Frame& F, const float* pp, const float* ps, bf16* P16) {
    const int gw = F.vcu * NWAVES + F.wave, NGW = F.G * NWAVES;
    for (int m = gw; m < NTOK; m += NGW) {
        const float* src = m < 32768 ? pp + (size_t)m * PLE_DIM : ps + (size_t)(m - 32768) * PLE_DIM;
        const f32x4 v = ((const f32x4*)src)[F.lane];
        u32x2 w; w.x = cvt_pk_bf16(v[0], v[1]); w.y = cvt_pk_bf16(v[2], v[3]);
        ((u32x2*)(P16 + (size_t)m * PLE_DIM))[F.lane] = w;
    }
}
__device__ __forceinline__ void unpack8(u32x4 w, float (&f)[8]) { f[0] = bf_lo(w.x); f[1] = bf_hi(w.x); f[2] = bf_lo(w.y); f[3] = bf_hi(w.y); f[4] = bf_lo(w.z); f[5] = bf_hi(w.z); f[6] = bf_lo(w.w); f[7] = bf_hi(w.w); }
__device__ __forceinline__ u32x4 pack8(const float (&f)[8]) { u32x4 w; w.x = cvt_pk_bf16(f[0], f[1]); w.y = cvt_pk_bf16(f[2], f[3]); w.z = cvt_pk_bf16(f[4], f[5]); w.w = cvt_pk_bf16(f[6], f[7]); return w; }

__device__ __forceinline__ void conv_block(Frame& F, const bf16* Z, bf16* YS, const float* cw  , int blk, int lseq) {
#pragma unroll 1
    for (int i = 0; i < 8; ++i) {
        const int idx = F.tid + 512 * i, r = blk * 64 + (idx >> 6), c = (idx & 63) * 8, lpos = r % lseq;
        const bf16* zr = Z + (size_t)r * MIX_IN;
        float bg[8], z0[8], acc[8], tmp[8], w[8];
        unpack8(*(const u32x4*)(zr + ZC_BG + c), bg);
        {   float cg[8], vv[8]; unpack8(*(const u32x4*)(zr + ZC_CG + c), cg); unpack8(*(const u32x4*)(zr + ZC_VB + c), vv);
            const f32x4 wa = *(const f32x4*)(cw + 512 + c), wb = *(const f32x4*)(cw + 512 + c + 4);
            w[0] = wa[0]; w[1] = wa[1]; w[2] = wa[2]; w[3] = wa[3]; w[4] = wb[0]; w[5] = wb[1]; w[6] = wb[2]; w[7] = wb[3];
#pragma unroll
            for (int j = 0; j < 8; ++j) { z0[j] = cg[j] * vv[j]; acc[j] = w[j] * z0[j]; } }
        if (lpos > 0) { float cg[8], vv[8]; unpack8(*(const u32x4*)(zr - MIX_IN + ZC_CG + c), cg); unpack8(*(const u32x4*)(zr - MIX_IN + ZC_VB + c), vv);
            const f32x4 wa = *(const f32x4*)(cw + c), wb = *(const f32x4*)(cw + c + 4);
            w[0] = wa[0]; w[1] = wa[1]; w[2] = wa[2]; w[3] = wa[3]; w[4] = wb[0]; w[5] = wb[1]; w[6] = wb[2]; w[7] = wb[3];
#pragma unroll
            for (int j = 0; j < 8; ++j) acc[j] += w[j] * (cg[j] * vv[j]); }
        if (lpos < lseq - 1) { float cg[8], vv[8]; unpack8(*(const u32x4*)(zr + MIX_IN + ZC_CG + c), cg); unpack8(*(const u32x4*)(zr + MIX_IN + ZC_VB + c), vv);
            const f32x4 wa = *(const f32x4*)(cw + 1024 + c), wb = *(const f32x4*)(cw + 1024 + c + 4);
            w[0] = wa[0]; w[1] = wa[1]; w[2] = wa[2]; w[3] = wa[3]; w[4] = wb[0]; w[5] = wb[1]; w[6] = wb[2]; w[7] = wb[3];
#pragma unroll
            for (int j = 0; j < 8; ++j) acc[j] += w[j] * (cg[j] * vv[j]); }
#pragma unroll
        for (int j = 0; j < 8; ++j) tmp[j] = bg[j] * acc[j];
        *(u32x4*)(YS + (size_t)r * D_MODEL + 512 + c) = pack8(tmp);
    }
}
__device__ __forceinline__ void s5fin_block(Frame& F, const bf16* Z, const float* YF, const float* YB, const float* dsk  , bf16* Y1, int blk) {
#pragma unroll 1
    for (int i = 0; i < 8; ++i) {
        const int idx = F.tid + 512 * i, r = blk * 64 + (idx >> 6), c = (idx & 63) * 8;
        float u[8], o[8]; unpack8(*(const u32x4*)(Z + (size_t)r * MIX_IN + ZC_UA + c), u);
        const f32x4 f0 = *(const f32x4*)(YF + (size_t)r * 512 + c), f1 = *(const f32x4*)(YF + (size_t)r * 512 + c + 4);
        const f32x4 b0 = *(const f32x4*)(YB + (size_t)r * 512 + c), b1 = *(const f32x4*)(YB + (size_t)r * 512 + c + 4);
        const f32x4 d0 = *(const f32x4*)(dsk + c), d1 = *(const f32x4*)(dsk + c + 4);
#pragma unroll
        for (int j = 0; j < 8; ++j) { const float yy = (j < 4 ? d0[j & 3] : d1[j & 3]) * u[j] + (j < 4 ? f0[j & 3] : f1[j & 3]) + (j < 4 ? b0[j & 3] : b1[j & 3]);
            const float a = 0.7978845608028654f * (yy + 0.044715f * yy * yy * yy);
            const float th = 1.0f - 2.0f * __builtin_amdgcn_rcpf(1.0f + __expf(2.0f * a));
            o[j] = 0.5f * yy * (1.0f + th); }
        *(u32x4*)(Y1 + (size_t)r * 512 + c) = pack8(o);
    }
}

constexpr int S5_SEG = 512, S5_TPS = S5_SEG / 16;
template <bool FULL>
__device__ __forceinline__ void s5_seg_task(Frame& F, const unsigned char* tb, const bf16* Zs, float* Yout, f32x2* Ev, int nseg, int seg, int dir, int g) {
#ifndef MK_S5_LDS_STRIDE
#define MK_S5_LDS_STRIDE 12288
#endif
    LAS float* BU = (LAS float*)(F.lds + F.wave * MK_S5_LDS_STRIDE);
    LAS unsigned* XD = (LAS unsigned*)(F.lds + F.wave * MK_S5_LDS_STRIDE + 8192);
    const int lane = F.lane, l15 = lane & 15, g4 = lane >> 4;
    const f32x2 ab = ((const f32x2*)(tb + S5T_AB))[lane];
    const float ar = ab.x, ai = ab.y;
    bf16x8 bbf[8];
#pragma unroll
    for (int cb = 0; cb < 8; ++cb) bbf[cb] = as_frag(((const u32x4*)(tb + S5T_BB))[cb * 64 + lane]);
    float xr = 0.f, xi = 0.f;
    float pwr[4], pwi[4];
    pwr[0] = ar; pwi[0] = ai;
#pragma unroll
    for (int j = 1; j < 4; ++j) { pwr[j] = pwr[j - 1] * ar - pwi[j - 1] * ai; pwi[j] = pwr[j - 1] * ai + pwi[j - 1] * ar; }
    if (FULL) {
        float pr = ar, pi = ai;
#pragma unroll
        for (int i = 0; i < 9; ++i) { const float nr = pr * pr - pi * pi, ni = 2.f * pr * pi; pr = nr; pi = ni; }
        if (dir == 0) { for (int j = 0; j < seg; ++j) { const f32x2 e = Ev[j * 64 + lane]; const float nr = pr * xr - pi * xi + e.x, ni = pr * xi + pi * xr + e.y; xr = nr; xi = ni; } }
        else { for (int j = nseg - 1; j > seg; --j) { const f32x2 e = Ev[j * 64 + lane]; const float nr = pr * xr - pi * xi + e.x, ni = pr * xi + pi * xr + e.y; xr = nr; xi = ni; } }
    }
    bf16x8 cf[4];
    if (FULL) {
#pragma unroll
        for (int ks = 0; ks < 4; ++ks) cf[ks] = as_frag(((const u32x4*)(tb + S5T_C))[ks * 64 + lane]);
    }
    const int tile0 = seg * S5_TPS;
    const bf16* zcol = Zs + ZC_UA + g * 16 + 8 * (g4 & 1);
    u32x4 ring[4];
#pragma unroll
    for (int j = 0; j < 4; ++j) { const int tile = tile0 + (dir ? S5_TPS - 1 - j : j); ring[j] = (u32x4){0u, 0u, 0u, 0u}; if (g4 < 2) ring[j] = *(const u32x4*)(zcol + (size_t)(tile * 16 + l15) * MIX_IN); }
#pragma unroll 1
    for (int it = 0; it < S5_TPS; it += 4) {
#pragma unroll
        for (int j = 0; j < 4; ++j) {
            const int tile = tile0 + (dir ? S5_TPS - 1 - (it + j) : it + j);
            const bf16x8 uf = as_frag(ring[j]);
            if (it + j + 4 < S5_TPS) { const int tn = dir ? tile - 4 : tile + 4; u32x4 nx = (u32x4){0u, 0u, 0u, 0u}; if (g4 < 2) nx = *(const u32x4*)(zcol + (size_t)(tn * 16 + l15) * MIX_IN); ring[j] = nx; }
            f32x4 a8[8];
#pragma unroll
            for (int cb = 0; cb < 8; ++cb) a8[cb] = mfma16(uf, bbf[cb], (f32x4){0.f, 0.f, 0.f, 0.f});
            MFMA_DRAIN();
#pragma unroll
            for (int cb = 0; cb < 8; ++cb)
#pragma unroll
                for (int q = 0; q < 4; ++q) BU[(4 * g4 + q) * 128 + 16 * cb + l15] = a8[cb][q];
            LDS_WAIT();
#pragma unroll
            for (int k = 0; k < 4; ++k) {
                float cr[4], ci[4], yr[4], yi[4];
                f32x2 bv[4];
#pragma unroll
                for (int j = 0; j < 4; ++j) { const int t = dir ? 15 - (4 * k + j) : 4 * k + j; bv[j] = *(const LAS f32x2*)(BU + t * 128 + 2 * lane); }
                cr[0] = bv[0].x; ci[0] = bv[0].y;
#pragma unroll
                for (int j = 1; j < 4; ++j) {
                    cr[j] = __builtin_fmaf(ar, cr[j - 1], __builtin_fmaf(-ai, ci[j - 1], bv[j].x));
                    ci[j] = __builtin_fmaf(ar, ci[j - 1], __builtin_fmaf(ai, cr[j - 1], bv[j].y));
                }
#pragma unroll
                for (int j = 0; j < 4; ++j) {
                    yr[j] = __builtin_fmaf(pwr[j], xr, __builtin_fmaf(-pwi[j], xi, cr[j]));
                    yi[j] = __builtin_fmaf(pwr[j], xi, __builtin_fmaf(pwi[j], xr, ci[j]));
                    if (FULL) { const int t = dir ? 15 - (4 * k + j) : 4 * k + j; XD[t * 64 + lane] = cvt_pk_bf16(yr[j], yi[j]); }
                }
                xr = yr[3]; xi = yi[3];
            }
            if (FULL) {
                LDS_WAIT();
                f32x4 y = (f32x4){0.f, 0.f, 0.f, 0.f};
#pragma unroll
                for (int ks = 0; ks < 4; ++ks) y = mfma16(as_frag(*(const LAS u32x4*)(XD + l15 * 64 + 16 * ks + 4 * g4)), cf[ks], y);
                MFMA_DRAIN();
                float* yo = Yout + (size_t)(tile * 16 + 4 * g4) * 512 + g * 16 + l15;
#pragma unroll
                for (int q = 0; q < 4; ++q) yo[(size_t)q * 512] = y[q];
            }
            LDS_WAIT();
        }
    }
    if (!FULL) { f32x2 e; e.x = xr; e.y = xi; Ev[seg * 64 + lane] = e; }
}

constexpr int NA_KL = 0, NA_VT = 73728, NA_BIAS = 147456;
constexpr int NA_RR = 8;
__device__ __forceinline__ void na_task(Frame& F, const bf16* Zs  , bf16* YSs  , int rows, int h, int r0,
                                        const float* qg, const float* kg, const float* relb  ) {
    LAS unsigned* KL = (LAS unsigned*)(F.lds + NA_KL); LAS unsigned* VT = (LAS unsigned*)(F.lds + NA_VT); LAS unsigned short* VT16 = (LAS unsigned short*)(F.lds + NA_VT);
    LAS float* BIAS = (LAS float*)(F.lds + NA_BIAS);
    const int tid = F.tid, lane = F.lane, l15 = lane & 15, g4 = lane >> 4;
    __syncthreads();
    for (int i = tid; i < 15 * 31; i += 512) BIAS[i] = relb[i];
    const int scol = tid >> 3, schunk = tid & 7;
    float kgv[8];
    { const f32x4 a = *(const f32x4*)(kg + 8 * schunk), b = *(const f32x4*)(kg + 8 * schunk + 4); kgv[0] = a[0]; kgv[1] = a[1]; kgv[2] = a[2]; kgv[3] = a[3]; kgv[4] = b[0]; kgv[5] = b[1]; kgv[6] = b[2]; kgv[7] = b[3]; }
    int rs0 = r0 - 4; rs0 = rs0 < 0 ? 0 : (rs0 > rows - 8 ? rows - 8 : rs0);
    int nextrow = rs0;
#pragma unroll 1
    for (int r = r0; r < r0 + NA_RR; ++r) {
        int rs = r - 4; rs = rs < 0 ? 0 : (rs > rows - 8 ? rows - 8 : rs);
        __syncthreads();
#pragma unroll 1
        for (int rho = nextrow; rho <= rs + 7; ++rho) {
            const bf16* zt = Zs + (size_t)(rho * 64 + scol) * MIX_IN + h * 64 + 8 * schunk;
            const u32x4 kraw = *(const u32x4*)(zt + ZC_K), vraw = *(const u32x4*)(zt + ZC_VC);
            float kf[8]; unpack8(kraw, kf);
            float ss = 0.f;
#pragma unroll
            for (int j = 0; j < 8; ++j) ss += kf[j] * kf[j];
            ss += __shfl_xor(ss, 1); ss += __shfl_xor(ss, 2); ss += __shfl_xor(ss, 4);
            const float rk = rsqrtf(ss * (1.0f / 64.0f) + EPS);
#pragma unroll
            for (int j = 0; j < 8; ++j) kf[j] = kf[j] * rk * kgv[j];
            const int slot = rho & 7;
            *(LAS u32x4*)(KL + (slot * 64 + scol) * 36 + schunk * 4) = pack8(kf);
            const unsigned vw[4] = {vraw.x, vraw.y, vraw.z, vraw.w};
#pragma unroll
            for (int j = 0; j < 8; ++j) VT16[(slot * 64 + 8 * schunk + j) * 72 + scol] = (unsigned short)((j & 1) ? (vw[j >> 1] >> 16) : (vw[j >> 1] & 0xffffu));
        }
        nextrow = rs + 8;
        __syncthreads();
        if (F.wave < 4) {
            const int jb = F.wave, qc = 16 * jb + l15;
            int kc0 = 16 * jb - 8; kc0 = kc0 < 0 ? 0 : (kc0 > 32 ? 32 : kc0);
            int cs = qc - 8; cs = cs < 0 ? 0 : (cs > 48 ? 48 : cs);
            bf16x8 qf[2];
            {
                const bf16* zq = Zs + (size_t)(r * 64 + qc) * MIX_IN + ZC_Q + h * 64 + 8 * g4;
                float q0[8], q1[8]; unpack8(*(const u32x4*)zq, q0); unpack8(*(const u32x4*)(zq + 32), q1);
                float ss = 0.f;
#pragma unroll
                for (int j = 0; j < 8; ++j) ss += q0[j] * q0[j] + q1[j] * q1[j];
                ss += __shfl_xor(ss, 16); ss += __shfl_xor(ss, 32);
                const float rq = rsqrtf(ss * (1.0f / 64.0f) + EPS) * 0.125f;
                const f32x4 ga = *(const f32x4*)(qg + 8 * g4), gb = *(const f32x4*)(qg + 8 * g4 + 4), gc = *(const f32x4*)(qg + 32 + 8 * g4), gd = *(const f32x4*)(qg + 32 + 8 * g4 + 4);
#pragma unroll
                for (int j = 0; j < 4; ++j) { q0[j] *= rq * ga[j]; q0[4 + j] *= rq * gb[j]; q1[j] *= rq * gc[j]; q1[4 + j] *= rq * gd[j]; }
                qf[0] = as_frag(pack8(q0)); qf[1] = as_frag(pack8(q1));
            }
            f32x4 S[8][2];
#pragma unroll
            for (int a = 0; a < 8; ++a) {
                const int slot = (rs + a) & 7;
#pragma unroll
                for (int kb2 = 0; kb2 < 2; ++kb2) {
                    const LAS unsigned* kp = KL + (slot * 64 + kc0 + 16 * kb2 + l15) * 36 + 4 * g4;
                    S[a][kb2] = mfma16(as_frag(*(const LAS u32x4*)kp), qf[0], (f32x4){0.f, 0.f, 0.f, 0.f});
                    S[a][kb2] = mfma16(as_frag(*(const LAS u32x4*)(kp + 16)), qf[1], S[a][kb2]);
                }
            }
            MFMA_DRAIN();
            float mx = -3.0e38f;
#pragma unroll
            for (int a = 0; a < 8; ++a) {
                const int dr = rs + a - r + 7;
#pragma unroll
                for (int kb2 = 0; kb2 < 2; ++kb2)
#pragma unroll
                    for (int q = 0; q < 4; ++q) {
                        const int kc = kc0 + 16 * kb2 + 4 * g4 + q; const bool valid = (kc >= cs) && (kc < cs + 16);
                        int dc = kc - qc + 15; dc = dc < 0 ? 0 : (dc > 30 ? 30 : dc);
                        const float s = valid ? S[a][kb2][q] + BIAS[dr * 31 + dc] : -1.0e30f;
                        S[a][kb2][q] = s; mx = fmaxf(mx, s);
                    }
            }
            mx = fmaxf(mx, __shfl_xor(mx, 16)); mx = fmaxf(mx, __shfl_xor(mx, 32));
            float sum = 0.f;
#pragma unroll
            for (int a = 0; a < 8; ++a)
#pragma unroll
                for (int kb2 = 0; kb2 < 2; ++kb2)
#pragma unroll
                    for (int q = 0; q < 4; ++q) { const float p = __expf(S[a][kb2][q] - mx); S[a][kb2][q] = p; sum += p; }
            sum += __shfl_xor(sum, 16); sum += __shfl_xor(sum, 32);
            const float rinv = 1.0f / sum;
            f32x4 O[4];
#pragma unroll
            for (int dt = 0; dt < 4; ++dt) O[dt] = (f32x4){0.f, 0.f, 0.f, 0.f};
#pragma unroll
            for (int a = 0; a < 8; ++a) {
                const int slot = (rs + a) & 7;
                u32x4 pw; pw.x = cvt_pk_bf16(S[a][0][0], S[a][0][1]); pw.y = cvt_pk_bf16(S[a][0][2], S[a][0][3]); pw.z = cvt_pk_bf16(S[a][1][0], S[a][1][1]); pw.w = cvt_pk_bf16(S[a][1][2], S[a][1][3]);
                const bf16x8 pf = as_frag(pw);
#pragma unroll
                for (int dt = 0; dt < 4; ++dt) {
                    const LAS unsigned* vp = VT + (slot * 64 + 16 * dt + l15) * 36 + (kc0 >> 1) + 2 * g4;
                    const u32x2 v0 = *(const LAS u32x2*)vp, v1 = *(const LAS u32x2*)(vp + 8);
                    u32x4 vw; vw.x = v0.x; vw.y = v0.y; vw.z = v1.x; vw.w = v1.y;
                    O[dt] = mfma16(as_frag(vw), pf, O[dt]);
                }
            }
            MFMA_DRAIN();
            bf16* yo = YSs + (size_t)(r * 64 + qc) * D_MODEL + 1024 + h * 64 + 4 * g4;
#pragma unroll
            for (int dt = 0; dt < 4; ++dt) { u32x2 w; w.x = cvt_pk_bf16(O[dt][0] * rinv, O[dt][1] * rinv); w.y = cvt_pk_bf16(O[dt][2] * rinv, O[dt][3] * rinv); *(u32x2*)(yo + 16 * dt) = w; }
        }
    }
}


#if defined(MK_PROBE)
#define PRB_FLAGS(F) ((unsigned*)((F).ws + WS_CTL + 512 * 1024))
__device__ __forceinline__ bool prb_big_bf(u32x4 w, unsigned ethr) { const unsigned v[4] = {w.x, w.y, w.z, w.w}; bool b = false;
#pragma unroll
    for (int i = 0; i < 4; ++i) b = b || (((v[i] >> 7) & 0xffu) >= ethr) || (((v[i] >> 23) & 0xffu) >= ethr); return b; }
__device__ __forceinline__ bool prb_big_f(f32x4 a, unsigned ethr) { bool b = false;
#pragma unroll
    for (int i = 0; i < 4; ++i) b = b || (((__float_as_uint(a[i]) >> 23) & 0xffu) >= ethr); return b; }
#define PRB(cond, bit) do { if (cond) atomicOr(PRB_FLAGS(F), 1u << (bit)); } while (0)
#else
#define PRB(cond, bit) do { } while (0)
#endif
constexpr int FN_XT = 0, FN_YR = 34816, FN_YI = 34816 + 34816;
template <int N1>
__device__ __forceinline__ void fnet1_tile(Frame& F, const bf16* Zs, bf16* ZFsg  , int g, int l2, const bf16* CT1, const bf16* ST1  , const bf16* C128, const bf16* S128) {
    constexpr int XS = N1 + 8, JT = N1 / 16, KS1 = N1 / 32;
    LAS unsigned short* XT = (LAS unsigned short*)(F.lds + FN_XT); LAS unsigned short* YR = (LAS unsigned short*)(F.lds + FN_YR); LAS unsigned short* YI = (LAS unsigned short*)(F.lds + FN_YI);
    const int tid = F.tid, lane = F.lane, l15 = lane & 15, g4 = lane >> 4, w = F.wave;
    __syncthreads();
    for (int idx = tid; idx < N1 * 16; idx += 512) {
        const int l1 = idx >> 4, ch = idx & 15;
        const u32x4 raw = *(const u32x4*)(Zs + (size_t)(128 * l1 + l2) * MIX_IN + ZC_UD + g * 128 + 8 * ch);
        const unsigned rw[4] = {raw.x, raw.y, raw.z, raw.w};
#pragma unroll
        for (int j = 0; j < 8; ++j) XT[(8 * ch + j) * XS + l1] = (unsigned short)((j & 1) ? (rw[j >> 1] >> 16) : (rw[j >> 1] & 0xffffu));
    }
    __syncthreads();
    {
        bf16x8 af[KS1];
#pragma unroll
        for (int ks = 0; ks < KS1; ++ks) { af[ks] = as_frag(*(const LAS u32x4*)(XT + (16 * w + l15) * XS + 32 * ks + 8 * g4)); }
#pragma unroll 1
        for (int tj = 0; tj < JT; ++tj) {
            const int k1 = 16 * tj + l15;
            f32x4 ar = (f32x4){0.f, 0.f, 0.f, 0.f}, as = (f32x4){0.f, 0.f, 0.f, 0.f};
#pragma unroll
            for (int ks = 0; ks < KS1; ++ks) {
                ar = mfma16(af[ks], as_frag(*(const u32x4*)(CT1 + k1 * N1 + 32 * ks + 8 * g4)), ar);
                as = mfma16(af[ks], as_frag(*(const u32x4*)(ST1 + k1 * N1 + 32 * ks + 8 * g4)), as);
            }
            MFMA_DRAIN();
            float tsn, tcs; sincospif((float)(k1 * l2) * (2.0f / (float)(N1 * 128)), &tsn, &tcs);
            float zr[4], zi[4];
#pragma unroll
            for (int q = 0; q < 4; ++q) { const float yr = ar[q], yi = -as[q]; zr[q] = yr * tcs + yi * tsn; zi[q] = yi * tcs - yr * tsn; }
            u32x2 wr2, wi2; wr2.x = cvt_pk_bf16(zr[0], zr[1]); wr2.y = cvt_pk_bf16(zr[2], zr[3]); wi2.x = cvt_pk_bf16(zi[0], zi[1]); wi2.y = cvt_pk_bf16(zi[2], zi[3]);
            *(LAS u32x2*)(YR + k1 * 136 + 16 * w + 4 * g4) = wr2; *(LAS u32x2*)(YI + k1 * 136 + 16 * w + 4 * g4) = wi2;
        }
    }
    __syncthreads();
    {
        bf16x8 cfr[4], sfr[4];
#pragma unroll
        for (int ks = 0; ks < 4; ++ks) { cfr[ks] = as_frag(*(const u32x4*)(C128 + (16 * w + l15) * 128 + 32 * ks + 8 * g4)); sfr[ks] = as_frag(*(const u32x4*)(S128 + (16 * w + l15) * 128 + 32 * ks + 8 * g4)); }
#pragma unroll 1
        for (int tj = 0; tj < JT; ++tj) {
            const int k1 = 16 * tj + l15;
            f32x4 zr = (f32x4){0.f, 0.f, 0.f, 0.f}, zi = (f32x4){0.f, 0.f, 0.f, 0.f};
#pragma unroll
            for (int ks = 0; ks < 4; ++ks) {
                const u32x4 yr = *(const LAS u32x4*)(YR + k1 * 136 + 32 * ks + 8 * g4), yi = *(const LAS u32x4*)(YI + k1 * 136 + 32 * ks + 8 * g4);
                u32x4 ny; ny.x = yr.x ^ 0x80008000u; ny.y = yr.y ^ 0x80008000u; ny.z = yr.z ^ 0x80008000u; ny.w = yr.w ^ 0x80008000u;
                zr = mfma16(cfr[ks], as_frag(yr), zr); zr = mfma16(sfr[ks], as_frag(yi), zr);
                zi = mfma16(cfr[ks], as_frag(yi), zi); zi = mfma16(sfr[ks], as_frag(ny), zi);
            }
            MFMA_DRAIN();
            bf16* zo = ZFsg + ((size_t)k1 * 128 + l2) * 256 + 16 * w + 4 * g4;
            u32x2 a, b; a.x = cvt_pk_bf16(zr[0], zr[1]); a.y = cvt_pk_bf16(zr[2], zr[3]); b.x = cvt_pk_bf16(zi[0], zi[1]); b.y = cvt_pk_bf16(zi[2], zi[3]);
            *(u32x2*)zo = a; *(u32x2*)(zo + 128) = b;
        }
    }
}
__device__ __forceinline__ void fnet2_tile(Frame& F, const bf16* ZFsg, bf16* YSs  , int g, int k1, int N1, const bf16* C128, const bf16* S128) {
    LAS unsigned short* ZT = (LAS unsigned short*)F.lds;
    const int tid = F.tid, lane = F.lane, l15 = lane & 15, g4 = lane >> 4, w = F.wave;
    __syncthreads();
    const bf16* src = ZFsg + (size_t)k1 * 128 * 256;
#pragma unroll 1
    for (int idx = tid; idx < 4096; idx += 512) {
        const int l2 = idx >> 5, ch = idx & 31;
        const u32x4 raw = *(const u32x4*)(src + (size_t)l2 * 256 + 8 * ch);
        const unsigned rw[4] = {raw.x, raw.y, raw.z, raw.w};
#pragma unroll
        for (int j = 0; j < 8; ++j) ZT[(8 * ch + j) * 136 + l2] = (unsigned short)((j & 1) ? (rw[j >> 1] >> 16) : (rw[j >> 1] & 0xffffu));
    }
    __syncthreads();
    bf16x8 zrf[4], zif[4];
#pragma unroll
    for (int ks = 0; ks < 4; ++ks) { zrf[ks] = as_frag(*(const LAS u32x4*)(ZT + (16 * w + l15) * 136 + 32 * ks + 8 * g4)); zif[ks] = as_frag(*(const LAS u32x4*)(ZT + (128 + 16 * w + l15) * 136 + 32 * ks + 8 * g4)); }
#pragma unroll 1
    for (int tj = 0; tj < 8; ++tj) {
        const int k2 = 16 * tj + l15;
        f32x4 y = (f32x4){0.f, 0.f, 0.f, 0.f};
#pragma unroll
        for (int ks = 0; ks < 4; ++ks) {
            y = mfma16(zrf[ks], as_frag(*(const u32x4*)(C128 + k2 * 128 + 32 * ks + 8 * g4)), y);
            y = mfma16(zif[ks], as_frag(*(const u32x4*)(S128 + k2 * 128 + 32 * ks + 8 * g4)), y);
        }
        MFMA_DRAIN();
        u32x2 o; o.x = cvt_pk_bf16(y[0], y[1]); o.y = cvt_pk_bf16(y[2], y[3]);
        *(u32x2*)(YSs + (size_t)(k1 + N1 * k2) * D_MODEL + 1536 + g * 128 + 16 * w + 4 * g4) = o;
    }
}

struct ChunkGeo { int nseq, lseq, rows, n1; };
__device__ __forceinline__ ChunkGeo chunk_geo(int ch) { ChunkGeo g; if (ch < 2) { g.nseq = 1; g.lseq = 16384; g.rows = 256; g.n1 = 128; } else { g.nseq = 4; g.lseq = 4096; g.rows = 64; g.n1 = 32; } return g; }

__device__ __forceinline__ void ph_s5a(Frame& F, const Args& A, int layer, int ch) {
    const ChunkGeo cg = chunk_geo(ch);
    const bf16* Z = (const bf16*)(F.ws + WS_Z); f32x2* EV = (f32x2*)(F.ws + WS_S5E);
    const int nseg = cg.lseq / S5_SEG, ntask = cg.nseq * nseg * 64;
#pragma unroll 1
    for (int tt = F.vcu * 8 + F.wave; tt < ntask; tt += F.G * 8) {
        const int dg = tt & 63, sg = tt >> 6, seg = sg % nseg, seq = sg / nseg, dir = dg >> 5, g = dg & 31;
        const unsigned char* tb = F.ws + TAB_S5 + (size_t)(((layer * 2 + dir) * 32) + g) * S5T_BYTES;
        s5_seg_task<false>(F, tb, Z + (size_t)seq * cg.lseq * MIX_IN, nullptr, EV + (size_t)(seq * 64 + dg) * nseg * 64, nseg, seg, dir, g);
    }
    int t0 = F.vcu; asm volatile("" : "+s"(t0));
    bf16* YS = (bf16*)(F.ws + WS_YS); bf16* ZF = (bf16*)(F.ws + WS_ZF);
    const int n_f1 = 512, n_cv = CH_TOK / 64;
#pragma unroll 1
    for (; t0 < n_f1 + n_cv; t0 += F.G) {
        if (t0 < n_f1) {
            const int u = t0;
            const bf16* C128 = (const bf16*)(F.ws + TAB_C128); const bf16* S128 = (const bf16*)(F.ws + TAB_S128);
            if (ch < 2) { const int g = u >> 7, l2 = u & 127;
                fnet1_tile<128>(F, Z, ZF + (size_t)g * 16384 * 256, g, l2, C128, S128, C128, S128);
            } else {
                const bf16* C32 = (const bf16*)(F.ws + TAB_C32); const bf16* S32 = (const bf16*)(F.ws + TAB_S32);
#pragma unroll 1
                for (int s = 0; s < 4; ++s) { const int uu = u * 4 + s, l2 = uu & 127, g = (uu >> 7) & 3, seq = uu >> 9;
                    fnet1_tile<32>(F, Z + (size_t)seq * 4096 * MIX_IN, ZF + (size_t)(seq * 4 + g) * 4096 * 256, g, l2, C32, S32, C128, S128); }
            }
        } else {
            conv_block(F, Z, YS, A.in[15] + (size_t)layer * 3 * 512, t0 - n_f1, cg.lseq);
        }
    }
}
__device__ __forceinline__ void ph_mix1(Frame& F, const Args& A, int layer, int ch) {
    const ChunkGeo cg = chunk_geo(ch);
    const bf16* Z = (const bf16*)(F.ws + WS_Z); bf16* YS = (bf16*)(F.ws + WS_YS); const bf16* ZF = (const bf16*)(F.ws + WS_ZF);
    float* YF = (float*)(F.ws + WS_YF); float* YB = (float*)(F.ws + WS_YB); f32x2* EV = (f32x2*)(F.ws + WS_S5E);
    const int nseg = cg.lseq / S5_SEG;
    const int n_s5 = cg.nseq * nseg * 8;
    const int n_na = cg.nseq * 8 * (cg.rows / NA_RR);
    const int n_f2 = 512;
    int t0 = F.vcu;
#pragma unroll 1
    for (; t0 < n_s5; t0 += F.G) {
        const int tt = t0 * 8 + F.wave, dg = tt & 63, sg = tt >> 6, seg = sg % nseg, seq = sg / nseg, dir = dg >> 5, g = dg & 31;
        const unsigned char* tb = F.ws + TAB_S5 + (size_t)(((layer * 2 + dir) * 32) + g) * S5T_BYTES;
        const size_t row0 = (size_t)seq * cg.lseq;
        s5_seg_task<true>(F, tb, Z + row0 * MIX_IN, (dir ? YB : YF) + row0 * 512, EV + (size_t)(seq * 64 + dg) * nseg * 64, nseg, seg, dir, g);
    }
    asm volatile("" : "+s"(t0));
#pragma unroll 1
    for (; t0 < n_s5 + n_na + n_f2; t0 += F.G) {
        const int t = t0 - n_s5;
        if (t < n_na) {
            const int runs = cg.rows / NA_RR, run = t % runs, h = (t / runs) & 7, seq = t / (runs * 8);
            const size_t row0 = (size_t)seq * cg.lseq;
            na_task(F, Z + row0 * MIX_IN, YS + row0 * D_MODEL, cg.rows, h, run * NA_RR, A.in[16] + layer * 64, A.in[17] + layer * 64, A.in[18] + ((size_t)layer * 8 + h) * 15 * 31);
        } else {
            const int u = t - n_na;
            const bf16* C128 = (const bf16*)(F.ws + TAB_C128); const bf16* S128 = (const bf16*)(F.ws + TAB_S128);
            int seq, g, k1; if (ch < 2) { seq = 0; g = u >> 7; k1 = u & 127; } else { k1 = u & 31; g = (u >> 5) & 3; seq = u >> 7; }
            fnet2_tile(F, ZF + (size_t)(seq * 4 + g) * cg.lseq * 256, YS + (size_t)seq * cg.lseq * D_MODEL, g, k1, cg.n1, C128, S128);
        }
    }
}
__device__ __forceinline__ void ph_mix2(Frame& F, const Args& A, int layer, int ch) {
    const bf16* Z = (const bf16*)(F.ws + WS_Z);
    const float* YF = (const float*)(F.ws + WS_YF); const float* YB = (const float*)(F.ws + WS_YB); bf16* Y1 = (bf16*)(F.ws + WS_Y1);
    (void)ch;
#pragma unroll 1
    for (int t = F.vcu; t < CH_TOK / 64; t += F.G) s5fin_block(F, Z, YF, YB, A.in[13] + (size_t)layer * 512, Y1, t);
}

constexpr int PH_A = 8, PH_PER_LAYER = 3 * PH_A + 1 + 3 + 3, N_PHASES = 1 + DEPTH * PH_PER_LAYER;
__global__ void __launch_bounds__(NWAVES * 64, 2) fwd_kernel(const Args A) {
    extern __shared__ __attribute__((aligned(16))) unsigned char lds_raw[];
    Frame F;
    F.lds = (LAS unsigned char*)lds_raw;
    F.tid = threadIdx.x; F.lane = F.tid & 63; F.wave = __builtin_amdgcn_readfirstlane(F.tid >> 6);
    F.G = gridDim.x; { const int bx = blockIdx.x; F.vcu = (F.G % 8 == 0) ? (bx % 8) * (F.G / 8) + bx / 8 : bx; }
    F.ws = A.ws;
    volatile LAS unsigned* LCTL = (volatile LAS unsigned*)(F.lds + LDSCTL_OFF);
    if (F.tid < 64) LCTL[F.tid] = 0u;
    __syncthreads();
    const int lo = A.ph_lo, hi = A.ph_hi;
    const bool multi = (hi - lo) > 1;
    XcdBarrier bar; bar.bar = (unsigned*)(F.ws + WS_CTL) + CW_BAR; bar.x = 0; bar.st = LCTL;
    if (multi) bar = xcd_barrier_post((unsigned*)(F.ws + WS_CTL) + CW_BAR, LCTL);
#define IN(k) (lo <= (k) && (k) < hi)
#define SEAM(k) do { if ((k) + 1 < hi) xcd_barrier(bar); } while (0)

    if (IN(0)) { Frame Fp = fresh(F); ph_prologue(Fp, A); SEAM(0); }

#pragma unroll 1
    for (int layer = 0; layer < DEPTH; ++layer) {
        const int pl = 1 + layer * PH_PER_LAYER;
        if (pl + PH_PER_LAYER <= lo || pl >= hi) continue;
        const unsigned char* wl = F.ws + WS_W + (size_t)layer * WL_BYTES;
        bf16* H = (bf16*)(F.ws + WS_H); bf16* Z = (bf16*)(F.ws + WS_Z); bf16* YS = (bf16*)(F.ws + WS_YS); bf16* MGA = (bf16*)(F.ws + WS_MG); bf16* GT = (bf16*)(F.ws + WS_GT);
        bf16* Y1 = (bf16*)(F.ws + WS_Y1); bf16* P16 = (bf16*)(F.ws + WS_P16); bf16* PP = (bf16*)(F.ws + WS_PP); float* MACC = (float*)(F.ws + WS_Z); bf16* HALL = (bf16*)(F.ws + WS_HALL);
#pragma unroll 1
        for (int ch = 0; ch < N_CHUNK; ++ch) {
            const int pb = pl + ch * PH_A;
            const float* x_cur = layer == 0 ? ((ch < 2) ? A.in[0] + (size_t)ch * CH_TOK * D_MODEL : A.in[1]) : A.out + (size_t)ch * CH_TOK * D_MODEL;
            bf16* MG = MGA + (size_t)ch * CH_TOK * D_MODEL;
            if (IN(pb + 0)) { Frame Fp = fresh(F); ph_norm(Fp, x_cur, A.in[4] + (size_t)layer * D_MODEL, H, CH_TOK); SEAM(pb + 0); }
            if (IN(pb + 1)) {
                pg8::Gemm g{H, (const bf16*)(wl + WL_MIX), D_MODEL, D_MODEL, D_MODEL, 0, 0, 0}; pg8::StaticOrder S; S.init(CH_TOK, MIX_IN, F.G, (int)blockIdx.x);
                pg8::EpiStoreBf16 E{Z, MIX_IN};
                pg8::gemm_phase<pg8::EpiStoreBf16, pg8::StaticOrder, true, true>(F.lds, g, S, E);
                SEAM(pb + 1); }
            if (IN(pb + 2)) { Frame Fp = fresh(F); ph_s5a(Fp, A, layer, ch); SEAM(pb + 2); }
            if (IN(pb + 3)) { Frame Fp = fresh(F); ph_mix1(Fp, A, layer, ch); SEAM(pb + 3); }
            if (IN(pb + 4)) { Frame Fp = fresh(F); ph_mix2(Fp, A, layer, ch); SEAM(pb + 4); }
            if (IN(pb + 5)) {
                pg8::Gemm g{Y1, (const bf16*)(wl + WL_GLU), 512, 512, 512, 0, 0, 0}; pg8::StaticOrder S; S.init(CH_TOK, 512, F.G, (int)blockIdx.x);
                pg8::EpiGlu E{Y1, 512, YS, D_MODEL};
                pg8::gemm_phase<pg8::EpiGlu, pg8::StaticOrder, true, true>(F.lds, g, S, E);
                SEAM(pb + 5); }
            if (IN(pb + 6)) {
                pg8::Gemm g{YS, (const bf16*)(wl + WL_BR), D_MODEL, 512, 512, 3, 512, 0}; pg8::StaticOrder S; S.init(CH_TOK, 8192, F.G, (int)blockIdx.x);
                pg8::EpiStoreBf16 E{GT, 8192};
                pg8::gemm_phase<pg8::EpiStoreBf16, pg8::StaticOrder, true, true>(F.lds, g, S, E);
                SEAM(pb + 6); }
            if (IN(pb + 7)) {
                pg8::Gemm g{H, (const bf16*)(wl + WL_G), D_MODEL, D_MODEL, D_MODEL, 0, 0, 1}; pg8::MergeOrder S; S.init(CH_TOK, F.G, (int)blockIdx.x);
                pg8::EpiMerge E{GT, MACC, MG};
                pg8::gemm_phase<pg8::EpiMerge, pg8::MergeOrder, true, true>(F.lds, g, S, E);
                SEAM(pb + 7); }
        }
        {
            const int pb = pl + 3 * PH_A;
            if (IN(pb)) {
                pg8::Gemm g{MGA, (const bf16*)(wl + WL_O), D_MODEL, D_MODEL, D_MODEL, 0, 0, 0}; pg8::StaticOrder S; S.init(NTOK, D_MODEL, F.G, (int)blockIdx.x);
                pg8::EpiResF32 E{layer == 0 ? A.in[0] : A.out, layer == 0 ? A.in[1] : A.out + (size_t)32768 * D_MODEL, 32768, A.out, D_MODEL};
                pg8::gemm_phase<pg8::EpiResF32, pg8::StaticOrder, true, true>(F.lds, g, S, E);
                SEAM(pb); }
        }
        {
            const int pb = pl + 3 * PH_A + 1;
            bf16* H2 = (bf16*)(F.ws + WS_H2ALL); bf16* MIDA = (bf16*)(F.ws + WS_MIDALL);
            if (IN(pb + 0)) { Frame Fp = fresh(F); ph_norm(Fp, A.out, A.in[21] + (size_t)layer * D_MODEL, H2, NTOK); SEAM(pb + 0); }
            if (IN(pb + 1)) {
                pg8::Gemm g{H2, (const bf16*)(wl + WL_FF), D_MODEL, D_MODEL, D_MODEL, 0, 0, 0}; pg8::StaticOrder S; S.init(NTOK, 2 * D_FF, F.G, (int)blockIdx.x);
                pg8::EpiSwiglu E{MIDA, D_FF};
                pg8::gemm_phase<pg8::EpiSwiglu, pg8::StaticOrder, true, true>(F.lds, g, S, E);
                SEAM(pb + 1); }
            if (IN(pb + 2)) {
                pg8::Gemm g{MIDA, (const bf16*)(wl + WL_FF2), D_FF, D_FF, D_FF, 0, 0, 0}; pg8::StaticOrder S; S.init(NTOK, D_MODEL, F.G, (int)blockIdx.x);
                pg8::EpiResF32 E{A.out, A.out, 1 << 30, A.out, D_MODEL};
                pg8::gemm_phase<pg8::EpiResF32, pg8::StaticOrder, true, true>(F.lds, g, S, E);
                SEAM(pb + 2); }
        }
        {
            const int pb = pl + 3 * PH_A + 1 + 3;
            if (IN(pb + 0)) { Frame Fp = fresh(F); ph_norm(Fp, A.out, A.in[24] + (size_t)layer * D_MODEL, HALL, NTOK);
                ph_pcvt(Fp, A.in[2] + (size_t)layer * 32768 * PLE_DIM, A.in[3] + (size_t)layer * CH_TOK * PLE_DIM, P16); SEAM(pb + 0); }
            if (IN(pb + 1)) {
                int kpp = PLE_DIM; asm volatile("" : "+s"(kpp));
                pg8::Gemm g{P16, (const bf16*)(wl + WL_PP), kpp, kpp, kpp, 0, 0, 0}; pg8::StaticOrder S; S.init(NTOK, D_MODEL, F.G, (int)blockIdx.x);
                pg8::EpiStoreBf16 E{PP, D_MODEL};
                pg8::gemm_phase<pg8::EpiStoreBf16, pg8::StaticOrder, true, true>(F.lds, g, S, E);
                SEAM(pb + 1); }
            if (IN(pb + 2)) {
                pg8::Gemm g{HALL, (const bf16*)(wl + WL_PG), D_MODEL, D_MODEL, D_MODEL, 0, 0, 0}; pg8::StaticOrder S; S.init(NTOK, D_MODEL, F.G, (int)blockIdx.x);
                pg8::EpiPle E{A.out, A.out, D_MODEL, PP, D_MODEL};
                pg8::gemm_phase<pg8::EpiPle, pg8::StaticOrder, true, true>(F.lds, g, S, E);
                SEAM(pb + 2); }
        }
    }
#undef IN
#undef SEAM
}

#ifndef MK_PER_PHASE
#define MK_PER_PHASE 0
#endif
extern "C" void kernel_launch(void* const* d_in, const int* in_sizes, int n_in, void* d_out, int out_size, void* d_ws, size_t ws_size, hipStream_t stream) {
    static int grid = 0;
    if (grid == 0) {
        if (n_in != 27 || out_size != NTOK * D_MODEL || ws_size < WS_END) { fprintf(stderr, "kernel_launch: unexpected shapes (n_in %d, out %d, ws %zu); nothing launched\n", n_in, out_size, ws_size); grid = -1; return; }
        int dev = 0, cus = 0, per_cu = 0;
        if (hipGetDevice(&dev) != hipSuccess || hipDeviceGetAttribute(&cus, hipDeviceAttributeMultiprocessorCount, dev) != hipSuccess) { grid = -1; return; }
        if (hipFuncSetAttribute((const void*)fwd_kernel, hipFuncAttributeMaxDynamicSharedMemorySize, LDS_BYTES) != hipSuccess) { fprintf(stderr, "kernel_launch: hipFuncSetAttribute failed\n"); grid = -1; return; }
        if (hipOccupancyMaxActiveBlocksPerMultiprocessor(&per_cu, (const void*)fwd_kernel, NWAVES * 64, LDS_BYTES) != hipSuccess || per_cu < 1)
            fprintf(stderr, "kernel_launch: occupancy query reports %d workgroups per CU\n", per_cu);
        (void)hipGetLastError();
        grid = cus;
    }
    if (grid < 0) return;
    (void)in_sizes;
    if (hipMemsetAsync((char*)d_ws + WS_CTL, 0, CTL_ZERO_BYTES, stream) != hipSuccess) return;
    Args a{};
    for (int i = 0; i < 27; ++i) a.in[i] = (const float*)d_in[i];
    a.out = (float*)d_out; a.ws = (unsigned char*)d_ws;
#if MK_PER_PHASE
    for (int p = 0; p < N_PHASES; ++p) { a.ph_lo = p; a.ph_hi = p + 1; hipLaunchKernelGGL(fwd_kernel, dim3(grid), dim3(NWAVES * 64), LDS_BYTES, stream, a); }
#else
    a.ph_lo = 0; a.ph_hi = N_PHASES;
    hipLaunchKernelGGL(fwd_kernel, dim3(grid), dim3(NWAVES * 64), LDS_BYTES, stream, a);
#endif
}
```

```cpp
#include <hip/hip_runtime.h>
#include <cstdio>
#include <cstdint>

namespace pg8 {
#define PG8_LAS __attribute__((address_space(3)))
typedef unsigned short bf16_t;
typedef short bf16x8 __attribute__((ext_vector_type(8)));
typedef float f32x4 __attribute__((ext_vector_type(4)));
typedef float f32x2 __attribute__((ext_vector_type(2)));
typedef unsigned u32x4 __attribute__((ext_vector_type(4)));
typedef unsigned u32x2 __attribute__((ext_vector_type(2)));
constexpr int BM = 256, BK = 64, HALF = 128, HTB = HALF * BK * 2  , STAGE_BYTES = 8 * HTB, NXCD = 8, WGM = 8;

__host__ __device__ __forceinline__ int lds_byte(int r, int c) { const int st = (r >> 4) * 2 + (c >> 5), rr = r & 15, cc = c & 31, ob = rr * 64 + cc * 2; return st * 1024 + (ob ^ (((ob >> 9) & 1) << 5)); }
__host__ __device__ __forceinline__ void stage_rc(int b, int& R, int& C) { const int st = b / 1024, sb = b % 1024, swz = sb ^ (((sb >> 9) & 1) << 5); R = (st >> 1) * 16 + swz / 64; C = (st & 1) * 32 + (swz % 64) / 2; }
__host__ __device__ __forceinline__ int perm32(int rho) { const int n = rho >> 4, i = rho & 15; return 8 * (i >> 2) + 4 * n + (i & 3); }

struct Unit { int pm, pn; };
struct Gemm { const bf16_t* A; const bf16_t* Bt; int lda, ldb, K, agrp_shift, agrp_stride, bmode; };

__device__ __forceinline__ void tile_of(int wgid, int nwg, int nM, int nN, int& pm, int& pn) {
    { const int q = nwg / NXCD, r = nwg % NXCD, xcd = wgid % NXCD, off = wgid / NXCD; wgid = (xcd < r ? xcd * (q + 1) : r * (q + 1) + (xcd - r) * q) + off; }
    const int nig = WGM * nN, gid = wgid / nig, fm = gid * WGM, gsz = (nM - fm) < WGM ? (nM - fm) : WGM;
    pm = fm + ((wgid % nig) % gsz); pn = (wgid % nig) / gsz;
}
struct StaticOrder {
    int nM, nN, nwg, G, c;
    __device__ __forceinline__ void init(int M, int N, int G_, int c_) { nM = M / BM; nN = N / BM; nwg = nM * nN; G = G_; c = c_; }
    __device__ __forceinline__ bool next(int i, Unit& u) const {
        const long L = (long)i * G + c; if (L >= nwg) return false;
        tile_of((int)L, nwg, nM, nN, u.pm, u.pn); return true;
    }
};
struct MergeOrder {
    int nM, ntile, G, c;
    __device__ __forceinline__ void init(int M, int G_, int c_) { nM = M / BM; ntile = nM * 16; G = G_; c = c_; }
    __device__ __forceinline__ bool next(int i, Unit& u) const {
        const long L = (long)(i >> 1) * G + c; if (L >= ntile) return false;
        int pm, ct; tile_of((int)L, ntile, nM, 16, pm, ct); u.pm = pm; u.pn = (i & 1) * 16 + ct; return true;
    }
};

typedef __bf16 bf16x2_t __attribute__((ext_vector_type(2)));
__device__ __forceinline__ unsigned cvt_pk_bf16(float lo, float hi) { const f32x2 v = {lo, hi}; return __builtin_bit_cast(unsigned, __builtin_convertvector(v, bf16x2_t)); }
__device__ __forceinline__ float bf_lo(unsigned w) { return __uint_as_float(w << 16); }
__device__ __forceinline__ float bf_hi(unsigned w) { return __uint_as_float(w & 0xffff0000u); }
__device__ __forceinline__ float sigmoidf_fast(float x) { return __builtin_amdgcn_rcpf(1.0f + __expf(-x)); }

struct EpiStoreBf16 {
    static constexpr bool PERM = true;
    bf16_t* O; int ldc;
    __device__ __forceinline__ void operator()(const f32x4 (&acc)[2][2][4][2], const Unit& u, int wr, int wc, int fr, int fq) const {
        const int row0 = u.pm * BM + wr * 64 + fr, col0 = u.pn * BM + wc * 32 + 8 * fq;
#pragma unroll
        for (int ai = 0; ai < 2; ++ai)
#pragma unroll
            for (int m = 0; m < 4; ++m) { bf16_t* rowp = O + (size_t)(row0 + ai * HALF + m * 16) * ldc + col0;
#pragma unroll
                for (int bj = 0; bj < 2; ++bj) { const f32x4 v0 = acc[ai][bj][m][0], v1 = acc[ai][bj][m][1];
                    u32x4 w; w.x = cvt_pk_bf16(v0[0], v0[1]); w.y = cvt_pk_bf16(v0[2], v0[3]); w.z = cvt_pk_bf16(v1[0], v1[1]); w.w = cvt_pk_bf16(v1[2], v1[3]);
                    *(u32x4*)(rowp + bj * HALF) = w; } }
    }
};
struct EpiGlu {
    static constexpr bool PERM = true;
    const bf16_t* Y1; int ld1; bf16_t* O; int ldc;
    __device__ __forceinline__ void operator()(const f32x4 (&acc)[2][2][4][2], const Unit& u, int wr, int wc, int fr, int fq) const {
        const int row0 = u.pm * BM + wr * 64 + fr, col0 = u.pn * BM + wc * 32 + 8 * fq;
#pragma unroll
        for (int ai = 0; ai < 2; ++ai)
#pragma unroll
            for (int m = 0; m < 4; ++m) { const size_t r = (size_t)(row0 + ai * HALF + m * 16);
#pragma unroll
                for (int bj = 0; bj < 2; ++bj) { const f32x4 v0 = acc[ai][bj][m][0], v1 = acc[ai][bj][m][1];
                    const u32x4 y = *(const u32x4*)(Y1 + r * ld1 + col0 + bj * HALF);
                    u32x4 w;
                    w.x = cvt_pk_bf16(bf_lo(y.x) * sigmoidf_fast(v0[0]), bf_hi(y.x) * sigmoidf_fast(v0[1]));
                    w.y = cvt_pk_bf16(bf_lo(y.y) * sigmoidf_fast(v0[2]), bf_hi(y.y) * sigmoidf_fast(v0[3]));
                    w.z = cvt_pk_bf16(bf_lo(y.z) * sigmoidf_fast(v1[0]), bf_hi(y.z) * sigmoidf_fast(v1[1]));
                    w.w = cvt_pk_bf16(bf_lo(y.w) * sigmoidf_fast(v1[2]), bf_hi(y.w) * sigmoidf_fast(v1[3]));
                    *(u32x4*)(O + r * ldc + col0 + bj * HALF) = w; } }
    }
};
struct EpiMerge {
    static constexpr bool PERM = true;
    const bf16_t* P; float* MACC; bf16_t* MG;
    __device__ __forceinline__ void operator()(const f32x4 (&acc)[2][2][4][2], const Unit& u, int wr, int wc, int fr, int fq) const {
        const int kp = u.pn >> 4, ct = u.pn & 15;
        const int row0 = u.pm * BM + wr * 64 + fr, c = ct * HALF + wc * 32 + 8 * fq;
#pragma unroll
        for (int ai = 0; ai < 2; ++ai)
#pragma unroll
            for (int m = 0; m < 4; ++m) { const size_t r = (size_t)(row0 + ai * HALF + m * 16);
                const u32x4 p0 = *(const u32x4*)(P + r * 8192 + (2 * kp) * 2048 + c), p1 = *(const u32x4*)(P + r * 8192 + (2 * kp + 1) * 2048 + c);
                const f32x4 a0 = acc[ai][0][m][0], a1 = acc[ai][0][m][1], b0 = acc[ai][1][m][0], b1 = acc[ai][1][m][1];
                f32x4 t0, t1;
                t0[0] = bf_lo(p0.x) * sigmoidf_fast(a0[0]) + bf_lo(p1.x) * sigmoidf_fast(b0[0]); t0[1] = bf_hi(p0.x) * sigmoidf_fast(a0[1]) + bf_hi(p1.x) * sigmoidf_fast(b0[1]);
                t0[2] = bf_lo(p0.y) * sigmoidf_fast(a0[2]) + bf_lo(p1.y) * sigmoidf_fast(b0[2]); t0[3] = bf_hi(p0.y) * sigmoidf_fast(a0[3]) + bf_hi(p1.y) * sigmoidf_fast(b0[3]);
                t1[0] = bf_lo(p0.z) * sigmoidf_fast(a1[0]) + bf_lo(p1.z) * sigmoidf_fast(b1[0]); t1[1] = bf_hi(p0.z) * sigmoidf_fast(a1[1]) + bf_hi(p1.z) * sigmoidf_fast(b1[1]);
                t1[2] = bf_lo(p0.w) * sigmoidf_fast(a1[2]) + bf_lo(p1.w) * sigmoidf_fast(b1[2]); t1[3] = bf_hi(p0.w) * sigmoidf_fast(a1[3]) + bf_hi(p1.w) * sigmoidf_fast(b1[3]);
                float* mp = MACC + r * 2048 + c;
                if (kp == 0) { *(f32x4*)mp = t0; *(f32x4*)(mp + 4) = t1; }
                else { t0 += *(const f32x4*)mp; t1 += *(const f32x4*)(mp + 4);
                    u32x4 w; w.x = cvt_pk_bf16(t0[0], t0[1]); w.y = cvt_pk_bf16(t0[2], t0[3]); w.z = cvt_pk_bf16(t1[0], t1[1]); w.w = cvt_pk_bf16(t1[2], t1[3]);
                    *(u32x4*)(MG + r * 2048 + c) = w; } }
    }
};
struct EpiResF32 {
    static constexpr bool PERM = false;
    const float* base; const float* base2; int split_row; float* out; int ldc;
    __device__ __forceinline__ void operator()(const f32x4 (&acc)[2][2][4][2], const Unit& u, int wr, int wc, int fr, int fq) const {
        const int row0 = u.pm * BM + wr * 64 + fr, col0 = u.pn * BM + wc * 32 + 4 * fq;
        const float* bp = (u.pm * BM >= split_row) ? base2 - (size_t)split_row * ldc : base;
#pragma unroll
        for (int ai = 0; ai < 2; ++ai)
#pragma unroll
            for (int m = 0; m < 4; ++m) { const size_t off = (size_t)(row0 + ai * HALF + m * 16) * ldc + col0;
#pragma unroll
                for (int bj = 0; bj < 2; ++bj)
#pragma unroll
                    for (int n = 0; n < 2; ++n) { const f32x4 bs = *(const f32x4*)(bp + off + bj * HALF + n * 16); *(f32x4*)(out + off + bj * HALF + n * 16) = bs + acc[ai][bj][m][n]; } }
    }
};
struct EpiSwiglu {
    static constexpr bool PERM = true;
    bf16_t* O; int ldc;
    __device__ __forceinline__ void operator()(const f32x4 (&acc)[2][2][4][2], const Unit& u, int wr, int wc, int fr, int fq) const {
        const int row0 = u.pm * BM + wr * 64 + fr, col0 = u.pn * HALF + wc * 32 + 8 * fq;
#pragma unroll
        for (int ai = 0; ai < 2; ++ai)
#pragma unroll
            for (int m = 0; m < 4; ++m) {
                f32x4 t[2];
#pragma unroll
                for (int n = 0; n < 2; ++n)
#pragma unroll
                    for (int j = 0; j < 4; ++j) { const float a = acc[ai][0][m][n][j], b = acc[ai][1][m][n][j]; t[n][j] = a * sigmoidf_fast(a) * b; }
                u32x4 w; w.x = cvt_pk_bf16(t[0][0], t[0][1]); w.y = cvt_pk_bf16(t[0][2], t[0][3]); w.z = cvt_pk_bf16(t[1][0], t[1][1]); w.w = cvt_pk_bf16(t[1][2], t[1][3]);
                *(u32x4*)(O + (size_t)(row0 + ai * HALF + m * 16) * ldc + col0) = w; }
    }
};
struct EpiPle {
    static constexpr bool PERM = false;
    const float* base; float* out; int ldc; const bf16_t* PP; int ldp;
    __device__ __forceinline__ void operator()(const f32x4 (&acc)[2][2][4][2], const Unit& u, int wr, int wc, int fr, int fq) const {
        const int row0 = u.pm * BM + wr * 64 + fr, col0 = u.pn * BM + wc * 32 + 4 * fq;
#pragma unroll
        for (int ai = 0; ai < 2; ++ai)
#pragma unroll
            for (int m = 0; m < 4; ++m) { const size_t r = (size_t)(row0 + ai * HALF + m * 16);
#pragma unroll
                for (int bj = 0; bj < 2; ++bj)
#pragma unroll
                    for (int n = 0; n < 2; ++n) { const int c = col0 + bj * HALF + n * 16; const f32x4 a = acc[ai][bj][m][n];
                        const f32x4 bs = *(const f32x4*)(base + r * ldc + c); const u32x2 p = *(const u32x2*)(PP + r * ldp + c);
                        f32x4 o; o[0] = bs[0] + sigmoidf_fast(a[0]) * bf_lo(p.x); o[1] = bs[1] + sigmoidf_fast(a[1]) * bf_hi(p.x); o[2] = bs[2] + sigmoidf_fast(a[2]) * bf_lo(p.y); o[3] = bs[3] + sigmoidf_fast(a[3]) * bf_hi(p.y);
                        *(f32x4*)(out + r * ldc + c) = o; } }
    }
};
template <class Epi, class Sched, bool ALIGN_EPI = false, bool SP2 = false>
__device__ __forceinline__ void gemm_phase(PG8_LAS unsigned char* lds, const Gemm g, const Sched& S, const Epi& E) {
    int tid_ = threadIdx.x; asm volatile("" : "+v"(tid_));
    const int tid = tid_, wid = __builtin_amdgcn_readfirstlane(tid >> 6), lane = tid & 63, wr = wid >> 2, wc = wid & 3, fr = lane & 15, fq = lane >> 4;
    const int K = g.K, nt = K / BK, lda = g.lda, ldb = g.ldb;
    unsigned voffA[2], voffB[2];
#pragma unroll
    for (int i = 0; i < 2; ++i) { int R, C; stage_rc(tid * 16 + i * 8192, R, C); const int Rb = Epi::PERM ? ((R & ~31) + perm32(R & 31)) : R;
        voffA[i] = (unsigned)(R * lda + C) * 2u; voffB[i] = (unsigned)(Rb * ldb + C) * 2u; }
    const size_t kstep = (size_t)(BK * 2);
    const size_t hstepA = (size_t)HALF * lda * 2, hstepB = (size_t)(g.bmode ? 2048 : HALF) * ldb * 2;
    const size_t tstepA = 2 * hstepA, tstepB = (size_t)BM * ldb * 2;
#define PG8_ABASE(u) ((const char*)g.A + (size_t)(u).pm * tstepA + (size_t)((u).pn >> g.agrp_shift) * (size_t)g.agrp_stride * 2)
#define PG8_BBASE(u) ((const char*)g.Bt + (g.bmode ? (size_t)(((u).pn >> 4) * 4096 + ((u).pn & 15) * HALF) * ldb * 2 : (size_t)(u).pn * tstepB))
    const unsigned ldsw = (unsigned)wid * 1024u;
    const int aoff = lds_byte(wr * 64 + fr, fq * 8), boff = lds_byte(wc * 32 + fr, fq * 8);
#define PG8_SA(b, h) (((b) * 2 + (h)) * HTB)
#define PG8_SB(b, h) ((4 + (b) * 2 + (h)) * HTB)
#define PG8_STAGE(bufoff, gbase, voff) do { _Pragma("unroll") for (int _i = 0; _i < 2; ++_i) \
        __builtin_amdgcn_global_load_lds((const unsigned*)((const char*)(gbase) + (voff)[_i]), (PG8_LAS unsigned*)(lds + (bufoff) + ldsw + _i * 8192), 16, 0, 0); } while (0)
#define PG8_LDA(dst, b, h) do { _Pragma("unroll") for (int m = 0; m < 4; ++m) _Pragma("unroll") for (int k = 0; k < 2; ++k) dst[m][k] = *(const PG8_LAS bf16x8*)(lds + PG8_SA(b, h) + aoff + m * 2048 + k * 1024); } while (0)
#define PG8_LDB(dst, b, h) do { _Pragma("unroll") for (int n = 0; n < 2; ++n) _Pragma("unroll") for (int k = 0; k < 2; ++k) dst[n][k] = *(const PG8_LAS bf16x8*)(lds + PG8_SB(b, h) + boff + n * 2048 + k * 1024); } while (0)
#define PG8_MMA(ai, bj, At, Bt) do { __builtin_amdgcn_s_setprio(1); _Pragma("unroll") for (int m = 0; m < 4; ++m) _Pragma("unroll") for (int n = 0; n < 2; ++n) _Pragma("unroll") for (int k = 0; k < 2; ++k) \
        acc[ai][bj][m][n] = __builtin_amdgcn_mfma_f32_16x16x32_bf16(Bt[n][k], At[m][k], acc[ai][bj][m][n], 0, 0, 0); __builtin_amdgcn_s_setprio(0); } while (0)
#define PG8_WAIT_V(n) asm volatile("s_waitcnt vmcnt(" #n ")" ::: "memory")
#define PG8_WAIT_L(n) asm volatile("s_waitcnt lgkmcnt(" #n ")" ::: "memory")
#define PG8_BAR __builtin_amdgcn_s_barrier()
#define PG8_SCHED __builtin_amdgcn_sched_barrier(0)
    Unit cur, nxt; int ui = 0;
    if (!S.next(0, cur)) return;
    f32x4 acc[2][2][4][2];
#pragma unroll
    for (int a = 0; a < 2; ++a)
#pragma unroll
        for (int b = 0; b < 2; ++b)
#pragma unroll
            for (int m = 0; m < 4; ++m)
#pragma unroll
                for (int n = 0; n < 2; ++n) acc[a][b][m][n] = (f32x4){0.f, 0.f, 0.f, 0.f};
    bf16x8 At[4][2], B0[2][2], B1[2][2];
    const char* cA = PG8_ABASE(cur); const char* cB = PG8_BBASE(cur);
    if constexpr (SP2) {
        PG8_STAGE(PG8_SB(0, 0), cB, voffB); PG8_STAGE(PG8_SB(0, 1), cB + hstepB, voffB); PG8_STAGE(PG8_SA(0, 0), cA, voffA); PG8_STAGE(PG8_SA(0, 1), cA + hstepA, voffA);
        if (wr == 1) PG8_BAR;
        PG8_WAIT_V(2); PG8_BAR;
        PG8_STAGE(PG8_SB(1, 0), cB + kstep, voffB); PG8_STAGE(PG8_SA(1, 0), cA + kstep, voffA); PG8_STAGE(PG8_SB(1, 1), cB + hstepB + kstep, voffB);
        PG8_WAIT_V(6); PG8_BAR;
    } else {
        PG8_STAGE(PG8_SB(0, 0), cB, voffB); PG8_STAGE(PG8_SA(0, 0), cA, voffA); PG8_STAGE(PG8_SB(0, 1), cB + hstepB, voffB); PG8_STAGE(PG8_SA(0, 1), cA + hstepA, voffA);
        if (wr == 1) PG8_BAR;
        PG8_WAIT_V(4); PG8_BAR;
        PG8_STAGE(PG8_SB(1, 0), cB + kstep, voffB); PG8_STAGE(PG8_SA(1, 0), cA + kstep, voffA); PG8_STAGE(PG8_SB(1, 1), cB + hstepB + kstep, voffB);
        PG8_WAIT_V(6); PG8_BAR;
    }
    for (;;) {
        const bool has_next = S.next(ui + 1, nxt);
        const char* nA = has_next ? PG8_ABASE(nxt) : cA; const char* nB = has_next ? PG8_BBASE(nxt) : cB;
        for (int t = 0; t < nt; t += 2) {
            const bool last = (t == nt - 2);
            const char* a1 = cA + (size_t)(t + 1) * kstep;
            const char* a2 = last ? nA : cA + (size_t)(t + 2) * kstep; const char* b2 = last ? nB : cB + (size_t)(t + 2) * kstep;
            const char* a3 = a2 + kstep; const char* b3 = b2 + kstep;
            if constexpr (SP2) {
            PG8_LDB(B0, 0, 0); PG8_LDB(B1, 0, 1); PG8_SCHED; PG8_LDA(At, 0, 0); PG8_STAGE(PG8_SA(1, 1), a1 + hstepA, voffA);
            PG8_WAIT_V(8); PG8_WAIT_L(0); PG8_BAR; PG8_MMA(0, 0, At, B0); PG8_MMA(0, 1, At, B1); PG8_BAR; PG8_SCHED;
            PG8_LDA(At, 0, 1); PG8_STAGE(PG8_SB(0, 0), b2, voffB); PG8_STAGE(PG8_SB(0, 1), b2 + hstepB, voffB); PG8_STAGE(PG8_SA(0, 0), a2, voffA);
            PG8_WAIT_V(8); PG8_WAIT_L(0); PG8_BAR; PG8_MMA(1, 0, At, B0); PG8_MMA(1, 1, At, B1); PG8_BAR; PG8_SCHED;
            PG8_LDB(B0, 1, 0); PG8_LDB(B1, 1, 1); PG8_SCHED; PG8_LDA(At, 1, 0); PG8_STAGE(PG8_SA(0, 1), a2 + hstepA, voffA);
            PG8_WAIT_V(8); PG8_WAIT_L(0); PG8_BAR; PG8_MMA(0, 0, At, B0); PG8_MMA(0, 1, At, B1); PG8_BAR; PG8_SCHED;
            PG8_LDA(At, 1, 1); PG8_STAGE(PG8_SB(1, 0), b3, voffB); PG8_STAGE(PG8_SB(1, 1), b3 + hstepB, voffB); PG8_STAGE(PG8_SA(1, 0), a3, voffA);
            PG8_WAIT_V(8); PG8_WAIT_L(0); PG8_BAR; PG8_MMA(1, 0, At, B0); PG8_MMA(1, 1, At, B1); PG8_BAR; PG8_SCHED;
            } else {
            PG8_LDB(B0, 0, 0); PG8_SCHED; PG8_LDA(At, 0, 0); PG8_STAGE(PG8_SA(1, 1), a1 + hstepA, voffA);
            PG8_WAIT_L(8); PG8_BAR; PG8_WAIT_L(0); PG8_MMA(0, 0, At, B0); PG8_BAR; PG8_SCHED;
            PG8_LDB(B1, 0, 1); PG8_STAGE(PG8_SB(0, 0), b2, voffB);
            PG8_BAR; PG8_WAIT_L(0); PG8_MMA(0, 1, At, B1); PG8_BAR;
            PG8_LDA(At, 0, 1); PG8_STAGE(PG8_SA(0, 0), a2, voffA);
            PG8_BAR; PG8_WAIT_L(0); PG8_MMA(1, 0, At, B0); PG8_BAR; PG8_SCHED;
            PG8_STAGE(PG8_SB(0, 1), b2 + hstepB, voffB);
            PG8_WAIT_V(6); PG8_BAR; PG8_MMA(1, 1, At, B1); PG8_BAR;
            PG8_LDB(B0, 1, 0); PG8_SCHED; PG8_LDA(At, 1, 0); PG8_STAGE(PG8_SA(0, 1), a2 + hstepA, voffA);
            PG8_WAIT_L(8); PG8_BAR; PG8_WAIT_L(0); PG8_MMA(0, 0, At, B0); PG8_BAR; PG8_SCHED;
            PG8_LDB(B1, 1, 1); PG8_STAGE(PG8_SB(1, 0), b3, voffB);
            PG8_BAR; PG8_WAIT_L(0); PG8_MMA(0, 1, At, B1); PG8_BAR;
            PG8_LDA(At, 1, 1); PG8_STAGE(PG8_SA(1, 0), a3, voffA);
            PG8_BAR; PG8_WAIT_L(0); PG8_MMA(1, 0, At, B0); PG8_BAR; PG8_SCHED;
            PG8_STAGE(PG8_SB(1, 1), b3 + hstepB, voffB);
            PG8_WAIT_V(6); PG8_BAR; PG8_MMA(1, 1, At, B1); PG8_BAR;
            }
        }
        if constexpr (ALIGN_EPI) { if (wr == 0) PG8_BAR; }
        { E(acc, cur, wr, wc, fr, fq); }
        if (!has_next) break;
#pragma unroll
        for (int a = 0; a < 2; ++a)
#pragma unroll
            for (int b = 0; b < 2; ++b)
#pragma unroll
                for (int m = 0; m < 4; ++m)
#pragma unroll
                    for (int n = 0; n < 2; ++n) acc[a][b][m][n] = (f32x4){0.f, 0.f, 0.f, 0.f};
        cur = nxt; cA = nA; cB = nB; ++ui;
        if constexpr (ALIGN_EPI) { if (wr == 1) PG8_BAR; }
    }
    PG8_WAIT_V(0);
    if constexpr (!ALIGN_EPI) { if (wr == 0) PG8_BAR; }
    PG8_BAR;
#undef PG8_ABASE
#undef PG8_BBASE
#undef PG8_SA
#undef PG8_SB
#undef PG8_STAGE
#undef PG8_LDA
#undef PG8_LDB
#undef PG8_MMA
#undef PG8_WAIT_V
#undef PG8_WAIT_L
#undef PG8_BAR
#undef PG8_SCHED
}
}


constexpr int D_MODEL = 2048, NTOK = 49152, CH_TOK = 16384, N_CHUNK = 3, DEPTH = 2;
constexpr int MIX_IN = 4096, IN_COLS = 12288, D_FF = 5632, PLE_DIM = 256;
constexpr int ZC_UA = 0, ZC_BG = 512, ZC_CG = 1024, ZC_VB = 1536, ZC_Q = 2048, ZC_K = 2560, ZC_VC = 3072, ZC_UD = 3584;
constexpr float EPS = 1e-6f;
constexpr int NWAVES = 8;

constexpr size_t MiB = 1u << 20;
constexpr size_t WS_CTL = 0, CTL_ZERO_BYTES = 1 * MiB;
constexpr size_t WS_TAB = 1 * MiB;
constexpr size_t S5T_BYTES = 12800, S5T_BB = 0, S5T_C = 8192, S5T_AB = 12288;
constexpr size_t TAB_S5 = WS_TAB, TAB_C128 = WS_TAB + 2 * MiB, TAB_S128 = TAB_C128 + 32768, TAB_C32 = TAB_S128 + 32768, TAB_S32 = TAB_C32 + 2048;
constexpr size_t WS_W = 8 * MiB;
constexpr size_t WL_MIX = 0, WL_G = 16 * MiB, WL_GLU = 48 * MiB, WL_BR = WL_GLU + MiB / 2, WL_O = WL_BR + 8 * MiB, WL_FF = WL_O + 8 * MiB, WL_FF2 = WL_FF + 44 * MiB, WL_PG = WL_FF2 + 22 * MiB, WL_PP = WL_PG + 8 * MiB;
constexpr size_t WL_BYTES = WL_PP + 1 * MiB;
static_assert(WL_BYTES == 139 * MiB + MiB / 2, "weight map");
constexpr size_t WS_H = 288 * MiB;
constexpr size_t WS_Z = 352 * MiB;
constexpr size_t WS_YS = 480 * MiB;
constexpr size_t WS_HALL = 352 * MiB;
constexpr size_t WS_MG = 544 * MiB;
constexpr size_t WS_GT = 736 * MiB;
constexpr size_t WS_YF = WS_GT, WS_YB = WS_GT + 32 * MiB, WS_ZF = WS_GT + 64 * MiB, WS_Y1 = WS_GT + 96 * MiB, WS_S5E = WS_GT + 112 * MiB;
constexpr size_t WS_H2ALL = 288 * MiB, WS_MIDALL = 480 * MiB;
constexpr size_t WS_PP = WS_GT;
constexpr size_t WS_P16 = 992 * MiB;
constexpr size_t WS_END = 1016 * MiB;
static_assert(WS_MIDALL + 528 * MiB <= WS_END && WS_H2ALL + 192 * MiB <= WS_MIDALL, "ffn map");
static_assert(WS_W + 2 * WL_BYTES <= WS_H && WS_MG + 192 * MiB <= WS_GT && WS_GT + 256 * MiB <= WS_P16, "ws map");
constexpr int CW_BAR = 4096;

constexpr int LDS_SCRATCH = 151552;
constexpr int LDSCTL_OFF = LDS_SCRATCH;
constexpr int LDS_BYTES = LDS_SCRATCH + 256;

#define GAS __attribute__((address_space(1)))
#define LAS __attribute__((address_space(3)))
typedef unsigned short bf16;
typedef unsigned u32x4 __attribute__((ext_vector_type(4)));
typedef unsigned u32x2 __attribute__((ext_vector_type(2)));
typedef float f32x4 __attribute__((ext_vector_type(4)));
typedef float f32x2 __attribute__((ext_vector_type(2)));
typedef short bf16x8 __attribute__((ext_vector_type(8)));
#define LDS_WAIT() asm volatile("s_waitcnt lgkmcnt(0)" ::: "memory")
using pg8::cvt_pk_bf16; using pg8::bf_lo; using pg8::bf_hi;
__device__ __forceinline__ bf16x8 as_frag(u32x4 v) { return __builtin_bit_cast(bf16x8, v); }
__device__ __forceinline__ void mfma_acc(f32x4& acc, bf16x8 a, bf16x8 b) { asm volatile("s_nop 1\n\tv_mfma_f32_16x16x32_bf16 %0, %1, %2, %0" : "+v"(acc) : "v"(a), "v"(b)); }
__device__ __forceinline__ f32x4 mfma16(bf16x8 a, bf16x8 b, f32x4 c) { mfma_acc(c, a, b); return c; }
#define MFMA_DRAIN() do { __builtin_amdgcn_sched_barrier(0); asm volatile("s_nop 15\n\ts_nop 15" ::: "memory"); __builtin_amdgcn_sched_barrier(0); } while (0)
__device__ __forceinline__ float wave_sum(float v) {
#pragma unroll
    for (int o = 1; o < 64; o <<= 1) v += __shfl_xor(v, o);
    return v;
}
__device__ __forceinline__ unsigned short f2bf(float f) { return (unsigned short)(cvt_pk_bf16(f, 0.f) & 0xffffu); }

#define XB_TMO      128
#define XB_XCNT(j)  (256  + 64 * (j))
#define XB_XSUB(j)  (1280 + 64 * (j))
#define XB_XGEN(j)  (2304 + 64 * (j))
#define XB_TOP      3328
#define XB_TOPGEN   3392
#define XCD_BAR_WORDS 3456
#define XB_SPIN_CAP (1u << 22)
__device__ __forceinline__ unsigned xb_ld(unsigned* p)              { return __hip_atomic_load(p, __ATOMIC_RELAXED, __HIP_MEMORY_SCOPE_AGENT); }
__device__ __forceinline__ unsigned xb_add(unsigned* p, unsigned v) { return __hip_atomic_fetch_add(p, v, __ATOMIC_RELAXED, __HIP_MEMORY_SCOPE_AGENT); }
__device__ __forceinline__ unsigned xb_xcc_id() { return (unsigned)__builtin_amdgcn_s_getreg((3 << 11) | 20) & 0xFu; }
#define XB_SPIN(cond, bar) do { unsigned _sp = 0; while (cond) { __builtin_amdgcn_s_sleep(1); \
    if ((++_sp & 255u) == 0u) { if (xb_ld(&(bar)[XB_TMO])) break; if (_sp > XB_SPIN_CAP) { atomicAdd(&(bar)[XB_TMO], 1u); break; } } } } while (0)
struct XcdBarrier { unsigned* bar; unsigned x; volatile LAS unsigned* st; };
__device__ __forceinline__ XcdBarrier xcd_barrier_post(unsigned* bar, volatile LAS unsigned* st) {
    XcdBarrier b; b.bar = bar; b.x = xb_xcc_id(); b.st = st;
    if (threadIdx.x == 0) (void)xb_add(&bar[XB_XCNT(b.x)], 1u);
    return b;
}
__device__ __forceinline__ void xcd_barrier_complete(unsigned* bar, unsigned x, unsigned& nloc, unsigned& nx) {
    const unsigned G = gridDim.x * gridDim.y * gridDim.z;
    unsigned sum, cnt, mine, sp = 0u;
    for (;;) {
        sum = 0u; cnt = 0u; mine = 0u;
#pragma unroll
        for (unsigned j = 0; j < 16; ++j) { const unsigned c = xb_ld(&bar[XB_XCNT(j)]); sum += c; cnt += (c > 0u) ? 1u : 0u; mine = (j == x) ? c : mine; }
        if (sum == G) break;
        __builtin_amdgcn_s_sleep(1);
        if ((++sp & 255u) == 0u) { if (xb_ld(&bar[XB_TMO])) break; if (sp > XB_SPIN_CAP) { atomicAdd(&bar[XB_TMO], 1u); break; } }
    }
    nloc = mine > 0u ? mine : 1u; nx = cnt > 0u ? cnt : 1u;
}
__device__ __forceinline__ void xcd_barrier(const XcdBarrier& b) {
    asm volatile("s_waitcnt vmcnt(0)" ::: "memory");
    __syncthreads();
    if (threadIdx.x == 0) {
        unsigned* bar = b.bar;
        __builtin_amdgcn_s_waitcnt(0);
        unsigned nloc = b.st[0], nx = b.st[1];
        if (nloc == 0u) { xcd_barrier_complete(bar, b.x, nloc, nx); b.st[0] = nloc; b.st[1] = nx; }
        const unsigned old = xb_add(&bar[XB_XSUB(b.x)], 1u);
        const unsigned gen = old / nloc;
        if (old + 1u == (gen + 1u) * nloc) {
            __builtin_amdgcn_fence(__ATOMIC_RELEASE, "agent");
            asm volatile("s_waitcnt vmcnt(0)" ::: "memory");
            const unsigned og = xb_add(&bar[XB_TOP], 1u);
            const unsigned tg = og / nx;
            if (og + 1u == (tg + 1u) * nx) xb_add(&bar[XB_TOPGEN], 1u);
            else XB_SPIN(xb_ld(&bar[XB_TOPGEN]) == tg, bar);
            __builtin_amdgcn_fence(__ATOMIC_ACQUIRE, "agent");
            xb_add(&bar[XB_XGEN(b.x)], 1u);
            asm volatile("s_waitcnt vmcnt(0)" ::: "memory");
        } else {
            XB_SPIN(xb_ld(&bar[XB_XGEN(b.x)]) == gen, bar);
            __builtin_amdgcn_fence(__ATOMIC_ACQUIRE, "agent");
            asm volatile("s_waitcnt vmcnt(0)" ::: "memory");
        }
    }
    __syncthreads();
}

struct Frame {
    LAS unsigned char* lds;
    int tid, lane, wave;
    int vcu, G;
    unsigned char* ws;
};
struct Args { const float* in[27]; float* out; unsigned char* ws; int ph_lo, ph_hi; };
__device__ __forceinline__ Frame fresh(const Frame& F0) { Frame F = F0; int t = F0.tid; asm volatile("" : "+v"(t)); F.tid = t; F.lane = t & 63; F.wave = __builtin_amdgcn_readfirstlane(t >> 6); return F; }

__device__ __forceinline__ void transpose_item(const float* W, int K, int N, bf16* WT, int k0, int n0, int drow0, LAS float* scr, int lane) {
#pragma unroll 8
    for (int i = 0; i < 32; ++i) { const int kk = 2 * i + (lane >> 5); scr[kk * 33 + (lane & 31)] = W[(size_t)(k0 + kk) * N + n0 + (lane & 31)]; }
    LDS_WAIT(); asm volatile("" ::: "memory");
    const int c = lane & 7;
#pragma unroll
    for (int j = 0; j < 4; ++j) { const int n = (lane >> 3) + 8 * j; const LAS float* s = scr + (8 * c) * 33 + n;
        u32x4 o; o.x = cvt_pk_bf16(s[0 * 33], s[1 * 33]); o.y = cvt_pk_bf16(s[2 * 33], s[3 * 33]); o.z = cvt_pk_bf16(s[4 * 33], s[5 * 33]); o.w = cvt_pk_bf16(s[6 * 33], s[7 * 33]);
        *(u32x4*)(WT + (size_t)(drow0 + n) * K + k0 + 8 * c) = o; }
    LDS_WAIT(); asm volatile("" ::: "memory");
}
__device__ __forceinline__ void conv_plain(const float* W, int K, int N, bf16* WT, int item, LAS float* scr, int lane) {
    const int nblk = N / 32, kb = item / nblk, nb = item % nblk;
    transpose_item(W, K, N, WT, 64 * kb, 32 * nb, 32 * nb, scr, lane);
}
__device__ __forceinline__ void ph_prologue(Frame& F, const Args& A) {
    LAS float* scr = (LAS float*)(F.lds + F.wave * 16384);
    const int gw = F.vcu * NWAVES + F.wave, NGW = F.G * NWAVES;
    constexpr int I_IN = (2048 / 64) * (IN_COLS / 32), I_GLU = (512 / 64) * (512 / 32), I_BR1 = (512 / 64) * (2048 / 32), I_BR = 4 * I_BR1, I_O = (2048 / 64) * (2048 / 32),
                  I_FF = (2048 / 64) * (2 * D_FF / 32), I_FF2 = (D_FF / 64) * (2048 / 32), I_PG = I_O, I_PP = (256 / 64) * (2048 / 32);
    constexpr int I_LAYER = I_IN + I_GLU + I_BR + I_O + I_FF + I_FF2 + I_PG + I_PP;
    for (int it = gw; it < DEPTH * I_LAYER; it += NGW) {
        const int l = it / I_LAYER; int r = it % I_LAYER;
        unsigned char* wl = F.ws + WS_W + (size_t)l * WL_BYTES;
        if (r < I_IN) {
            const float* W = A.in[5] + (size_t)l * 2048 * IN_COLS; const int nblk = IN_COLS / 32, kb = r / nblk, nb = r % nblk, n0 = 32 * nb;
            if (n0 < MIX_IN) transpose_item(W, 2048, IN_COLS, (bf16*)(wl + WL_MIX), 64 * kb, n0, n0, scr, F.lane);
            else transpose_item(W, 2048, IN_COLS, (bf16*)(wl + WL_G), 64 * kb, n0, n0 - MIX_IN, scr, F.lane);
            continue; } r -= I_IN;
        if (r < I_GLU) { conv_plain(A.in[14] + (size_t)l * 512 * 512, 512, 512, (bf16*)(wl + WL_GLU), r, scr, F.lane); continue; } r -= I_GLU;
        if (r < I_BR) { const int kb = r / I_BR1; conv_plain(A.in[19] + ((size_t)l * 4 + kb) * 512 * 2048, 512, 2048, (bf16*)(wl + WL_BR) + (size_t)kb * 2048 * 512, r % I_BR1, scr, F.lane); continue; } r -= I_BR;
        if (r < I_O) { conv_plain(A.in[20] + (size_t)l * 2048 * 2048, 2048, 2048, (bf16*)(wl + WL_O), r, scr, F.lane); continue; } r -= I_O;
        if (r < I_FF) {
            const float* W = A.in[22] + (size_t)l * 2048 * 2 * D_FF; const int nblk = 2 * D_FF / 32, kb = r / nblk, nb = r % nblk, n0 = 32 * nb;
            const int j = n0 / D_FF, rr = n0 % D_FF, pn = rr / 128, cc = rr % 128;
            transpose_item(W, 2048, 2 * D_FF, (bf16*)(wl + WL_FF), 64 * kb, n0, 256 * pn + 128 * j + cc, scr, F.lane);
            continue; } r -= I_FF;
        if (r < I_FF2) { conv_plain(A.in[23] + (size_t)l * D_FF * 2048, D_FF, 2048, (bf16*)(wl + WL_FF2), r, scr, F.lane); continue; } r -= I_FF2;
        if (r < I_PG) { conv_plain(A.in[25] + (size_t)l * 2048 * 2048, 2048, 2048, (bf16*)(wl + WL_PG), r, scr, F.lane); continue; } r -= I_PG;
        conv_plain(A.in[26] + (size_t)l * 256 * 2048, 256, 2048, (bf16*)(wl + WL_PP), r, scr, F.lane);
    }
    {
        const int gt = F.vcu * 512 + F.tid, NT = F.G * 512;
        bf16* c128 = (bf16*)(F.ws + TAB_C128); bf16* s128 = (bf16*)(F.ws + TAB_S128); bf16* c32 = (bf16*)(F.ws + TAB_C32); bf16* s32 = (bf16*)(F.ws + TAB_S32);
        for (int e = gt; e < 128 * 128 + 32 * 32; e += NT) {
            if (e < 128 * 128) { const int i = e >> 7, k = e & 127, m = (i * k) & 127; float sn, cs; sincospif((float)m * (1.0f / 64.0f), &sn, &cs);
                c128[e] = f2bf(cs * 0.08838834764831845f); s128[e] = f2bf(sn * 0.08838834764831845f); }
            else { const int e2 = e - 128 * 128, i = e2 >> 5, k = e2 & 31, m = (i * k) & 31; float sn, cs; sincospif((float)m * (1.0f / 16.0f), &sn, &cs);
                c32[e2] = f2bf(cs * 0.17677669529663687f); s32[e2] = f2bf(sn * 0.17677669529663687f); }
        }
    }
    for (int t = gw; t < DEPTH * 2 * 32; t += NGW) {
        const int g = t & 31, ld = t >> 5;
        unsigned char* tb = F.ws + TAB_S5 + (size_t)t * S5T_BYTES;
        const float* lam_re = A.in[6] + (size_t)t * 64; const float* lam_im = A.in[7] + (size_t)t * 64;
        const float dt = expf(A.in[8][t]);
        const float* b_re = A.in[9] + (size_t)t * 64 * 16; const float* b_im = A.in[10] + (size_t)t * 64 * 16;
        const float* c_re = A.in[11] + (size_t)t * 16 * 64; const float* c_im = A.in[12] + (size_t)t * 16 * 64;
        (void)g; (void)ld;
        const int lane = F.lane, l15 = lane & 15, g4 = lane >> 4;
        {
            const float lr = lam_re[lane], li = lam_im[lane], mag = expf(lr * dt); float sn, cs; sincosf(li * dt, &sn, &cs);
            f32x2 ab; ab.x = mag * cs; ab.y = mag * sn; ((f32x2*)(tb + S5T_AB))[lane] = ab;
        }
#pragma unroll 1
        for (int cb = 0; cb < 8; ++cb) {
            const int col = 16 * cb + l15, p = col >> 1, ri = col & 1;
            const float lr = lam_re[p], li = lam_im[p], mag = expf(lr * dt); float sn, cs; sincosf(li * dt, &sn, &cs);
            const float ar = mag * cs, ai = mag * sn, den = lr * lr + li * li;
            const float fr = ((ar - 1.0f) * lr + ai * li) / den, fi = (ai * lr - (ar - 1.0f) * li) / den;
            float v[8];
#pragma unroll
            for (int j = 0; j < 8; ++j) { const int h = 8 * g4 + j; float x = 0.f;
                if (h < 16) { const float br = b_re[p * 16 + h], bi = b_im[p * 16 + h]; x = ri ? (fr * bi + fi * br) : (fr * br - fi * bi); }
                v[j] = x; }
            u32x4 o; o.x = cvt_pk_bf16(v[0], v[1]); o.y = cvt_pk_bf16(v[2], v[3]); o.z = cvt_pk_bf16(v[4], v[5]); o.w = cvt_pk_bf16(v[6], v[7]);
            ((u32x4*)(tb + S5T_BB))[cb * 64 + lane] = o;
        }
#pragma unroll 1
        for (int ks = 0; ks < 4; ++ks) {
            float v[8];
#pragma unroll
            for (int j = 0; j < 8; ++j) { const int col = 32 * ks + 8 * g4 + j, p = col >> 1, ri = col & 1; v[j] = ri ? -c_im[l15 * 64 + p] : c_re[l15 * 64 + p]; }
            u32x4 o; o.x = cvt_pk_bf16(v[0], v[1]); o.y = cvt_pk_bf16(v[2], v[3]); o.z = cvt_pk_bf16(v[4], v[5]); o.w = cvt_pk_bf16(v[6], v[7]);
            ((u32x4*)(tb + S5T_C))[ks * 64 + lane] = o;
        }
    }
}

__device__ __forceinline__ void ph_norm(Frame& F, const float* xsrc, const float* gain, bf16* H, int nrows) {
    const int gw = F.vcu * NWAVES + F.wave, NGW = F.G * NWAVES;
    f32x4 gv[8];
#pragma unroll
    for (int j = 0; j < 8; ++j) gv[j] = ((const f32x4*)gain)[F.lane + 64 * j];
    for (int m = gw; m < nrows; m += NGW) {
        const f32x4* xr = (const f32x4*)(xsrc + (size_t)m * D_MODEL) + F.lane;
        f32x4 v[8]; float s = 0.f;
#pragma unroll
        for (int j = 0; j < 8; ++j) { v[j] = xr[64 * j]; s += (v[j][0] * v[j][0] + v[j][1] * v[j][1]) + (v[j][2] * v[j][2] + v[j][3] * v[j][3]); }
        const float rstd = rsqrtf(wave_sum(s) * (1.0f / D_MODEL) + EPS);
        u32x2* o = (u32x2*)(H + (size_t)m * D_MODEL) + F.lane;
#pragma unroll
        for (int j = 0; j < 8; ++j) { u32x2 w; w.x = cvt_pk_bf16(v[j][0] * rstd * gv[j][0], v[j][1] * rstd * gv[j][1]); w.y = cvt_pk_bf16(v[j][2] * rstd * gv[j][2], v[j][3] * rstd * gv[j][3]); o[64 * j] = w; }
    }
}
__device__ __forceinline__ void ph_pcvt(Frame& F, const float* pp, const float* ps, bf16* P16) {
    const int gw = F.vcu * NWAVES + F.wave, NGW = F.G * NWAVES;
    for (int m = gw; m < NTOK; m += NGW) {
        const float* src = m < 32768 ? pp + (size_t)m * PLE_DIM : ps + (size_t)(m - 32768) * PLE_DIM;
        const f32x4 v = ((const f32x4*)src)[F.lane];
        u32x2 w; w.x = cvt_pk_bf16(v[0], v[1]); w.y = cvt_pk_bf16(v[2], v[3]);
        ((u32x2*)(P16 + (size_t)m * PLE_DIM))[F.lane] = w;
    }
}
__device__ __forceinline__ void unpack8(u32x4 w, float (&f)[8]) { f[0] = bf_lo(w.x); f[1] = bf_hi(w.x); f[2] = bf_lo(w.y); f[3] = bf_hi(w.y); f[4] = bf_lo(w.z); f[5] = bf_hi(w.z); f[6] = bf_lo(w.w); f[7] = bf_hi(w.w); }
__device__ __forceinline__ u32x4 pack8(const float (&f)[8]) { u32x4 w; w.x = cvt_pk_bf16(f[0], f[1]); w.y = cvt_pk_bf16(f[2], f[3]); w.z = cvt_pk_bf16(f[4], f[5]); w.w = cvt_pk_bf16(f[6], f[7]); return w; }

__device__ __forceinline__ void conv_block(Frame& F, const bf16* Z, bf16* YS, const float* cw  , int blk, int lseq) {
#pragma unroll 1
    for (int i = 0; i < 8; ++i) {
        const int idx = F.tid + 512 * i, r = blk * 64 + (idx >> 6), c = (idx & 63) * 8, lpos = r % lseq;
        const bf16* zr = Z + (size_t)r * MIX_IN;
        float bg[8], z0[8], acc[8], tmp[8], w[8];
        unpack8(*(const u32x4*)(zr + ZC_BG + c), bg);
        {   float cg[8], vv[8]; unpack8(*(const u32x4*)(zr + ZC_CG + c), cg); unpack8(*(const u32x4*)(zr + ZC_VB + c), vv);
            const f32x4 wa = *(const f32x4*)(cw + 512 + c), wb = *(const f32x4*)(cw + 512 + c + 4);
            w[0] = wa[0]; w[1] = wa[1]; w[2] = wa[2]; w[3] = wa[3]; w[4] = wb[0]; w[5] = wb[1]; w[6] = wb[2]; w[7] = wb[3];
#pragma unroll
            for (int j = 0; j < 8; ++j) { z0[j] = cg[j] * vv[j]; acc[j] = w[j] * z0[j]; } }
        if (lpos > 0) { float cg[8], vv[8]; unpack8(*(const u32x4*)(zr - MIX_IN + ZC_CG + c), cg); unpack8(*(const u32x4*)(zr - MIX_IN + ZC_VB + c), vv);
            const f32x4 wa = *(const f32x4*)(cw + c), wb = *(const f32x4*)(cw + c + 4);
            w[0] = wa[0]; w[1] = wa[1]; w[2] = wa[2]; w[3] = wa[3]; w[4] = wb[0]; w[5] = wb[1]; w[6] = wb[2]; w[7] = wb[3];
#pragma unroll
            for (int j = 0; j < 8; ++j) acc[j] += w[j] * (cg[j] * vv[j]); }
        if (lpos < lseq - 1) { float cg[8], vv[8]; unpack8(*(const u32x4*)(zr + MIX_IN + ZC_CG + c), cg); unpack8(*(const u32x4*)(zr + MIX_IN + ZC_VB + c), vv);
            const f32x4 wa = *(const f32x4*)(cw + 1024 + c), wb = *(const f32x4*)(cw + 1024 + c + 4);
            w[0] = wa[0]; w[1] = wa[1]; w[2] = wa[2]; w[3] = wa[3]; w[4] = wb[0]; w[5] = wb[1]; w[6] = wb[2]; w[7] = wb[3];
#pragma unroll
            for (int j = 0; j < 8; ++j) acc[j] += w[j] * (cg[j] * vv[j]); }
#pragma unroll
        for (int j = 0; j < 8; ++j) tmp[j] = bg[j] * acc[j];
        *(u32x4*)(YS + (size_t)r * D_MODEL + 512 + c) = pack8(tmp);
    }
}
__device__ __forceinline__ void s5fin_block(Frame& F, const bf16* Z, const float* YF, const float* YB, const float* dsk  , bf16* Y1, int blk) {
#pragma unroll 1
    for (int i = 0; i < 8; ++i) {
        const int idx = F.tid + 512 * i, r = blk * 64 + (idx >> 6), c = (idx & 63) * 8;
        float u[8], o[8]; unpack8(*(const u32x4*)(Z + (size_t)r * MIX_IN + ZC_UA + c), u);
        const f32x4 f0 = *(const f32x4*)(YF + (size_t)r * 512 + c), f1 = *(const f32x4*)(YF + (size_t)r * 512 + c + 4);
        const f32x4 b0 = *(const f32x4*)(YB + (size_t)r * 512 + c), b1 = *(const f32x4*)(YB + (size_t)r * 512 + c + 4);
        const f32x4 d0 = *(const f32x4*)(dsk + c), d1 = *(const f32x4*)(dsk + c + 4);
#pragma unroll
        for (int j = 0; j < 8; ++j) { const float yy = (j < 4 ? d0[j & 3] : d1[j & 3]) * u[j] + (j < 4 ? f0[j & 3] : f1[j & 3]) + (j < 4 ? b0[j & 3] : b1[j & 3]);
            const float a = 0.7978845608028654f * (yy + 0.044715f * yy * yy * yy);
            const float th = 1.0f - 2.0f * __builtin_amdgcn_rcpf(1.0f + __expf(2.0f * a));
            o[j] = 0.5f * yy * (1.0f + th); }
        *(u32x4*)(Y1 + (size_t)r * 512 + c) = pack8(o);
    }
}

constexpr int S5_SEG = 512, S5_TPS = S5_SEG / 16;
template <bool FULL>
__device__ __forceinline__ void s5_seg_task(Frame& F, const unsigned char* tb, const bf16* Zs, float* Yout, f32x2* Ev, int nseg, int seg, int dir, int g) {
#ifndef MK_S5_LDS_STRIDE
#define MK_S5_LDS_STRIDE 12288
#endif
    LAS float* BU = (LAS float*)(F.lds + F.wave * MK_S5_LDS_STRIDE);
    LAS unsigned* XD = (LAS unsigned*)(F.lds + F.wave * MK_S5_LDS_STRIDE + 8192);
    const int lane = F.lane, l15 = lane & 15, g4 = lane >> 4;
    const f32x2 ab = ((const f32x2*)(tb + S5T_AB))[lane];
    const float ar = ab.x, ai = ab.y;
    bf16x8 bbf[8];
#pragma unroll
    for (int cb = 0; cb < 8; ++cb) bbf[cb] = as_frag(((const u32x4*)(tb + S5T_BB))[cb * 64 + lane]);
    float xr = 0.f, xi = 0.f;
    float pwr[4], pwi[4];
    pwr[0] = ar; pwi[0] = ai;
#pragma unroll
    for (int j = 1; j < 4; ++j) { pwr[j] = pwr[j - 1] * ar - pwi[j - 1] * ai; pwi[j] = pwr[j - 1] * ai + pwi[j - 1] * ar; }
    if (FULL) {
        float pr = ar, pi = ai;
#pragma unroll
        for (int i = 0; i < 9; ++i) { const float nr = pr * pr - pi * pi, ni = 2.f * pr * pi; pr = nr; pi = ni; }
        if (dir == 0) { for (int j = 0; j < seg; ++j) { const f32x2 e = Ev[j * 64 + lane]; const float nr = pr * xr - pi * xi + e.x, ni = pr * xi + pi * xr + e.y; xr = nr; xi = ni; } }
        else { for (int j = nseg - 1; j > seg; --j) { const f32x2 e = Ev[j * 64 + lane]; const float nr = pr * xr - pi * xi + e.x, ni = pr * xi + pi * xr + e.y; xr = nr; xi = ni; } }
    }
    bf16x8 cf[4];
    if (FULL) {
#pragma unroll
        for (int ks = 0; ks < 4; ++ks) cf[ks] = as_frag(((const u32x4*)(tb + S5T_C))[ks * 64 + lane]);
    }
    const int tile0 = seg * S5_TPS;
    const bf16* zcol = Zs + ZC_UA + g * 16 + 8 * (g4 & 1);
    u32x4 ring[4];
#pragma unroll
    for (int j = 0; j < 4; ++j) { const int tile = tile0 + (dir ? S5_TPS - 1 - j : j); ring[j] = (u32x4){0u, 0u, 0u, 0u}; if (g4 < 2) ring[j] = *(const u32x4*)(zcol + (size_t)(tile * 16 + l15) * MIX_IN); }
#pragma unroll 1
    for (int it = 0; it < S5_TPS; it += 4) {
#pragma unroll
        for (int j = 0; j < 4; ++j) {
            const int tile = tile0 + (dir ? S5_TPS - 1 - (it + j) : it + j);
            const bf16x8 uf = as_frag(ring[j]);
            if (it + j + 4 < S5_TPS) { const int tn = dir ? tile - 4 : tile + 4; u32x4 nx = (u32x4){0u, 0u, 0u, 0u}; if (g4 < 2) nx = *(const u32x4*)(zcol + (size_t)(tn * 16 + l15) * MIX_IN); ring[j] = nx; }
            f32x4 a8[8];
#pragma unroll
            for (int cb = 0; cb < 8; ++cb) a8[cb] = mfma16(uf, bbf[cb], (f32x4){0.f, 0.f, 0.f, 0.f});
            MFMA_DRAIN();
#pragma unroll
            for (int cb = 0; cb < 8; ++cb)
#pragma unroll
                for (int q = 0; q < 4; ++q) BU[(4 * g4 + q) * 128 + 16 * cb + l15] = a8[cb][q];
            LDS_WAIT();
#pragma unroll
            for (int k = 0; k < 4; ++k) {
                float cr[4], ci[4], yr[4], yi[4];
                f32x2 bv[4];
#pragma unroll
                for (int j = 0; j < 4; ++j) { const int t = dir ? 15 - (4 * k + j) : 4 * k + j; bv[j] = *(const LAS f32x2*)(BU + t * 128 + 2 * lane); }
                cr[0] = bv[0].x; ci[0] = bv[0].y;
#pragma unroll
                for (int j = 1; j < 4; ++j) {
                    cr[j] = __builtin_fmaf(ar, cr[j - 1], __builtin_fmaf(-ai, ci[j - 1], bv[j].x));
                    ci[j] = __builtin_fmaf(ar, ci[j - 1], __builtin_fmaf(ai, cr[j - 1], bv[j].y));
                }
#pragma unroll
                for (int j = 0; j < 4; ++j) {
                    yr[j] = __builtin_fmaf(pwr[j], xr, __builtin_fmaf(-pwi[j], xi, cr[j]));
                    yi[j] = __builtin_fmaf(pwr[j], xi, __builtin_fmaf(pwi[j], xr, ci[j]));
                    if (FULL) { const int t = dir ? 15 - (4 * k + j) : 4 * k + j; XD[t * 64 + lane] = cvt_pk_bf16(yr[j], yi[j]); }
                }
                xr = yr[3]; xi = yi[3];
            }
            if (FULL) {
                LDS_WAIT();
                f32x4 y = (f32x4){0.f, 0.f, 0.f, 0.f};
#pragma unroll
                for (int ks = 0; ks < 4; ++ks) y = mfma16(as_frag(*(const LAS u32x4*)(XD + l15 * 64 + 16 * ks + 4 * g4)), cf[ks], y);
                MFMA_DRAIN();
                float* yo = Yout + (size_t)(tile * 16 + 4 * g4) * 512 + g * 16 + l15;
#pragma unroll
                for (int q = 0; q < 4; ++q) yo[(size_t)q * 512] = y[q];
            }
            LDS_WAIT();
        }
    }
    if (!FULL) { f32x2 e; e.x = xr; e.y = xi; Ev[seg * 64 + lane] = e; }
}

constexpr int NA_KL = 0, NA_VT = 73728, NA_BIAS = 147456;
constexpr int NA_RR = 8;
__device__ __forceinline__ void na_task(Frame& F, const bf16* Zs  , bf16* YSs  , int rows, int h, int r0,
                                        const float* qg, const float* kg, const float* relb  ) {
    LAS unsigned* KL = (LAS unsigned*)(F.lds + NA_KL); LAS unsigned* VT = (LAS unsigned*)(F.lds + NA_VT); LAS unsigned short* VT16 = (LAS unsigned short*)(F.lds + NA_VT);
    LAS float* BIAS = (LAS float*)(F.lds + NA_BIAS);
    const int tid = F.tid, lane = F.lane, l15 = lane & 15, g4 = lane >> 4;
    __syncthreads();
    for (int i = tid; i < 15 * 31; i += 512) BIAS[i] = relb[i];
    const int scol = tid >> 3, schunk = tid & 7;
    float kgv[8];
    { const f32x4 a = *(const f32x4*)(kg + 8 * schunk), b = *(const f32x4*)(kg + 8 * schunk + 4); kgv[0] = a[0]; kgv[1] = a[1]; kgv[2] = a[2]; kgv[3] = a[3]; kgv[4] = b[0]; kgv[5] = b[1]; kgv[6] = b[2]; kgv[7] = b[3]; }
    int rs0 = r0 - 4; rs0 = rs0 < 0 ? 0 : (rs0 > rows - 8 ? rows - 8 : rs0);
    const bf16* zst = Zs + (size_t)scol * MIX_IN + h * 64 + 8 * schunk;
#define NA_LOAD(rho, kr, vr) do { const bf16* zt_ = zst + (size_t)(rho) * 64 * MIX_IN; kr = *(const u32x4*)(zt_ + ZC_K); vr = *(const u32x4*)(zt_ + ZC_VC); } while (0)
#define NA_STORE(rho, kr, vr) do { float kf_[8]; unpack8(kr, kf_); float ss_ = 0.f; \
        _Pragma("unroll") for (int j_ = 0; j_ < 8; ++j_) ss_ += kf_[j_] * kf_[j_]; \
        ss_ += __shfl_xor(ss_, 1); ss_ += __shfl_xor(ss_, 2); ss_ += __shfl_xor(ss_, 4); \
        const float rk_ = rsqrtf(ss_ * (1.0f / 64.0f) + EPS); \
        _Pragma("unroll") for (int j_ = 0; j_ < 8; ++j_) kf_[j_] = kf_[j_] * rk_ * kgv[j_]; \
        const int slot_ = (rho) & 7; \
        *(LAS u32x4*)(KL + (slot_ * 64 + scol) * 36 + schunk * 4) = pack8(kf_); \
        const unsigned vw_[4] = {vr.x, vr.y, vr.z, vr.w}; \
        _Pragma("unroll") for (int j_ = 0; j_ < 8; ++j_) VT16[(slot_ * 64 + 8 * schunk + j_) * 72 + scol] = (unsigned short)((j_ & 1) ? (vw_[j_ >> 1] >> 16) : (vw_[j_ >> 1] & 0xffffu)); } while (0)
    {
        __syncthreads();
#pragma unroll 1
        for (int b = 0; b < 2; ++b) {
            u32x4 kr[4], vr[4];
#pragma unroll
            for (int i = 0; i < 4; ++i) NA_LOAD(rs0 + 4 * b + i, kr[i], vr[i]);
#pragma unroll
            for (int i = 0; i < 4; ++i) NA_STORE(rs0 + 4 * b + i, kr[i], vr[i]);
        }
    }
    int nextrow = rs0 + 8;
#pragma unroll 1
    for (int r = r0; r < r0 + NA_RR; ++r) {
        int rs = r - 4; rs = rs < 0 ? 0 : (rs > rows - 8 ? rows - 8 : rs);
        int rsn = r + 1 - 4; rsn = rsn < 0 ? 0 : (rsn > rows - 8 ? rows - 8 : rsn);
        const bool pre = (r + 1 < r0 + NA_RR) && (rsn + 7 >= nextrow);
        u32x4 pk = (u32x4){0u, 0u, 0u, 0u}, pv = (u32x4){0u, 0u, 0u, 0u};
        if (pre) NA_LOAD(nextrow, pk, pv);
        __syncthreads();
        if (F.wave < 4) {
            const int jb = F.wave, qc = 16 * jb + l15;
            int kc0 = 16 * jb - 8; kc0 = kc0 < 0 ? 0 : (kc0 > 32 ? 32 : kc0);
            int cs = qc - 8; cs = cs < 0 ? 0 : (cs > 48 ? 48 : cs);
            bf16x8 qf[2];
            {
                const bf16* zq = Zs + (size_t)(r * 64 + qc) * MIX_IN + ZC_Q + h * 64 + 8 * g4;
                float q0[8], q1[8]; unpack8(*(const u32x4*)zq, q0); unpack8(*(const u32x4*)(zq + 32), q1);
                float ss = 0.f;
#pragma unroll
                for (int j = 0; j < 8; ++j) ss += q0[j] * q0[j] + q1[j] * q1[j];
                ss += __shfl_xor(ss, 16); ss += __shfl_xor(ss, 32);
                const float rq = rsqrtf(ss * (1.0f / 64.0f) + EPS) * 0.125f;
                const f32x4 ga = *(const f32x4*)(qg + 8 * g4), gb = *(const f32x4*)(qg + 8 * g4 + 4), gc = *(const f32x4*)(qg + 32 + 8 * g4), gd = *(const f32x4*)(qg + 32 + 8 * g4 + 4);
#pragma unroll
                for (int j = 0; j < 4; ++j) { q0[j] *= rq * ga[j]; q0[4 + j] *= rq * gb[j]; q1[j] *= rq * gc[j]; q1[4 + j] *= rq * gd[j]; }
                qf[0] = as_frag(pack8(q0)); qf[1] = as_frag(pack8(q1));
            }
            f32x4 S[8][2];
#pragma unroll
            for (int a = 0; a < 8; ++a) {
                const int slot = (rs + a) & 7;
#pragma unroll
                for (int kb2 = 0; kb2 < 2; ++kb2) {
                    const LAS unsigned* kp = KL + (slot * 64 + kc0 + 16 * kb2 + l15) * 36 + 4 * g4;
                    S[a][kb2] = mfma16(as_frag(*(const LAS u32x4*)kp), qf[0], (f32x4){0.f, 0.f, 0.f, 0.f});
                    S[a][kb2] = mfma16(as_frag(*(const LAS u32x4*)(kp + 16)), qf[1], S[a][kb2]);
                }
            }
            MFMA_DRAIN();
            float mx = -3.0e38f;
#pragma unroll
            for (int a = 0; a < 8; ++a) {
                const int dr = rs + a - r + 7;
#pragma unroll
                for (int kb2 = 0; kb2 < 2; ++kb2)
#pragma unroll
                    for (int q = 0; q < 4; ++q) {
                        const int kc = kc0 + 16 * kb2 + 4 * g4 + q; const bool valid = (kc >= cs) && (kc < cs + 16);
                        int dc = kc - qc + 15; dc = dc < 0 ? 0 : (dc > 30 ? 30 : dc);
                        const float s = valid ? S[a][kb2][q] + BIAS[dr * 31 + dc] : -1.0e30f;
                        S[a][kb2][q] = s; mx = fmaxf(mx, s);
                    }
            }
            mx = fmaxf(mx, __shfl_xor(mx, 16)); mx = fmaxf(mx, __shfl_xor(mx, 32));
            float sum = 0.f;
#pragma unroll
            for (int a = 0; a < 8; ++a)
#pragma unroll
                for (int kb2 = 0; kb2 < 2; ++kb2)
#pragma unroll
                    for (int q = 0; q < 4; ++q) { const float p = __expf(S[a][kb2][q] - mx); S[a][kb2][q] = p; sum += p; }
            sum += __shfl_xor(sum, 16); sum += __shfl_xor(sum, 32);
            const float rinv = 1.0f / sum;
            f32x4 O[4];
#pragma unroll
            for (int dt = 0; dt < 4; ++dt) O[dt] = (f32x4){0.f, 0.f, 0.f, 0.f};
#pragma unroll
            for (int a = 0; a < 8; ++a) {
                const int slot = (rs + a) & 7;
                u32x4 pw; pw.x = cvt_pk_bf16(S[a][0][0], S[a][0][1]); pw.y = cvt_pk_bf16(S[a][0][2], S[a][0][3]); pw.z = cvt_pk_bf16(S[a][1][0], S[a][1][1]); pw.w = cvt_pk_bf16(S[a][1][2], S[a][1][3]);
                const bf16x8 pf = as_frag(pw);
#pragma unroll
                for (int dt = 0; dt < 4; ++dt) {
                    const LAS unsigned* vp = VT + (slot * 64 + 16 * dt + l15) * 36 + (kc0 >> 1) + 2 * g4;
                    const u32x2 v0 = *(const LAS u32x2*)vp, v1 = *(const LAS u32x2*)(vp + 8);
                    u32x4 vw; vw.x = v0.x; vw.y = v0.y; vw.z = v1.x; vw.w = v1.y;
                    O[dt] = mfma16(as_frag(vw), pf, O[dt]);
                }
            }
            MFMA_DRAIN();
            bf16* yo = YSs + (size_t)(r * 64 + qc) * D_MODEL + 1024 + h * 64 + 4 * g4;
#pragma unroll
            for (int dt = 0; dt < 4; ++dt) { u32x2 w; w.x = cvt_pk_bf16(O[dt][0] * rinv, O[dt][1] * rinv); w.y = cvt_pk_bf16(O[dt][2] * rinv, O[dt][3] * rinv); *(u32x2*)(yo + 16 * dt) = w; }
        }
        __syncthreads();
        if (pre) { NA_STORE(nextrow, pk, pv); nextrow += 1; }
    }
#undef NA_LOAD
#undef NA_STORE
}


#if defined(MK_PROBE)
#define PRB_FLAGS(F) ((unsigned*)((F).ws + WS_CTL + 512 * 1024))
__device__ __forceinline__ bool prb_big_bf(u32x4 w, unsigned ethr) { const unsigned v[4] = {w.x, w.y, w.z, w.w}; bool b = false;
#pragma unroll
    for (int i = 0; i < 4; ++i) b = b || (((v[i] >> 7) & 0xffu) >= ethr) || (((v[i] >> 23) & 0xffu) >= ethr); return b; }
__device__ __forceinline__ bool prb_big_f(f32x4 a, unsigned ethr) { bool b = false;
#pragma unroll
    for (int i = 0; i < 4; ++i) b = b || (((__float_as_uint(a[i]) >> 23) & 0xffu) >= ethr); return b; }
#define PRB(cond, bit) do { if (cond) atomicOr(PRB_FLAGS(F), 1u << (bit)); } while (0)
#else
#define PRB(cond, bit) do { } while (0)
#endif
constexpr int FN_XT = 0, FN_YR = 34816, FN_YI = 34816 + 34816;
template <int N1>
__device__ __forceinline__ void fnet1_tile(Frame& F, const bf16* Zs, bf16* ZFsg  , int g, int l2, const bf16* CT1, const bf16* ST1  , const bf16* C128, const bf16* S128) {
    constexpr int XS = N1 + 8, JT = N1 / 16, KS1 = N1 / 32;
    LAS unsigned short* XT = (LAS unsigned short*)(F.lds + FN_XT); LAS unsigned short* YR = (LAS unsigned short*)(F.lds + FN_YR); LAS unsigned short* YI = (LAS unsigned short*)(F.lds + FN_YI);
    const int tid = F.tid, lane = F.lane, l15 = lane & 15, g4 = lane >> 4, w = F.wave;
    __syncthreads();
    {
        constexpr int NI = (N1 * 16) / 512;
        u32x4 raw[NI];
#pragma unroll
        for (int i = 0; i < NI; ++i) { const int idx = tid + 512 * i, l1 = idx >> 4, ch = idx & 15; raw[i] = *(const u32x4*)(Zs + (size_t)(128 * l1 + l2) * MIX_IN + ZC_UD + g * 128 + 8 * ch); }
#pragma unroll
        for (int i = 0; i < NI; ++i) { const int idx = tid + 512 * i, l1 = idx >> 4, ch = idx & 15;
            const unsigned rw[4] = {raw[i].x, raw[i].y, raw[i].z, raw[i].w};
#pragma unroll
            for (int j = 0; j < 8; ++j) XT[(8 * ch + j) * XS + l1] = (unsigned short)((j & 1) ? (rw[j >> 1] >> 16) : (rw[j >> 1] & 0xffffu)); }
    }
    __syncthreads();
    {
        bf16x8 af[KS1];
#pragma unroll
        for (int ks = 0; ks < KS1; ++ks) { af[ks] = as_frag(*(const LAS u32x4*)(XT + (16 * w + l15) * XS + 32 * ks + 8 * g4)); }
#pragma unroll 1
        for (int tj = 0; tj < JT; ++tj) {
            const int k1 = 16 * tj + l15;
            f32x4 ar = (f32x4){0.f, 0.f, 0.f, 0.f}, as = (f32x4){0.f, 0.f, 0.f, 0.f};
#pragma unroll
            for (int ks = 0; ks < KS1; ++ks) {
                ar = mfma16(af[ks], as_frag(*(const u32x4*)(CT1 + k1 * N1 + 32 * ks + 8 * g4)), ar);
                as = mfma16(af[ks], as_frag(*(const u32x4*)(ST1 + k1 * N1 + 32 * ks + 8 * g4)), as);
            }
            MFMA_DRAIN();
            float tsn, tcs; sincospif((float)(k1 * l2) * (2.0f / (float)(N1 * 128)), &tsn, &tcs);
            float zr[4], zi[4];
#pragma unroll
            for (int q = 0; q < 4; ++q) { const float yr = ar[q], yi = -as[q]; zr[q] = yr * tcs + yi * tsn; zi[q] = yi * tcs - yr * tsn; }
            u32x2 wr2, wi2; wr2.x = cvt_pk_bf16(zr[0], zr[1]); wr2.y = cvt_pk_bf16(zr[2], zr[3]); wi2.x = cvt_pk_bf16(zi[0], zi[1]); wi2.y = cvt_pk_bf16(zi[2], zi[3]);
            *(LAS u32x2*)(YR + k1 * 136 + 16 * w + 4 * g4) = wr2; *(LAS u32x2*)(YI + k1 * 136 + 16 * w + 4 * g4) = wi2;
        }
    }
    __syncthreads();
    {
        bf16x8 cfr[4], sfr[4];
#pragma unroll
        for (int ks = 0; ks < 4; ++ks) { cfr[ks] = as_frag(*(const u32x4*)(C128 + (16 * w + l15) * 128 + 32 * ks + 8 * g4)); sfr[ks] = as_frag(*(const u32x4*)(S128 + (16 * w + l15) * 128 + 32 * ks + 8 * g4)); }
#pragma unroll 1
        for (int tj = 0; tj < JT; ++tj) {
            const int k1 = 16 * tj + l15;
            f32x4 zr = (f32x4){0.f, 0.f, 0.f, 0.f}, zi = (f32x4){0.f, 0.f, 0.f, 0.f};
#pragma unroll
            for (int ks = 0; ks < 4; ++ks) {
                const u32x4 yr = *(const LAS u32x4*)(YR + k1 * 136 + 32 * ks + 8 * g4), yi = *(const LAS u32x4*)(YI + k1 * 136 + 32 * ks + 8 * g4);
                u32x4 ny; ny.x = yr.x ^ 0x80008000u; ny.y = yr.y ^ 0x80008000u; ny.z = yr.z ^ 0x80008000u; ny.w = yr.w ^ 0x80008000u;
                zr = mfma16(cfr[ks], as_frag(yr), zr); zr = mfma16(sfr[ks], as_frag(yi), zr);
                zi = mfma16(cfr[ks], as_frag(yi), zi); zi = mfma16(sfr[ks], as_frag(ny), zi);
            }
            MFMA_DRAIN();
            bf16* zo = ZFsg + ((size_t)k1 * 128 + l2) * 256 + 16 * w + 4 * g4;
            u32x2 a, b; a.x = cvt_pk_bf16(zr[0], zr[1]); a.y = cvt_pk_bf16(zr[2], zr[3]); b.x = cvt_pk_bf16(zi[0], zi[1]); b.y = cvt_pk_bf16(zi[2], zi[3]);
            *(u32x2*)zo = a; *(u32x2*)(zo + 128) = b;
        }
    }
}
__device__ __forceinline__ void fnet2_tile(Frame& F, const bf16* ZFsg, bf16* YSs  , int g, int k1, int N1, const bf16* C128, const bf16* S128) {
    LAS unsigned short* ZT = (LAS unsigned short*)F.lds;
    const int tid = F.tid, lane = F.lane, l15 = lane & 15, g4 = lane >> 4, w = F.wave;
    __syncthreads();
    const bf16* src = ZFsg + (size_t)k1 * 128 * 256;
    {
        u32x4 raw[8];
#pragma unroll
        for (int i = 0; i < 8; ++i) { const int idx = tid + 512 * i, l2 = idx >> 5, ch = idx & 31; raw[i] = *(const u32x4*)(src + (size_t)l2 * 256 + 8 * ch); }
#pragma unroll
        for (int i = 0; i < 8; ++i) { const int idx = tid + 512 * i, l2 = idx >> 5, ch = idx & 31;
            const unsigned rw[4] = {raw[i].x, raw[i].y, raw[i].z, raw[i].w};
#pragma unroll
            for (int j = 0; j < 8; ++j) ZT[(8 * ch + j) * 136 + l2] = (unsigned short)((j & 1) ? (rw[j >> 1] >> 16) : (rw[j >> 1] & 0xffffu)); }
    }
    __syncthreads();
    bf16x8 zrf[4], zif[4];
#pragma unroll
    for (int ks = 0; ks < 4; ++ks) { zrf[ks] = as_frag(*(const LAS u32x4*)(ZT + (16 * w + l15) * 136 + 32 * ks + 8 * g4)); zif[ks] = as_frag(*(const LAS u32x4*)(ZT + (128 + 16 * w + l15) * 136 + 32 * ks + 8 * g4)); }
#pragma unroll 1
    for (int tj = 0; tj < 8; ++tj) {
        const int k2 = 16 * tj + l15;
        f32x4 y = (f32x4){0.f, 0.f, 0.f, 0.f};
#pragma unroll
        for (int ks = 0; ks < 4; ++ks) {
            y = mfma16(zrf[ks], as_frag(*(const u32x4*)(C128 + k2 * 128 + 32 * ks + 8 * g4)), y);
            y = mfma16(zif[ks], as_frag(*(const u32x4*)(S128 + k2 * 128 + 32 * ks + 8 * g4)), y);
        }
        MFMA_DRAIN();
        u32x2 o; o.x = cvt_pk_bf16(y[0], y[1]); o.y = cvt_pk_bf16(y[2], y[3]);
        *(u32x2*)(YSs + (size_t)(k1 + N1 * k2) * D_MODEL + 1536 + g * 128 + 16 * w + 4 * g4) = o;
    }
}

struct ChunkGeo { int nseq, lseq, rows, n1; };
__device__ __forceinline__ ChunkGeo chunk_geo(int ch) { ChunkGeo g; if (ch < 2) { g.nseq = 1; g.lseq = 16384; g.rows = 256; g.n1 = 128; } else { g.nseq = 4; g.lseq = 4096; g.rows = 64; g.n1 = 32; } return g; }

__device__ __forceinline__ void ph_s5a(Frame& F, const Args& A, int layer, int ch) {
    const ChunkGeo cg = chunk_geo(ch);
    const bf16* Z = (const bf16*)(F.ws + WS_Z); f32x2* EV = (f32x2*)(F.ws + WS_S5E);
    const int nseg = cg.lseq / S5_SEG, ntask = cg.nseq * nseg * 64;
#pragma unroll 1
    for (int tt = F.vcu * 8 + F.wave; tt < ntask; tt += F.G * 8) {
        const int dg = tt & 63, sg = tt >> 6, seg = sg % nseg, seq = sg / nseg, dir = dg >> 5, g = dg & 31;
        const unsigned char* tb = F.ws + TAB_S5 + (size_t)(((layer * 2 + dir) * 32) + g) * S5T_BYTES;
        s5_seg_task<false>(F, tb, Z + (size_t)seq * cg.lseq * MIX_IN, nullptr, EV + (size_t)(seq * 64 + dg) * nseg * 64, nseg, seg, dir, g);
    }
    int t0 = F.vcu; asm volatile("" : "+s"(t0));
    bf16* YS = (bf16*)(F.ws + WS_YS); bf16* ZF = (bf16*)(F.ws + WS_ZF);
    const int n_f1 = 512, n_cv = CH_TOK / 64;
#pragma unroll 1
    for (; t0 < n_f1 + n_cv; t0 += F.G) {
        if (t0 < n_f1) {
            const int u = t0;
            const bf16* C128 = (const bf16*)(F.ws + TAB_C128); const bf16* S128 = (const bf16*)(F.ws + TAB_S128);
            if (ch < 2) { const int g = u >> 7, l2 = u & 127;
                fnet1_tile<128>(F, Z, ZF + (size_t)g * 16384 * 256, g, l2, C128, S128, C128, S128);
            } else {
                const bf16* C32 = (const bf16*)(F.ws + TAB_C32); const bf16* S32 = (const bf16*)(F.ws + TAB_S32);
#pragma unroll 1
                for (int s = 0; s < 4; ++s) { const int uu = u * 4 + s, l2 = uu & 127, g = (uu >> 7) & 3, seq = uu >> 9;
                    fnet1_tile<32>(F, Z + (size_t)seq * 4096 * MIX_IN, ZF + (size_t)(seq * 4 + g) * 4096 * 256, g, l2, C32, S32, C128, S128); }
            }
        } else {
            conv_block(F, Z, YS, A.in[15] + (size_t)layer * 3 * 512, t0 - n_f1, cg.lseq);
        }
    }
}
__device__ __forceinline__ void ph_mix1(Frame& F, const Args& A, int layer, int ch) {
    const ChunkGeo cg = chunk_geo(ch);
    const bf16* Z = (const bf16*)(F.ws + WS_Z); bf16* YS = (bf16*)(F.ws + WS_YS); const bf16* ZF = (const bf16*)(F.ws + WS_ZF);
    float* YF = (float*)(F.ws + WS_YF); float* YB = (float*)(F.ws + WS_YB); f32x2* EV = (f32x2*)(F.ws + WS_S5E);
    const int nseg = cg.lseq / S5_SEG;
    const int n_s5 = cg.nseq * nseg * 8;
    const int n_na = cg.nseq * 8 * (cg.rows / NA_RR);
    const int n_f2 = 512;
    int t0 = F.vcu;
#pragma unroll 1
    for (; t0 < n_s5; t0 += F.G) {
        const int tt = t0 * 8 + F.wave, dg = tt & 63, sg = tt >> 6, seg = sg % nseg, seq = sg / nseg, dir = dg >> 5, g = dg & 31;
        const unsigned char* tb = F.ws + TAB_S5 + (size_t)(((layer * 2 + dir) * 32) + g) * S5T_BYTES;
        const size_t row0 = (size_t)seq * cg.lseq;
#if defined(MK_X2_S5B)
#pragma unroll 1
        for (int rep = 0; rep < 2; ++rep)
#endif
        s5_seg_task<true>(F, tb, Z + row0 * MIX_IN, (dir ? YB : YF) + row0 * 512, EV + (size_t)(seq * 64 + dg) * nseg * 64, nseg, seg, dir, g);
    }
    asm volatile("" : "+s"(t0));
#pragma unroll 1
    for (; t0 < n_s5 + n_na + n_f2; t0 += F.G) {
        const int t = t0 - n_s5;
        if (t < n_na) {
            const int runs = cg.rows / NA_RR, run = t % runs, h = (t / runs) & 7, seq = t / (runs * 8);
            const size_t row0 = (size_t)seq * cg.lseq;
#if defined(MK_X2_NA)
#pragma unroll 1
            for (int rep = 0; rep < 2; ++rep)
#endif
            na_task(F, Z + row0 * MIX_IN, YS + row0 * D_MODEL, cg.rows, h, run * NA_RR, A.in[16] + layer * 64, A.in[17] + layer * 64, A.in[18] + ((size_t)layer * 8 + h) * 15 * 31);
        } else {
            const int u = t - n_na;
            const bf16* C128 = (const bf16*)(F.ws + TAB_C128); const bf16* S128 = (const bf16*)(F.ws + TAB_S128);
            int seq, g, k1; if (ch < 2) { seq = 0; g = u >> 7; k1 = u & 127; } else { k1 = u & 31; g = (u >> 5) & 3; seq = u >> 7; }
#if defined(MK_X2_F2)
#pragma unroll 1
            for (int rep = 0; rep < 2; ++rep)
#endif
            fnet2_tile(F, ZF + (size_t)(seq * 4 + g) * cg.lseq * 256, YS + (size_t)seq * cg.lseq * D_MODEL, g, k1, cg.n1, C128, S128);
        }
    }
}
__device__ __forceinline__ void ph_mix2(Frame& F, const Args& A, int layer, int ch) {
    const bf16* Z = (const bf16*)(F.ws + WS_Z);
    const float* YF = (const float*)(F.ws + WS_YF); const float* YB = (const float*)(F.ws + WS_YB); bf16* Y1 = (bf16*)(F.ws + WS_Y1);
    (void)ch;
#pragma unroll 1
    for (int t = F.vcu; t < CH_TOK / 64; t += F.G) s5fin_block(F, Z, YF, YB, A.in[13] + (size_t)layer * 512, Y1, t);
}

constexpr int PH_A = 8, PH_PER_LAYER = 3 * PH_A + 1 + 3 + 3, N_PHASES = 1 + DEPTH * PH_PER_LAYER;
__global__ void __launch_bounds__(NWAVES * 64, 2) fwd_kernel(const Args A) {
    extern __shared__ __attribute__((aligned(16))) unsigned char lds_raw[];
    Frame F;
    F.lds = (LAS unsigned char*)lds_raw;
    F.tid = threadIdx.x; F.lane = F.tid & 63; F.wave = __builtin_amdgcn_readfirstlane(F.tid >> 6);
    F.G = gridDim.x; { const int bx = blockIdx.x; F.vcu = (F.G % 8 == 0) ? (bx % 8) * (F.G / 8) + bx / 8 : bx; }
    F.ws = A.ws;
    volatile LAS unsigned* LCTL = (volatile LAS unsigned*)(F.lds + LDSCTL_OFF);
    if (F.tid < 64) LCTL[F.tid] = 0u;
    __syncthreads();
    const int lo = A.ph_lo, hi = A.ph_hi;
    const bool multi = (hi - lo) > 1;
    XcdBarrier bar; bar.bar = (unsigned*)(F.ws + WS_CTL) + CW_BAR; bar.x = 0; bar.st = LCTL;
    if (multi) bar = xcd_barrier_post((unsigned*)(F.ws + WS_CTL) + CW_BAR, LCTL);
#define IN(k) (lo <= (k) && (k) < hi)
#define SEAM(k) do { if ((k) + 1 < hi) xcd_barrier(bar); } while (0)

    if (IN(0)) { Frame Fp = fresh(F); ph_prologue(Fp, A); SEAM(0); }

#pragma unroll 1
    for (int layer = 0; layer < DEPTH; ++layer) {
        const int pl = 1 + layer * PH_PER_LAYER;
        if (pl + PH_PER_LAYER <= lo || pl >= hi) continue;
        const unsigned char* wl = F.ws + WS_W + (size_t)layer * WL_BYTES;
        bf16* H = (bf16*)(F.ws + WS_H); bf16* Z = (bf16*)(F.ws + WS_Z); bf16* YS = (bf16*)(F.ws + WS_YS); bf16* MGA = (bf16*)(F.ws + WS_MG); bf16* GT = (bf16*)(F.ws + WS_GT);
        bf16* Y1 = (bf16*)(F.ws + WS_Y1); bf16* P16 = (bf16*)(F.ws + WS_P16); bf16* PP = (bf16*)(F.ws + WS_PP); float* MACC = (float*)(F.ws + WS_Z); bf16* HALL = (bf16*)(F.ws + WS_HALL);
#pragma unroll 1
        for (int ch = 0; ch < N_CHUNK; ++ch) {
            const int pb = pl + ch * PH_A;
            const float* x_cur = layer == 0 ? ((ch < 2) ? A.in[0] + (size_t)ch * CH_TOK * D_MODEL : A.in[1]) : A.out + (size_t)ch * CH_TOK * D_MODEL;
            bf16* MG = MGA + (size_t)ch * CH_TOK * D_MODEL;
            if (IN(pb + 0)) { Frame Fp = fresh(F); ph_norm(Fp, x_cur, A.in[4] + (size_t)layer * D_MODEL, H, CH_TOK); SEAM(pb + 0); }
            if (IN(pb + 1)) {
                pg8::Gemm g{H, (const bf16*)(wl + WL_MIX), D_MODEL, D_MODEL, D_MODEL, 0, 0, 0}; pg8::StaticOrder S; S.init(CH_TOK, MIX_IN, F.G, (int)blockIdx.x);
                pg8::EpiStoreBf16 E{Z, MIX_IN};
                pg8::gemm_phase<pg8::EpiStoreBf16, pg8::StaticOrder, true, true>(F.lds, g, S, E);
                SEAM(pb + 1); }
            if (IN(pb + 2)) { Frame Fp = fresh(F); ph_s5a(Fp, A, layer, ch); SEAM(pb + 2); }
            if (IN(pb + 3)) { Frame Fp = fresh(F); ph_mix1(Fp, A, layer, ch); SEAM(pb + 3); }
            if (IN(pb + 4)) { Frame Fp = fresh(F); ph_mix2(Fp, A, layer, ch); SEAM(pb + 4); }
            if (IN(pb + 5)) {
                pg8::Gemm g{Y1, (const bf16*)(wl + WL_GLU), 512, 512, 512, 0, 0, 0}; pg8::StaticOrder S; S.init(CH_TOK, 512, F.G, (int)blockIdx.x);
                pg8::EpiGlu E{Y1, 512, YS, D_MODEL};
                pg8::gemm_phase<pg8::EpiGlu, pg8::StaticOrder, true, true>(F.lds, g, S, E);
                SEAM(pb + 5); }
            if (IN(pb + 6)) {
                pg8::Gemm g{YS, (const bf16*)(wl + WL_BR), D_MODEL, 512, 512, 3, 512, 0}; pg8::StaticOrder S; S.init(CH_TOK, 8192, F.G, (int)blockIdx.x);
                pg8::EpiStoreBf16 E{GT, 8192};
                pg8::gemm_phase<pg8::EpiStoreBf16, pg8::StaticOrder, true, true>(F.lds, g, S, E);
                SEAM(pb + 6); }
            if (IN(pb + 7)) {
                pg8::Gemm g{H, (const bf16*)(wl + WL_G), D_MODEL, D_MODEL, D_MODEL, 0, 0, 1}; pg8::MergeOrder S; S.init(CH_TOK, F.G, (int)blockIdx.x);
                pg8::EpiMerge E{GT, MACC, MG};
                pg8::gemm_phase<pg8::EpiMerge, pg8::MergeOrder, true, true>(F.lds, g, S, E);
                SEAM(pb + 7); }
        }
        {
            const int pb = pl + 3 * PH_A;
            if (IN(pb)) {
                pg8::Gemm g{MGA, (const bf16*)(wl + WL_O), D_MODEL, D_MODEL, D_MODEL, 0, 0, 0}; pg8::StaticOrder S; S.init(NTOK, D_MODEL, F.G, (int)blockIdx.x);
                pg8::EpiResF32 E{layer == 0 ? A.in[0] : A.out, layer == 0 ? A.in[1] : A.out + (size_t)32768 * D_MODEL, 32768, A.out, D_MODEL};
                pg8::gemm_phase<pg8::EpiResF32, pg8::StaticOrder, true, true>(F.lds, g, S, E);
                SEAM(pb); }
        }
        {
            const int pb = pl + 3 * PH_A + 1;
            bf16* H2 = (bf16*)(F.ws + WS_H2ALL); bf16* MIDA = (bf16*)(F.ws + WS_MIDALL);
            if (IN(pb + 0)) { Frame Fp = fresh(F); ph_norm(Fp, A.out, A.in[21] + (size_t)layer * D_MODEL, H2, NTOK); SEAM(pb + 0); }
            if (IN(pb + 1)) {
                pg8::Gemm g{H2, (const bf16*)(wl + WL_FF), D_MODEL, D_MODEL, D_MODEL, 0, 0, 0}; pg8::StaticOrder S; S.init(NTOK, 2 * D_FF, F.G, (int)blockIdx.x);
                pg8::EpiSwiglu E{MIDA, D_FF};
                pg8::gemm_phase<pg8::EpiSwiglu, pg8::StaticOrder, true, true>(F.lds, g, S, E);
                SEAM(pb + 1); }
            if (IN(pb + 2)) {
                pg8::Gemm g{MIDA, (const bf16*)(wl + WL_FF2), D_FF, D_FF, D_FF, 0, 0, 0}; pg8::StaticOrder S; S.init(NTOK, D_MODEL, F.G, (int)blockIdx.x);
                pg8::EpiResF32 E{A.out, A.out, 1 << 30, A.out, D_MODEL};
                pg8::gemm_phase<pg8::EpiResF32, pg8::StaticOrder, true, true>(F.lds, g, S, E);
                SEAM(pb + 2); }
        }
        {
            const int pb = pl + 3 * PH_A + 1 + 3;
            if (IN(pb + 0)) { Frame Fp = fresh(F); ph_norm(Fp, A.out, A.in[24] + (size_t)layer * D_MODEL, HALL, NTOK);
                ph_pcvt(Fp, A.in[2] + (size_t)layer * 32768 * PLE_DIM, A.in[3] + (size_t)layer * CH_TOK * PLE_DIM, P16); SEAM(pb + 0); }
            if (IN(pb + 1)) {
                int kpp = PLE_DIM; asm volatile("" : "+s"(kpp));
                pg8::Gemm g{P16, (const bf16*)(wl + WL_PP), kpp, kpp, kpp, 0, 0, 0}; pg8::StaticOrder S; S.init(NTOK, D_MODEL, F.G, (int)blockIdx.x);
                pg8::EpiStoreBf16 E{PP, D_MODEL};
                pg8::gemm_phase<pg8::EpiStoreBf16, pg8::StaticOrder, true, true>(F.lds, g, S, E);
                SEAM(pb + 1); }
            if (IN(pb + 2)) {
                pg8::Gemm g{HALL, (const bf16*)(wl + WL_PG), D_MODEL, D_MODEL, D_MODEL, 0, 0, 0}; pg8::StaticOrder S; S.init(NTOK, D_MODEL, F.G, (int)blockIdx.x);
                pg8::EpiPle E{A.out, A.out, D_MODEL, PP, D_MODEL};
                pg8::gemm_phase<pg8::EpiPle, pg8::StaticOrder, true, true>(F.lds, g, S, E);
                SEAM(pb + 2); }
        }
    }
#undef IN
#undef SEAM
}

#ifndef MK_PER_PHASE
#define MK_PER_PHASE 0
#endif
extern "C" void kernel_launch(void* const* d_in, const int* in_sizes, int n_in, void* d_out, int out_size, void* d_ws, size_t ws_size, hipStream_t stream) {
    static int grid = 0;
    if (grid == 0) {
        if (n_in != 27 || out_size != NTOK * D_MODEL || ws_size < WS_END) { fprintf(stderr, "kernel_launch: unexpected shapes (n_in %d, out %d, ws %zu); nothing launched\n", n_in, out_size, ws_size); grid = -1; return; }
        int dev = 0, cus = 0, per_cu = 0;
        if (hipGetDevice(&dev) != hipSuccess || hipDeviceGetAttribute(&cus, hipDeviceAttributeMultiprocessorCount, dev) != hipSuccess) { grid = -1; return; }
        if (hipFuncSetAttribute((const void*)fwd_kernel, hipFuncAttributeMaxDynamicSharedMemorySize, LDS_BYTES) != hipSuccess) { fprintf(stderr, "kernel_launch: hipFuncSetAttribute failed\n"); grid = -1; return; }
        if (hipOccupancyMaxActiveBlocksPerMultiprocessor(&per_cu, (const void*)fwd_kernel, NWAVES * 64, LDS_BYTES) != hipSuccess || per_cu < 1)
            fprintf(stderr, "kernel_launch: occupancy query reports %d workgroups per CU\n", per_cu);
        (void)hipGetLastError();
        grid = cus;
    }
    if (grid < 0) return;
    (void)in_sizes;
    if (hipMemsetAsync((char*)d_ws + WS_CTL, 0, CTL_ZERO_BYTES, stream) != hipSuccess) return;
    Args a{};
    for (int i = 0; i < 27; ++i) a.in[i] = (const float*)d_in[i];
    a.out = (float*)d_out; a.ws = (unsigned char*)d_ws;
#if MK_PER_PHASE
    for (int p = 0; p < N_PHASES; ++p) { a.ph_lo = p; a.ph_hi = p + 1; hipLaunchKernelGGL(fwd_kernel, dim3(grid), dim3(NWAVES * 64), LDS_BYTES, stream, a); }
#else
    a.ph_lo = 0; a.ph_hi = N_PHASES;
    hipLaunchKernelGGL(fwd_kernel, dim3(grid), dim3(NWAVES * 64), LDS_BYTES, stream, a);
#endif
}
```

```cpp
#include <hip/hip_runtime.h>
#include <cstdio>
#include <cstdint>

namespace pg8 {
#define PG8_LAS __attribute__((address_space(3)))
typedef unsigned short bf16_t;
typedef short bf16x8 __attribute__((ext_vector_type(8)));
typedef float f32x4 __attribute__((ext_vector_type(4)));
typedef float f32x2 __attribute__((ext_vector_type(2)));
typedef unsigned u32x4 __attribute__((ext_vector_type(4)));
typedef unsigned u32x2 __attribute__((ext_vector_type(2)));
constexpr int BM = 256, BK = 64, HALF = 128, HTB = HALF * BK * 2  , STAGE_BYTES = 8 * HTB, NXCD = 8, WGM = 8;

__host__ __device__ __forceinline__ int lds_byte(int r, int c) { const int st = (r >> 4) * 2 + (c >> 5), rr = r & 15, cc = c & 31, ob = rr * 64 + cc * 2; return st * 1024 + (ob ^ (((ob >> 9) & 1) << 5)); }
__host__ __device__ __forceinline__ void stage_rc(int b, int& R, int& C) { const int st = b / 1024, sb = b % 1024, swz = sb ^ (((sb >> 9) & 1) << 5); R = (st >> 1) * 16 + swz / 64; C = (st & 1) * 32 + (swz % 64) / 2; }
__host__ __device__ __forceinline__ int perm32(int rho) { const int n = rho >> 4, i = rho & 15; return 8 * (i >> 2) + 4 * n + (i & 3); }

struct Unit { int pm, pn; };
struct Gemm { const bf16_t* A; const bf16_t* Bt; int lda, ldb, K, agrp_shift, agrp_stride, bmode, stagger; };

__device__ __forceinline__ void tile_of(int wgid, int nwg, int nM, int nN, int& pm, int& pn) {
    { const int q = nwg / NXCD, r = nwg % NXCD, xcd = wgid % NXCD, off = wgid / NXCD; wgid = (xcd < r ? xcd * (q + 1) : r * (q + 1) + (xcd - r) * q) + off; }
    const int nig = WGM * nN, gid = wgid / nig, fm = gid * WGM, gsz = (nM - fm) < WGM ? (nM - fm) : WGM;
    pm = fm + ((wgid % nig) % gsz); pn = (wgid % nig) / gsz;
}
struct StaticOrder {
    int nM, nN, nwg, G, c;
    __device__ __forceinline__ void init(int M, int N, int G_, int c_) { nM = M / BM; nN = N / BM; nwg = nM * nN; G = G_; c = c_; }
    __device__ __forceinline__ bool next(int i, Unit& u) const {
        const long L = (long)i * G + c; if (L >= nwg) return false;
        tile_of((int)L, nwg, nM, nN, u.pm, u.pn); return true;
    }
};
struct MergeOrder {
    int nM, ntile, G, c;
    __device__ __forceinline__ void init(int M, int G_, int c_) { nM = M / BM; ntile = nM * 16; G = G_; c = c_; }
    __device__ __forceinline__ bool next(int i, Unit& u) const {
        const long L = (long)(i >> 1) * G + c; if (L >= ntile) return false;
        int pm, ct; tile_of((int)L, ntile, nM, 16, pm, ct); u.pm = pm; u.pn = (i & 1) * 16 + ct; return true;
    }
};

typedef __bf16 bf16x2_t __attribute__((ext_vector_type(2)));
__device__ __forceinline__ unsigned cvt_pk_bf16(float lo, float hi) { const f32x2 v = {lo, hi}; return __builtin_bit_cast(unsigned, __builtin_convertvector(v, bf16x2_t)); }
__device__ __forceinline__ float bf_lo(unsigned w) { return __uint_as_float(w << 16); }
__device__ __forceinline__ float bf_hi(unsigned w) { return __uint_as_float(w & 0xffff0000u); }
__device__ __forceinline__ float sigmoidf_fast(float x) { return __builtin_amdgcn_rcpf(1.0f + __expf(-x)); }

__device__ __forceinline__ void st16(void* p, u32x4 v) { *(u32x4*)p = v; }
struct EpiStoreBf16 {
    static constexpr bool PERM = true;
    bf16_t* O; int ldc;
    __device__ __forceinline__ void operator()(const f32x4 (&acc)[2][2][4][2], const Unit& u, int wr, int wc, int fr, int fq) const {
        const int row0 = u.pm * BM + wr * 64 + fr, col0 = u.pn * BM + wc * 32 + 8 * fq;
#pragma unroll
        for (int ai = 0; ai < 2; ++ai)
#pragma unroll
            for (int m = 0; m < 4; ++m) { bf16_t* rowp = O + (size_t)(row0 + ai * HALF + m * 16) * ldc + col0;
#pragma unroll
                for (int bj = 0; bj < 2; ++bj) { const f32x4 v0 = acc[ai][bj][m][0], v1 = acc[ai][bj][m][1];
                    u32x4 w; w.x = cvt_pk_bf16(v0[0], v0[1]); w.y = cvt_pk_bf16(v0[2], v0[3]); w.z = cvt_pk_bf16(v1[0], v1[1]); w.w = cvt_pk_bf16(v1[2], v1[3]);
                    st16(rowp + bj * HALF, w); } }
    }
};
struct EpiGlu {
    static constexpr bool PERM = true;
    const bf16_t* Y1; int ld1; bf16_t* O; int ldc;
    __device__ __forceinline__ void operator()(const f32x4 (&acc)[2][2][4][2], const Unit& u, int wr, int wc, int fr, int fq) const {
        const int row0 = u.pm * BM + wr * 64 + fr, col0 = u.pn * BM + wc * 32 + 8 * fq;
        u32x4 y[2][4][2];
#pragma unroll
        for (int ai = 0; ai < 2; ++ai)
#pragma unroll
            for (int m = 0; m < 4; ++m)
#pragma unroll
                for (int bj = 0; bj < 2; ++bj) y[ai][m][bj] = *(const u32x4*)(Y1 + (size_t)(row0 + ai * HALF + m * 16) * ld1 + col0 + bj * HALF);
#pragma unroll
        for (int ai = 0; ai < 2; ++ai)
#pragma unroll
            for (int m = 0; m < 4; ++m) { const size_t r = (size_t)(row0 + ai * HALF + m * 16);
#pragma unroll
                for (int bj = 0; bj < 2; ++bj) { const f32x4 v0 = acc[ai][bj][m][0], v1 = acc[ai][bj][m][1]; const u32x4 yy = y[ai][m][bj];
                    u32x4 w;
                    w.x = cvt_pk_bf16(bf_lo(yy.x) * sigmoidf_fast(v0[0]), bf_hi(yy.x) * sigmoidf_fast(v0[1]));
                    w.y = cvt_pk_bf16(bf_lo(yy.y) * sigmoidf_fast(v0[2]), bf_hi(yy.y) * sigmoidf_fast(v0[3]));
                    w.z = cvt_pk_bf16(bf_lo(yy.z) * sigmoidf_fast(v1[0]), bf_hi(yy.z) * sigmoidf_fast(v1[1]));
                    w.w = cvt_pk_bf16(bf_lo(yy.w) * sigmoidf_fast(v1[2]), bf_hi(yy.w) * sigmoidf_fast(v1[3]));
                    *(u32x4*)(O + r * ldc + col0 + bj * HALF) = w; } }
    }
};
struct EpiMerge {
    static constexpr bool PERM = true;
    const bf16_t* P; bf16_t* MG;
    __device__ __forceinline__ void operator()(const f32x4 (&acc)[2][2][4][2], const Unit& u, int wr, int wc, int fr, int fq) const {
        const int row0 = u.pm * BM + wr * 64 + fr, c = u.pn * 64 + wc * 16 + 4 * fq;
#pragma unroll
        for (int ai = 0; ai < 2; ++ai) {
            u32x2 p[4][4];
#pragma unroll
            for (int m = 0; m < 4; ++m)
#pragma unroll
                for (int kb = 0; kb < 4; ++kb) p[m][kb] = *(const u32x2*)(P + (size_t)(row0 + ai * HALF + m * 16) * 8192 + kb * 2048 + c);
#pragma unroll
            for (int m = 0; m < 4; ++m) { const size_t r = (size_t)(row0 + ai * HALF + m * 16);
                f32x4 t = (f32x4){0.f, 0.f, 0.f, 0.f};
#pragma unroll
                for (int kb = 0; kb < 4; ++kb) { const f32x4 a = acc[ai][kb >> 1][m][kb & 1]; const u32x2 q = p[m][kb];
                    t[0] += bf_lo(q.x) * sigmoidf_fast(a[0]); t[1] += bf_hi(q.x) * sigmoidf_fast(a[1]); t[2] += bf_lo(q.y) * sigmoidf_fast(a[2]); t[3] += bf_hi(q.y) * sigmoidf_fast(a[3]); }
                u32x2 w; w.x = cvt_pk_bf16(t[0], t[1]); w.y = cvt_pk_bf16(t[2], t[3]);
                *(u32x2*)(MG + r * 2048 + c) = w; }
        }
    }
};
struct EpiResF32 {
    static constexpr bool PERM = true;
    const float* base; const float* base2; int split_row; float* out; int ldc;
    __device__ __forceinline__ void operator()(const f32x4 (&acc)[2][2][4][2], const Unit& u, int wr, int wc, int fr, int fq) const {
        const int row0 = u.pm * BM + wr * 64 + fr, col0 = u.pn * BM + wc * 32 + 8 * fq;
        const float* bp = (u.pm * BM >= split_row) ? base2 - (size_t)split_row * ldc : base;
#pragma unroll
        for (int ai = 0; ai < 2; ++ai) {
            f32x4 bs[4][2][2];
#pragma unroll
            for (int m = 0; m < 4; ++m)
#pragma unroll
                for (int bj = 0; bj < 2; ++bj)
#pragma unroll
                    for (int n = 0; n < 2; ++n) bs[m][bj][n] = *(const f32x4*)(bp + (size_t)(row0 + ai * HALF + m * 16) * ldc + col0 + bj * HALF + n * 4);
#pragma unroll
            for (int m = 0; m < 4; ++m)
#pragma unroll
                for (int bj = 0; bj < 2; ++bj)
#pragma unroll
                    for (int n = 0; n < 2; ++n) *(f32x4*)(out + (size_t)(row0 + ai * HALF + m * 16) * ldc + col0 + bj * HALF + n * 4) = bs[m][bj][n] + acc[ai][bj][m][n];
        }
    }
};
struct EpiSwiglu {
    static constexpr bool PERM = true;
    bf16_t* O; int ldc;
    __device__ __forceinline__ void operator()(const f32x4 (&acc)[2][2][4][2], const Unit& u, int wr, int wc, int fr, int fq) const {
        const int row0 = u.pm * BM + wr * 64 + fr, col0 = u.pn * HALF + wc * 32 + 8 * fq;
#pragma unroll
        for (int ai = 0; ai < 2; ++ai)
#pragma unroll
            for (int m = 0; m < 4; ++m) {
                f32x4 t[2];
#pragma unroll
                for (int n = 0; n < 2; ++n)
#pragma unroll
                    for (int j = 0; j < 4; ++j) { const float a = acc[ai][0][m][n][j], b = acc[ai][1][m][n][j]; t[n][j] = a * sigmoidf_fast(a) * b; }
                u32x4 w; w.x = cvt_pk_bf16(t[0][0], t[0][1]); w.y = cvt_pk_bf16(t[0][2], t[0][3]); w.z = cvt_pk_bf16(t[1][0], t[1][1]); w.w = cvt_pk_bf16(t[1][2], t[1][3]);
                st16(O + (size_t)(row0 + ai * HALF + m * 16) * ldc + col0, w); }
    }
};
struct EpiPle {
    static constexpr bool PERM = true;
    const float* base; float* out; int ldc; const bf16_t* PP; int ldp;
    __device__ __forceinline__ void operator()(const f32x4 (&acc)[2][2][4][2], const Unit& u, int wr, int wc, int fr, int fq) const {
        const int row0 = u.pm * BM + wr * 64 + fr, col0 = u.pn * BM + wc * 32 + 8 * fq;
#pragma unroll
        for (int ai = 0; ai < 2; ++ai)
#pragma unroll
            for (int mh = 0; mh < 2; ++mh) {
                f32x4 b0[2][2], b1[2][2]; u32x4 pp[2][2];
#pragma unroll
                for (int mm = 0; mm < 2; ++mm)
#pragma unroll
                    for (int bj = 0; bj < 2; ++bj) { const size_t r = (size_t)(row0 + ai * HALF + (2 * mh + mm) * 16); const int c = col0 + bj * HALF;
                        b0[mm][bj] = *(const f32x4*)(base + r * ldc + c); b1[mm][bj] = *(const f32x4*)(base + r * ldc + c + 4); pp[mm][bj] = *(const u32x4*)(PP + r * ldp + c); }
#pragma unroll
                for (int mm = 0; mm < 2; ++mm)
#pragma unroll
                    for (int bj = 0; bj < 2; ++bj) { const int m = 2 * mh + mm; const size_t r = (size_t)(row0 + ai * HALF + m * 16); const int c = col0 + bj * HALF;
                        const f32x4 a0 = acc[ai][bj][m][0], a1 = acc[ai][bj][m][1]; const u32x4 p = pp[mm][bj];
                        f32x4 o0 = b0[mm][bj], o1 = b1[mm][bj];
                        o0[0] += sigmoidf_fast(a0[0]) * bf_lo(p.x); o0[1] += sigmoidf_fast(a0[1]) * bf_hi(p.x); o0[2] += sigmoidf_fast(a0[2]) * bf_lo(p.y); o0[3] += sigmoidf_fast(a0[3]) * bf_hi(p.y);
                        o1[0] += sigmoidf_fast(a1[0]) * bf_lo(p.z); o1[1] += sigmoidf_fast(a1[1]) * bf_hi(p.z); o1[2] += sigmoidf_fast(a1[2]) * bf_lo(p.w); o1[3] += sigmoidf_fast(a1[3]) * bf_hi(p.w);
                        *(f32x4*)(out + r * ldc + c) = o0; *(f32x4*)(out + r * ldc + c + 4) = o1; }
            }
    }
};
template <class Epi, class Sched, bool ALIGN_EPI = false, bool SP2 = false>
__device__ __forceinline__ void gemm_phase(PG8_LAS unsigned char* lds, const Gemm g, const Sched& S, const Epi& E) {
    int tid_ = threadIdx.x; asm volatile("" : "+v"(tid_));
    const int tid = tid_, wid = __builtin_amdgcn_readfirstlane(tid >> 6), lane = tid & 63, wr = wid >> 2, wc = wid & 3, fr = lane & 15, fq = lane >> 4;
    const int K = g.K, nt = K / BK, lda = g.lda, ldb = g.ldb;
    unsigned voffA[2], voffB[2];
#pragma unroll
    for (int i = 0; i < 2; ++i) { int R, C; stage_rc(tid * 16 + i * 8192, R, C); const int Rb = Epi::PERM ? ((R & ~31) + perm32(R & 31)) : R;
        const int Rg = (g.bmode == 2) ? (((Rb >> 2) & 1) * 2048 + 16 * (Rb >> 5) + 4 * ((Rb >> 3) & 3) + (Rb & 3)) : Rb;
        voffA[i] = (unsigned)(R * lda + C) * 2u; voffB[i] = (unsigned)(Rg * ldb + C) * 2u; }
    const size_t kstep = (size_t)(BK * 2);
    const size_t hstepA = (size_t)HALF * lda * 2, hstepB = (size_t)(g.bmode == 2 ? 4096 : (g.bmode ? 2048 : HALF)) * ldb * 2;
    const size_t tstepA = 2 * hstepA, tstepB = (size_t)BM * ldb * 2;
#define PG8_ABASE(u) ((const char*)g.A + (size_t)(u).pm * tstepA + (size_t)((u).pn >> g.agrp_shift) * (size_t)g.agrp_stride * 2)
#define PG8_BBASE(u) ((const char*)g.Bt + (g.bmode == 2 ? (size_t)((u).pn * 64) * ldb * 2 : (g.bmode ? (size_t)(((u).pn >> 4) * 4096 + ((u).pn & 15) * HALF) * ldb * 2 : (size_t)(u).pn * tstepB)))
    const unsigned ldsw = (unsigned)wid * 1024u;
    const int aoff = lds_byte(wr * 64 + fr, fq * 8), boff = lds_byte(wc * 32 + fr, fq * 8);
#define PG8_SA(b, h) (((b) * 2 + (h)) * HTB)
#define PG8_SB(b, h) ((4 + (b) * 2 + (h)) * HTB)
#define PG8_STAGE(bufoff, gbase, voff) do { _Pragma("unroll") for (int _i = 0; _i < 2; ++_i) \
        __builtin_amdgcn_global_load_lds((const unsigned*)((const char*)(gbase) + (voff)[_i]), (PG8_LAS unsigned*)(lds + (bufoff) + ldsw + _i * 8192), 16, 0, 0); } while (0)
#define PG8_LDA(dst, b, h) do { _Pragma("unroll") for (int m = 0; m < 4; ++m) _Pragma("unroll") for (int k = 0; k < 2; ++k) dst[m][k] = *(const PG8_LAS bf16x8*)(lds + PG8_SA(b, h) + aoff + m * 2048 + k * 1024); } while (0)
#define PG8_LDB(dst, b, h) do { _Pragma("unroll") for (int n = 0; n < 2; ++n) _Pragma("unroll") for (int k = 0; k < 2; ++k) dst[n][k] = *(const PG8_LAS bf16x8*)(lds + PG8_SB(b, h) + boff + n * 2048 + k * 1024); } while (0)
#define PG8_MMA(ai, bj, At, Bt) do { __builtin_amdgcn_s_setprio(1); _Pragma("unroll") for (int m = 0; m < 4; ++m) _Pragma("unroll") for (int n = 0; n < 2; ++n) _Pragma("unroll") for (int k = 0; k < 2; ++k) \
        acc[ai][bj][m][n] = __builtin_amdgcn_mfma_f32_16x16x32_bf16(Bt[n][k], At[m][k], acc[ai][bj][m][n], 0, 0, 0); __builtin_amdgcn_s_setprio(0); } while (0)
#define PG8_WAIT_V(n) asm volatile("s_waitcnt vmcnt(" #n ")" ::: "memory")
#define PG8_WAIT_L(n) asm volatile("s_waitcnt lgkmcnt(" #n ")" ::: "memory")
#define PG8_BAR __builtin_amdgcn_s_barrier()
#define PG8_SCHED __builtin_amdgcn_sched_barrier(0)
    Unit cur, nxt; int ui = 0;
    if (!S.next(0, cur)) return;
    if (g.stagger) { const unsigned long long t0_ = __builtin_amdgcn_s_memrealtime(), d_ = (unsigned long long)(((blockIdx.x >> 3) & 7) * g.stagger);
        while (__builtin_amdgcn_s_memrealtime() - t0_ < d_) __builtin_amdgcn_s_sleep(8); }
    f32x4 acc[2][2][4][2];
#pragma unroll
    for (int a = 0; a < 2; ++a)
#pragma unroll
        for (int b = 0; b < 2; ++b)
#pragma unroll
            for (int m = 0; m < 4; ++m)
#pragma unroll
                for (int n = 0; n < 2; ++n) acc[a][b][m][n] = (f32x4){0.f, 0.f, 0.f, 0.f};
    bf16x8 At[4][2], B0[2][2], B1[2][2];
    const char* cA = PG8_ABASE(cur); const char* cB = PG8_BBASE(cur);
    if constexpr (SP2) {
        PG8_STAGE(PG8_SB(0, 0), cB, voffB); PG8_STAGE(PG8_SB(0, 1), cB + hstepB, voffB); PG8_STAGE(PG8_SA(0, 0), cA, voffA); PG8_STAGE(PG8_SA(0, 1), cA + hstepA, voffA);
        if (wr == 1) PG8_BAR;
        PG8_WAIT_V(2); PG8_BAR;
        PG8_STAGE(PG8_SB(1, 0), cB + kstep, voffB); PG8_STAGE(PG8_SA(1, 0), cA + kstep, voffA); PG8_STAGE(PG8_SB(1, 1), cB + hstepB + kstep, voffB);
        PG8_WAIT_V(6); PG8_BAR;
    } else {
        PG8_STAGE(PG8_SB(0, 0), cB, voffB); PG8_STAGE(PG8_SA(0, 0), cA, voffA); PG8_STAGE(PG8_SB(0, 1), cB + hstepB, voffB); PG8_STAGE(PG8_SA(0, 1), cA + hstepA, voffA);
        if (wr == 1) PG8_BAR;
        PG8_WAIT_V(4); PG8_BAR;
        PG8_STAGE(PG8_SB(1, 0), cB + kstep, voffB); PG8_STAGE(PG8_SA(1, 0), cA + kstep, voffA); PG8_STAGE(PG8_SB(1, 1), cB + hstepB + kstep, voffB);
        PG8_WAIT_V(6); PG8_BAR;
    }
    for (;;) {
        const bool has_next = S.next(ui + 1, nxt);
        const char* nA = has_next ? PG8_ABASE(nxt) : cA; const char* nB = has_next ? PG8_BBASE(nxt) : cB;
        for (int t = 0; t < nt; t += 2) {
            const bool last = (t == nt - 2);
            const char* a1 = cA + (size_t)(t + 1) * kstep;
            const char* a2 = last ? nA : cA + (size_t)(t + 2) * kstep; const char* b2 = last ? nB : cB + (size_t)(t + 2) * kstep;
            const char* a3 = a2 + kstep; const char* b3 = b2 + kstep;
            if constexpr (SP2) {
            PG8_LDB(B0, 0, 0); PG8_LDB(B1, 0, 1); PG8_SCHED; PG8_LDA(At, 0, 0); PG8_STAGE(PG8_SA(1, 1), a1 + hstepA, voffA);
            PG8_WAIT_V(8); PG8_WAIT_L(0); PG8_BAR; PG8_MMA(0, 0, At, B0); PG8_MMA(0, 1, At, B1); PG8_BAR; PG8_SCHED;
            PG8_LDA(At, 0, 1); PG8_STAGE(PG8_SB(0, 0), b2, voffB); PG8_STAGE(PG8_SB(0, 1), b2 + hstepB, voffB); PG8_STAGE(PG8_SA(0, 0), a2, voffA);
            PG8_WAIT_V(8); PG8_WAIT_L(0); PG8_BAR; PG8_MMA(1, 0, At, B0); PG8_MMA(1, 1, At, B1); PG8_BAR; PG8_SCHED;
            PG8_LDB(B0, 1, 0); PG8_LDB(B1, 1, 1); PG8_SCHED; PG8_LDA(At, 1, 0); PG8_STAGE(PG8_SA(0, 1), a2 + hstepA, voffA);
            PG8_WAIT_V(8); PG8_WAIT_L(0); PG8_BAR; PG8_MMA(0, 0, At, B0); PG8_MMA(0, 1, At, B1); PG8_BAR; PG8_SCHED;
            PG8_LDA(At, 1, 1); PG8_STAGE(PG8_SB(1, 0), b3, voffB); PG8_STAGE(PG8_SB(1, 1), b3 + hstepB, voffB); PG8_STAGE(PG8_SA(1, 0), a3, voffA);
            PG8_WAIT_V(8); PG8_WAIT_L(0); PG8_BAR; PG8_MMA(1, 0, At, B0); PG8_MMA(1, 1, At, B1); PG8_BAR; PG8_SCHED;
            } else {
            PG8_LDB(B0, 0, 0); PG8_SCHED; PG8_LDA(At, 0, 0); PG8_STAGE(PG8_SA(1, 1), a1 + hstepA, voffA);
            PG8_WAIT_L(8); PG8_BAR; PG8_WAIT_L(0); PG8_MMA(0, 0, At, B0); PG8_BAR; PG8_SCHED;
            PG8_LDB(B1, 0, 1); PG8_STAGE(PG8_SB(0, 0), b2, voffB);
            PG8_BAR; PG8_WAIT_L(0); PG8_MMA(0, 1, At, B1); PG8_BAR;
            PG8_LDA(At, 0, 1); PG8_STAGE(PG8_SA(0, 0), a2, voffA);
            PG8_BAR; PG8_WAIT_L(0); PG8_MMA(1, 0, At, B0); PG8_BAR; PG8_SCHED;
            PG8_STAGE(PG8_SB(0, 1), b2 + hstepB, voffB);
            PG8_WAIT_V(6); PG8_BAR; PG8_MMA(1, 1, At, B1); PG8_BAR;
            PG8_LDB(B0, 1, 0); PG8_SCHED; PG8_LDA(At, 1, 0); PG8_STAGE(PG8_SA(0, 1), a2 + hstepA, voffA);
            PG8_WAIT_L(8); PG8_BAR; PG8_WAIT_L(0); PG8_MMA(0, 0, At, B0); PG8_BAR; PG8_SCHED;
            PG8_LDB(B1, 1, 1); PG8_STAGE(PG8_SB(1, 0), b3, voffB);
            PG8_BAR; PG8_WAIT_L(0); PG8_MMA(0, 1, At, B1); PG8_BAR;
            PG8_LDA(At, 1, 1); PG8_STAGE(PG8_SA(1, 0), a3, voffA);
            PG8_BAR; PG8_WAIT_L(0); PG8_MMA(1, 0, At, B0); PG8_BAR; PG8_SCHED;
            PG8_STAGE(PG8_SB(1, 1), b3 + hstepB, voffB);
            PG8_WAIT_V(6); PG8_BAR; PG8_MMA(1, 1, At, B1); PG8_BAR;
            }
        }
        if constexpr (ALIGN_EPI) { if (wr == 0) PG8_BAR; }
        { E(acc, cur, wr, wc, fr, fq); }
        if (!has_next) break;
#pragma unroll
        for (int a = 0; a < 2; ++a)
#pragma unroll
            for (int b = 0; b < 2; ++b)
#pragma unroll
                for (int m = 0; m < 4; ++m)
#pragma unroll
                    for (int n = 0; n < 2; ++n) acc[a][b][m][n] = (f32x4){0.f, 0.f, 0.f, 0.f};
        cur = nxt; cA = nA; cB = nB; ++ui;
        if constexpr (ALIGN_EPI) { if (wr == 1) PG8_BAR; }
    }
    PG8_WAIT_V(0);
    if constexpr (!ALIGN_EPI) { if (wr == 0) PG8_BAR; }
    PG8_BAR;
#undef PG8_ABASE
#undef PG8_BBASE
#undef PG8_SA
#undef PG8_SB
#undef PG8_STAGE
#undef PG8_LDA
#undef PG8_LDB
#undef PG8_MMA
#undef PG8_WAIT_V
#undef PG8_WAIT_L
#undef PG8_BAR
#undef PG8_SCHED
}
}


constexpr int D_MODEL = 2048, NTOK = 49152, CH_TOK = 16384, N_CHUNK = 3, DEPTH = 2;
constexpr int MIX_IN = 4096, IN_COLS = 12288, D_FF = 5632, PLE_DIM = 256;
constexpr int ZC_UA = 0, ZC_BG = 512, ZC_CG = 1024, ZC_VB = 1536, ZC_Q = 2048, ZC_K = 2560, ZC_VC = 3072, ZC_UD = 3584;
constexpr float EPS = 1e-6f;
constexpr int NWAVES = 8;

constexpr size_t MiB = 1u << 20;
constexpr size_t WS_CTL = 0, CTL_ZERO_BYTES = 1 * MiB;
constexpr size_t WS_TAB = 1 * MiB;
constexpr size_t S5T_BYTES = 12800, S5T_BB = 0, S5T_C = 8192, S5T_AB = 12288;
constexpr size_t TAB_S5 = WS_TAB, TAB_C128 = WS_TAB + 2 * MiB, TAB_S128 = TAB_C128 + 32768, TAB_C32 = TAB_S128 + 32768, TAB_S32 = TAB_C32 + 2048;
constexpr size_t WS_W = 8 * MiB;
constexpr size_t WL_MIX = 0, WL_G = 16 * MiB, WL_GLU = 48 * MiB, WL_BR = WL_GLU + MiB / 2, WL_O = WL_BR + 8 * MiB, WL_FF = WL_O + 8 * MiB, WL_FF2 = WL_FF + 44 * MiB, WL_PG = WL_FF2 + 22 * MiB, WL_PP = WL_PG + 8 * MiB;
constexpr size_t WL_BYTES = WL_PP + 1 * MiB;
static_assert(WL_BYTES == 139 * MiB + MiB / 2, "weight map");
constexpr size_t WS_H = 288 * MiB;
constexpr size_t WS_Z = 352 * MiB;
constexpr size_t WS_YS = 480 * MiB;
constexpr size_t WS_HALL = 352 * MiB;
constexpr size_t WS_MG = 544 * MiB;
constexpr size_t WS_GT = 736 * MiB;
constexpr size_t WS_YF = WS_GT, WS_YB = WS_GT + 32 * MiB, WS_ZF = WS_GT + 64 * MiB, WS_Y1 = WS_GT + 96 * MiB, WS_S5E = WS_GT + 112 * MiB;
constexpr size_t WS_H2ALL = 288 * MiB, WS_MIDALL = 480 * MiB;
constexpr size_t WS_PP = WS_GT;
constexpr size_t WS_P16 = 992 * MiB;
constexpr size_t WS_END = 1016 * MiB;
static_assert(WS_MIDALL + 528 * MiB <= WS_END && WS_H2ALL + 192 * MiB <= WS_MIDALL, "ffn map");
static_assert(WS_W + 2 * WL_BYTES <= WS_H && WS_MG + 192 * MiB <= WS_GT && WS_GT + 256 * MiB <= WS_P16, "ws map");
constexpr int CW_BAR = 4096;

constexpr int LDS_SCRATCH = 151552;
constexpr int LDSCTL_OFF = LDS_SCRATCH;
constexpr int LDS_BYTES = LDS_SCRATCH + 256;

#define GAS __attribute__((address_space(1)))
#define LAS __attribute__((address_space(3)))
typedef unsigned short bf16;
typedef unsigned u32x4 __attribute__((ext_vector_type(4)));
typedef unsigned u32x2 __attribute__((ext_vector_type(2)));
typedef float f32x4 __attribute__((ext_vector_type(4)));
typedef float f32x2 __attribute__((ext_vector_type(2)));
typedef short bf16x8 __attribute__((ext_vector_type(8)));
#define LDS_WAIT() asm volatile("s_waitcnt lgkmcnt(0)" ::: "memory")
using pg8::cvt_pk_bf16; using pg8::bf_lo; using pg8::bf_hi;
__device__ __forceinline__ bf16x8 as_frag(u32x4 v) { return __builtin_bit_cast(bf16x8, v); }
__device__ __forceinline__ void mfma_acc(f32x4& acc, bf16x8 a, bf16x8 b) { asm volatile("s_nop 1\n\tv_mfma_f32_16x16x32_bf16 %0, %1, %2, %0" : "+v"(acc) : "v"(a), "v"(b)); }
__device__ __forceinline__ f32x4 mfma16(bf16x8 a, bf16x8 b, f32x4 c) { mfma_acc(c, a, b); return c; }
#define MFMA_DRAIN() do { __builtin_amdgcn_sched_barrier(0); asm volatile("s_nop 15\n\ts_nop 15" ::: "memory"); __builtin_amdgcn_sched_barrier(0); } while (0)
__device__ __forceinline__ float wave_sum(float v) {
#pragma unroll
    for (int o = 1; o < 64; o <<= 1) v += __shfl_xor(v, o);
    return v;
}
__device__ __forceinline__ unsigned short f2bf(float f) { return (unsigned short)(cvt_pk_bf16(f, 0.f) & 0xffffu); }

#define XB_TMO      128
#define XB_XCNT(j)  (256  + 64 * (j))
#define XB_XSUB(j)  (1280 + 64 * (j))
#define XB_XGEN(j)  (2304 + 64 * (j))
#define XB_TOP      3328
#define XB_TOPGEN   3392
#define XCD_BAR_WORDS 3456
#define XB_SPIN_CAP (1u << 22)
__device__ __forceinline__ unsigned xb_ld(unsigned* p)              { return __hip_atomic_load(p, __ATOMIC_RELAXED, __HIP_MEMORY_SCOPE_AGENT); }
__device__ __forceinline__ unsigned xb_add(unsigned* p, unsigned v) { return __hip_atomic_fetch_add(p, v, __ATOMIC_RELAXED, __HIP_MEMORY_SCOPE_AGENT); }
__device__ __forceinline__ unsigned xb_xcc_id() { return (unsigned)__builtin_amdgcn_s_getreg((3 << 11) | 20) & 0xFu; }
#define XB_SPIN(cond, bar) do { unsigned _sp = 0; while (cond) { __builtin_amdgcn_s_sleep(1); \
    if ((++_sp & 255u) == 0u) { if (xb_ld(&(bar)[XB_TMO])) break; if (_sp > XB_SPIN_CAP) { atomicAdd(&(bar)[XB_TMO], 1u); break; } } } } while (0)
struct XcdBarrier { unsigned* bar; unsigned x; volatile LAS unsigned* st; };
__device__ __forceinline__ XcdBarrier xcd_barrier_post(unsigned* bar, volatile LAS unsigned* st) {
    XcdBarrier b; b.bar = bar; b.x = xb_xcc_id(); b.st = st;
    if (threadIdx.x == 0) (void)xb_add(&bar[XB_XCNT(b.x)], 1u);
    return b;
}
__device__ __forceinline__ void xcd_barrier_complete(unsigned* bar, unsigned x, unsigned& nloc, unsigned& nx) {
    const unsigned G = gridDim.x * gridDim.y * gridDim.z;
    unsigned sum, cnt, mine, sp = 0u;
    for (;;) {
        sum = 0u; cnt = 0u; mine = 0u;
#pragma unroll
        for (unsigned j = 0; j < 16; ++j) { const unsigned c = xb_ld(&bar[XB_XCNT(j)]); sum += c; cnt += (c > 0u) ? 1u : 0u; mine = (j == x) ? c : mine; }
        if (sum == G) break;
        __builtin_amdgcn_s_sleep(1);
        if ((++sp & 255u) == 0u) { if (xb_ld(&bar[XB_TMO])) break; if (sp > XB_SPIN_CAP) { atomicAdd(&bar[XB_TMO], 1u); break; } }
    }
    nloc = mine > 0u ? mine : 1u; nx = cnt > 0u ? cnt : 1u;
}
__device__ __forceinline__ void xcd_barrier(const XcdBarrier& b) {
    asm volatile("s_waitcnt vmcnt(0)" ::: "memory");
    __syncthreads();
    if (threadIdx.x == 0) {
        unsigned* bar = b.bar;
        __builtin_amdgcn_s_waitcnt(0);
        unsigned nloc = b.st[0], nx = b.st[1];
        if (nloc == 0u) { xcd_barrier_complete(bar, b.x, nloc, nx); b.st[0] = nloc; b.st[1] = nx; }
        const unsigned old = xb_add(&bar[XB_XSUB(b.x)], 1u);
        const unsigned gen = old / nloc;
        if (old + 1u == (gen + 1u) * nloc) {
            __builtin_amdgcn_fence(__ATOMIC_RELEASE, "agent");
            asm volatile("s_waitcnt vmcnt(0)" ::: "memory");
            const unsigned og = xb_add(&bar[XB_TOP], 1u);
            const unsigned tg = og / nx;
            if (og + 1u == (tg + 1u) * nx) xb_add(&bar[XB_TOPGEN], 1u);
            else XB_SPIN(xb_ld(&bar[XB_TOPGEN]) == tg, bar);
            __builtin_amdgcn_fence(__ATOMIC_ACQUIRE, "agent");
            xb_add(&bar[XB_XGEN(b.x)], 1u);
            asm volatile("s_waitcnt vmcnt(0)" ::: "memory");
        } else {
            XB_SPIN(xb_ld(&bar[XB_XGEN(b.x)]) == gen, bar);
            __builtin_amdgcn_fence(__ATOMIC_ACQUIRE, "agent");
            asm volatile("s_waitcnt vmcnt(0)" ::: "memory");
        }
    }
    __syncthreads();
}

struct Frame {
    LAS unsigned char* lds;
    int tid, lane, wave;
    int vcu, G;
    unsigned char* ws;
};
struct Args { const float* in[27]; float* out; unsigned char* ws; int ph_lo, ph_hi; };
__device__ __forceinline__ Frame fresh(const Frame& F0) { Frame F = F0; int t = F0.tid; asm volatile("" : "+v"(t)); F.tid = t; F.lane = t & 63; F.wave = __builtin_amdgcn_readfirstlane(t >> 6); return F; }

__device__ __forceinline__ void transpose_item(const float* W, int K, int N, bf16* WT, int k0, int n0, int drow0, LAS float* scr, int lane) {
#pragma unroll 8
    for (int i = 0; i < 32; ++i) { const int kk = 2 * i + (lane >> 5); scr[kk * 33 + (lane & 31)] = W[(size_t)(k0 + kk) * N + n0 + (lane & 31)]; }
    LDS_WAIT(); asm volatile("" ::: "memory");
    const int c = lane & 7;
#pragma unroll
    for (int j = 0; j < 4; ++j) { const int n = (lane >> 3) + 8 * j; const LAS float* s = scr + (8 * c) * 33 + n;
        u32x4 o; o.x = cvt_pk_bf16(s[0 * 33], s[1 * 33]); o.y = cvt_pk_bf16(s[2 * 33], s[3 * 33]); o.z = cvt_pk_bf16(s[4 * 33], s[5 * 33]); o.w = cvt_pk_bf16(s[6 * 33], s[7 * 33]);
        *(u32x4*)(WT + (size_t)(drow0 + n) * K + k0 + 8 * c) = o; }
    LDS_WAIT(); asm volatile("" ::: "memory");
}
__device__ __forceinline__ void conv_plain(const float* W, int K, int N, bf16* WT, int item, LAS float* scr, int lane) {
    const int nblk = N / 32, kb = item / nblk, nb = item % nblk;
    transpose_item(W, K, N, WT, 64 * kb, 32 * nb, 32 * nb, scr, lane);
}
__device__ __forceinline__ void ph_prologue(Frame& F, const Args& A) {
    LAS float* scr = (LAS float*)(F.lds + F.wave * 16384);
    const int gw = F.vcu * NWAVES + F.wave, NGW = F.G * NWAVES;
    constexpr int I_IN = (2048 / 64) * (IN_COLS / 32), I_GLU = (512 / 64) * (512 / 32), I_BR1 = (512 / 64) * (2048 / 32), I_BR = 4 * I_BR1, I_O = (2048 / 64) * (2048 / 32),
                  I_FF = (2048 / 64) * (2 * D_FF / 32), I_FF2 = (D_FF / 64) * (2048 / 32), I_PG = I_O, I_PP = (256 / 64) * (2048 / 32);
    constexpr int I_LAYER = I_IN + I_GLU + I_BR + I_O + I_FF + I_FF2 + I_PG + I_PP;
    for (int it = gw; it < DEPTH * I_LAYER; it += NGW) {
        const int l = it / I_LAYER; int r = it % I_LAYER;
        unsigned char* wl = F.ws + WS_W + (size_t)l * WL_BYTES;
        if (r < I_IN) {
            const float* W = A.in[5] + (size_t)l * 2048 * IN_COLS; const int nblk = IN_COLS / 32, kb = r / nblk, nb = r % nblk, n0 = 32 * nb;
            if (n0 < MIX_IN) transpose_item(W, 2048, IN_COLS, (bf16*)(wl + WL_MIX), 64 * kb, n0, n0, scr, F.lane);
            else transpose_item(W, 2048, IN_COLS, (bf16*)(wl + WL_G), 64 * kb, n0, n0 - MIX_IN, scr, F.lane);
            continue; } r -= I_IN;
        if (r < I_GLU) { conv_plain(A.in[14] + (size_t)l * 512 * 512, 512, 512, (bf16*)(wl + WL_GLU), r, scr, F.lane); continue; } r -= I_GLU;
        if (r < I_BR) { const int kb = r / I_BR1; conv_plain(A.in[19] + ((size_t)l * 4 + kb) * 512 * 2048, 512, 2048, (bf16*)(wl + WL_BR) + (size_t)kb * 2048 * 512, r % I_BR1, scr, F.lane); continue; } r -= I_BR;
        if (r < I_O) { conv_plain(A.in[20] + (size_t)l * 2048 * 2048, 2048, 2048, (bf16*)(wl + WL_O), r, scr, F.lane); continue; } r -= I_O;
        if (r < I_FF) {
            const float* W = A.in[22] + (size_t)l * 2048 * 2 * D_FF; const int nblk = 2 * D_FF / 32, kb = r / nblk, nb = r % nblk, n0 = 32 * nb;
            const int j = n0 / D_FF, rr = n0 % D_FF, pn = rr / 128, cc = rr % 128;
            transpose_item(W, 2048, 2 * D_FF, (bf16*)(wl + WL_FF), 64 * kb, n0, 256 * pn + 128 * j + cc, scr, F.lane);
            continue; } r -= I_FF;
        if (r < I_FF2) { conv_plain(A.in[23] + (size_t)l * D_FF * 2048, D_FF, 2048, (bf16*)(wl + WL_FF2), r, scr, F.lane); continue; } r -= I_FF2;
        if (r < I_PG) { conv_plain(A.in[25] + (size_t)l * 2048 * 2048, 2048, 2048, (bf16*)(wl + WL_PG), r, scr, F.lane); continue; } r -= I_PG;
        conv_plain(A.in[26] + (size_t)l * 256 * 2048, 256, 2048, (bf16*)(wl + WL_PP), r, scr, F.lane);
    }
    {
        const int gt = F.vcu * 512 + F.tid, NT = F.G * 512;
        bf16* c128 = (bf16*)(F.ws + TAB_C128); bf16* s128 = (bf16*)(F.ws + TAB_S128); bf16* c32 = (bf16*)(F.ws + TAB_C32); bf16* s32 = (bf16*)(F.ws + TAB_S32);
        for (int e = gt; e < 128 * 128 + 32 * 32; e += NT) {
            if (e < 128 * 128) { const int i = e >> 7, k = e & 127, m = (i * k) & 127; float sn, cs; sincospif((float)m * (1.0f / 64.0f), &sn, &cs);
                c128[e] = f2bf(cs * 0.08838834764831845f); s128[e] = f2bf(sn * 0.08838834764831845f); }
            else { const int e2 = e - 128 * 128, i = e2 >> 5, k = e2 & 31, m = (i * k) & 31; float sn, cs; sincospif((float)m * (1.0f / 16.0f), &sn, &cs);
                c32[e2] = f2bf(cs * 0.17677669529663687f); s32[e2] = f2bf(sn * 0.17677669529663687f); }
        }
    }
    for (int t = gw; t < DEPTH * 2 * 32; t += NGW) {
        const int g = t & 31, ld = t >> 5;
        unsigned char* tb = F.ws + TAB_S5 + (size_t)t * S5T_BYTES;
        const float* lam_re = A.in[6] + (size_t)t * 64; const float* lam_im = A.in[7] + (size_t)t * 64;
        const float dt = expf(A.in[8][t]);
        const float* b_re = A.in[9] + (size_t)t * 64 * 16; const float* b_im = A.in[10] + (size_t)t * 64 * 16;
        const float* c_re = A.in[11] + (size_t)t * 16 * 64; const float* c_im = A.in[12] + (size_t)t * 16 * 64;
        (void)g; (void)ld;
        const int lane = F.lane, l15 = lane & 15, g4 = lane >> 4;
        {
            const float lr = lam_re[lane], li = lam_im[lane], mag = expf(lr * dt); float sn, cs; sincosf(li * dt, &sn, &cs);
            f32x2 ab; ab.x = mag * cs; ab.y = mag * sn; ((f32x2*)(tb + S5T_AB))[lane] = ab;
        }
#pragma unroll 1
        for (int cb = 0; cb < 8; ++cb) {
            const int col = 16 * cb + l15, p = col >> 1, ri = col & 1;
            const float lr = lam_re[p], li = lam_im[p], mag = expf(lr * dt); float sn, cs; sincosf(li * dt, &sn, &cs);
            const float ar = mag * cs, ai = mag * sn, den = lr * lr + li * li;
            const float fr = ((ar - 1.0f) * lr + ai * li) / den, fi = (ai * lr - (ar - 1.0f) * li) / den;
            float v[8];
#pragma unroll
            for (int j = 0; j < 8; ++j) { const int h = 8 * g4 + j; float x = 0.f;
                if (h < 16) { const float br = b_re[p * 16 + h], bi = b_im[p * 16 + h]; x = ri ? (fr * bi + fi * br) : (fr * br - fi * bi); }
                v[j] = x; }
            u32x4 o; o.x = cvt_pk_bf16(v[0], v[1]); o.y = cvt_pk_bf16(v[2], v[3]); o.z = cvt_pk_bf16(v[4], v[5]); o.w = cvt_pk_bf16(v[6], v[7]);
            ((u32x4*)(tb + S5T_BB))[cb * 64 + lane] = o;
        }
#pragma unroll 1
        for (int ks = 0; ks < 4; ++ks) {
            float v[8];
#pragma unroll
            for (int j = 0; j < 8; ++j) { const int col = 32 * ks + 8 * g4 + j, p = col >> 1, ri = col & 1; v[j] = ri ? -c_im[l15 * 64 + p] : c_re[l15 * 64 + p]; }
            u32x4 o; o.x = cvt_pk_bf16(v[0], v[1]); o.y = cvt_pk_bf16(v[2], v[3]); o.z = cvt_pk_bf16(v[4], v[5]); o.w = cvt_pk_bf16(v[6], v[7]);
            ((u32x4*)(tb + S5T_C))[ks * 64 + lane] = o;
        }
    }
}

__device__ __forceinline__ void ph_norm(Frame& F, const float* xsrc, const float* gain, bf16* H, int nrows) {
    const int gw = F.vcu * NWAVES + F.wave, NGW = F.G * NWAVES;
    f32x4 gv[8];
#pragma unroll
    for (int j = 0; j < 8; ++j) gv[j] = ((const f32x4*)gain)[F.lane + 64 * j];
    for (int m = gw; m < nrows; m += NGW) {
        const f32x4* xr = (const f32x4*)(xsrc + (size_t)m * D_MODEL) + F.lane;
        f32x4 v[8]; float s = 0.f;
#pragma unroll
        for (int j = 0; j < 8; ++j) { v[j] = xr[64 * j]; s += (v[j][0] * v[j][0] + v[j][1] * v[j][1]) + (v[j][2] * v[j][2] + v[j][3] * v[j][3]); }
        const float rstd = rsqrtf(wave_sum(s) * (1.0f / D_MODEL) + EPS);
        u32x2* o = (u32x2*)(H + (size_t)m * D_MODEL) + F.lane;
#pragma unroll
        for (int j = 0; j < 8; ++j) { u32x2 w; w.x = cvt_pk_bf16(v[j][0] * rstd * gv[j][0], v[j][1] * rstd * gv[j][1]); w.y = cvt_pk_bf16(v[j][2] * rstd * gv[j][2], v[j][3] * rstd * gv[j][3]); o[64 * j] = w; }
    }
}
__device__ __forceinline__ void ph_pcvt(Frame& F, const float* pp, const float* ps, bf16* P16) {
    const int gw = F.vcu * NWAVES + F.wave, NGW = F.G * NWAVES;
    for (int m = gw; m < NTOK; m += NGW) {
        const float* src = m < 32768 ? pp + (size_t)m * PLE_DIM : ps + (size_t)(m - 32768) * PLE_DIM;
        const f32x4 v = ((const f32x4*)src)[F.lane];
        u32x2 w; w.x = cvt_pk_bf16(v[0], v[1]); w.y = cvt_pk_bf16(v[2], v[3]);
        ((u32x2*)(P16 + (size_t)m * PLE_DIM))[F.lane] = w;
    }
}
__device__ __forceinline__ void unpack8(u32x4 w, float (&f)[8]) { f[0] = bf_lo(w.x); f[1] = bf_hi(w.x); f[2] = bf_lo(w.y); f[3] = bf_hi(w.y); f[4] = bf_lo(w.z); f[5] = bf_hi(w.z); f[6] = bf_lo(w.w); f[7] = bf_hi(w.w); }
__device__ __forceinline__ u32x4 pack8(const float (&f)[8]) { u32x4 w; w.x = cvt_pk_bf16(f[0], f[1]); w.y = cvt_pk_bf16(f[2], f[3]); w.z = cvt_pk_bf16(f[4], f[5]); w.w = cvt_pk_bf16(f[6], f[7]); return w; }

__device__ __forceinline__ void conv_block(Frame& F, const bf16* Z, bf16* YS, const float* cw  , int blk, int lseq) {
#pragma unroll 1
    for (int i = 0; i < 8; ++i) {
        const int idx = F.tid + 512 * i, r = blk * 64 + (idx >> 6), c = (idx & 63) * 8, lpos = r % lseq;
        const bf16* zr = Z + (size_t)r * MIX_IN;
        float bg[8], z0[8], acc[8], tmp[8], w[8];
        unpack8(*(const u32x4*)(zr + ZC_BG + c), bg);
        {   float cg[8], vv[8]; unpack8(*(const u32x4*)(zr + ZC_CG + c), cg); unpack8(*(const u32x4*)(zr + ZC_VB + c), vv);
            const f32x4 wa = *(const f32x4*)(cw + 512 + c), wb = *(const f32x4*)(cw + 512 + c + 4);
            w[0] = wa[0]; w[1] = wa[1]; w[2] = wa[2]; w[3] = wa[3]; w[4] = wb[0]; w[5] = wb[1]; w[6] = wb[2]; w[7] = wb[3];
#pragma unroll
            for (int j = 0; j < 8; ++j) { z0[j] = cg[j] * vv[j]; acc[j] = w[j] * z0[j]; } }
        if (lpos > 0) { float cg[8], vv[8]; unpack8(*(const u32x4*)(zr - MIX_IN + ZC_CG + c), cg); unpack8(*(const u32x4*)(zr - MIX_IN + ZC_VB + c), vv);
            const f32x4 wa = *(const f32x4*)(cw + c), wb = *(const f32x4*)(cw + c + 4);
            w[0] = wa[0]; w[1] = wa[1]; w[2] = wa[2]; w[3] = wa[3]; w[4] = wb[0]; w[5] = wb[1]; w[6] = wb[2]; w[7] = wb[3];
#pragma unroll
            for (int j = 0; j < 8; ++j) acc[j] += w[j] * (cg[j] * vv[j]); }
        if (lpos < lseq - 1) { float cg[8], vv[8]; unpack8(*(const u32x4*)(zr + MIX_IN + ZC_CG + c), cg); unpack8(*(const u32x4*)(zr + MIX_IN + ZC_VB + c), vv);
            const f32x4 wa = *(const f32x4*)(cw + 1024 + c), wb = *(const f32x4*)(cw + 1024 + c + 4);
            w[0] = wa[0]; w[1] = wa[1]; w[2] = wa[2]; w[3] = wa[3]; w[4] = wb[0]; w[5] = wb[1]; w[6] = wb[2]; w[7] = wb[3];
#pragma unroll
            for (int j = 0; j < 8; ++j) acc[j] += w[j] * (cg[j] * vv[j]); }
#pragma unroll
        for (int j = 0; j < 8; ++j) tmp[j] = bg[j] * acc[j];
        *(u32x4*)(YS + (size_t)r * D_MODEL + 512 + c) = pack8(tmp);
    }
}
__device__ __forceinline__ void s5fin_block(Frame& F, const bf16* Z, const float* YF, const float* YB, const float* dsk  , bf16* Y1, int blk) {
#pragma unroll 1
    for (int i = 0; i < 8; ++i) {
        const int idx = F.tid + 512 * i, r = blk * 64 + (idx >> 6), c = (idx & 63) * 8;
        float u[8], o[8]; unpack8(*(const u32x4*)(Z + (size_t)r * MIX_IN + ZC_UA + c), u);
        const f32x4 f0 = *(const f32x4*)(YF + (size_t)r * 512 + c), f1 = *(const f32x4*)(YF + (size_t)r * 512 + c + 4);
        const f32x4 b0 = *(const f32x4*)(YB + (size_t)r * 512 + c), b1 = *(const f32x4*)(YB + (size_t)r * 512 + c + 4);
        const f32x4 d0 = *(const f32x4*)(dsk + c), d1 = *(const f32x4*)(dsk + c + 4);
#pragma unroll
        for (int j = 0; j < 8; ++j) { const float yy = (j < 4 ? d0[j & 3] : d1[j & 3]) * u[j] + (j < 4 ? f0[j & 3] : f1[j & 3]) + (j < 4 ? b0[j & 3] : b1[j & 3]);
            const float a = 0.7978845608028654f * (yy + 0.044715f * yy * yy * yy);
            const float th = 1.0f - 2.0f * __builtin_amdgcn_rcpf(1.0f + __expf(2.0f * a));
            o[j] = 0.5f * yy * (1.0f + th); }
        *(u32x4*)(Y1 + (size_t)r * 512 + c) = pack8(o);
    }
}

constexpr int S5_SEG = 512, S5_TPS = S5_SEG / 16;
template <bool FULL>
__device__ __forceinline__ void s5_seg_task(Frame& F, const unsigned char* tb, const bf16* Zs, float* Yout, f32x2* Ev, int nseg, int seg, int dir, int g) {
    LAS float* BU = (LAS float*)(F.lds + F.wave * 12288);
    LAS unsigned* XD = (LAS unsigned*)(F.lds + F.wave * 12288 + 8192);
    const int lane = F.lane, l15 = lane & 15, g4 = lane >> 4;
    const f32x2 ab = ((const f32x2*)(tb + S5T_AB))[lane];
    const float ar = ab.x, ai = ab.y;
    bf16x8 bbf[8];
#pragma unroll
    for (int cb = 0; cb < 8; ++cb) bbf[cb] = as_frag(((const u32x4*)(tb + S5T_BB))[cb * 64 + lane]);
    float xr = 0.f, xi = 0.f;
    float pwr[4], pwi[4];
    pwr[0] = ar; pwi[0] = ai;
#pragma unroll
    for (int j = 1; j < 4; ++j) { pwr[j] = pwr[j - 1] * ar - pwi[j - 1] * ai; pwi[j] = pwr[j - 1] * ai + pwi[j - 1] * ar; }
    if (FULL) {
        float pr = ar, pi = ai;
#pragma unroll
        for (int i = 0; i < 9; ++i) { const float nr = pr * pr - pi * pi, ni = 2.f * pr * pi; pr = nr; pi = ni; }
        if (dir == 0) { for (int j = 0; j < seg; ++j) { const f32x2 e = Ev[j * 64 + lane]; const float nr = pr * xr - pi * xi + e.x, ni = pr * xi + pi * xr + e.y; xr = nr; xi = ni; } }
        else { for (int j = nseg - 1; j > seg; --j) { const f32x2 e = Ev[j * 64 + lane]; const float nr = pr * xr - pi * xi + e.x, ni = pr * xi + pi * xr + e.y; xr = nr; xi = ni; } }
    }
    bf16x8 cf[4];
    if (FULL) {
#pragma unroll
        for (int ks = 0; ks < 4; ++ks) cf[ks] = as_frag(((const u32x4*)(tb + S5T_C))[ks * 64 + lane]);
    }
    const int tile0 = seg * S5_TPS;
    const bf16* zcol = Zs + ZC_UA + g * 16 + 8 * (g4 & 1);
    u32x4 ring[4];
#pragma unroll
    for (int j = 0; j < 4; ++j) { const int tile = tile0 + (dir ? S5_TPS - 1 - j : j); ring[j] = (u32x4){0u, 0u, 0u, 0u}; if (g4 < 2) ring[j] = *(const u32x4*)(zcol + (size_t)(tile * 16 + l15) * MIX_IN); }
#pragma unroll 1
    for (int it = 0; it < S5_TPS; it += 4) {
#pragma unroll
        for (int j = 0; j < 4; ++j) {
            const int tile = tile0 + (dir ? S5_TPS - 1 - (it + j) : it + j);
            const bf16x8 uf = as_frag(ring[j]);
            if (it + j + 4 < S5_TPS) { const int tn = dir ? tile - 4 : tile + 4; u32x4 nx = (u32x4){0u, 0u, 0u, 0u}; if (g4 < 2) nx = *(const u32x4*)(zcol + (size_t)(tn * 16 + l15) * MIX_IN); ring[j] = nx; }
            f32x4 a8[8];
#pragma unroll
            for (int cb = 0; cb < 8; ++cb) a8[cb] = mfma16(uf, bbf[cb], (f32x4){0.f, 0.f, 0.f, 0.f});
            MFMA_DRAIN();
#pragma unroll
            for (int cb = 0; cb < 8; ++cb)
#pragma unroll
                for (int q = 0; q < 4; ++q) BU[(4 * g4 + q) * 128 + 16 * cb + l15] = a8[cb][q];
            LDS_WAIT();
#pragma unroll
            for (int k = 0; k < 4; ++k) {
                float cr[4], ci[4], yr[4], yi[4];
                f32x2 bv[4];
#pragma unroll
                for (int j = 0; j < 4; ++j) { const int t = dir ? 15 - (4 * k + j) : 4 * k + j; bv[j] = *(const LAS f32x2*)(BU + t * 128 + 2 * lane); }
                cr[0] = bv[0].x; ci[0] = bv[0].y;
#pragma unroll
                for (int j = 1; j < 4; ++j) {
                    cr[j] = __builtin_fmaf(ar, cr[j - 1], __builtin_fmaf(-ai, ci[j - 1], bv[j].x));
                    ci[j] = __builtin_fmaf(ar, ci[j - 1], __builtin_fmaf(ai, cr[j - 1], bv[j].y));
                }
#pragma unroll
                for (int j = 0; j < 4; ++j) {
                    yr[j] = __builtin_fmaf(pwr[j], xr, __builtin_fmaf(-pwi[j], xi, cr[j]));
                    yi[j] = __builtin_fmaf(pwr[j], xi, __builtin_fmaf(pwi[j], xr, ci[j]));
                    if (FULL) { const int t = dir ? 15 - (4 * k + j) : 4 * k + j; XD[t * 64 + lane] = cvt_pk_bf16(yr[j], yi[j]); }
                }
                xr = yr[3]; xi = yi[3];
            }
            if (FULL) {
                LDS_WAIT();
                f32x4 y = (f32x4){0.f, 0.f, 0.f, 0.f};
#pragma unroll
                for (int ks = 0; ks < 4; ++ks) y = mfma16(as_frag(*(const LAS u32x4*)(XD + l15 * 64 + 16 * ks + 4 * g4)), cf[ks], y);
                MFMA_DRAIN();
                float* yo = Yout + (size_t)(tile * 16 + 4 * g4) * 512 + g * 16 + l15;
#pragma unroll
                for (int q = 0; q < 4; ++q) yo[(size_t)q * 512] = y[q];
            }
            LDS_WAIT();
        }
    }
    if (!FULL) { f32x2 e; e.x = xr; e.y = xi; Ev[seg * 64 + lane] = e; }
}

constexpr int NA_KL = 0, NA_VT = 73728, NA_BIAS = 147456;
constexpr int NA_RR = 8;
__device__ __forceinline__ void na_task(Frame& F, const bf16* Zs  , bf16* YSs  , int rows, int h, int r0,
                                        const float* qg, const float* kg, const float* relb  ) {
    LAS unsigned* KL = (LAS unsigned*)(F.lds + NA_KL); LAS unsigned* VT = (LAS unsigned*)(F.lds + NA_VT); LAS unsigned short* VT16 = (LAS unsigned short*)(F.lds + NA_VT);
    LAS float* BIAS = (LAS float*)(F.lds + NA_BIAS);
    const int tid = F.tid, lane = F.lane, l15 = lane & 15, g4 = lane >> 4;
    __syncthreads();
    for (int i = tid; i < 15 * 31; i += 512) BIAS[i] = relb[i];
    const int scol = tid >> 3, schunk = tid & 7;
    float kgv[8];
    { const f32x4 a = *(const f32x4*)(kg + 8 * schunk), b = *(const f32x4*)(kg + 8 * schunk + 4); kgv[0] = a[0]; kgv[1] = a[1]; kgv[2] = a[2]; kgv[3] = a[3]; kgv[4] = b[0]; kgv[5] = b[1]; kgv[6] = b[2]; kgv[7] = b[3]; }
    int rs0 = r0 - 4; rs0 = rs0 < 0 ? 0 : (rs0 > rows - 8 ? rows - 8 : rs0);
    const bf16* zst = Zs + (size_t)scol * MIX_IN + h * 64 + 8 * schunk;
#define NA_LOAD(rho, kr, vr) do { const bf16* zt_ = zst + (size_t)(rho) * 64 * MIX_IN; kr = *(const u32x4*)(zt_ + ZC_K); vr = *(const u32x4*)(zt_ + ZC_VC); } while (0)
#define NA_STORE(rho, kr, vr) do { float kf_[8]; unpack8(kr, kf_); float ss_ = 0.f; \
        _Pragma("unroll") for (int j_ = 0; j_ < 8; ++j_) ss_ += kf_[j_] * kf_[j_]; \
        ss_ += __shfl_xor(ss_, 1); ss_ += __shfl_xor(ss_, 2); ss_ += __shfl_xor(ss_, 4); \
        const float rk_ = rsqrtf(ss_ * (1.0f / 64.0f) + EPS); \
        _Pragma("unroll") for (int j_ = 0; j_ < 8; ++j_) kf_[j_] = kf_[j_] * rk_ * kgv[j_]; \
        const int slot_ = (rho) & 7; \
        *(LAS u32x4*)(KL + (slot_ * 64 + scol) * 36 + schunk * 4) = pack8(kf_); \
        const unsigned vw_[4] = {vr.x, vr.y, vr.z, vr.w}; \
        _Pragma("unroll") for (int j_ = 0; j_ < 8; ++j_) VT16[(slot_ * 64 + 8 * schunk + j_) * 72 + scol] = (unsigned short)((j_ & 1) ? (vw_[j_ >> 1] >> 16) : (vw_[j_ >> 1] & 0xffffu)); } while (0)
    {
        __syncthreads();
#pragma unroll 1
        for (int b = 0; b < 2; ++b) {
            u32x4 kr[4], vr[4];
#pragma unroll
            for (int i = 0; i < 4; ++i) NA_LOAD(rs0 + 4 * b + i, kr[i], vr[i]);
#pragma unroll
            for (int i = 0; i < 4; ++i) NA_STORE(rs0 + 4 * b + i, kr[i], vr[i]);
        }
    }
    int nextrow = rs0 + 8;
#pragma unroll 1
    for (int r = r0; r < r0 + NA_RR; ++r) {
        int rs = r - 4; rs = rs < 0 ? 0 : (rs > rows - 8 ? rows - 8 : rs);
        int rsn = r + 1 - 4; rsn = rsn < 0 ? 0 : (rsn > rows - 8 ? rows - 8 : rsn);
        const bool pre = (r + 1 < r0 + NA_RR) && (rsn + 7 >= nextrow);
        u32x4 pk = (u32x4){0u, 0u, 0u, 0u}, pv = (u32x4){0u, 0u, 0u, 0u};
        if (pre) NA_LOAD(nextrow, pk, pv);
        __syncthreads();
        if (F.wave < 4) {
            const int jb = F.wave, qc = 16 * jb + l15;
            int kc0 = 16 * jb - 8; kc0 = kc0 < 0 ? 0 : (kc0 > 32 ? 32 : kc0);
            int cs = qc - 8; cs = cs < 0 ? 0 : (cs > 48 ? 48 : cs);
            bf16x8 qf[2];
            {
                const bf16* zq = Zs + (size_t)(r * 64 + qc) * MIX_IN + ZC_Q + h * 64 + 8 * g4;
                float q0[8], q1[8]; unpack8(*(const u32x4*)zq, q0); unpack8(*(const u32x4*)(zq + 32), q1);
                float ss = 0.f;
#pragma unroll
                for (int j = 0; j < 8; ++j) ss += q0[j] * q0[j] + q1[j] * q1[j];
                ss += __shfl_xor(ss, 16); ss += __shfl_xor(ss, 32);
                const float rq = rsqrtf(ss * (1.0f / 64.0f) + EPS) * 0.125f;
                const f32x4 ga = *(const f32x4*)(qg + 8 * g4), gb = *(const f32x4*)(qg + 8 * g4 + 4), gc = *(const f32x4*)(qg + 32 + 8 * g4), gd = *(const f32x4*)(qg + 32 + 8 * g4 + 4);
#pragma unroll
                for (int j = 0; j < 4; ++j) { q0[j] *= rq * ga[j]; q0[4 + j] *= rq * gb[j]; q1[j] *= rq * gc[j]; q1[4 + j] *= rq * gd[j]; }
                qf[0] = as_frag(pack8(q0)); qf[1] = as_frag(pack8(q1));
            }
            f32x4 S[8][2];
#pragma unroll
            for (int a = 0; a < 8; ++a) {
                const int slot = (rs + a) & 7;
#pragma unroll
                for (int kb2 = 0; kb2 < 2; ++kb2) {
                    const LAS unsigned* kp = KL + (slot * 64 + kc0 + 16 * kb2 + l15) * 36 + 4 * g4;
                    S[a][kb2] = mfma16(as_frag(*(const LAS u32x4*)kp), qf[0], (f32x4){0.f, 0.f, 0.f, 0.f});
                    S[a][kb2] = mfma16(as_frag(*(const LAS u32x4*)(kp + 16)), qf[1], S[a][kb2]);
                }
            }
            MFMA_DRAIN();
            float mx = -3.0e38f;
#pragma unroll
            for (int a = 0; a < 8; ++a) {
                const int dr = rs + a - r + 7;
#pragma unroll
                for (int kb2 = 0; kb2 < 2; ++kb2)
#pragma unroll
                    for (int q = 0; q < 4; ++q) {
                        const int kc = kc0 + 16 * kb2 + 4 * g4 + q; const bool valid = (kc >= cs) && (kc < cs + 16);
                        int dc = kc - qc + 15; dc = dc < 0 ? 0 : (dc > 30 ? 30 : dc);
                        const float s = valid ? S[a][kb2][q] + BIAS[dr * 31 + dc] : -1.0e30f;
                        S[a][kb2][q] = s; mx = fmaxf(mx, s);
                    }
            }
            mx = fmaxf(mx, __shfl_xor(mx, 16)); mx = fmaxf(mx, __shfl_xor(mx, 32));
            float sum = 0.f;
#pragma unroll
            for (int a = 0; a < 8; ++a)
#pragma unroll
                for (int kb2 = 0; kb2 < 2; ++kb2)
#pragma unroll
                    for (int q = 0; q < 4; ++q) { const float p = __expf(S[a][kb2][q] - mx); S[a][kb2][q] = p; sum += p; }
            sum += __shfl_xor(sum, 16); sum += __shfl_xor(sum, 32);
            const float rinv = 1.0f / sum;
            f32x4 O[4];
#pragma unroll
            for (int dt = 0; dt < 4; ++dt) O[dt] = (f32x4){0.f, 0.f, 0.f, 0.f};
#pragma unroll
            for (int a = 0; a < 8; ++a) {
                const int slot = (rs + a) & 7;
                u32x4 pw; pw.x = cvt_pk_bf16(S[a][0][0], S[a][0][1]); pw.y = cvt_pk_bf16(S[a][0][2], S[a][0][3]); pw.z = cvt_pk_bf16(S[a][1][0], S[a][1][1]); pw.w = cvt_pk_bf16(S[a][1][2], S[a][1][3]);
                const bf16x8 pf = as_frag(pw);
#pragma unroll
                for (int dt = 0; dt < 4; ++dt) {
                    const LAS unsigned* vp = VT + (slot * 64 + 16 * dt + l15) * 36 + (kc0 >> 1) + 2 * g4;
                    const u32x2 v0 = *(const LAS u32x2*)vp, v1 = *(const LAS u32x2*)(vp + 8);
                    u32x4 vw; vw.x = v0.x; vw.y = v0.y; vw.z = v1.x; vw.w = v1.y;
                    O[dt] = mfma16(as_frag(vw), pf, O[dt]);
                }
            }
            MFMA_DRAIN();
            bf16* yo = YSs + (size_t)(r * 64 + qc) * D_MODEL + 1024 + h * 64 + 4 * g4;
#pragma unroll
            for (int dt = 0; dt < 4; ++dt) { u32x2 w; w.x = cvt_pk_bf16(O[dt][0] * rinv, O[dt][1] * rinv); w.y = cvt_pk_bf16(O[dt][2] * rinv, O[dt][3] * rinv); *(u32x2*)(yo + 16 * dt) = w; }
        }
        __syncthreads();
        if (pre) { NA_STORE(nextrow, pk, pv); nextrow += 1; }
    }
#undef NA_LOAD
#undef NA_STORE
}


#define TR2(o0, o1, off0, off1) "ds_read_b64_tr_b16 %" #o0 ", %16 offset:" #off0 "\n\tds_read_b64_tr_b16 %" #o1 ", %16 offset:" #off1 "\n\t"
constexpr int FN_XT = 0, FN_YR = 34816, FN_YI = 34816 + 34816;
template <int N1>
__device__ __forceinline__ void fnet1_tile(Frame& F, const bf16* Zs, bf16* ZFsg  , int g, int l2, const bf16* CT1, const bf16* ST1  , const bf16* C128, const bf16* S128) {
    constexpr int JT = N1 / 16, KS1 = N1 / 32;
    LAS unsigned short* YR = (LAS unsigned short*)(F.lds + FN_YR); LAS unsigned short* YI = (LAS unsigned short*)(F.lds + FN_YI);
    const int tid = F.tid, lane = F.lane, l15 = lane & 15, g4 = lane >> 4, w = F.wave;
    __syncthreads();
    {
        constexpr int NI = (N1 * 16) / 512;
        u32x4 raw[NI];
#pragma unroll
        for (int i = 0; i < NI; ++i) { const int idx = tid + 512 * i, l1 = idx >> 4, ch = idx & 15; raw[i] = *(const u32x4*)(Zs + (size_t)(128 * l1 + l2) * MIX_IN + ZC_UD + g * 128 + 8 * ch); }
#pragma unroll
        for (int i = 0; i < NI; ++i) { const int idx = tid + 512 * i, l1 = idx >> 4, ch = idx & 15; *(LAS u32x4*)(F.lds + FN_XT + l1 * 272 + ch * 16) = raw[i]; }
    }
    __syncthreads();
    {
        bf16x8 af[KS1];
        {
            const unsigned base = (unsigned)(size_t)F.lds + (unsigned)(FN_XT + (8 * g4 + (l15 >> 2)) * 272 + (16 * w + 4 * (lane & 3)) * 2);
            if constexpr (KS1 == 4) {
                u32x2 t_[8];
                asm volatile("ds_read_b64_tr_b16 %0, %8\n\tds_read_b64_tr_b16 %1, %8 offset:1088\n\tds_read_b64_tr_b16 %2, %8 offset:8704\n\tds_read_b64_tr_b16 %3, %8 offset:9792\n\t"
                             "ds_read_b64_tr_b16 %4, %8 offset:17408\n\tds_read_b64_tr_b16 %5, %8 offset:18496\n\tds_read_b64_tr_b16 %6, %8 offset:26112\n\tds_read_b64_tr_b16 %7, %8 offset:27200\n\ts_waitcnt lgkmcnt(0)"
                             : "=&v"(t_[0]), "=&v"(t_[1]), "=&v"(t_[2]), "=&v"(t_[3]), "=&v"(t_[4]), "=&v"(t_[5]), "=&v"(t_[6]), "=&v"(t_[7]) : "v"(base) : "memory");
#pragma unroll
                for (int ks = 0; ks < 4; ++ks) { u32x4 a; a.x = t_[2 * ks].x; a.y = t_[2 * ks].y; a.z = t_[2 * ks + 1].x; a.w = t_[2 * ks + 1].y; af[ks] = as_frag(a); }
            } else {
                u32x2 t0_, t1_;
                asm volatile("ds_read_b64_tr_b16 %0, %2\n\tds_read_b64_tr_b16 %1, %2 offset:1088\n\ts_waitcnt lgkmcnt(0)" : "=&v"(t0_), "=&v"(t1_) : "v"(base) : "memory");
                u32x4 a; a.x = t0_.x; a.y = t0_.y; a.z = t1_.x; a.w = t1_.y; af[0] = as_frag(a);
            }
        }
#pragma unroll 1
        for (int tj = 0; tj < JT; ++tj) {
            const int k1 = 16 * tj + l15;
            f32x4 ar = (f32x4){0.f, 0.f, 0.f, 0.f}, as = (f32x4){0.f, 0.f, 0.f, 0.f};
#pragma unroll
            for (int ks = 0; ks < KS1; ++ks) {
                ar = mfma16(af[ks], as_frag(*(const u32x4*)(CT1 + k1 * N1 + 32 * ks + 8 * g4)), ar);
                as = mfma16(af[ks], as_frag(*(const u32x4*)(ST1 + k1 * N1 + 32 * ks + 8 * g4)), as);
            }
            MFMA_DRAIN();
            float tsn, tcs; sincospif((float)(k1 * l2) * (2.0f / (float)(N1 * 128)), &tsn, &tcs);
            float zr[4], zi[4];
#pragma unroll
            for (int q = 0; q < 4; ++q) { const float yr = ar[q], yi = -as[q]; zr[q] = yr * tcs + yi * tsn; zi[q] = yi * tcs - yr * tsn; }
            u32x2 wr2, wi2; wr2.x = cvt_pk_bf16(zr[0], zr[1]); wr2.y = cvt_pk_bf16(zr[2], zr[3]); wi2.x = cvt_pk_bf16(zi[0], zi[1]); wi2.y = cvt_pk_bf16(zi[2], zi[3]);
            *(LAS u32x2*)(YR + k1 * 136 + 16 * w + 4 * g4) = wr2; *(LAS u32x2*)(YI + k1 * 136 + 16 * w + 4 * g4) = wi2;
        }
    }
    __syncthreads();
    {
        bf16x8 cfr[4], sfr[4];
#pragma unroll
        for (int ks = 0; ks < 4; ++ks) { cfr[ks] = as_frag(*(const u32x4*)(C128 + (16 * w + l15) * 128 + 32 * ks + 8 * g4)); sfr[ks] = as_frag(*(const u32x4*)(S128 + (16 * w + l15) * 128 + 32 * ks + 8 * g4)); }
#pragma unroll 1
        for (int tj = 0; tj < JT; ++tj) {
            const int k1 = 16 * tj + l15;
            f32x4 zr = (f32x4){0.f, 0.f, 0.f, 0.f}, zi = (f32x4){0.f, 0.f, 0.f, 0.f};
#pragma unroll
            for (int ks = 0; ks < 4; ++ks) {
                const u32x4 yr = *(const LAS u32x4*)(YR + k1 * 136 + 32 * ks + 8 * g4), yi = *(const LAS u32x4*)(YI + k1 * 136 + 32 * ks + 8 * g4);
                u32x4 ny; ny.x = yr.x ^ 0x80008000u; ny.y = yr.y ^ 0x80008000u; ny.z = yr.z ^ 0x80008000u; ny.w = yr.w ^ 0x80008000u;
                zr = mfma16(cfr[ks], as_frag(yr), zr); zr = mfma16(sfr[ks], as_frag(yi), zr);
                zi = mfma16(cfr[ks], as_frag(yi), zi); zi = mfma16(sfr[ks], as_frag(ny), zi);
            }
            MFMA_DRAIN();
            bf16* zo = ZFsg + ((size_t)k1 * 128 + l2) * 256 + 16 * w + 4 * g4;
            u32x2 a, b; a.x = cvt_pk_bf16(zr[0], zr[1]); a.y = cvt_pk_bf16(zr[2], zr[3]); b.x = cvt_pk_bf16(zi[0], zi[1]); b.y = cvt_pk_bf16(zi[2], zi[3]);
            *(u32x2*)zo = a; *(u32x2*)(zo + 128) = b;
        }
    }
}
__device__ __forceinline__ void fnet2_tile(Frame& F, const bf16* ZFsg, bf16* YSs  , int g, int k1, int N1, const bf16* C128, const bf16* S128) {
    constexpr int RS = 528;
    const int tid = F.tid, lane = F.lane, l15 = lane & 15, g4 = lane >> 4, w = F.wave;
    __syncthreads();
    const bf16* src = ZFsg + (size_t)k1 * 128 * 256;
    {
        u32x4 raw[8];
#pragma unroll
        for (int i = 0; i < 8; ++i) { const int idx = tid + 512 * i; raw[i] = *(const u32x4*)(src + (size_t)idx * 8); }
#pragma unroll
        for (int i = 0; i < 8; ++i) { const int idx = tid + 512 * i, l2 = idx >> 5, ch = idx & 31; *(LAS u32x4*)(F.lds + l2 * RS + ch * 16) = raw[i]; }
    }
    __syncthreads();
    const unsigned base = (unsigned)(size_t)F.lds + (unsigned)((8 * g4 + (l15 >> 2)) * RS + (16 * w + 4 * (lane & 3)) * 2);
    u32x2 t_[16];
    asm volatile(
        TR2(0, 1, 0, 2112) TR2(2, 3, 16896, 19008) TR2(4, 5, 33792, 35904) TR2(6, 7, 50688, 52800)
        TR2(8, 9, 256, 2368) TR2(10, 11, 17152, 19264) TR2(12, 13, 34048, 36160) TR2(14, 15, 50944, 53056)
        "s_waitcnt lgkmcnt(0)"
        : "=&v"(t_[0]), "=&v"(t_[1]), "=&v"(t_[2]), "=&v"(t_[3]), "=&v"(t_[4]), "=&v"(t_[5]), "=&v"(t_[6]), "=&v"(t_[7]),
          "=&v"(t_[8]), "=&v"(t_[9]), "=&v"(t_[10]), "=&v"(t_[11]), "=&v"(t_[12]), "=&v"(t_[13]), "=&v"(t_[14]), "=&v"(t_[15])
        : "v"(base) : "memory");
    bf16x8 zrf[4], zif[4];
#pragma unroll
    for (int ks = 0; ks < 4; ++ks) { u32x4 a; a.x = t_[2 * ks].x; a.y = t_[2 * ks].y; a.z = t_[2 * ks + 1].x; a.w = t_[2 * ks + 1].y; zrf[ks] = as_frag(a);
        u32x4 b; b.x = t_[8 + 2 * ks].x; b.y = t_[8 + 2 * ks].y; b.z = t_[8 + 2 * ks + 1].x; b.w = t_[8 + 2 * ks + 1].y; zif[ks] = as_frag(b); }
#pragma unroll 1
    for (int tj = 0; tj < 8; ++tj) {
        const int k2 = 16 * tj + l15;
        f32x4 y = (f32x4){0.f, 0.f, 0.f, 0.f};
#pragma unroll
        for (int ks = 0; ks < 4; ++ks) {
            y = mfma16(zrf[ks], as_frag(*(const u32x4*)(C128 + k2 * 128 + 32 * ks + 8 * g4)), y);
            y = mfma16(zif[ks], as_frag(*(const u32x4*)(S128 + k2 * 128 + 32 * ks + 8 * g4)), y);
        }
        MFMA_DRAIN();
        u32x2 o; o.x = cvt_pk_bf16(y[0], y[1]); o.y = cvt_pk_bf16(y[2], y[3]);
        *(u32x2*)(YSs + (size_t)(k1 + N1 * k2) * D_MODEL + 1536 + g * 128 + 16 * w + 4 * g4) = o;
    }
}

struct ChunkGeo { int nseq, lseq, rows, n1; };
__device__ __forceinline__ ChunkGeo chunk_geo(int ch) { ChunkGeo g; if (ch < 2) { g.nseq = 1; g.lseq = 16384; g.rows = 256; g.n1 = 128; } else { g.nseq = 4; g.lseq = 4096; g.rows = 64; g.n1 = 32; } return g; }

__device__ __forceinline__ void ph_s5a(Frame& F, const Args& A, int layer, int ch) {
    const ChunkGeo cg = chunk_geo(ch);
    const bf16* Z = (const bf16*)(F.ws + WS_Z); f32x2* EV = (f32x2*)(F.ws + WS_S5E);
    const int nseg = cg.lseq / S5_SEG, ntask = cg.nseq * nseg * 64;
#pragma unroll 1
    for (int tt = F.vcu * 8 + F.wave; tt < ntask; tt += F.G * 8) {
        const int dg = tt & 63, sg = tt >> 6, seg = sg % nseg, seq = sg / nseg, dir = dg >> 5, g = dg & 31;
        const unsigned char* tb = F.ws + TAB_S5 + (size_t)(((layer * 2 + dir) * 32) + g) * S5T_BYTES;
        s5_seg_task<false>(F, tb, Z + (size_t)seq * cg.lseq * MIX_IN, nullptr, EV + (size_t)(seq * 64 + dg) * nseg * 64, nseg, seg, dir, g);
    }
    int t0 = F.vcu; asm volatile("" : "+s"(t0));
    bf16* YS = (bf16*)(F.ws + WS_YS); bf16* ZF = (bf16*)(F.ws + WS_ZF);
    const int n_f1 = 512, n_cv = CH_TOK / 64;
#pragma unroll 1
    for (; t0 < n_f1 + n_cv; t0 += F.G) {
        if (t0 < n_f1) {
            const int u = t0;
            const bf16* C128 = (const bf16*)(F.ws + TAB_C128); const bf16* S128 = (const bf16*)(F.ws + TAB_S128);
            if (ch < 2) { const int g = u >> 7, l2 = u & 127;
                fnet1_tile<128>(F, Z, ZF + (size_t)g * 16384 * 256, g, l2, C128, S128, C128, S128);
            } else {
                const bf16* C32 = (const bf16*)(F.ws + TAB_C32); const bf16* S32 = (const bf16*)(F.ws + TAB_S32);
#pragma unroll 1
                for (int s = 0; s < 4; ++s) { const int uu = u * 4 + s, l2 = uu & 127, g = (uu >> 7) & 3, seq = uu >> 9;
                    fnet1_tile<32>(F, Z + (size_t)seq * 4096 * MIX_IN, ZF + (size_t)(seq * 4 + g) * 4096 * 256, g, l2, C32, S32, C128, S128); }
            }
        } else {
            conv_block(F, Z, YS, A.in[15] + (size_t)layer * 3 * 512, t0 - n_f1, cg.lseq);
        }
    }
}
__device__ __forceinline__ void ph_mix1(Frame& F, const Args& A, int layer, int ch) {
    const ChunkGeo cg = chunk_geo(ch);
    const bf16* Z = (const bf16*)(F.ws + WS_Z); bf16* YS = (bf16*)(F.ws + WS_YS); const bf16* ZF = (const bf16*)(F.ws + WS_ZF);
    float* YF = (float*)(F.ws + WS_YF); float* YB = (float*)(F.ws + WS_YB); f32x2* EV = (f32x2*)(F.ws + WS_S5E);
    const int nseg = cg.lseq / S5_SEG;
    const int n_s5 = cg.nseq * nseg * 8;
    const int n_na = cg.nseq * 8 * (cg.rows / NA_RR);
    const int n_f2 = 512;
    int t0 = F.vcu;
#pragma unroll 1
    for (; t0 < n_s5; t0 += F.G) {
        const int tt = t0 * 8 + F.wave, dg = tt & 63, sg = tt >> 6, seg = sg % nseg, seq = sg / nseg, dir = dg >> 5, g = dg & 31;
        const unsigned char* tb = F.ws + TAB_S5 + (size_t)(((layer * 2 + dir) * 32) + g) * S5T_BYTES;
        const size_t row0 = (size_t)seq * cg.lseq;
        s5_seg_task<true>(F, tb, Z + row0 * MIX_IN, (dir ? YB : YF) + row0 * 512, EV + (size_t)(seq * 64 + dg) * nseg * 64, nseg, seg, dir, g);
    }
    asm volatile("" : "+s"(t0));
#pragma unroll 1
    for (; t0 < n_s5 + n_na + n_f2; t0 += F.G) {
        const int t = t0 - n_s5;
        if (t < n_na) {
            const int runs = cg.rows / NA_RR, run = t % runs, h = (t / runs) & 7, seq = t / (runs * 8);
            const size_t row0 = (size_t)seq * cg.lseq;
            na_task(F, Z + row0 * MIX_IN, YS + row0 * D_MODEL, cg.rows, h, run * NA_RR, A.in[16] + layer * 64, A.in[17] + layer * 64, A.in[18] + ((size_t)layer * 8 + h) * 15 * 31);
        } else {
            const int u = t - n_na;
            const bf16* C128 = (const bf16*)(F.ws + TAB_C128); const bf16* S128 = (const bf16*)(F.ws + TAB_S128);
            int seq, g, k1; if (ch < 2) { seq = 0; g = u >> 7; k1 = u & 127; } else { k1 = u & 31; g = (u >> 5) & 3; seq = u >> 7; }
            fnet2_tile(F, ZF + (size_t)(seq * 4 + g) * cg.lseq * 256, YS + (size_t)seq * cg.lseq * D_MODEL, g, k1, cg.n1, C128, S128);
        }
    }
}
__device__ __forceinline__ void ph_mix2(Frame& F, const Args& A, int layer, int ch) {
    const bf16* Z = (const bf16*)(F.ws + WS_Z);
    const float* YF = (const float*)(F.ws + WS_YF); const float* YB = (const float*)(F.ws + WS_YB); bf16* Y1 = (bf16*)(F.ws + WS_Y1);
    (void)ch;
#pragma unroll 1
    for (int t = F.vcu; t < CH_TOK / 64; t += F.G) s5fin_block(F, Z, YF, YB, A.in[13] + (size_t)layer * 512, Y1, t);
}

constexpr int MK_STAG = 0, MK_STAG_MERGE = 0;
constexpr int PH_A = 8, PH_PER_LAYER = 3 * PH_A + 1 + 3 + 3, N_PHASES = 1 + DEPTH * PH_PER_LAYER;
__global__ void __launch_bounds__(NWAVES * 64, 2) fwd_kernel(const Args A) {
    extern __shared__ __attribute__((aligned(16))) unsigned char lds_raw[];
    Frame F;
    F.lds = (LAS unsigned char*)lds_raw;
    F.tid = threadIdx.x; F.lane = F.tid & 63; F.wave = __builtin_amdgcn_readfirstlane(F.tid >> 6);
    F.G = gridDim.x; { const int bx = blockIdx.x; F.vcu = (F.G % 8 == 0) ? (bx % 8) * (F.G / 8) + bx / 8 : bx; }
    F.ws = A.ws;
    volatile LAS unsigned* LCTL = (volatile LAS unsigned*)(F.lds + LDSCTL_OFF);
    if (F.tid < 64) LCTL[F.tid] = 0u;
    __syncthreads();
    const int lo = A.ph_lo, hi = A.ph_hi;
    const bool multi = (hi - lo) > 1;
    XcdBarrier bar; bar.bar = (unsigned*)(F.ws + WS_CTL) + CW_BAR; bar.x = 0; bar.st = LCTL;
    if (multi) bar = xcd_barrier_post((unsigned*)(F.ws + WS_CTL) + CW_BAR, LCTL);
#define IN(k) (lo <= (k) && (k) < hi)
#define SEAM(k) do { if ((k) + 1 < hi) xcd_barrier(bar); } while (0)

    if (IN(0)) { Frame Fp = fresh(F); ph_prologue(Fp, A); SEAM(0); }

#pragma unroll 1
    for (int layer = 0; layer < DEPTH; ++layer) {
        const int pl = 1 + layer * PH_PER_LAYER;
        if (pl + PH_PER_LAYER <= lo || pl >= hi) continue;
        const unsigned char* wl = F.ws + WS_W + (size_t)layer * WL_BYTES;
        bf16* H = (bf16*)(F.ws + WS_H); bf16* Z = (bf16*)(F.ws + WS_Z); bf16* YS = (bf16*)(F.ws + WS_YS); bf16* MGA = (bf16*)(F.ws + WS_MG); bf16* GT = (bf16*)(F.ws + WS_GT);
        bf16* Y1 = (bf16*)(F.ws + WS_Y1); bf16* P16 = (bf16*)(F.ws + WS_P16); bf16* PP = (bf16*)(F.ws + WS_PP); bf16* HALL = (bf16*)(F.ws + WS_HALL);
#pragma unroll 1
        for (int ch = 0; ch < N_CHUNK; ++ch) {
            const int pb = pl + ch * PH_A;
            const float* x_cur = layer == 0 ? ((ch < 2) ? A.in[0] + (size_t)ch * CH_TOK * D_MODEL : A.in[1]) : A.out + (size_t)ch * CH_TOK * D_MODEL;
            bf16* MG = MGA + (size_t)ch * CH_TOK * D_MODEL;
            if (IN(pb + 0)) { Frame Fp = fresh(F); ph_norm(Fp, x_cur, A.in[4] + (size_t)layer * D_MODEL, H, CH_TOK); SEAM(pb + 0); }
            if (IN(pb + 1)) {
                pg8::Gemm g{H, (const bf16*)(wl + WL_MIX), D_MODEL, D_MODEL, D_MODEL, 0, 0, 0, 0}; pg8::StaticOrder S; S.init(CH_TOK, MIX_IN, F.G, (int)blockIdx.x);
                pg8::EpiStoreBf16 E{Z, MIX_IN};

                pg8::gemm_phase<pg8::EpiStoreBf16, pg8::StaticOrder, true, true>(F.lds, g, S, E);
                SEAM(pb + 1); }
            if (IN(pb + 2)) { Frame Fp = fresh(F); ph_s5a(Fp, A, layer, ch); SEAM(pb + 2); }
            if (IN(pb + 3)) { Frame Fp = fresh(F); ph_mix1(Fp, A, layer, ch); SEAM(pb + 3); }
            if (IN(pb + 4)) { Frame Fp = fresh(F); ph_mix2(Fp, A, layer, ch); SEAM(pb + 4); }
            if (IN(pb + 5)) {
                pg8::Gemm g{Y1, (const bf16*)(wl + WL_GLU), 512, 512, 512, 0, 0, 0, 0}; pg8::StaticOrder S; S.init(CH_TOK, 512, F.G, (int)blockIdx.x);
                pg8::EpiGlu E{Y1, 512, YS, D_MODEL};
                pg8::gemm_phase<pg8::EpiGlu, pg8::StaticOrder, true, true>(F.lds, g, S, E);
                SEAM(pb + 5); }
            if (IN(pb + 6)) {
                pg8::Gemm g{YS, (const bf16*)(wl + WL_BR), D_MODEL, 512, 512, 3, 512, 0, 0}; pg8::StaticOrder S; S.init(CH_TOK, 8192, F.G, (int)blockIdx.x);
                pg8::EpiStoreBf16 E{GT, 8192};

                pg8::gemm_phase<pg8::EpiStoreBf16, pg8::StaticOrder, false, true>(F.lds, g, S, E);
                SEAM(pb + 6); }
            if (IN(pb + 7)) {
                pg8::Gemm g{H, (const bf16*)(wl + WL_G), D_MODEL, D_MODEL, D_MODEL, 0, 0, 2, MK_STAG_MERGE}; pg8::StaticOrder S; S.init(CH_TOK, 32 * 256, F.G, (int)blockIdx.x);
                pg8::EpiMerge E{GT, MG};

                pg8::gemm_phase<pg8::EpiMerge, pg8::StaticOrder, true, true>(F.lds, g, S, E);
                SEAM(pb + 7); }
        }
        {
            const int pb = pl + 3 * PH_A;
            if (IN(pb)) {
                pg8::Gemm g{MGA, (const bf16*)(wl + WL_O), D_MODEL, D_MODEL, D_MODEL, 0, 0, 0, MK_STAG}; pg8::StaticOrder S; S.init(NTOK, D_MODEL, F.G, (int)blockIdx.x);
                pg8::EpiResF32 E{layer == 0 ? A.in[0] : A.out, layer == 0 ? A.in[1] : A.out + (size_t)32768 * D_MODEL, 32768, A.out, D_MODEL};
                pg8::gemm_phase<pg8::EpiResF32, pg8::StaticOrder, true, true>(F.lds, g, S, E);
                SEAM(pb); }
        }
        {
            const int pb = pl + 3 * PH_A + 1;
            bf16* H2 = (bf16*)(F.ws + WS_H2ALL); bf16* MIDA = (bf16*)(F.ws + WS_MIDALL);
            if (IN(pb + 0)) { Frame Fp = fresh(F); ph_norm(Fp, A.out, A.in[21] + (size_t)layer * D_MODEL, H2, NTOK); SEAM(pb + 0); }
            if (IN(pb + 1)) {
                pg8::Gemm g{H2, (const bf16*)(wl + WL_FF), D_MODEL, D_MODEL, D_MODEL, 0, 0, 0, 0}; pg8::StaticOrder S; S.init(NTOK, 2 * D_FF, F.G, (int)blockIdx.x);
                pg8::EpiSwiglu E{MIDA, D_FF};

                pg8::gemm_phase<pg8::EpiSwiglu, pg8::StaticOrder, true, true>(F.lds, g, S, E);
                SEAM(pb + 1); }
            if (IN(pb + 2)) {
                pg8::Gemm g{MIDA, (const bf16*)(wl + WL_FF2), D_FF, D_FF, D_FF, 0, 0, 0, MK_STAG}; pg8::StaticOrder S; S.init(NTOK, D_MODEL, F.G, (int)blockIdx.x);
                pg8::EpiResF32 E{A.out, A.out, 1 << 30, A.out, D_MODEL};
                pg8::gemm_phase<pg8::EpiResF32, pg8::StaticOrder, true, true>(F.lds, g, S, E);
                SEAM(pb + 2); }
        }
        {
            const int pb = pl + 3 * PH_A + 1 + 3;
            if (IN(pb + 0)) { Frame Fp = fresh(F); ph_norm(Fp, A.out, A.in[24] + (size_t)layer * D_MODEL, HALL, NTOK);
                ph_pcvt(Fp, A.in[2] + (size_t)layer * 32768 * PLE_DIM, A.in[3] + (size_t)layer * CH_TOK * PLE_DIM, P16); SEAM(pb + 0); }
            if (IN(pb + 1)) {
                int kpp = PLE_DIM; asm volatile("" : "+s"(kpp));
                pg8::Gemm g{P16, (const bf16*)(wl + WL_PP), kpp, kpp, kpp, 0, 0, 0, 0}; pg8::StaticOrder S; S.init(NTOK, D_MODEL, F.G, (int)blockIdx.x);
                pg8::EpiStoreBf16 E{PP, D_MODEL};
                pg8::gemm_phase<pg8::EpiStoreBf16, pg8::StaticOrder, true, true>(F.lds, g, S, E);
                SEAM(pb + 1); }
            if (IN(pb + 2)) {
                pg8::Gemm g{HALL, (const bf16*)(wl + WL_PG), D_MODEL, D_MODEL, D_MODEL, 0, 0, 0, MK_STAG}; pg8::StaticOrder S; S.init(NTOK, D_MODEL, F.G, (int)blockIdx.x);
                pg8::EpiPle E{A.out, A.out, D_MODEL, PP, D_MODEL};
                pg8::gemm_phase<pg8::EpiPle, pg8::StaticOrder, true, true>(F.lds, g, S, E);
                SEAM(pb + 2); }
        }
    }
#undef IN
#undef SEAM
}

#ifndef MK_PER_PHASE
#define MK_PER_PHASE 0
#endif
extern "C" void kernel_launch(void* const* d_in, const int* in_sizes, int n_in, void* d_out, int out_size, void* d_ws, size_t ws_size, hipStream_t stream) {
    static int grid = 0;
    if (grid == 0) {
        if (n_in != 27 || out_size != NTOK * D_MODEL || ws_size < WS_END) { fprintf(stderr, "kernel_launch: unexpected shapes (n_in %d, out %d, ws %zu); nothing launched\n", n_in, out_size, ws_size); grid = -1; return; }
        int dev = 0, cus = 0, per_cu = 0;
        if (hipGetDevice(&dev) != hipSuccess || hipDeviceGetAttribute(&cus, hipDeviceAttributeMultiprocessorCount, dev) != hipSuccess) { grid = -1; return; }
        if (hipFuncSetAttribute((const void*)fwd_kernel, hipFuncAttributeMaxDynamicSharedMemorySize, LDS_BYTES) != hipSuccess) { fprintf(stderr, "kernel_launch: hipFuncSetAttribute failed\n"); grid = -1; return; }
        if (hipOccupancyMaxActiveBlocksPerMultiprocessor(&per_cu, (const void*)fwd_kernel, NWAVES * 64, LDS_BYTES) != hipSuccess || per_cu < 1)
            fprintf(stderr, "kernel_launch: occupancy query reports %d workgroups per CU\n", per_cu);
        (void)hipGetLastError();
        grid = cus;
    }
    if (grid < 0) return;
    (void)in_sizes;
    if (hipMemsetAsync((char*)d_ws + WS_CTL, 0, CTL_ZERO_BYTES, stream) != hipSuccess) return;
    Args a{};
    for (int i = 0; i < 27; ++i) a.in[i] = (const float*)d_in[i];
    a.out = (float*)d_out; a.ws = (unsigned char*)d_ws;
#if MK_PER_PHASE
    for (int p = 0; p < N_PHASES; ++p) { a.ph_lo = p; a.ph_hi = p + 1; hipLaunchKernelGGL(fwd_kernel, dim3(grid), dim3(NWAVES * 64), LDS_BYTES, stream, a); }
#else
    a.ph_lo = 0; a.ph_hi = N_PHASES;
    hipLaunchKernelGGL(fwd_kernel, dim3(grid), dim3(NWAVES * 64), LDS_BYTES, stream, a);
#endif
}
```

```cpp
#include <hip/hip_runtime.h>
#include <cstdio>
#include <cstdint>

namespace pg8 {
#define PG8_LAS __attribute__((address_space(3)))
typedef unsigned short bf16_t;
typedef short bf16x8 __attribute__((ext_vector_type(8)));
typedef float f32x4 __attribute__((ext_vector_type(4)));
typedef float f32x2 __attribute__((ext_vector_type(2)));
typedef unsigned u32x4 __attribute__((ext_vector_type(4)));
typedef unsigned u32x2 __attribute__((ext_vector_type(2)));
constexpr int BM = 256, BK = 64, HALF = 128, HTB = HALF * BK * 2  , STAGE_BYTES = 8 * HTB, NXCD = 8, WGM = 8;

__host__ __device__ __forceinline__ int lds_byte(int r, int c) { const int st = (r >> 4) * 2 + (c >> 5), rr = r & 15, cc = c & 31, ob = rr * 64 + cc * 2; return st * 1024 + (ob ^ (((ob >> 9) & 1) << 5)); }
__host__ __device__ __forceinline__ void stage_rc(int b, int& R, int& C) { const int st = b / 1024, sb = b % 1024, swz = sb ^ (((sb >> 9) & 1) << 5); R = (st >> 1) * 16 + swz / 64; C = (st & 1) * 32 + (swz % 64) / 2; }
__host__ __device__ __forceinline__ int perm32(int rho) { const int n = rho >> 4, i = rho & 15; return 8 * (i >> 2) + 4 * n + (i & 3); }

struct Unit { int pm, pn; };
struct Gemm { const bf16_t* A; const bf16_t* Bt; int lda, ldb, K, agrp_shift, agrp_stride, bmode, stagger; };

__device__ __forceinline__ void tile_of(int wgid, int nwg, int nM, int nN, int& pm, int& pn) {
    { const int q = nwg / NXCD, r = nwg % NXCD, xcd = wgid % NXCD, off = wgid / NXCD; wgid = (xcd < r ? xcd * (q + 1) : r * (q + 1) + (xcd - r) * q) + off; }
    const int nig = WGM * nN, gid = wgid / nig, fm = gid * WGM, gsz = (nM - fm) < WGM ? (nM - fm) : WGM;
    pm = fm + ((wgid % nig) % gsz); pn = (wgid % nig) / gsz;
}
struct StaticOrder {
    int nM, nN, nwg, G, c;
    __device__ __forceinline__ void init(int M, int N, int G_, int c_) { nM = M / BM; nN = N / BM; nwg = nM * nN; G = G_; c = c_; }
    __device__ __forceinline__ bool next(int i, Unit& u) const {
        const long L = (long)i * G + c; if (L >= nwg) return false;
        tile_of((int)L, nwg, nM, nN, u.pm, u.pn); return true;
    }
};
struct MergeOrder {
    int nM, ntile, G, c;
    __device__ __forceinline__ void init(int M, int G_, int c_) { nM = M / BM; ntile = nM * 16; G = G_; c = c_; }
    __device__ __forceinline__ bool next(int i, Unit& u) const {
        const long L = (long)(i >> 1) * G + c; if (L >= ntile) return false;
        int pm, ct; tile_of((int)L, ntile, nM, 16, pm, ct); u.pm = pm; u.pn = (i & 1) * 16 + ct; return true;
    }
};

typedef __bf16 bf16x2_t __attribute__((ext_vector_type(2)));
__device__ __forceinline__ unsigned cvt_pk_bf16(float lo, float hi) { const f32x2 v = {lo, hi}; return __builtin_bit_cast(unsigned, __builtin_convertvector(v, bf16x2_t)); }
__device__ __forceinline__ float bf_lo(unsigned w) { return __uint_as_float(w << 16); }
__device__ __forceinline__ float bf_hi(unsigned w) { return __uint_as_float(w & 0xffff0000u); }
__device__ __forceinline__ float sigmoidf_fast(float x) { return __builtin_amdgcn_rcpf(1.0f + __expf(-x)); }

__device__ __forceinline__ void st16(void* p, u32x4 v) { *(u32x4*)p = v; }
struct EpiStoreBf16 {
    static constexpr bool PERM = true;
    bf16_t* O; int ldc;
    __device__ __forceinline__ void operator()(const f32x4 (&acc)[2][2][4][2], const Unit& u, int wr, int wc, int fr, int fq) const {
        const int row0 = u.pm * BM + wr * 64 + fr, col0 = u.pn * BM + wc * 32 + 8 * fq;
#pragma unroll
        for (int ai = 0; ai < 2; ++ai)
#pragma unroll
            for (int m = 0; m < 4; ++m) { bf16_t* rowp = O + (size_t)(row0 + ai * HALF + m * 16) * ldc + col0;
#pragma unroll
                for (int bj = 0; bj < 2; ++bj) { const f32x4 v0 = acc[ai][bj][m][0], v1 = acc[ai][bj][m][1];
                    u32x4 w; w.x = cvt_pk_bf16(v0[0], v0[1]); w.y = cvt_pk_bf16(v0[2], v0[3]); w.z = cvt_pk_bf16(v1[0], v1[1]); w.w = cvt_pk_bf16(v1[2], v1[3]);
                    st16(rowp + bj * HALF, w); } }
    }
};
struct EpiStoreBlk {
    static constexpr bool PERM = true;
    bf16_t* O;
    __device__ __forceinline__ void operator()(const f32x4 (&acc)[2][2][4][2], const Unit& u, int wr, int wc, int fr, int fq) const {
        bf16_t* base = O + ((size_t)(u.pm * 16 + wr * 4) * 512 + (u.pn * 16 + wc * 2 + (fq >> 1))) * 256 + fr * 16 + (fq & 1) * 8;
#pragma unroll
        for (int ai = 0; ai < 2; ++ai)
#pragma unroll
            for (int m = 0; m < 4; ++m) { bf16_t* rowp = base + (size_t)(ai * 8 + m) * 512 * 256;
#pragma unroll
                for (int bj = 0; bj < 2; ++bj) { const f32x4 v0 = acc[ai][bj][m][0], v1 = acc[ai][bj][m][1];
                    u32x4 w; w.x = cvt_pk_bf16(v0[0], v0[1]); w.y = cvt_pk_bf16(v0[2], v0[3]); w.z = cvt_pk_bf16(v1[0], v1[1]); w.w = cvt_pk_bf16(v1[2], v1[3]);
                    st16(rowp + bj * 8 * 256, w); } }
    }
};
struct EpiGlu {
    static constexpr bool PERM = true;
    const bf16_t* Y1; int ld1; bf16_t* O; int ldc;
    __device__ __forceinline__ void operator()(const f32x4 (&acc)[2][2][4][2], const Unit& u, int wr, int wc, int fr, int fq) const {
        const int row0 = u.pm * BM + wr * 64 + fr, col0 = u.pn * BM + wc * 32 + 8 * fq;
        u32x4 y[2][4][2];
#pragma unroll
        for (int ai = 0; ai < 2; ++ai)
#pragma unroll
            for (int m = 0; m < 4; ++m)
#pragma unroll
                for (int bj = 0; bj < 2; ++bj) y[ai][m][bj] = *(const u32x4*)(Y1 + (size_t)(row0 + ai * HALF + m * 16) * ld1 + col0 + bj * HALF);
#pragma unroll
        for (int ai = 0; ai < 2; ++ai)
#pragma unroll
            for (int m = 0; m < 4; ++m) { const size_t r = (size_t)(row0 + ai * HALF + m * 16);
#pragma unroll
                for (int bj = 0; bj < 2; ++bj) { const f32x4 v0 = acc[ai][bj][m][0], v1 = acc[ai][bj][m][1]; const u32x4 yy = y[ai][m][bj];
                    u32x4 w;
                    w.x = cvt_pk_bf16(bf_lo(yy.x) * sigmoidf_fast(v0[0]), bf_hi(yy.x) * sigmoidf_fast(v0[1]));
                    w.y = cvt_pk_bf16(bf_lo(yy.y) * sigmoidf_fast(v0[2]), bf_hi(yy.y) * sigmoidf_fast(v0[3]));
                    w.z = cvt_pk_bf16(bf_lo(yy.z) * sigmoidf_fast(v1[0]), bf_hi(yy.z) * sigmoidf_fast(v1[1]));
                    w.w = cvt_pk_bf16(bf_lo(yy.w) * sigmoidf_fast(v1[2]), bf_hi(yy.w) * sigmoidf_fast(v1[3]));
                    *(u32x4*)(O + r * ldc + col0 + bj * HALF) = w; } }
    }
};
struct EpiMerge {
    static constexpr bool PERM = true;
    const bf16_t* P; bf16_t* MG;
    __device__ __forceinline__ void operator()(const f32x4 (&acc)[2][2][4][2], const Unit& u, int wr, int wc, int fr, int fq) const {
        const int row0 = u.pm * BM + wr * 64 + fr, c = u.pn * 64 + wc * 16 + 4 * fq;
        const bf16_t* Pb = P + ((size_t)(u.pm * 16 + wr * 4) * 512 + (u.pn * 4 + wc)) * 256 + fr * 16 + 4 * fq;
#pragma unroll
        for (int ai = 0; ai < 2; ++ai) {
            u32x2 p[4][4];
#pragma unroll
            for (int m = 0; m < 4; ++m)
#pragma unroll
                for (int kb = 0; kb < 4; ++kb) p[m][kb] = *(const u32x2*)(Pb + ((size_t)(ai * 8 + m) * 512 + kb * 128) * 256);
#pragma unroll
            for (int m = 0; m < 4; ++m) { const size_t r = (size_t)(row0 + ai * HALF + m * 16);
                f32x4 t = (f32x4){0.f, 0.f, 0.f, 0.f};
#pragma unroll
                for (int kb = 0; kb < 4; ++kb) { const f32x4 a = acc[ai][kb >> 1][m][kb & 1]; const u32x2 q = p[m][kb];
                    t[0] += bf_lo(q.x) * sigmoidf_fast(a[0]); t[1] += bf_hi(q.x) * sigmoidf_fast(a[1]); t[2] += bf_lo(q.y) * sigmoidf_fast(a[2]); t[3] += bf_hi(q.y) * sigmoidf_fast(a[3]); }
                u32x2 w; w.x = cvt_pk_bf16(t[0], t[1]); w.y = cvt_pk_bf16(t[2], t[3]);
                *(u32x2*)(MG + r * 2048 + c) = w; }
        }
    }
};
struct EpiResF32 {
    static constexpr bool PERM = true;
    const float* base; const float* base2; int split_row; float* out; int ldc;
    __device__ __forceinline__ void operator()(const f32x4 (&acc)[2][2][4][2], const Unit& u, int wr, int wc, int fr, int fq) const {
        const int row0 = u.pm * BM + wr * 64 + fr, col0 = u.pn * BM + wc * 32 + 8 * fq;
        const float* bp = (u.pm * BM >= split_row) ? base2 - (size_t)split_row * ldc : base;
#pragma unroll
        for (int ai = 0; ai < 2; ++ai) {
            f32x4 bs[4][2][2];
#pragma unroll
            for (int m = 0; m < 4; ++m)
#pragma unroll
                for (int bj = 0; bj < 2; ++bj)
#pragma unroll
                    for (int n = 0; n < 2; ++n) bs[m][bj][n] = *(const f32x4*)(bp + (size_t)(row0 + ai * HALF + m * 16) * ldc + col0 + bj * HALF + n * 4);
#pragma unroll
            for (int m = 0; m < 4; ++m)
#pragma unroll
                for (int bj = 0; bj < 2; ++bj)
#pragma unroll
                    for (int n = 0; n < 2; ++n) *(f32x4*)(out + (size_t)(row0 + ai * HALF + m * 16) * ldc + col0 + bj * HALF + n * 4) = bs[m][bj][n] + acc[ai][bj][m][n];
        }
    }
};
struct EpiSwiglu {
    static constexpr bool PERM = true;
    bf16_t* O; int ldc;
    __device__ __forceinline__ void operator()(const f32x4 (&acc)[2][2][4][2], const Unit& u, int wr, int wc, int fr, int fq) const {
        const int row0 = u.pm * BM + wr * 64 + fr, col0 = u.pn * HALF + wc * 32 + 8 * fq;
#pragma unroll
        for (int ai = 0; ai < 2; ++ai)
#pragma unroll
            for (int m = 0; m < 4; ++m) {
                f32x4 t[2];
#pragma unroll
                for (int n = 0; n < 2; ++n)
#pragma unroll
                    for (int j = 0; j < 4; ++j) { const float a = acc[ai][0][m][n][j], b = acc[ai][1][m][n][j]; t[n][j] = a * sigmoidf_fast(a) * b; }
                u32x4 w; w.x = cvt_pk_bf16(t[0][0], t[0][1]); w.y = cvt_pk_bf16(t[0][2], t[0][3]); w.z = cvt_pk_bf16(t[1][0], t[1][1]); w.w = cvt_pk_bf16(t[1][2], t[1][3]);
                st16(O + (size_t)(row0 + ai * HALF + m * 16) * ldc + col0, w); }
    }
};
struct EpiPle {
    static constexpr bool PERM = true;
    const float* base; float* out; int ldc; const bf16_t* PP; int ldp;
    __device__ __forceinline__ void operator()(const f32x4 (&acc)[2][2][4][2], const Unit& u, int wr, int wc, int fr, int fq) const {
        const int row0 = u.pm * BM + wr * 64 + fr, col0 = u.pn * BM + wc * 32 + 8 * fq;
#pragma unroll
        for (int ai = 0; ai < 2; ++ai)
#pragma unroll
            for (int mh = 0; mh < 2; ++mh) {
                f32x4 b0[2][2], b1[2][2]; u32x4 pp[2][2];
#pragma unroll
                for (int mm = 0; mm < 2; ++mm)
#pragma unroll
                    for (int bj = 0; bj < 2; ++bj) { const size_t r = (size_t)(row0 + ai * HALF + (2 * mh + mm) * 16); const int c = col0 + bj * HALF;
                        b0[mm][bj] = *(const f32x4*)(base + r * ldc + c); b1[mm][bj] = *(const f32x4*)(base + r * ldc + c + 4); pp[mm][bj] = *(const u32x4*)(PP + r * ldp + c); }
#pragma unroll
                for (int mm = 0; mm < 2; ++mm)
#pragma unroll
                    for (int bj = 0; bj < 2; ++bj) { const int m = 2 * mh + mm; const size_t r = (size_t)(row0 + ai * HALF + m * 16); const int c = col0 + bj * HALF;
                        const f32x4 a0 = acc[ai][bj][m][0], a1 = acc[ai][bj][m][1]; const u32x4 p = pp[mm][bj];
                        f32x4 o0 = b0[mm][bj], o1 = b1[mm][bj];
                        o0[0] += sigmoidf_fast(a0[0]) * bf_lo(p.x); o0[1] += sigmoidf_fast(a0[1]) * bf_hi(p.x); o0[2] += sigmoidf_fast(a0[2]) * bf_lo(p.y); o0[3] += sigmoidf_fast(a0[3]) * bf_hi(p.y);
                        o1[0] += sigmoidf_fast(a1[0]) * bf_lo(p.z); o1[1] += sigmoidf_fast(a1[1]) * bf_hi(p.z); o1[2] += sigmoidf_fast(a1[2]) * bf_lo(p.w); o1[3] += sigmoidf_fast(a1[3]) * bf_hi(p.w);
                        *(f32x4*)(out + r * ldc + c) = o0; *(f32x4*)(out + r * ldc + c + 4) = o1; }
            }
    }
};
template <class Epi, class Sched, bool ALIGN_EPI = false, bool SP2 = false>
__device__ __forceinline__ void gemm_phase(PG8_LAS unsigned char* lds, const Gemm g, const Sched& S, const Epi& E) {
    int tid_ = threadIdx.x; asm volatile("" : "+v"(tid_));
    const int tid = tid_, wid = __builtin_amdgcn_readfirstlane(tid >> 6), lane = tid & 63, wr = wid >> 2, wc = wid & 3, fr = lane & 15, fq = lane >> 4;
    const int K = g.K, nt = K / BK, lda = g.lda, ldb = g.ldb;
    unsigned voffA[2], voffB[2];
#pragma unroll
    for (int i = 0; i < 2; ++i) { int R, C; stage_rc(tid * 16 + i * 8192, R, C); const int Rb = Epi::PERM ? ((R & ~31) + perm32(R & 31)) : R;
        const int Rg = (g.bmode == 2) ? (((Rb >> 2) & 1) * 2048 + 16 * (Rb >> 5) + 4 * ((Rb >> 3) & 3) + (Rb & 3)) : Rb;
        voffA[i] = (unsigned)(R * lda + C) * 2u; voffB[i] = (unsigned)(Rg * ldb + C) * 2u; }
    const size_t kstep = (size_t)(BK * 2);
    const size_t hstepA = (size_t)HALF * lda * 2, hstepB = (size_t)(g.bmode == 2 ? 4096 : (g.bmode ? 2048 : HALF)) * ldb * 2;
    const size_t tstepA = 2 * hstepA, tstepB = (size_t)BM * ldb * 2;
#define PG8_ABASE(u) ((const char*)g.A + (size_t)(u).pm * tstepA + (size_t)((u).pn >> g.agrp_shift) * (size_t)g.agrp_stride * 2)
#define PG8_BBASE(u) ((const char*)g.Bt + (g.bmode == 2 ? (size_t)((u).pn * 64) * ldb * 2 : (g.bmode ? (size_t)(((u).pn >> 4) * 4096 + ((u).pn & 15) * HALF) * ldb * 2 : (size_t)(u).pn * tstepB)))
    const unsigned ldsw = (unsigned)wid * 1024u;
    const int aoff = lds_byte(wr * 64 + fr, fq * 8), boff = lds_byte(wc * 32 + fr, fq * 8);
#define PG8_SA(b, h) (((b) * 2 + (h)) * HTB)
#define PG8_SB(b, h) ((4 + (b) * 2 + (h)) * HTB)
#define PG8_STAGE(bufoff, gbase, voff) do { _Pragma("unroll") for (int _i = 0; _i < 2; ++_i) \
        __builtin_amdgcn_global_load_lds((const unsigned*)((const char*)(gbase) + (voff)[_i]), (PG8_LAS unsigned*)(lds + (bufoff) + ldsw + _i * 8192), 16, 0, 0); } while (0)
#define PG8_LDA(dst, b, h) do { _Pragma("unroll") for (int m = 0; m < 4; ++m) _Pragma("unroll") for (int k = 0; k < 2; ++k) dst[m][k] = *(const PG8_LAS bf16x8*)(lds + PG8_SA(b, h) + aoff + m * 2048 + k * 1024); } while (0)
#define PG8_LDB(dst, b, h) do { _Pragma("unroll") for (int n = 0; n < 2; ++n) _Pragma("unroll") for (int k = 0; k < 2; ++k) dst[n][k] = *(const PG8_LAS bf16x8*)(lds + PG8_SB(b, h) + boff + n * 2048 + k * 1024); } while (0)
#define PG8_MMA(ai, bj, At, Bt) do { __builtin_amdgcn_s_setprio(1); _Pragma("unroll") for (int m = 0; m < 4; ++m) _Pragma("unroll") for (int n = 0; n < 2; ++n) _Pragma("unroll") for (int k = 0; k < 2; ++k) \
        acc[ai][bj][m][n] = __builtin_amdgcn_mfma_f32_16x16x32_bf16(Bt[n][k], At[m][k], acc[ai][bj][m][n], 0, 0, 0); __builtin_amdgcn_s_setprio(0); } while (0)
#define PG8_WAIT_V(n) asm volatile("s_waitcnt vmcnt(" #n ")" ::: "memory")
#define PG8_WAIT_L(n) asm volatile("s_waitcnt lgkmcnt(" #n ")" ::: "memory")
#define PG8_BAR __builtin_amdgcn_s_barrier()
#define PG8_SCHED __builtin_amdgcn_sched_barrier(0)
    Unit cur, nxt; int ui = 0;
    if (!S.next(0, cur)) return;
    if (g.stagger) { const unsigned long long t0_ = __builtin_amdgcn_s_memrealtime(), d_ = (unsigned long long)(((blockIdx.x >> 3) & 7) * g.stagger);
        while (__builtin_amdgcn_s_memrealtime() - t0_ < d_) __builtin_amdgcn_s_sleep(8); }
    f32x4 acc[2][2][4][2];
#pragma unroll
    for (int a = 0; a < 2; ++a)
#pragma unroll
        for (int b = 0; b < 2; ++b)
#pragma unroll
            for (int m = 0; m < 4; ++m)
#pragma unroll
                for (int n = 0; n < 2; ++n) acc[a][b][m][n] = (f32x4){0.f, 0.f, 0.f, 0.f};
    bf16x8 At[4][2], B0[2][2], B1[2][2];
    const char* cA = PG8_ABASE(cur); const char* cB = PG8_BBASE(cur);
    if constexpr (SP2) {
        PG8_STAGE(PG8_SB(0, 0), cB, voffB); PG8_STAGE(PG8_SB(0, 1), cB + hstepB, voffB); PG8_STAGE(PG8_SA(0, 0), cA, voffA); PG8_STAGE(PG8_SA(0, 1), cA + hstepA, voffA);
        if (wr == 1) PG8_BAR;
        PG8_WAIT_V(2); PG8_BAR;
        PG8_STAGE(PG8_SB(1, 0), cB + kstep, voffB); PG8_STAGE(PG8_SA(1, 0), cA + kstep, voffA); PG8_STAGE(PG8_SB(1, 1), cB + hstepB + kstep, voffB);
        PG8_WAIT_V(6); PG8_BAR;
    } else {
        PG8_STAGE(PG8_SB(0, 0), cB, voffB); PG8_STAGE(PG8_SA(0, 0), cA, voffA); PG8_STAGE(PG8_SB(0, 1), cB + hstepB, voffB); PG8_STAGE(PG8_SA(0, 1), cA + hstepA, voffA);
        if (wr == 1) PG8_BAR;
        PG8_WAIT_V(4); PG8_BAR;
        PG8_STAGE(PG8_SB(1, 0), cB + kstep, voffB); PG8_STAGE(PG8_SA(1, 0), cA + kstep, voffA); PG8_STAGE(PG8_SB(1, 1), cB + hstepB + kstep, voffB);
        PG8_WAIT_V(6); PG8_BAR;
    }
    for (;;) {
        const bool has_next = S.next(ui + 1, nxt);
        const char* nA = has_next ? PG8_ABASE(nxt) : cA; const char* nB = has_next ? PG8_BBASE(nxt) : cB;
        for (int t = 0; t < nt; t += 2) {
            const bool last = (t == nt - 2);
            const char* a1 = cA + (size_t)(t + 1) * kstep;
            const char* a2 = last ? nA : cA + (size_t)(t + 2) * kstep; const char* b2 = last ? nB : cB + (size_t)(t + 2) * kstep;
            const char* a3 = a2 + kstep; const char* b3 = b2 + kstep;
            if constexpr (SP2) {
            PG8_LDB(B0, 0, 0); PG8_LDB(B1, 0, 1); PG8_SCHED; PG8_LDA(At, 0, 0); PG8_STAGE(PG8_SA(1, 1), a1 + hstepA, voffA);
            PG8_WAIT_V(8); PG8_WAIT_L(0); PG8_BAR; PG8_MMA(0, 0, At, B0); PG8_MMA(0, 1, At, B1); PG8_BAR; PG8_SCHED;
            PG8_LDA(At, 0, 1); PG8_STAGE(PG8_SB(0, 0), b2, voffB); PG8_STAGE(PG8_SB(0, 1), b2 + hstepB, voffB); PG8_STAGE(PG8_SA(0, 0), a2, voffA);
            PG8_WAIT_V(8); PG8_WAIT_L(0); PG8_BAR; PG8_MMA(1, 0, At, B0); PG8_MMA(1, 1, At, B1); PG8_BAR; PG8_SCHED;
            PG8_LDB(B0, 1, 0); PG8_LDB(B1, 1, 1); PG8_SCHED; PG8_LDA(At, 1, 0); PG8_STAGE(PG8_SA(0, 1), a2 + hstepA, voffA);
            PG8_WAIT_V(8); PG8_WAIT_L(0); PG8_BAR; PG8_MMA(0, 0, At, B0); PG8_MMA(0, 1, At, B1); PG8_BAR; PG8_SCHED;
            PG8_LDA(At, 1, 1); PG8_STAGE(PG8_SB(1, 0), b3, voffB); PG8_STAGE(PG8_SB(1, 1), b3 + hstepB, voffB); PG8_STAGE(PG8_SA(1, 0), a3, voffA);
            PG8_WAIT_V(8); PG8_WAIT_L(0); PG8_BAR; PG8_MMA(1, 0, At, B0); PG8_MMA(1, 1, At, B1); PG8_BAR; PG8_SCHED;
            } else {
            PG8_LDB(B0, 0, 0); PG8_SCHED; PG8_LDA(At, 0, 0); PG8_STAGE(PG8_SA(1, 1), a1 + hstepA, voffA);
            PG8_WAIT_L(8); PG8_BAR; PG8_WAIT_L(0); PG8_MMA(0, 0, At, B0); PG8_BAR; PG8_SCHED;
            PG8_LDB(B1, 0, 1); PG8_STAGE(PG8_SB(0, 0), b2, voffB);
            PG8_BAR; PG8_WAIT_L(0); PG8_MMA(0, 1, At, B1); PG8_BAR;
            PG8_LDA(At, 0, 1); PG8_STAGE(PG8_SA(0, 0), a2, voffA);
            PG8_BAR; PG8_WAIT_L(0); PG8_MMA(1, 0, At, B0); PG8_BAR; PG8_SCHED;
            PG8_STAGE(PG8_SB(0, 1), b2 + hstepB, voffB);
            PG8_WAIT_V(6); PG8_BAR; PG8_MMA(1, 1, At, B1); PG8_BAR;
            PG8_LDB(B0, 1, 0); PG8_SCHED; PG8_LDA(At, 1, 0); PG8_STAGE(PG8_SA(0, 1), a2 + hstepA, voffA);
            PG8_WAIT_L(8); PG8_BAR; PG8_WAIT_L(0); PG8_MMA(0, 0, At, B0); PG8_BAR; PG8_SCHED;
            PG8_LDB(B1, 1, 1); PG8_STAGE(PG8_SB(1, 0), b3, voffB);
            PG8_BAR; PG8_WAIT_L(0); PG8_MMA(0, 1, At, B1); PG8_BAR;
            PG8_LDA(At, 1, 1); PG8_STAGE(PG8_SA(1, 0), a3, voffA);
            PG8_BAR; PG8_WAIT_L(0); PG8_MMA(1, 0, At, B0); PG8_BAR; PG8_SCHED;
            PG8_STAGE(PG8_SB(1, 1), b3 + hstepB, voffB);
            PG8_WAIT_V(6); PG8_BAR; PG8_MMA(1, 1, At, B1); PG8_BAR;
            }
        }
        if constexpr (ALIGN_EPI) { if (wr == 0) PG8_BAR; }
        { E(acc, cur, wr, wc, fr, fq); }
        if (!has_next) break;
#pragma unroll
        for (int a = 0; a < 2; ++a)
#pragma unroll
            for (int b = 0; b < 2; ++b)
#pragma unroll
                for (int m = 0; m < 4; ++m)
#pragma unroll
                    for (int n = 0; n < 2; ++n) acc[a][b][m][n] = (f32x4){0.f, 0.f, 0.f, 0.f};
        cur = nxt; cA = nA; cB = nB; ++ui;
        if constexpr (ALIGN_EPI) { if (wr == 1) PG8_BAR; }
    }
    PG8_WAIT_V(0);
    if constexpr (!ALIGN_EPI) { if (wr == 0) PG8_BAR; }
    PG8_BAR;
#undef PG8_ABASE
#undef PG8_BBASE
#undef PG8_SA
#undef PG8_SB
#undef PG8_STAGE
#undef PG8_LDA
#undef PG8_LDB
#undef PG8_MMA
#undef PG8_WAIT_V
#undef PG8_WAIT_L
#undef PG8_BAR
#undef PG8_SCHED
}
}


constexpr int D_MODEL = 2048, NTOK = 49152, CH_TOK = 16384, N_CHUNK = 3, DEPTH = 2;
constexpr int MIX_IN = 4096, IN_COLS = 12288, D_FF = 5632, PLE_DIM = 256;
constexpr int ZC_UA = 0, ZC_BG = 512, ZC_CG = 1024, ZC_VB = 1536, ZC_Q = 2048, ZC_K = 2560, ZC_VC = 3072, ZC_UD = 3584;
constexpr float EPS = 1e-6f;
constexpr int NWAVES = 8;

constexpr size_t MiB = 1u << 20;
constexpr size_t WS_CTL = 0, CTL_ZERO_BYTES = 1 * MiB;
constexpr size_t WS_TAB = 1 * MiB;
constexpr size_t S5T_BYTES = 12800, S5T_BB = 0, S5T_C = 8192, S5T_AB = 12288;
constexpr size_t TAB_S5 = WS_TAB, TAB_C128 = WS_TAB + 2 * MiB, TAB_S128 = TAB_C128 + 32768, TAB_C32 = TAB_S128 + 32768, TAB_S32 = TAB_C32 + 2048;
constexpr size_t WS_W = 8 * MiB;
constexpr size_t WL_MIX = 0, WL_G = 16 * MiB, WL_GLU = 48 * MiB, WL_BR = WL_GLU + MiB / 2, WL_O = WL_BR + 8 * MiB, WL_FF = WL_O + 8 * MiB, WL_FF2 = WL_FF + 44 * MiB, WL_PG = WL_FF2 + 22 * MiB, WL_PP = WL_PG + 8 * MiB;
constexpr size_t WL_BYTES = WL_PP + 1 * MiB;
static_assert(WL_BYTES == 139 * MiB + MiB / 2, "weight map");
constexpr size_t WS_H = 288 * MiB;
constexpr size_t WS_Z = 352 * MiB;
constexpr size_t WS_YS = 480 * MiB;
constexpr size_t WS_HALL = 352 * MiB;
constexpr size_t WS_MG = 544 * MiB;
constexpr size_t WS_GT = 736 * MiB;
constexpr size_t WS_YF = WS_GT, WS_YB = WS_GT + 32 * MiB, WS_ZF = WS_GT + 64 * MiB, WS_Y1 = WS_GT + 96 * MiB, WS_S5E = WS_GT + 112 * MiB;
constexpr size_t WS_H2ALL = 288 * MiB, WS_MIDALL = 480 * MiB;
constexpr size_t WS_PP = WS_GT;
constexpr size_t WS_P16 = 992 * MiB;
constexpr size_t WS_END = 1016 * MiB;
static_assert(WS_MIDALL + 528 * MiB <= WS_END && WS_H2ALL + 192 * MiB <= WS_MIDALL, "ffn map");
static_assert(WS_W + 2 * WL_BYTES <= WS_H && WS_MG + 192 * MiB <= WS_GT && WS_GT + 256 * MiB <= WS_P16, "ws map");
constexpr int CW_BAR = 4096;

constexpr int LDS_SCRATCH = 151552;
constexpr int LDSCTL_OFF = LDS_SCRATCH;
constexpr int LDS_BYTES = LDS_SCRATCH + 256;

#define GAS __attribute__((address_space(1)))
#define LAS __attribute__((address_space(3)))
typedef unsigned short bf16;
typedef unsigned u32x4 __attribute__((ext_vector_type(4)));
typedef unsigned u32x2 __attribute__((ext_vector_type(2)));
typedef float f32x4 __attribute__((ext_vector_type(4)));
typedef float f32x2 __attribute__((ext_vector_type(2)));
typedef short bf16x8 __attribute__((ext_vector_type(8)));
#define LDS_WAIT() asm volatile("s_waitcnt lgkmcnt(0)" ::: "memory")
using pg8::cvt_pk_bf16; using pg8::bf_lo; using pg8::bf_hi;
__device__ __forceinline__ bf16x8 as_frag(u32x4 v) { return __builtin_bit_cast(bf16x8, v); }
__device__ __forceinline__ void mfma_acc(f32x4& acc, bf16x8 a, bf16x8 b) { asm volatile("s_nop 1\n\tv_mfma_f32_16x16x32_bf16 %0, %1, %2, %0" : "+v"(acc) : "v"(a), "v"(b)); }
__device__ __forceinline__ f32x4 mfma16(bf16x8 a, bf16x8 b, f32x4 c) { mfma_acc(c, a, b); return c; }
#define MFMA_DRAIN() do { __builtin_amdgcn_sched_barrier(0); asm volatile("s_nop 15\n\ts_nop 15" ::: "memory"); __builtin_amdgcn_sched_barrier(0); } while (0)
__device__ __forceinline__ float wave_sum(float v) {
#pragma unroll
    for (int o = 1; o < 64; o <<= 1) v += __shfl_xor(v, o);
    return v;
}
__device__ __forceinline__ unsigned short f2bf(float f) { return (unsigned short)(cvt_pk_bf16(f, 0.f) & 0xffffu); }

#define XB_TMO      128
#define XB_XCNT(j)  (256  + 64 * (j))
#define XB_XSUB(j)  (1280 + 64 * (j))
#define XB_XGEN(j)  (2304 + 64 * (j))
#define XB_TOP      3328
#define XB_TOPGEN   3392
#define XCD_BAR_WORDS 3456
#define XB_SPIN_CAP (1u << 22)
__device__ __forceinline__ unsigned xb_ld(unsigned* p)              { return __hip_atomic_load(p, __ATOMIC_RELAXED, __HIP_MEMORY_SCOPE_AGENT); }
__device__ __forceinline__ unsigned xb_add(unsigned* p, unsigned v) { return __hip_atomic_fetch_add(p, v, __ATOMIC_RELAXED, __HIP_MEMORY_SCOPE_AGENT); }
__device__ __forceinline__ unsigned xb_xcc_id() { return (unsigned)__builtin_amdgcn_s_getreg((3 << 11) | 20) & 0xFu; }
#define XB_SPIN(cond, bar) do { unsigned _sp = 0; while (cond) { __builtin_amdgcn_s_sleep(1); \
    if ((++_sp & 255u) == 0u) { if (xb_ld(&(bar)[XB_TMO])) break; if (_sp > XB_SPIN_CAP) { atomicAdd(&(bar)[XB_TMO], 1u); break; } } } } while (0)
struct XcdBarrier { unsigned* bar; unsigned x; volatile LAS unsigned* st; };
__device__ __forceinline__ XcdBarrier xcd_barrier_post(unsigned* bar, volatile LAS unsigned* st) {
    XcdBarrier b; b.bar = bar; b.x = xb_xcc_id(); b.st = st;
    if (threadIdx.x == 0) (void)xb_add(&bar[XB_XCNT(b.x)], 1u);
    return b;
}
__device__ __forceinline__ void xcd_barrier_complete(unsigned* bar, unsigned x, unsigned& nloc, unsigned& nx) {
    const unsigned G = gridDim.x * gridDim.y * gridDim.z;
    unsigned sum, cnt, mine, sp = 0u;
    for (;;) {
        sum = 0u; cnt = 0u; mine = 0u;
#pragma unroll
        for (unsigned j = 0; j < 16; ++j) { const unsigned c = xb_ld(&bar[XB_XCNT(j)]); sum += c; cnt += (c > 0u) ? 1u : 0u; mine = (j == x) ? c : mine; }
        if (sum == G) break;
        __builtin_amdgcn_s_sleep(1);
        if ((++sp & 255u) == 0u) { if (xb_ld(&bar[XB_TMO])) break; if (sp > XB_SPIN_CAP) { atomicAdd(&bar[XB_TMO], 1u); break; } }
    }
    nloc = mine > 0u ? mine : 1u; nx = cnt > 0u ? cnt : 1u;
}
__device__ __forceinline__ void xcd_barrier(const XcdBarrier& b) {
    asm volatile("s_waitcnt vmcnt(0)" ::: "memory");
    __syncthreads();
    if (threadIdx.x == 0) {
        unsigned* bar = b.bar;
        __builtin_amdgcn_s_waitcnt(0);
        unsigned nloc = b.st[0], nx = b.st[1];
        if (nloc == 0u) { xcd_barrier_complete(bar, b.x, nloc, nx); b.st[0] = nloc; b.st[1] = nx; }
        const unsigned old = xb_add(&bar[XB_XSUB(b.x)], 1u);
        const unsigned gen = old / nloc;
        if (old + 1u == (gen + 1u) * nloc) {
            __builtin_amdgcn_fence(__ATOMIC_RELEASE, "agent");
            asm volatile("s_waitcnt vmcnt(0)" ::: "memory");
            const unsigned og = xb_add(&bar[XB_TOP], 1u);
            const unsigned tg = og / nx;
            if (og + 1u == (tg + 1u) * nx) xb_add(&bar[XB_TOPGEN], 1u);
            else XB_SPIN(xb_ld(&bar[XB_TOPGEN]) == tg, bar);
            __builtin_amdgcn_fence(__ATOMIC_ACQUIRE, "agent");
            xb_add(&bar[XB_XGEN(b.x)], 1u);
            asm volatile("s_waitcnt vmcnt(0)" ::: "memory");
        } else {
            XB_SPIN(xb_ld(&bar[XB_XGEN(b.x)]) == gen, bar);
            __builtin_amdgcn_fence(__ATOMIC_ACQUIRE, "agent");
            asm volatile("s_waitcnt vmcnt(0)" ::: "memory");
        }
    }
    __syncthreads();
}

struct Frame {
    LAS unsigned char* lds;
    int tid, lane, wave;
    int vcu, G;
    unsigned char* ws;
};
struct Args { const float* in[27]; float* out; unsigned char* ws; int ph_lo, ph_hi; };
__device__ __forceinline__ Frame fresh(const Frame& F0) { Frame F = F0; int t = F0.tid; asm volatile("" : "+v"(t)); F.tid = t; F.lane = t & 63; F.wave = __builtin_amdgcn_readfirstlane(t >> 6); return F; }

__device__ __forceinline__ void transpose_item(const float* W, int K, int N, bf16* WT, int k0, int n0, int drow0, LAS float* scr, int lane) {
#pragma unroll 8
    for (int i = 0; i < 32; ++i) { const int kk = 2 * i + (lane >> 5); scr[kk * 33 + (lane & 31)] = W[(size_t)(k0 + kk) * N + n0 + (lane & 31)]; }
    LDS_WAIT(); asm volatile("" ::: "memory");
    const int c = lane & 7;
#pragma unroll
    for (int j = 0; j < 4; ++j) { const int n = (lane >> 3) + 8 * j; const LAS float* s = scr + (8 * c) * 33 + n;
        u32x4 o; o.x = cvt_pk_bf16(s[0 * 33], s[1 * 33]); o.y = cvt_pk_bf16(s[2 * 33], s[3 * 33]); o.z = cvt_pk_bf16(s[4 * 33], s[5 * 33]); o.w = cvt_pk_bf16(s[6 * 33], s[7 * 33]);
        *(u32x4*)(WT + (size_t)(drow0 + n) * K + k0 + 8 * c) = o; }
    LDS_WAIT(); asm volatile("" ::: "memory");
}
__device__ __forceinline__ void conv_plain(const float* W, int K, int N, bf16* WT, int item, LAS float* scr, int lane) {
    const int nblk = N / 32, kb = item / nblk, nb = item % nblk;
    transpose_item(W, K, N, WT, 64 * kb, 32 * nb, 32 * nb, scr, lane);
}
__device__ __forceinline__ void ph_prologue(Frame& F, const Args& A) {
    LAS float* scr = (LAS float*)(F.lds + F.wave * 16384);
    const int gw = F.vcu * NWAVES + F.wave, NGW = F.G * NWAVES;
    constexpr int I_IN = (2048 / 64) * (IN_COLS / 32), I_GLU = (512 / 64) * (512 / 32), I_BR1 = (512 / 64) * (2048 / 32), I_BR = 4 * I_BR1, I_O = (2048 / 64) * (2048 / 32),
                  I_FF = (2048 / 64) * (2 * D_FF / 32), I_FF2 = (D_FF / 64) * (2048 / 32), I_PG = I_O, I_PP = (256 / 64) * (2048 / 32);
    constexpr int I_LAYER = I_IN + I_GLU + I_BR + I_O + I_FF + I_FF2 + I_PG + I_PP;
    for (int it = gw; it < DEPTH * I_LAYER; it += NGW) {
        const int l = it / I_LAYER; int r = it % I_LAYER;
        unsigned char* wl = F.ws + WS_W + (size_t)l * WL_BYTES;
        if (r < I_IN) {
            const float* W = A.in[5] + (size_t)l * 2048 * IN_COLS; const int nblk = IN_COLS / 32, kb = r / nblk, nb = r % nblk, n0 = 32 * nb;
            if (n0 < MIX_IN) transpose_item(W, 2048, IN_COLS, (bf16*)(wl + WL_MIX), 64 * kb, n0, n0, scr, F.lane);
            else transpose_item(W, 2048, IN_COLS, (bf16*)(wl + WL_G), 64 * kb, n0, n0 - MIX_IN, scr, F.lane);
            continue; } r -= I_IN;
        if (r < I_GLU) { conv_plain(A.in[14] + (size_t)l * 512 * 512, 512, 512, (bf16*)(wl + WL_GLU), r, scr, F.lane); continue; } r -= I_GLU;
        if (r < I_BR) { const int kb = r / I_BR1; conv_plain(A.in[19] + ((size_t)l * 4 + kb) * 512 * 2048, 512, 2048, (bf16*)(wl + WL_BR) + (size_t)kb * 2048 * 512, r % I_BR1, scr, F.lane); continue; } r -= I_BR;
        if (r < I_O) { conv_plain(A.in[20] + (size_t)l * 2048 * 2048, 2048, 2048, (bf16*)(wl + WL_O), r, scr, F.lane); continue; } r -= I_O;
        if (r < I_FF) {
            const float* W = A.in[22] + (size_t)l * 2048 * 2 * D_FF; const int nblk = 2 * D_FF / 32, kb = r / nblk, nb = r % nblk, n0 = 32 * nb;
            const int j = n0 / D_FF, rr = n0 % D_FF, pn = rr / 128, cc = rr % 128;
            transpose_item(W, 2048, 2 * D_FF, (bf16*)(wl + WL_FF), 64 * kb, n0, 256 * pn + 128 * j + cc, scr, F.lane);
            continue; } r -= I_FF;
        if (r < I_FF2) { conv_plain(A.in[23] + (size_t)l * D_FF * 2048, D_FF, 2048, (bf16*)(wl + WL_FF2), r, scr, F.lane); continue; } r -= I_FF2;
        if (r < I_PG) { conv_plain(A.in[25] + (size_t)l * 2048 * 2048, 2048, 2048, (bf16*)(wl + WL_PG), r, scr, F.lane); continue; } r -= I_PG;
        conv_plain(A.in[26] + (size_t)l * 256 * 2048, 256, 2048, (bf16*)(wl + WL_PP), r, scr, F.lane);
    }
    {
        const int gt = F.vcu * 512 + F.tid, NT = F.G * 512;
        bf16* c128 = (bf16*)(F.ws + TAB_C128); bf16* s128 = (bf16*)(F.ws + TAB_S128); bf16* c32 = (bf16*)(F.ws + TAB_C32); bf16* s32 = (bf16*)(F.ws + TAB_S32);
        for (int e = gt; e < 128 * 128 + 32 * 32; e += NT) {
            if (e < 128 * 128) { const int i = e >> 7, k = e & 127, m = (i * k) & 127; float sn, cs; sincospif((float)m * (1.0f / 64.0f), &sn, &cs);
                c128[e] = f2bf(cs * 0.08838834764831845f); s128[e] = f2bf(sn * 0.08838834764831845f); }
            else { const int e2 = e - 128 * 128, i = e2 >> 5, k = e2 & 31, m = (i * k) & 31; float sn, cs; sincospif((float)m * (1.0f / 16.0f), &sn, &cs);
                c32[e2] = f2bf(cs * 0.17677669529663687f); s32[e2] = f2bf(sn * 0.17677669529663687f); }
        }
    }
    for (int t = gw; t < DEPTH * 2 * 32; t += NGW) {
        const int g = t & 31, ld = t >> 5;
        unsigned char* tb = F.ws + TAB_S5 + (size_t)t * S5T_BYTES;
        const float* lam_re = A.in[6] + (size_t)t * 64; const float* lam_im = A.in[7] + (size_t)t * 64;
        const float dt = expf(A.in[8][t]);
        const float* b_re = A.in[9] + (size_t)t * 64 * 16; const float* b_im = A.in[10] + (size_t)t * 64 * 16;
        const float* c_re = A.in[11] + (size_t)t * 16 * 64; const float* c_im = A.in[12] + (size_t)t * 16 * 64;
        (void)g; (void)ld;
        const int lane = F.lane, l15 = lane & 15, g4 = lane >> 4;
        {
            const float lr = lam_re[lane], li = lam_im[lane], mag = expf(lr * dt); float sn, cs; sincosf(li * dt, &sn, &cs);
            f32x2 ab; ab.x = mag * cs; ab.y = mag * sn; ((f32x2*)(tb + S5T_AB))[lane] = ab;
        }
#pragma unroll 1
        for (int cb = 0; cb < 8; ++cb) {
            const int col = 16 * cb + l15, p = col >> 1, ri = col & 1;
            const float lr = lam_re[p], li = lam_im[p], mag = expf(lr * dt); float sn, cs; sincosf(li * dt, &sn, &cs);
            const float ar = mag * cs, ai = mag * sn, den = lr * lr + li * li;
            const float fr = ((ar - 1.0f) * lr + ai * li) / den, fi = (ai * lr - (ar - 1.0f) * li) / den;
            float v[8];
#pragma unroll
            for (int j = 0; j < 8; ++j) { const int h = 8 * g4 + j; float x = 0.f;
                if (h < 16) { const float br = b_re[p * 16 + h], bi = b_im[p * 16 + h]; x = ri ? (fr * bi + fi * br) : (fr * br - fi * bi); }
                v[j] = x; }
            u32x4 o; o.x = cvt_pk_bf16(v[0], v[1]); o.y = cvt_pk_bf16(v[2], v[3]); o.z = cvt_pk_bf16(v[4], v[5]); o.w = cvt_pk_bf16(v[6], v[7]);
            ((u32x4*)(tb + S5T_BB))[cb * 64 + lane] = o;
        }
#pragma unroll 1
        for (int ks = 0; ks < 4; ++ks) {
            float v[8];
#pragma unroll
            for (int j = 0; j < 8; ++j) { const int col = 32 * ks + 8 * g4 + j, p = col >> 1, ri = col & 1; v[j] = ri ? -c_im[l15 * 64 + p] : c_re[l15 * 64 + p]; }
            u32x4 o; o.x = cvt_pk_bf16(v[0], v[1]); o.y = cvt_pk_bf16(v[2], v[3]); o.z = cvt_pk_bf16(v[4], v[5]); o.w = cvt_pk_bf16(v[6], v[7]);
            ((u32x4*)(tb + S5T_C))[ks * 64 + lane] = o;
        }
    }
}

__device__ __forceinline__ void ph_norm(Frame& F, const float* xsrc, const float* gain, bf16* H, int nrows) {
    const int gw = F.vcu * NWAVES + F.wave, NGW = F.G * NWAVES;
    f32x4 gv[8];
#pragma unroll
    for (int j = 0; j < 8; ++j) gv[j] = ((const f32x4*)gain)[F.lane + 64 * j];
    for (int m = gw; m < nrows; m += NGW) {
        const f32x4* xr = (const f32x4*)(xsrc + (size_t)m * D_MODEL) + F.lane;
        f32x4 v[8]; float s = 0.f;
#pragma unroll
        for (int j = 0; j < 8; ++j) { v[j] = xr[64 * j]; s += (v[j][0] * v[j][0] + v[j][1] * v[j][1]) + (v[j][2] * v[j][2] + v[j][3] * v[j][3]); }
        const float rstd = rsqrtf(wave_sum(s) * (1.0f / D_MODEL) + EPS);
        u32x2* o = (u32x2*)(H + (size_t)m * D_MODEL) + F.lane;
#pragma unroll
        for (int j = 0; j < 8; ++j) { u32x2 w; w.x = cvt_pk_bf16(v[j][0] * rstd * gv[j][0], v[j][1] * rstd * gv[j][1]); w.y = cvt_pk_bf16(v[j][2] * rstd * gv[j][2], v[j][3] * rstd * gv[j][3]); o[64 * j] = w; }
    }
}
__device__ __forceinline__ void ph_pcvt(Frame& F, const float* pp, const float* ps, bf16* P16) {
    const int gw = F.vcu * NWAVES + F.wave, NGW = F.G * NWAVES;
    for (int m = gw; m < NTOK; m += NGW) {
        const float* src = m < 32768 ? pp + (size_t)m * PLE_DIM : ps + (size_t)(m - 32768) * PLE_DIM;
        const f32x4 v = ((const f32x4*)src)[F.lane];
        u32x2 w; w.x = cvt_pk_bf16(v[0], v[1]); w.y = cvt_pk_bf16(v[2], v[3]);
        ((u32x2*)(P16 + (size_t)m * PLE_DIM))[F.lane] = w;
    }
}
__device__ __forceinline__ void unpack8(u32x4 w, float (&f)[8]) { f[0] = bf_lo(w.x); f[1] = bf_hi(w.x); f[2] = bf_lo(w.y); f[3] = bf_hi(w.y); f[4] = bf_lo(w.z); f[5] = bf_hi(w.z); f[6] = bf_lo(w.w); f[7] = bf_hi(w.w); }
__device__ __forceinline__ u32x4 pack8(const float (&f)[8]) { u32x4 w; w.x = cvt_pk_bf16(f[0], f[1]); w.y = cvt_pk_bf16(f[2], f[3]); w.z = cvt_pk_bf16(f[4], f[5]); w.w = cvt_pk_bf16(f[6], f[7]); return w; }

__device__ __forceinline__ void conv_block(Frame& F, const bf16* Z, bf16* YS, const float* cw  , int blk, int lseq) {
#pragma unroll 1
    for (int i = 0; i < 8; ++i) {
        const int idx = F.tid + 512 * i, r = blk * 64 + (idx >> 6), c = (idx & 63) * 8, lpos = r % lseq;
        const bf16* zr = Z + (size_t)r * MIX_IN;
        float bg[8], z0[8], acc[8], tmp[8], w[8];
        unpack8(*(const u32x4*)(zr + ZC_BG + c), bg);
        {   float cg[8], vv[8]; unpack8(*(const u32x4*)(zr + ZC_CG + c), cg); unpack8(*(const u32x4*)(zr + ZC_VB + c), vv);
            const f32x4 wa = *(const f32x4*)(cw + 512 + c), wb = *(const f32x4*)(cw + 512 + c + 4);
            w[0] = wa[0]; w[1] = wa[1]; w[2] = wa[2]; w[3] = wa[3]; w[4] = wb[0]; w[5] = wb[1]; w[6] = wb[2]; w[7] = wb[3];
#pragma unroll
            for (int j = 0; j < 8; ++j) { z0[j] = cg[j] * vv[j]; acc[j] = w[j] * z0[j]; } }
        if (lpos > 0) { float cg[8], vv[8]; unpack8(*(const u32x4*)(zr - MIX_IN + ZC_CG + c), cg); unpack8(*(const u32x4*)(zr - MIX_IN + ZC_VB + c), vv);
            const f32x4 wa = *(const f32x4*)(cw + c), wb = *(const f32x4*)(cw + c + 4);
            w[0] = wa[0]; w[1] = wa[1]; w[2] = wa[2]; w[3] = wa[3]; w[4] = wb[0]; w[5] = wb[1]; w[6] = wb[2]; w[7] = wb[3];
#pragma unroll
            for (int j = 0; j < 8; ++j) acc[j] += w[j] * (cg[j] * vv[j]); }
        if (lpos < lseq - 1) { float cg[8], vv[8]; unpack8(*(const u32x4*)(zr + MIX_IN + ZC_CG + c), cg); unpack8(*(const u32x4*)(zr + MIX_IN + ZC_VB + c), vv);
            const f32x4 wa = *(const f32x4*)(cw + 1024 + c), wb = *(const f32x4*)(cw + 1024 + c + 4);
            w[0] = wa[0]; w[1] = wa[1]; w[2] = wa[2]; w[3] = wa[3]; w[4] = wb[0]; w[5] = wb[1]; w[6] = wb[2]; w[7] = wb[3];
#pragma unroll
            for (int j = 0; j < 8; ++j) acc[j] += w[j] * (cg[j] * vv[j]); }
#pragma unroll
        for (int j = 0; j < 8; ++j) tmp[j] = bg[j] * acc[j];
        *(u32x4*)(YS + (size_t)r * D_MODEL + 512 + c) = pack8(tmp);
    }
}
__device__ __forceinline__ void s5fin_block(Frame& F, const bf16* Z, const float* YF, const float* YB, const float* dsk  , bf16* Y1, int blk) {
#pragma unroll 1
    for (int i = 0; i < 8; ++i) {
        const int idx = F.tid + 512 * i, r = blk * 64 + (idx >> 6), c = (idx & 63) * 8;
        float u[8], o[8]; unpack8(*(const u32x4*)(Z + (size_t)r * MIX_IN + ZC_UA + c), u);
        const f32x4 f0 = *(const f32x4*)(YF + (size_t)r * 512 + c), f1 = *(const f32x4*)(YF + (size_t)r * 512 + c + 4);
        const f32x4 b0 = *(const f32x4*)(YB + (size_t)r * 512 + c), b1 = *(const f32x4*)(YB + (size_t)r * 512 + c + 4);
        const f32x4 d0 = *(const f32x4*)(dsk + c), d1 = *(const f32x4*)(dsk + c + 4);
#pragma unroll
        for (int j = 0; j < 8; ++j) { const float yy = (j < 4 ? d0[j & 3] : d1[j & 3]) * u[j] + (j < 4 ? f0[j & 3] : f1[j & 3]) + (j < 4 ? b0[j & 3] : b1[j & 3]);
            const float a = 0.7978845608028654f * (yy + 0.044715f * yy * yy * yy);
            const float th = 1.0f - 2.0f * __builtin_amdgcn_rcpf(1.0f + __expf(2.0f * a));
            o[j] = 0.5f * yy * (1.0f + th); }
        *(u32x4*)(Y1 + (size_t)r * 512 + c) = pack8(o);
    }
}

constexpr int S5_SEG = 512, S5_TPS = S5_SEG / 16;
template <bool FULL>
__device__ __forceinline__ void s5_seg_task(Frame& F, const unsigned char* tb, const bf16* Zs, float* Yout, f32x2* Ev, int nseg, int seg, int dir, int g) {
    LAS float* BU = (LAS float*)(F.lds + F.wave * 12288);
    LAS unsigned* XD = (LAS unsigned*)(F.lds + F.wave * 12288 + 8192);
    const int lane = F.lane, l15 = lane & 15, g4 = lane >> 4;
    const f32x2 ab = ((const f32x2*)(tb + S5T_AB))[lane];
    const float ar = ab.x, ai = ab.y;
    bf16x8 bbf[8];
#pragma unroll
    for (int cb = 0; cb < 8; ++cb) bbf[cb] = as_frag(((const u32x4*)(tb + S5T_BB))[cb * 64 + lane]);
    float xr = 0.f, xi = 0.f;
    float pwr[4], pwi[4];
    pwr[0] = ar; pwi[0] = ai;
#pragma unroll
    for (int j = 1; j < 4; ++j) { pwr[j] = pwr[j - 1] * ar - pwi[j - 1] * ai; pwi[j] = pwr[j - 1] * ai + pwi[j - 1] * ar; }
    if (FULL) {
        float pr = ar, pi = ai;
#pragma unroll
        for (int i = 0; i < 9; ++i) { const float nr = pr * pr - pi * pi, ni = 2.f * pr * pi; pr = nr; pi = ni; }
        if (dir == 0) { for (int j = 0; j < seg; ++j) { const f32x2 e = Ev[j * 64 + lane]; const float nr = pr * xr - pi * xi + e.x, ni = pr * xi + pi * xr + e.y; xr = nr; xi = ni; } }
        else { for (int j = nseg - 1; j > seg; --j) { const f32x2 e = Ev[j * 64 + lane]; const float nr = pr * xr - pi * xi + e.x, ni = pr * xi + pi * xr + e.y; xr = nr; xi = ni; } }
    }
    bf16x8 cf[4];
    if (FULL) {
#pragma unroll
        for (int ks = 0; ks < 4; ++ks) cf[ks] = as_frag(((const u32x4*)(tb + S5T_C))[ks * 64 + lane]);
    }
    const int tile0 = seg * S5_TPS;
    const bf16* zcol = Zs + ZC_UA + g * 16 + 8 * (g4 & 1);
    u32x4 ring[4];
#pragma unroll
    for (int j = 0; j < 4; ++j) { const int tile = tile0 + (dir ? S5_TPS - 1 - j : j); ring[j] = (u32x4){0u, 0u, 0u, 0u}; if (g4 < 2) ring[j] = *(const u32x4*)(zcol + (size_t)(tile * 16 + l15) * MIX_IN); }
#pragma unroll 1
    for (int it = 0; it < S5_TPS; it += 4) {
#pragma unroll
        for (int j = 0; j < 4; ++j) {
            const int tile = tile0 + (dir ? S5_TPS - 1 - (it + j) : it + j);
            const bf16x8 uf = as_frag(ring[j]);
            if (it + j + 4 < S5_TPS) { const int tn = dir ? tile - 4 : tile + 4; u32x4 nx = (u32x4){0u, 0u, 0u, 0u}; if (g4 < 2) nx = *(const u32x4*)(zcol + (size_t)(tn * 16 + l15) * MIX_IN); ring[j] = nx; }
            f32x4 a8[8];
#pragma unroll
            for (int cb = 0; cb < 8; ++cb) a8[cb] = mfma16(uf, bbf[cb], (f32x4){0.f, 0.f, 0.f, 0.f});
            MFMA_DRAIN();
#pragma unroll
            for (int cb = 0; cb < 8; ++cb)
#pragma unroll
                for (int q = 0; q < 4; ++q) BU[(4 * g4 + q) * 128 + 16 * cb + l15] = a8[cb][q];
            LDS_WAIT();
#pragma unroll
            for (int k = 0; k < 4; ++k) {
                float cr[4], ci[4], yr[4], yi[4];
                f32x2 bv[4];
#pragma unroll
                for (int j = 0; j < 4; ++j) { const int t = dir ? 15 - (4 * k + j) : 4 * k + j; bv[j] = *(const LAS f32x2*)(BU + t * 128 + 2 * lane); }
                cr[0] = bv[0].x; ci[0] = bv[0].y;
#pragma unroll
                for (int j = 1; j < 4; ++j) {
                    cr[j] = __builtin_fmaf(ar, cr[j - 1], __builtin_fmaf(-ai, ci[j - 1], bv[j].x));
                    ci[j] = __builtin_fmaf(ar, ci[j - 1], __builtin_fmaf(ai, cr[j - 1], bv[j].y));
                }
#pragma unroll
                for (int j = 0; j < 4; ++j) {
                    yr[j] = __builtin_fmaf(pwr[j], xr, __builtin_fmaf(-pwi[j], xi, cr[j]));
                    yi[j] = __builtin_fmaf(pwr[j], xi, __builtin_fmaf(pwi[j], xr, ci[j]));
                    if (FULL) { const int t = dir ? 15 - (4 * k + j) : 4 * k + j; XD[t * 64 + lane] = cvt_pk_bf16(yr[j], yi[j]); }
                }
                xr = yr[3]; xi = yi[3];
            }
            if (FULL) {
                LDS_WAIT();
                f32x4 y = (f32x4){0.f, 0.f, 0.f, 0.f};
#pragma unroll
                for (int ks = 0; ks < 4; ++ks) y = mfma16(as_frag(*(const LAS u32x4*)(XD + l15 * 64 + 16 * ks + 4 * g4)), cf[ks], y);
                MFMA_DRAIN();
                float* yo = Yout + (size_t)(tile * 16 + 4 * g4) * 512 + g * 16 + l15;
#pragma unroll
                for (int q = 0; q < 4; ++q) yo[(size_t)q * 512] = y[q];
            }
            LDS_WAIT();
        }
    }
    if (!FULL) { f32x2 e; e.x = xr; e.y = xi; Ev[seg * 64 + lane] = e; }
}

constexpr int NA_KL = 0, NA_VT = 73728, NA_BIAS = 147456;
constexpr int NA_RR = 8;
__device__ __forceinline__ void na_task(Frame& F, const bf16* Zs  , bf16* YSs  , int rows, int h, int r0,
                                        const float* qg, const float* kg, const float* relb  ) {
    LAS unsigned* KL = (LAS unsigned*)(F.lds + NA_KL); LAS unsigned* VT = (LAS unsigned*)(F.lds + NA_VT); LAS unsigned short* VT16 = (LAS unsigned short*)(F.lds + NA_VT);
    LAS float* BIAS = (LAS float*)(F.lds + NA_BIAS);
    const int tid = F.tid, lane = F.lane, l15 = lane & 15, g4 = lane >> 4;
    __syncthreads();
    for (int i = tid; i < 15 * 31; i += 512) BIAS[i] = relb[i];
    const int scol = tid >> 3, schunk = tid & 7;
    float kgv[8];
    { const f32x4 a = *(const f32x4*)(kg + 8 * schunk), b = *(const f32x4*)(kg + 8 * schunk + 4); kgv[0] = a[0]; kgv[1] = a[1]; kgv[2] = a[2]; kgv[3] = a[3]; kgv[4] = b[0]; kgv[5] = b[1]; kgv[6] = b[2]; kgv[7] = b[3]; }
    int rs0 = r0 - 4; rs0 = rs0 < 0 ? 0 : (rs0 > rows - 8 ? rows - 8 : rs0);
    const bf16* zst = Zs + (size_t)scol * MIX_IN + h * 64 + 8 * schunk;
#define NA_LOAD(rho, kr, vr) do { const bf16* zt_ = zst + (size_t)(rho) * 64 * MIX_IN; kr = *(const u32x4*)(zt_ + ZC_K); vr = *(const u32x4*)(zt_ + ZC_VC); } while (0)
#define NA_STORE(rho, kr, vr) do { float kf_[8]; unpack8(kr, kf_); float ss_ = 0.f; \
        _Pragma("unroll") for (int j_ = 0; j_ < 8; ++j_) ss_ += kf_[j_] * kf_[j_]; \
        ss_ += __shfl_xor(ss_, 1); ss_ += __shfl_xor(ss_, 2); ss_ += __shfl_xor(ss_, 4); \
        const float rk_ = rsqrtf(ss_ * (1.0f / 64.0f) + EPS); \
        _Pragma("unroll") for (int j_ = 0; j_ < 8; ++j_) kf_[j_] = kf_[j_] * rk_ * kgv[j_]; \
        const int slot_ = (rho) & 7; \
        *(LAS u32x4*)(KL + (slot_ * 64 + scol) * 36 + schunk * 4) = pack8(kf_); \
        const unsigned vw_[4] = {vr.x, vr.y, vr.z, vr.w}; \
        _Pragma("unroll") for (int j_ = 0; j_ < 8; ++j_) VT16[(slot_ * 64 + 8 * schunk + j_) * 72 + scol] = (unsigned short)((j_ & 1) ? (vw_[j_ >> 1] >> 16) : (vw_[j_ >> 1] & 0xffffu)); } while (0)
    {
        __syncthreads();
#pragma unroll 1
        for (int b = 0; b < 2; ++b) {
            u32x4 kr[4], vr[4];
#pragma unroll
            for (int i = 0; i < 4; ++i) NA_LOAD(rs0 + 4 * b + i, kr[i], vr[i]);
#pragma unroll
            for (int i = 0; i < 4; ++i) NA_STORE(rs0 + 4 * b + i, kr[i], vr[i]);
        }
    }
    int nextrow = rs0 + 8;
#pragma unroll 1
    for (int r = r0; r < r0 + NA_RR; ++r) {
        int rs = r - 4; rs = rs < 0 ? 0 : (rs > rows - 8 ? rows - 8 : rs);
        int rsn = r + 1 - 4; rsn = rsn < 0 ? 0 : (rsn > rows - 8 ? rows - 8 : rsn);
        const bool pre = (r + 1 < r0 + NA_RR) && (rsn + 7 >= nextrow);
        u32x4 pk = (u32x4){0u, 0u, 0u, 0u}, pv = (u32x4){0u, 0u, 0u, 0u};
        if (pre) NA_LOAD(nextrow, pk, pv);
        __syncthreads();
        if (F.wave < 4) {
            const int jb = F.wave, qc = 16 * jb + l15;
            int kc0 = 16 * jb - 8; kc0 = kc0 < 0 ? 0 : (kc0 > 32 ? 32 : kc0);
            int cs = qc - 8; cs = cs < 0 ? 0 : (cs > 48 ? 48 : cs);
            bf16x8 qf[2];
            {
                const bf16* zq = Zs + (size_t)(r * 64 + qc) * MIX_IN + ZC_Q + h * 64 + 8 * g4;
                float q0[8], q1[8]; unpack8(*(const u32x4*)zq, q0); unpack8(*(const u32x4*)(zq + 32), q1);
                float ss = 0.f;
#pragma unroll
                for (int j = 0; j < 8; ++j) ss += q0[j] * q0[j] + q1[j] * q1[j];
                ss += __shfl_xor(ss, 16); ss += __shfl_xor(ss, 32);
                const float rq = rsqrtf(ss * (1.0f / 64.0f) + EPS) * 0.125f;
                const f32x4 ga = *(const f32x4*)(qg + 8 * g4), gb = *(const f32x4*)(qg + 8 * g4 + 4), gc = *(const f32x4*)(qg + 32 + 8 * g4), gd = *(const f32x4*)(qg + 32 + 8 * g4 + 4);
#pragma unroll
                for (int j = 0; j < 4; ++j) { q0[j] *= rq * ga[j]; q0[4 + j] *= rq * gb[j]; q1[j] *= rq * gc[j]; q1[4 + j] *= rq * gd[j]; }
                qf[0] = as_frag(pack8(q0)); qf[1] = as_frag(pack8(q1));
            }
            f32x4 S[8][2];
#pragma unroll
            for (int a = 0; a < 8; ++a) {
                const int slot = (rs + a) & 7;
#pragma unroll
                for (int kb2 = 0; kb2 < 2; ++kb2) {
                    const LAS unsigned* kp = KL + (slot * 64 + kc0 + 16 * kb2 + l15) * 36 + 4 * g4;
                    S[a][kb2] = mfma16(as_frag(*(const LAS u32x4*)kp), qf[0], (f32x4){0.f, 0.f, 0.f, 0.f});
                    S[a][kb2] = mfma16(as_frag(*(const LAS u32x4*)(kp + 16)), qf[1], S[a][kb2]);
                }
            }
            MFMA_DRAIN();
            float mx = -3.0e38f;
#pragma unroll
            for (int a = 0; a < 8; ++a) {
                const int dr = rs + a - r + 7;
#pragma unroll
                for (int kb2 = 0; kb2 < 2; ++kb2)
#pragma unroll
                    for (int q = 0; q < 4; ++q) {
                        const int kc = kc0 + 16 * kb2 + 4 * g4 + q; const bool valid = (kc >= cs) && (kc < cs + 16);
                        int dc = kc - qc + 15; dc = dc < 0 ? 0 : (dc > 30 ? 30 : dc);
                        const float s = valid ? S[a][kb2][q] + BIAS[dr * 31 + dc] : -1.0e30f;
                        S[a][kb2][q] = s; mx = fmaxf(mx, s);
                    }
            }
            mx = fmaxf(mx, __shfl_xor(mx, 16)); mx = fmaxf(mx, __shfl_xor(mx, 32));
            float sum = 0.f;
#pragma unroll
            for (int a = 0; a < 8; ++a)
#pragma unroll
                for (int kb2 = 0; kb2 < 2; ++kb2)
#pragma unroll
                    for (int q = 0; q < 4; ++q) { const float p = __expf(S[a][kb2][q] - mx); S[a][kb2][q] = p; sum += p; }
            sum += __shfl_xor(sum, 16); sum += __shfl_xor(sum, 32);
            const float rinv = 1.0f / sum;
            f32x4 O[4];
#pragma unroll
            for (int dt = 0; dt < 4; ++dt) O[dt] = (f32x4){0.f, 0.f, 0.f, 0.f};
#pragma unroll
            for (int a = 0; a < 8; ++a) {
                const int slot = (rs + a) & 7;
                u32x4 pw; pw.x = cvt_pk_bf16(S[a][0][0], S[a][0][1]); pw.y = cvt_pk_bf16(S[a][0][2], S[a][0][3]); pw.z = cvt_pk_bf16(S[a][1][0], S[a][1][1]); pw.w = cvt_pk_bf16(S[a][1][2], S[a][1][3]);
                const bf16x8 pf = as_frag(pw);
#pragma unroll
                for (int dt = 0; dt < 4; ++dt) {
                    const LAS unsigned* vp = VT + (slot * 64 + 16 * dt + l15) * 36 + (kc0 >> 1) + 2 * g4;
                    const u32x2 v0 = *(const LAS u32x2*)vp, v1 = *(const LAS u32x2*)(vp + 8);
                    u32x4 vw; vw.x = v0.x; vw.y = v0.y; vw.z = v1.x; vw.w = v1.y;
                    O[dt] = mfma16(as_frag(vw), pf, O[dt]);
                }
            }
            MFMA_DRAIN();
            bf16* yo = YSs + (size_t)(r * 64 + qc) * D_MODEL + 1024 + h * 64 + 4 * g4;
#pragma unroll
            for (int dt = 0; dt < 4; ++dt) { u32x2 w; w.x = cvt_pk_bf16(O[dt][0] * rinv, O[dt][1] * rinv); w.y = cvt_pk_bf16(O[dt][2] * rinv, O[dt][3] * rinv); *(u32x2*)(yo + 16 * dt) = w; }
        }
        __syncthreads();
        if (pre) { NA_STORE(nextrow, pk, pv); nextrow += 1; }
    }
#undef NA_LOAD
#undef NA_STORE
}


#define TR2(o0, o1, off0, off1) "ds_read_b64_tr_b16 %" #o0 ", %16 offset:" #off0 "\n\tds_read_b64_tr_b16 %" #o1 ", %16 offset:" #off1 "\n\t"
constexpr int FN_XT = 0, FN_YR = 34816, FN_YI = 34816 + 34816;
template <int N1>
__device__ __forceinline__ void fnet1_tile(Frame& F, const bf16* Zs, bf16* ZFsg  , int g, int l2, const bf16* CT1, const bf16* ST1  , const bf16* C128, const bf16* S128) {
    constexpr int JT = N1 / 16, KS1 = N1 / 32;
    LAS unsigned short* YR = (LAS unsigned short*)(F.lds + FN_YR); LAS unsigned short* YI = (LAS unsigned short*)(F.lds + FN_YI);
    const int tid = F.tid, lane = F.lane, l15 = lane & 15, g4 = lane >> 4, w = F.wave;
    __syncthreads();
    {
        constexpr int NI = (N1 * 16) / 512;
        u32x4 raw[NI];
#pragma unroll
        for (int i = 0; i < NI; ++i) { const int idx = tid + 512 * i, l1 = idx >> 4, ch = idx & 15; raw[i] = *(const u32x4*)(Zs + (size_t)(128 * l1 + l2) * MIX_IN + ZC_UD + g * 128 + 8 * ch); }
#pragma unroll
        for (int i = 0; i < NI; ++i) { const int idx = tid + 512 * i, l1 = idx >> 4, ch = idx & 15; *(LAS u32x4*)(F.lds + FN_XT + l1 * 272 + ch * 16) = raw[i]; }
    }
    __syncthreads();
    {
        bf16x8 af[KS1];
        {
            const unsigned base = (unsigned)(size_t)F.lds + (unsigned)(FN_XT + (8 * g4 + (l15 >> 2)) * 272 + (16 * w + 4 * (lane & 3)) * 2);
            if constexpr (KS1 == 4) {
                u32x2 t_[8];
                asm volatile("ds_read_b64_tr_b16 %0, %8\n\tds_read_b64_tr_b16 %1, %8 offset:1088\n\tds_read_b64_tr_b16 %2, %8 offset:8704\n\tds_read_b64_tr_b16 %3, %8 offset:9792\n\t"
                             "ds_read_b64_tr_b16 %4, %8 offset:17408\n\tds_read_b64_tr_b16 %5, %8 offset:18496\n\tds_read_b64_tr_b16 %6, %8 offset:26112\n\tds_read_b64_tr_b16 %7, %8 offset:27200\n\ts_waitcnt lgkmcnt(0)"
                             : "=&v"(t_[0]), "=&v"(t_[1]), "=&v"(t_[2]), "=&v"(t_[3]), "=&v"(t_[4]), "=&v"(t_[5]), "=&v"(t_[6]), "=&v"(t_[7]) : "v"(base) : "memory");
#pragma unroll
                for (int ks = 0; ks < 4; ++ks) { u32x4 a; a.x = t_[2 * ks].x; a.y = t_[2 * ks].y; a.z = t_[2 * ks + 1].x; a.w = t_[2 * ks + 1].y; af[ks] = as_frag(a); }
            } else {
                u32x2 t0_, t1_;
                asm volatile("ds_read_b64_tr_b16 %0, %2\n\tds_read_b64_tr_b16 %1, %2 offset:1088\n\ts_waitcnt lgkmcnt(0)" : "=&v"(t0_), "=&v"(t1_) : "v"(base) : "memory");
                u32x4 a; a.x = t0_.x; a.y = t0_.y; a.z = t1_.x; a.w = t1_.y; af[0] = as_frag(a);
            }
        }
#pragma unroll 1
        for (int tj = 0; tj < JT; ++tj) {
            const int k1 = 16 * tj + l15;
            f32x4 ar = (f32x4){0.f, 0.f, 0.f, 0.f}, as = (f32x4){0.f, 0.f, 0.f, 0.f};
#pragma unroll
            for (int ks = 0; ks < KS1; ++ks) {
                ar = mfma16(af[ks], as_frag(*(const u32x4*)(CT1 + k1 * N1 + 32 * ks + 8 * g4)), ar);
                as = mfma16(af[ks], as_frag(*(const u32x4*)(ST1 + k1 * N1 + 32 * ks + 8 * g4)), as);
            }
            MFMA_DRAIN();
            float tsn, tcs; sincospif((float)(k1 * l2) * (2.0f / (float)(N1 * 128)), &tsn, &tcs);
            float zr[4], zi[4];
#pragma unroll
            for (int q = 0; q < 4; ++q) { const float yr = ar[q], yi = -as[q]; zr[q] = yr * tcs + yi * tsn; zi[q] = yi * tcs - yr * tsn; }
            u32x2 wr2, wi2; wr2.x = cvt_pk_bf16(zr[0], zr[1]); wr2.y = cvt_pk_bf16(zr[2], zr[3]); wi2.x = cvt_pk_bf16(zi[0], zi[1]); wi2.y = cvt_pk_bf16(zi[2], zi[3]);
            *(LAS u32x2*)(YR + k1 * 136 + 16 * w + 4 * g4) = wr2; *(LAS u32x2*)(YI + k1 * 136 + 16 * w + 4 * g4) = wi2;
        }
    }
    __syncthreads();
    {
        bf16x8 cfr[4], sfr[4];
#pragma unroll
        for (int ks = 0; ks < 4; ++ks) { cfr[ks] = as_frag(*(const u32x4*)(C128 + (16 * w + l15) * 128 + 32 * ks + 8 * g4)); sfr[ks] = as_frag(*(const u32x4*)(S128 + (16 * w + l15) * 128 + 32 * ks + 8 * g4)); }
#pragma unroll 1
        for (int tj = 0; tj < JT; ++tj) {
            const int k1 = 16 * tj + l15;
            f32x4 zr = (f32x4){0.f, 0.f, 0.f, 0.f}, zi = (f32x4){0.f, 0.f, 0.f, 0.f};
#pragma unroll
            for (int ks = 0; ks < 4; ++ks) {
                const u32x4 yr = *(const LAS u32x4*)(YR + k1 * 136 + 32 * ks + 8 * g4), yi = *(const LAS u32x4*)(YI + k1 * 136 + 32 * ks + 8 * g4);
                u32x4 ny; ny.x = yr.x ^ 0x80008000u; ny.y = yr.y ^ 0x80008000u; ny.z = yr.z ^ 0x80008000u; ny.w = yr.w ^ 0x80008000u;
                zr = mfma16(cfr[ks], as_frag(yr), zr); zr = mfma16(sfr[ks], as_frag(yi), zr);
                zi = mfma16(cfr[ks], as_frag(yi), zi); zi = mfma16(sfr[ks], as_frag(ny), zi);
            }
            MFMA_DRAIN();
            bf16* zo = ZFsg + ((size_t)k1 * 128 + l2) * 256 + 16 * w + 4 * g4;
            u32x2 a, b; a.x = cvt_pk_bf16(zr[0], zr[1]); a.y = cvt_pk_bf16(zr[2], zr[3]); b.x = cvt_pk_bf16(zi[0], zi[1]); b.y = cvt_pk_bf16(zi[2], zi[3]);
            *(u32x2*)zo = a; *(u32x2*)(zo + 128) = b;
        }
    }
}
__device__ __forceinline__ void fnet2_tile(Frame& F, const bf16* ZFsg, bf16* YSs  , int g, int k1, int N1, const bf16* C128, const bf16* S128) {
    constexpr int RS = 528;
    const int tid = F.tid, lane = F.lane, l15 = lane & 15, g4 = lane >> 4, w = F.wave;
    __syncthreads();
    const bf16* src = ZFsg + (size_t)k1 * 128 * 256;
    {
        u32x4 raw[8];
#pragma unroll
        for (int i = 0; i < 8; ++i) { const int idx = tid + 512 * i; raw[i] = *(const u32x4*)(src + (size_t)idx * 8); }
#pragma unroll
        for (int i = 0; i < 8; ++i) { const int idx = tid + 512 * i, l2 = idx >> 5, ch = idx & 31; *(LAS u32x4*)(F.lds + l2 * RS + ch * 16) = raw[i]; }
    }
    __syncthreads();
    const unsigned base = (unsigned)(size_t)F.lds + (unsigned)((8 * g4 + (l15 >> 2)) * RS + (16 * w + 4 * (lane & 3)) * 2);
    u32x2 t_[16];
    asm volatile(
        TR2(0, 1, 0, 2112) TR2(2, 3, 16896, 19008) TR2(4, 5, 33792, 35904) TR2(6, 7, 50688, 52800)
        TR2(8, 9, 256, 2368) TR2(10, 11, 17152, 19264) TR2(12, 13, 34048, 36160) TR2(14, 15, 50944, 53056)
        "s_waitcnt lgkmcnt(0)"
        : "=&v"(t_[0]), "=&v"(t_[1]), "=&v"(t_[2]), "=&v"(t_[3]), "=&v"(t_[4]), "=&v"(t_[5]), "=&v"(t_[6]), "=&v"(t_[7]),
          "=&v"(t_[8]), "=&v"(t_[9]), "=&v"(t_[10]), "=&v"(t_[11]), "=&v"(t_[12]), "=&v"(t_[13]), "=&v"(t_[14]), "=&v"(t_[15])
        : "v"(base) : "memory");
    bf16x8 zrf[4], zif[4];
#pragma unroll
    for (int ks = 0; ks < 4; ++ks) { u32x4 a; a.x = t_[2 * ks].x; a.y = t_[2 * ks].y; a.z = t_[2 * ks + 1].x; a.w = t_[2 * ks + 1].y; zrf[ks] = as_frag(a);
        u32x4 b; b.x = t_[8 + 2 * ks].x; b.y = t_[8 + 2 * ks].y; b.z = t_[8 + 2 * ks + 1].x; b.w = t_[8 + 2 * ks + 1].y; zif[ks] = as_frag(b); }
#pragma unroll 1
    for (int tj = 0; tj < 8; ++tj) {
        const int k2 = 16 * tj + l15;
        f32x4 y = (f32x4){0.f, 0.f, 0.f, 0.f};
#pragma unroll
        for (int ks = 0; ks < 4; ++ks) {
            y = mfma16(zrf[ks], as_frag(*(const u32x4*)(C128 + k2 * 128 + 32 * ks + 8 * g4)), y);
            y = mfma16(zif[ks], as_frag(*(const u32x4*)(S128 + k2 * 128 + 32 * ks + 8 * g4)), y);
        }
        MFMA_DRAIN();
        u32x2 o; o.x = cvt_pk_bf16(y[0], y[1]); o.y = cvt_pk_bf16(y[2], y[3]);
        *(u32x2*)(YSs + (size_t)(k1 + N1 * k2) * D_MODEL + 1536 + g * 128 + 16 * w + 4 * g4) = o;
    }
}

struct ChunkGeo { int nseq, lseq, rows, n1; };
__device__ __forceinline__ ChunkGeo chunk_geo(int ch) { ChunkGeo g; if (ch < 2) { g.nseq = 1; g.lseq = 16384; g.rows = 256; g.n1 = 128; } else { g.nseq = 4; g.lseq = 4096; g.rows = 64; g.n1 = 32; } return g; }

__device__ __forceinline__ void ph_s5a(Frame& F, const Args& A, int layer, int ch) {
    const ChunkGeo cg = chunk_geo(ch);
    const bf16* Z = (const bf16*)(F.ws + WS_Z); f32x2* EV = (f32x2*)(F.ws + WS_S5E);
    const int nseg = cg.lseq / S5_SEG, ntask = cg.nseq * nseg * 64;
#pragma unroll 1
    for (int tt = F.vcu * 8 + F.wave; tt < ntask; tt += F.G * 8) {
        const int dg = tt & 63, sg = tt >> 6, seg = sg % nseg, seq = sg / nseg, dir = dg >> 5, g = dg & 31;
        const unsigned char* tb = F.ws + TAB_S5 + (size_t)(((layer * 2 + dir) * 32) + g) * S5T_BYTES;
        s5_seg_task<false>(F, tb, Z + (size_t)seq * cg.lseq * MIX_IN, nullptr, EV + (size_t)(seq * 64 + dg) * nseg * 64, nseg, seg, dir, g);
    }
    int t0 = F.vcu; asm volatile("" : "+s"(t0));
    bf16* YS = (bf16*)(F.ws + WS_YS); bf16* ZF = (bf16*)(F.ws + WS_ZF);
    const int n_f1 = 512, n_cv = CH_TOK / 64;
#pragma unroll 1
    for (; t0 < n_f1 + n_cv; t0 += F.G) {
        if (t0 < n_f1) {
            const int u = t0;
            const bf16* C128 = (const bf16*)(F.ws + TAB_C128); const bf16* S128 = (const bf16*)(F.ws + TAB_S128);
            if (ch < 2) { const int g = u >> 7, l2 = u & 127;
                fnet1_tile<128>(F, Z, ZF + (size_t)g * 16384 * 256, g, l2, C128, S128, C128, S128);
            } else {
                const bf16* C32 = (const bf16*)(F.ws + TAB_C32); const bf16* S32 = (const bf16*)(F.ws + TAB_S32);
#pragma unroll 1
                for (int s = 0; s < 4; ++s) { const int uu = u * 4 + s, l2 = uu & 127, g = (uu >> 7) & 3, seq = uu >> 9;
                    fnet1_tile<32>(F, Z + (size_t)seq * 4096 * MIX_IN, ZF + (size_t)(seq * 4 + g) * 4096 * 256, g, l2, C32, S32, C128, S128); }
            }
        } else {
            conv_block(F, Z, YS, A.in[15] + (size_t)layer * 3 * 512, t0 - n_f1, cg.lseq);
        }
    }
}
__device__ __forceinline__ void ph_mix1(Frame& F, const Args& A, int layer, int ch) {
    const ChunkGeo cg = chunk_geo(ch);
    const bf16* Z = (const bf16*)(F.ws + WS_Z); bf16* YS = (bf16*)(F.ws + WS_YS); const bf16* ZF = (const bf16*)(F.ws + WS_ZF);
    float* YF = (float*)(F.ws + WS_YF); float* YB = (float*)(F.ws + WS_YB); f32x2* EV = (f32x2*)(F.ws + WS_S5E);
    const int nseg = cg.lseq / S5_SEG;
    const int n_s5 = cg.nseq * nseg * 8;
    const int n_na = cg.nseq * 8 * (cg.rows / NA_RR);
    const int n_f2 = 512;
    int t0 = F.vcu;
#pragma unroll 1
    for (; t0 < n_s5; t0 += F.G) {
        const int tt = t0 * 8 + F.wave, dg = tt & 63, sg = tt >> 6, seg = sg % nseg, seq = sg / nseg, dir = dg >> 5, g = dg & 31;
        const unsigned char* tb = F.ws + TAB_S5 + (size_t)(((layer * 2 + dir) * 32) + g) * S5T_BYTES;
        const size_t row0 = (size_t)seq * cg.lseq;
        s5_seg_task<true>(F, tb, Z + row0 * MIX_IN, (dir ? YB : YF) + row0 * 512, EV + (size_t)(seq * 64 + dg) * nseg * 64, nseg, seg, dir, g);
    }
    asm volatile("" : "+s"(t0));
#pragma unroll 1
    for (; t0 < n_s5 + n_na + n_f2; t0 += F.G) {
        const int t = t0 - n_s5;
        if (t < n_na) {
            const int runs = cg.rows / NA_RR, run = t % runs, h = (t / runs) & 7, seq = t / (runs * 8);
            const size_t row0 = (size_t)seq * cg.lseq;
            na_task(F, Z + row0 * MIX_IN, YS + row0 * D_MODEL, cg.rows, h, run * NA_RR, A.in[16] + layer * 64, A.in[17] + layer * 64, A.in[18] + ((size_t)layer * 8 + h) * 15 * 31);
        } else {
            const int u = t - n_na;
            const bf16* C128 = (const bf16*)(F.ws + TAB_C128); const bf16* S128 = (const bf16*)(F.ws + TAB_S128);
            int seq, g, k1; if (ch < 2) { seq = 0; g = u >> 7; k1 = u & 127; } else { k1 = u & 31; g = (u >> 5) & 3; seq = u >> 7; }
            fnet2_tile(F, ZF + (size_t)(seq * 4 + g) * cg.lseq * 256, YS + (size_t)seq * cg.lseq * D_MODEL, g, k1, cg.n1, C128, S128);
        }
    }
}
__device__ __forceinline__ void ph_mix2(Frame& F, const Args& A, int layer, int ch) {
    const bf16* Z = (const bf16*)(F.ws + WS_Z);
    const float* YF = (const float*)(F.ws + WS_YF); const float* YB = (const float*)(F.ws + WS_YB); bf16* Y1 = (bf16*)(F.ws + WS_Y1);
    (void)ch;
#pragma unroll 1
    for (int t = F.vcu; t < CH_TOK / 64; t += F.G) s5fin_block(F, Z, YF, YB, A.in[13] + (size_t)layer * 512, Y1, t);
}

constexpr int MK_STAG = 0, MK_STAG_MERGE = 0;
constexpr int PH_A = 8, PH_PER_LAYER = 3 * PH_A + 1 + 3 + 3, N_PHASES = 1 + DEPTH * PH_PER_LAYER;
__global__ void __launch_bounds__(NWAVES * 64, 2) fwd_kernel(const Args A) {
    extern __shared__ __attribute__((aligned(16))) unsigned char lds_raw[];
    Frame F;
    F.lds = (LAS unsigned char*)lds_raw;
    F.tid = threadIdx.x; F.lane = F.tid & 63; F.wave = __builtin_amdgcn_readfirstlane(F.tid >> 6);
    F.G = gridDim.x; { const int bx = blockIdx.x; F.vcu = (F.G % 8 == 0) ? (bx % 8) * (F.G / 8) + bx / 8 : bx; }
    F.ws = A.ws;
    volatile LAS unsigned* LCTL = (volatile LAS unsigned*)(F.lds + LDSCTL_OFF);
    if (F.tid < 64) LCTL[F.tid] = 0u;
    __syncthreads();
    const int lo = A.ph_lo, hi = A.ph_hi;
    const bool multi = (hi - lo) > 1;
    XcdBarrier bar; bar.bar = (unsigned*)(F.ws + WS_CTL) + CW_BAR; bar.x = 0; bar.st = LCTL;
    if (multi) bar = xcd_barrier_post((unsigned*)(F.ws + WS_CTL) + CW_BAR, LCTL);
#define IN(k) (lo <= (k) && (k) < hi)
#define SEAM(k) do { if ((k) + 1 < hi) xcd_barrier(bar); } while (0)

    if (IN(0)) { Frame Fp = fresh(F); ph_prologue(Fp, A); SEAM(0); }

#pragma unroll 1
    for (int layer = 0; layer < DEPTH; ++layer) {
        const int pl = 1 + layer * PH_PER_LAYER;
        if (pl + PH_PER_LAYER <= lo || pl >= hi) continue;
        const unsigned char* wl = F.ws + WS_W + (size_t)layer * WL_BYTES;
        bf16* H = (bf16*)(F.ws + WS_H); bf16* Z = (bf16*)(F.ws + WS_Z); bf16* YS = (bf16*)(F.ws + WS_YS); bf16* MGA = (bf16*)(F.ws + WS_MG); bf16* GT = (bf16*)(F.ws + WS_GT);
        bf16* Y1 = (bf16*)(F.ws + WS_Y1); bf16* P16 = (bf16*)(F.ws + WS_P16); bf16* PP = (bf16*)(F.ws + WS_PP); bf16* HALL = (bf16*)(F.ws + WS_HALL);
#pragma unroll 1
        for (int ch = 0; ch < N_CHUNK; ++ch) {
            const int pb = pl + ch * PH_A;
            const float* x_cur = layer == 0 ? ((ch < 2) ? A.in[0] + (size_t)ch * CH_TOK * D_MODEL : A.in[1]) : A.out + (size_t)ch * CH_TOK * D_MODEL;
            bf16* MG = MGA + (size_t)ch * CH_TOK * D_MODEL;
            if (IN(pb + 0)) { Frame Fp = fresh(F); ph_norm(Fp, x_cur, A.in[4] + (size_t)layer * D_MODEL, H, CH_TOK); SEAM(pb + 0); }
            if (IN(pb + 1)) {
                pg8::Gemm g{H, (const bf16*)(wl + WL_MIX), D_MODEL, D_MODEL, D_MODEL, 0, 0, 0, 0}; pg8::StaticOrder S; S.init(CH_TOK, MIX_IN, F.G, (int)blockIdx.x);
                pg8::EpiStoreBf16 E{Z, MIX_IN};

                pg8::gemm_phase<pg8::EpiStoreBf16, pg8::StaticOrder, true, true>(F.lds, g, S, E);
                SEAM(pb + 1); }
            if (IN(pb + 2)) { Frame Fp = fresh(F); ph_s5a(Fp, A, layer, ch); SEAM(pb + 2); }
            if (IN(pb + 3)) { Frame Fp = fresh(F); ph_mix1(Fp, A, layer, ch); SEAM(pb + 3); }
            if (IN(pb + 4)) { Frame Fp = fresh(F); ph_mix2(Fp, A, layer, ch); SEAM(pb + 4); }
            if (IN(pb + 5)) {
                pg8::Gemm g{Y1, (const bf16*)(wl + WL_GLU), 512, 512, 512, 0, 0, 0, 0}; pg8::StaticOrder S; S.init(CH_TOK, 512, F.G, (int)blockIdx.x);
                pg8::EpiGlu E{Y1, 512, YS, D_MODEL};
                pg8::gemm_phase<pg8::EpiGlu, pg8::StaticOrder, true, true>(F.lds, g, S, E);
                SEAM(pb + 5); }
            if (IN(pb + 6)) {
                pg8::Gemm g{YS, (const bf16*)(wl + WL_BR), D_MODEL, 512, 512, 3, 512, 0, 0}; pg8::StaticOrder S; S.init(CH_TOK, 8192, F.G, (int)blockIdx.x);
                pg8::EpiStoreBlk E{GT};

                pg8::gemm_phase<pg8::EpiStoreBlk, pg8::StaticOrder, false, true>(F.lds, g, S, E);
                SEAM(pb + 6); }
            if (IN(pb + 7)) {
                pg8::Gemm g{H, (const bf16*)(wl + WL_G), D_MODEL, D_MODEL, D_MODEL, 0, 0, 2, MK_STAG_MERGE}; pg8::StaticOrder S; S.init(CH_TOK, 32 * 256, F.G, (int)blockIdx.x);
                pg8::EpiMerge E{GT, MG};

                pg8::gemm_phase<pg8::EpiMerge, pg8::StaticOrder, true, true>(F.lds, g, S, E);
                SEAM(pb + 7); }
        }
        {
            const int pb = pl + 3 * PH_A;
            if (IN(pb)) {
                pg8::Gemm g{MGA, (const bf16*)(wl + WL_O), D_MODEL, D_MODEL, D_MODEL, 0, 0, 0, MK_STAG}; pg8::StaticOrder S; S.init(NTOK, D_MODEL, F.G, (int)blockIdx.x);
                pg8::EpiResF32 E{layer == 0 ? A.in[0] : A.out, layer == 0 ? A.in[1] : A.out + (size_t)32768 * D_MODEL, 32768, A.out, D_MODEL};
                pg8::gemm_phase<pg8::EpiResF32, pg8::StaticOrder, true, true>(F.lds, g, S, E);
                SEAM(pb); }
        }
        {
            const int pb = pl + 3 * PH_A + 1;
            bf16* H2 = (bf16*)(F.ws + WS_H2ALL); bf16* MIDA = (bf16*)(F.ws + WS_MIDALL);
            if (IN(pb + 0)) { Frame Fp = fresh(F); ph_norm(Fp, A.out, A.in[21] + (size_t)layer * D_MODEL, H2, NTOK); SEAM(pb + 0); }
            if (IN(pb + 1)) {
                pg8::Gemm g{H2, (const bf16*)(wl + WL_FF), D_MODEL, D_MODEL, D_MODEL, 0, 0, 0, 0}; pg8::StaticOrder S; S.init(NTOK, 2 * D_FF, F.G, (int)blockIdx.x);
                pg8::EpiSwiglu E{MIDA, D_FF};

                pg8::gemm_phase<pg8::EpiSwiglu, pg8::StaticOrder, true, true>(F.lds, g, S, E);
                SEAM(pb + 1); }
            if (IN(pb + 2)) {
                pg8::Gemm g{MIDA, (const bf16*)(wl + WL_FF2), D_FF, D_FF, D_FF, 0, 0, 0, MK_STAG}; pg8::StaticOrder S; S.init(NTOK, D_MODEL, F.G, (int)blockIdx.x);
                pg8::EpiResF32 E{A.out, A.out, 1 << 30, A.out, D_MODEL};
                pg8::gemm_phase<pg8::EpiResF32, pg8::StaticOrder, true, true>(F.lds, g, S, E);
                SEAM(pb + 2); }
        }
        {
            const int pb = pl + 3 * PH_A + 1 + 3;
            if (IN(pb + 0)) { Frame Fp = fresh(F); ph_norm(Fp, A.out, A.in[24] + (size_t)layer * D_MODEL, HALL, NTOK);
                ph_pcvt(Fp, A.in[2] + (size_t)layer * 32768 * PLE_DIM, A.in[3] + (size_t)layer * CH_TOK * PLE_DIM, P16); SEAM(pb + 0); }
            if (IN(pb + 1)) {
                int kpp = PLE_DIM; asm volatile("" : "+s"(kpp));
                pg8::Gemm g{P16, (const bf16*)(wl + WL_PP), kpp, kpp, kpp, 0, 0, 0, 0}; pg8::StaticOrder S; S.init(NTOK, D_MODEL, F.G, (int)blockIdx.x);
                pg8::EpiStoreBf16 E{PP, D_MODEL};
                pg8::gemm_phase<pg8::EpiStoreBf16, pg8::StaticOrder, true, true>(F.lds, g, S, E);
                SEAM(pb + 1); }
            if (IN(pb + 2)) {
                pg8::Gemm g{HALL, (const bf16*)(wl + WL_PG), D_MODEL, D_MODEL, D_MODEL, 0, 0, 0, MK_STAG}; pg8::StaticOrder S; S.init(NTOK, D_MODEL, F.G, (int)blockIdx.x);
                pg8::EpiPle E{A.out, A.out, D_MODEL, PP, D_MODEL};
                pg8::gemm_phase<pg8::EpiPle, pg8::StaticOrder, true, true>(F.lds, g, S, E);
                SEAM(pb + 2); }
        }
    }
#undef IN
#undef SEAM
}

#ifndef MK_PER_PHASE
#define MK_PER_PHASE 0
#endif
extern "C" void kernel_launch(void* const* d_in, const int* in_sizes, int n_in, void* d_out, int out_size, void* d_ws, size_t ws_size, hipStream_t stream) {
    static int grid = 0;
    if (grid == 0) {
        if (n_in != 27 || out_size != NTOK * D_MODEL || ws_size < WS_END) { fprintf(stderr, "kernel_launch: unexpected shapes (n_in %d, out %d, ws %zu); nothing launched\n", n_in, out_size, ws_size); grid = -1; return; }
        int dev = 0, cus = 0, per_cu = 0;
        if (hipGetDevice(&dev) != hipSuccess || hipDeviceGetAttribute(&cus, hipDeviceAttributeMultiprocessorCount, dev) != hipSuccess) { grid = -1; return; }
        if (hipFuncSetAttribute((const void*)fwd_kernel, hipFuncAttributeMaxDynamicSharedMemorySize, LDS_BYTES) != hipSuccess) { fprintf(stderr, "kernel_launch: hipFuncSetAttribute failed\n"); grid = -1; return; }
        if (hipOccupancyMaxActiveBlocksPerMultiprocessor(&per_cu, (const void*)fwd_kernel, NWAVES * 64, LDS_BYTES) != hipSuccess || per_cu < 1)
            fprintf(stderr, "kernel_launch: occupancy query reports %d workgroups per CU\n", per_cu);
        (void)hipGetLastError();
        grid = cus;
    }
    if (grid < 0) return;
    (void)in_sizes;
    if (hipMemsetAsync((char*)d_ws + WS_CTL, 0, CTL_ZERO_BYTES, stream) != hipSuccess) return;
    Args a{};
    for (int i = 0; i < 27; ++i) a.in[i] = (const float*)d_in[i];
    a.out = (float*)d_out; a.ws = (unsigned char*)d_ws;
#if MK_PER_PHASE
    for (int p = 0; p < N_PHASES; ++p) { a.ph_lo = p; a.ph_hi = p + 1; hipLaunchKernelGGL(fwd_kernel, dim3(grid), dim3(NWAVES * 64), LDS_BYTES, stream, a); }
#else
    a.ph_lo = 0; a.ph_hi = N_PHASES;
    hipLaunchKernelGGL(fwd_kernel, dim3(grid), dim3(NWAVES * 64), LDS_BYTES, stream, a);
#endif
}
```

```cpp
#include <hip/hip_runtime.h>
#include <cstdio>
#include <cstdint>

namespace pg8 {
#define PG8_LAS __attribute__((address_space(3)))
typedef unsigned short bf16_t;
typedef short bf16x8 __attribute__((ext_vector_type(8)));
typedef float f32x4 __attribute__((ext_vector_type(4)));
typedef float f32x2 __attribute__((ext_vector_type(2)));
typedef unsigned u32x4 __attribute__((ext_vector_type(4)));
typedef unsigned u32x2 __attribute__((ext_vector_type(2)));
constexpr int BM = 256, BK = 64, HALF = 128, HTB = HALF * BK * 2  , STAGE_BYTES = 8 * HTB, NXCD = 8, WGM = 8;

__host__ __device__ __forceinline__ int lds_byte(int r, int c) { const int st = (r >> 4) * 2 + (c >> 5), rr = r & 15, cc = c & 31, ob = rr * 64 + cc * 2; return st * 1024 + (ob ^ (((ob >> 9) & 1) << 5)); }
__host__ __device__ __forceinline__ void stage_rc(int b, int& R, int& C) { const int st = b / 1024, sb = b % 1024, swz = sb ^ (((sb >> 9) & 1) << 5); R = (st >> 1) * 16 + swz / 64; C = (st & 1) * 32 + (swz % 64) / 2; }
__host__ __device__ __forceinline__ int perm32(int rho) { const int n = rho >> 4, i = rho & 15; return 8 * (i >> 2) + 4 * n + (i & 3); }

struct Unit { int pm, pn; };
struct Gemm { const bf16_t* A; const bf16_t* Bt; int lda, ldb, K, agrp_shift, agrp_stride, bmode, stagger, ablk; };
#ifndef MK_BLK_PP
#define MK_BLK_PP 1
#endif
#ifndef MK_BLK_MG
#define MK_BLK_MG 1
#endif
#ifndef MK_BLK_MID
#define MK_BLK_MID 1
#endif

__device__ __forceinline__ void tile_of(int wgid, int nwg, int nM, int nN, int& pm, int& pn) {
    { const int q = nwg / NXCD, r = nwg % NXCD, xcd = wgid % NXCD, off = wgid / NXCD; wgid = (xcd < r ? xcd * (q + 1) : r * (q + 1) + (xcd - r) * q) + off; }
    const int nig = WGM * nN, gid = wgid / nig, fm = gid * WGM, gsz = (nM - fm) < WGM ? (nM - fm) : WGM;
    pm = fm + ((wgid % nig) % gsz); pn = (wgid % nig) / gsz;
}
struct StaticOrder {
    int nM, nN, nwg, G, c;
    __device__ __forceinline__ void init(int M, int N, int G_, int c_) { nM = M / BM; nN = N / BM; nwg = nM * nN; G = G_; c = c_; }
    __device__ __forceinline__ bool next(int i, Unit& u) const {
        const long L = (long)i * G + c; if (L >= nwg) return false;
        tile_of((int)L, nwg, nM, nN, u.pm, u.pn); return true;
    }
};
struct MergeOrder {
    int nM, ntile, G, c;
    __device__ __forceinline__ void init(int M, int G_, int c_) { nM = M / BM; ntile = nM * 16; G = G_; c = c_; }
    __device__ __forceinline__ bool next(int i, Unit& u) const {
        const long L = (long)(i >> 1) * G + c; if (L >= ntile) return false;
        int pm, ct; tile_of((int)L, ntile, nM, 16, pm, ct); u.pm = pm; u.pn = (i & 1) * 16 + ct; return true;
    }
};

typedef __bf16 bf16x2_t __attribute__((ext_vector_type(2)));
__device__ __forceinline__ unsigned cvt_pk_bf16(float lo, float hi) { const f32x2 v = {lo, hi}; return __builtin_bit_cast(unsigned, __builtin_convertvector(v, bf16x2_t)); }
__device__ __forceinline__ float bf_lo(unsigned w) { return __uint_as_float(w << 16); }
__device__ __forceinline__ float bf_hi(unsigned w) { return __uint_as_float(w & 0xffff0000u); }
__device__ __forceinline__ float sigmoidf_fast(float x) { return __builtin_amdgcn_rcpf(1.0f + __expf(-x)); }

__device__ __forceinline__ void st16(void* p, u32x4 v) { *(u32x4*)p = v; }
struct EpiStoreBf16 {
    static constexpr bool PERM = true;
    bf16_t* O; int ldc;
    __device__ __forceinline__ void operator()(const f32x4 (&acc)[2][2][4][2], const Unit& u, int wr, int wc, int fr, int fq) const {
        const int row0 = u.pm * BM + wr * 64 + fr, col0 = u.pn * BM + wc * 32 + 8 * fq;
#pragma unroll
        for (int ai = 0; ai < 2; ++ai)
#pragma unroll
            for (int m = 0; m < 4; ++m) { bf16_t* rowp = O + (size_t)(row0 + ai * HALF + m * 16) * ldc + col0;
#pragma unroll
                for (int bj = 0; bj < 2; ++bj) { const f32x4 v0 = acc[ai][bj][m][0], v1 = acc[ai][bj][m][1];
                    u32x4 w; w.x = cvt_pk_bf16(v0[0], v0[1]); w.y = cvt_pk_bf16(v0[2], v0[3]); w.z = cvt_pk_bf16(v1[0], v1[1]); w.w = cvt_pk_bf16(v1[2], v1[3]);
                    st16(rowp + bj * HALF, w); } }
    }
};
struct EpiStoreBlk {
    static constexpr bool PERM = true;
    bf16_t* O;
    __device__ __forceinline__ void operator()(const f32x4 (&acc)[2][2][4][2], const Unit& u, int wr, int wc, int fr, int fq) const {
        bf16_t* base = O + ((size_t)(u.pm * 16 + wr * 4) * 512 + (u.pn * 16 + wc * 2 + (fq >> 1))) * 256 + fr * 16 + (fq & 1) * 8;
#pragma unroll
        for (int ai = 0; ai < 2; ++ai)
#pragma unroll
            for (int m = 0; m < 4; ++m) { bf16_t* rowp = base + (size_t)(ai * 8 + m) * 512 * 256;
#pragma unroll
                for (int bj = 0; bj < 2; ++bj) { const f32x4 v0 = acc[ai][bj][m][0], v1 = acc[ai][bj][m][1];
                    u32x4 w; w.x = cvt_pk_bf16(v0[0], v0[1]); w.y = cvt_pk_bf16(v0[2], v0[3]); w.z = cvt_pk_bf16(v1[0], v1[1]); w.w = cvt_pk_bf16(v1[2], v1[3]);
                    st16(rowp + bj * 8 * 256, w); } }
    }
};
struct EpiStoreBlk32 {
    static constexpr bool PERM = true;
    bf16_t* O; int nbc;
    __device__ __forceinline__ void operator()(const f32x4 (&acc)[2][2][4][2], const Unit& u, int wr, int wc, int fr, int fq) const {
        bf16_t* base = O + ((size_t)(u.pm * 16 + wr * 4) * nbc + (u.pn * 8 + wc)) * 512 + fr * 32 + fq * 8;
#pragma unroll
        for (int ai = 0; ai < 2; ++ai)
#pragma unroll
            for (int m = 0; m < 4; ++m) { bf16_t* rowp = base + (size_t)(ai * 8 + m) * nbc * 512;
#pragma unroll
                for (int bj = 0; bj < 2; ++bj) { const f32x4 v0 = acc[ai][bj][m][0], v1 = acc[ai][bj][m][1];
                    u32x4 w; w.x = cvt_pk_bf16(v0[0], v0[1]); w.y = cvt_pk_bf16(v0[2], v0[3]); w.z = cvt_pk_bf16(v1[0], v1[1]); w.w = cvt_pk_bf16(v1[2], v1[3]);
                    st16(rowp + bj * 4 * 512, w); } }
    }
};
struct EpiGlu {
    static constexpr bool PERM = true;
    const bf16_t* Y1; int ld1; bf16_t* O; int ldc;
    __device__ __forceinline__ void operator()(const f32x4 (&acc)[2][2][4][2], const Unit& u, int wr, int wc, int fr, int fq) const {
        const int row0 = u.pm * BM + wr * 64 + fr, col0 = u.pn * BM + wc * 32 + 8 * fq;
        u32x4 y[2][4][2];
#pragma unroll
        for (int ai = 0; ai < 2; ++ai)
#pragma unroll
            for (int m = 0; m < 4; ++m)
#pragma unroll
                for (int bj = 0; bj < 2; ++bj) y[ai][m][bj] = *(const u32x4*)(Y1 + (size_t)(row0 + ai * HALF + m * 16) * ld1 + col0 + bj * HALF);
#pragma unroll
        for (int ai = 0; ai < 2; ++ai)
#pragma unroll
            for (int m = 0; m < 4; ++m) { const size_t r = (size_t)(row0 + ai * HALF + m * 16);
#pragma unroll
                for (int bj = 0; bj < 2; ++bj) { const f32x4 v0 = acc[ai][bj][m][0], v1 = acc[ai][bj][m][1]; const u32x4 yy = y[ai][m][bj];
                    u32x4 w;
                    w.x = cvt_pk_bf16(bf_lo(yy.x) * sigmoidf_fast(v0[0]), bf_hi(yy.x) * sigmoidf_fast(v0[1]));
                    w.y = cvt_pk_bf16(bf_lo(yy.y) * sigmoidf_fast(v0[2]), bf_hi(yy.y) * sigmoidf_fast(v0[3]));
                    w.z = cvt_pk_bf16(bf_lo(yy.z) * sigmoidf_fast(v1[0]), bf_hi(yy.z) * sigmoidf_fast(v1[1]));
                    w.w = cvt_pk_bf16(bf_lo(yy.w) * sigmoidf_fast(v1[2]), bf_hi(yy.w) * sigmoidf_fast(v1[3]));
                    *(u32x4*)(O + r * ldc + col0 + bj * HALF) = w; } }
    }
};
struct EpiMerge {
    static constexpr bool PERM = true;
    const bf16_t* P; bf16_t* MG;
    __device__ __forceinline__ void operator()(const f32x4 (&acc)[2][2][4][2], const Unit& u, int wr, int wc, int fr, int fq) const {
        const int row0 = u.pm * BM + wr * 64 + fr, c = u.pn * 64 + wc * 16 + 4 * fq;
        const bf16_t* Pb = P + ((size_t)(u.pm * 16 + wr * 4) * 512 + (u.pn * 4 + wc)) * 256 + fr * 16 + 4 * fq;
#pragma unroll
        for (int ai = 0; ai < 2; ++ai) {
            u32x2 p[4][4];
#pragma unroll
            for (int m = 0; m < 4; ++m)
#pragma unroll
                for (int kb = 0; kb < 4; ++kb) p[m][kb] = *(const u32x2*)(Pb + ((size_t)(ai * 8 + m) * 512 + kb * 128) * 256);
#pragma unroll
            for (int m = 0; m < 4; ++m) { const size_t r = (size_t)(row0 + ai * HALF + m * 16);
                f32x4 t = (f32x4){0.f, 0.f, 0.f, 0.f};
#pragma unroll
                for (int kb = 0; kb < 4; ++kb) { const f32x4 a = acc[ai][kb >> 1][m][kb & 1]; const u32x2 q = p[m][kb];
                    t[0] += bf_lo(q.x) * sigmoidf_fast(a[0]); t[1] += bf_hi(q.x) * sigmoidf_fast(a[1]); t[2] += bf_lo(q.y) * sigmoidf_fast(a[2]); t[3] += bf_hi(q.y) * sigmoidf_fast(a[3]); }
                u32x2 w; w.x = cvt_pk_bf16(t[0], t[1]); w.y = cvt_pk_bf16(t[2], t[3]);
                if (MK_BLK_MG) *(u32x2*)(MG + ((size_t)(u.pm * 16 + wr * 4 + ai * 8 + m) * 128 + (u.pn * 4 + wc)) * 256 + fr * 16 + 4 * fq) = w;
                else *(u32x2*)(MG + r * 2048 + c) = w; }
        }
    }
};
struct EpiResF32 {
    static constexpr bool PERM = true;
    const float* base; const float* base2; int split_row; float* out; int ldc;
    __device__ __forceinline__ void operator()(const f32x4 (&acc)[2][2][4][2], const Unit& u, int wr, int wc, int fr, int fq) const {
        const int row0 = u.pm * BM + wr * 64 + fr, col0 = u.pn * BM + wc * 32 + 8 * fq;
        const float* bp = (u.pm * BM >= split_row) ? base2 - (size_t)split_row * ldc : base;
#pragma unroll
        for (int ai = 0; ai < 2; ++ai) {
            f32x4 bs[4][2][2];
#pragma unroll
            for (int m = 0; m < 4; ++m)
#pragma unroll
                for (int bj = 0; bj < 2; ++bj)
#pragma unroll
                    for (int n = 0; n < 2; ++n) bs[m][bj][n] = *(const f32x4*)(bp + (size_t)(row0 + ai * HALF + m * 16) * ldc + col0 + bj * HALF + n * 4);
#pragma unroll
            for (int m = 0; m < 4; ++m)
#pragma unroll
                for (int bj = 0; bj < 2; ++bj)
#pragma unroll
                    for (int n = 0; n < 2; ++n) *(f32x4*)(out + (size_t)(row0 + ai * HALF + m * 16) * ldc + col0 + bj * HALF + n * 4) = bs[m][bj][n] + acc[ai][bj][m][n];
        }
    }
};
struct EpiSwiglu {
    static constexpr bool PERM = true;
    bf16_t* O; int ldc;
    __device__ __forceinline__ void operator()(const f32x4 (&acc)[2][2][4][2], const Unit& u, int wr, int wc, int fr, int fq) const {
        const int row0 = u.pm * BM + wr * 64 + fr, col0 = u.pn * HALF + wc * 32 + 8 * fq;
#pragma unroll
        for (int ai = 0; ai < 2; ++ai)
#pragma unroll
            for (int m = 0; m < 4; ++m) {
                f32x4 t[2];
#pragma unroll
                for (int n = 0; n < 2; ++n)
#pragma unroll
                    for (int j = 0; j < 4; ++j) { const float a = acc[ai][0][m][n][j], b = acc[ai][1][m][n][j]; t[n][j] = a * sigmoidf_fast(a) * b; }
                u32x4 w; w.x = cvt_pk_bf16(t[0][0], t[0][1]); w.y = cvt_pk_bf16(t[0][2], t[0][3]); w.z = cvt_pk_bf16(t[1][0], t[1][1]); w.w = cvt_pk_bf16(t[1][2], t[1][3]);
                if (MK_BLK_MID) st16(O + ((size_t)(u.pm * 16 + wr * 4 + ai * 8 + m) * (ldc >> 5) + (u.pn * 4 + wc)) * 512 + fr * 32 + fq * 8, w);
                else st16(O + (size_t)(row0 + ai * HALF + m * 16) * ldc + col0, w); }
    }
};
struct EpiPle {
    static constexpr bool PERM = true;
    const float* base; float* out; int ldc; const bf16_t* PP; int ldp;
    __device__ __forceinline__ void operator()(const f32x4 (&acc)[2][2][4][2], const Unit& u, int wr, int wc, int fr, int fq) const {
        const int row0 = u.pm * BM + wr * 64 + fr, col0 = u.pn * BM + wc * 32 + 8 * fq;
#pragma unroll
        for (int ai = 0; ai < 2; ++ai)
#pragma unroll
            for (int mh = 0; mh < 2; ++mh) {
                f32x4 b0[2][2], b1[2][2]; u32x4 pp[2][2];
#pragma unroll
                for (int mm = 0; mm < 2; ++mm)
#pragma unroll
                    for (int bj = 0; bj < 2; ++bj) { const size_t r = (size_t)(row0 + ai * HALF + (2 * mh + mm) * 16); const int c = col0 + bj * HALF;
                        b0[mm][bj] = *(const f32x4*)(base + r * ldc + c); b1[mm][bj] = *(const f32x4*)(base + r * ldc + c + 4); pp[mm][bj] = MK_BLK_PP ? *(const u32x4*)(PP + ((size_t)(u.pm * 16 + wr * 4 + ai * 8 + 2 * mh + mm) * (ldp >> 5) + (u.pn * 8 + bj * 4 + wc)) * 512 + fr * 32 + fq * 8) : *(const u32x4*)(PP + r * ldp + c); }
#pragma unroll
                for (int mm = 0; mm < 2; ++mm)
#pragma unroll
                    for (int bj = 0; bj < 2; ++bj) { const int m = 2 * mh + mm; const size_t r = (size_t)(row0 + ai * HALF + m * 16); const int c = col0 + bj * HALF;
                        const f32x4 a0 = acc[ai][bj][m][0], a1 = acc[ai][bj][m][1]; const u32x4 p = pp[mm][bj];
                        f32x4 o0 = b0[mm][bj], o1 = b1[mm][bj];
                        o0[0] += sigmoidf_fast(a0[0]) * bf_lo(p.x); o0[1] += sigmoidf_fast(a0[1]) * bf_hi(p.x); o0[2] += sigmoidf_fast(a0[2]) * bf_lo(p.y); o0[3] += sigmoidf_fast(a0[3]) * bf_hi(p.y);
                        o1[0] += sigmoidf_fast(a1[0]) * bf_lo(p.z); o1[1] += sigmoidf_fast(a1[1]) * bf_hi(p.z); o1[2] += sigmoidf_fast(a1[2]) * bf_lo(p.w); o1[3] += sigmoidf_fast(a1[3]) * bf_hi(p.w);
                        *(f32x4*)(out + r * ldc + c) = o0; *(f32x4*)(out + r * ldc + c + 4) = o1; }
            }
    }
};
template <class Epi, class Sched, bool ALIGN_EPI = false, bool SP2 = false>
__device__ __forceinline__ void gemm_phase(PG8_LAS unsigned char* lds, const Gemm g, const Sched& S, const Epi& E) {
    int tid_ = threadIdx.x; asm volatile("" : "+v"(tid_));
    const int tid = tid_, wid = __builtin_amdgcn_readfirstlane(tid >> 6), lane = tid & 63, wr = wid >> 2, wc = wid & 3, fr = lane & 15, fq = lane >> 4;
    const int K = g.K, nt = K / BK, lda = g.lda, ldb = g.ldb;
    unsigned voffA[2], voffB[2];
#pragma unroll
    for (int i = 0; i < 2; ++i) { int R, C; stage_rc(tid * 16 + i * 8192, R, C); const int Rb = Epi::PERM ? ((R & ~31) + perm32(R & 31)) : R;
        const int Rg = (g.bmode == 2) ? (((Rb >> 2) & 1) * 2048 + 16 * (Rb >> 5) + 4 * ((Rb >> 3) & 3) + (Rb & 3)) : Rb;
        voffA[i] = g.ablk ? (unsigned)(((((R >> 4) * (K >> g.ablk) + (C >> g.ablk)) * 16 + (R & 15)) << g.ablk) + (C & ((1 << g.ablk) - 1))) * 2u : (unsigned)(R * lda + C) * 2u; voffB[i] = (unsigned)(Rg * ldb + C) * 2u; }
    const size_t kstep = (size_t)(BK * 2);
    const size_t kstepA = g.ablk ? (size_t)(BK * 32) : kstep;
    const size_t hstepA = (size_t)HALF * lda * 2, hstepB = (size_t)(g.bmode == 2 ? 4096 : (g.bmode ? 2048 : HALF)) * ldb * 2;
    const size_t tstepA = 2 * hstepA, tstepB = (size_t)BM * ldb * 2;
#define PG8_ABASE(u) ((const char*)g.A + (size_t)(u).pm * tstepA + (size_t)((u).pn >> g.agrp_shift) * (size_t)g.agrp_stride * 2)
#define PG8_BBASE(u) ((const char*)g.Bt + (g.bmode == 2 ? (size_t)((u).pn * 64) * ldb * 2 : (g.bmode ? (size_t)(((u).pn >> 4) * 4096 + ((u).pn & 15) * HALF) * ldb * 2 : (size_t)(u).pn * tstepB)))
    const unsigned ldsw = (unsigned)wid * 1024u;
    const int aoff = lds_byte(wr * 64 + fr, fq * 8), boff = lds_byte(wc * 32 + fr, fq * 8);
#define PG8_SA(b, h) (((b) * 2 + (h)) * HTB)
#define PG8_SB(b, h) ((4 + (b) * 2 + (h)) * HTB)
#define PG8_STAGE(bufoff, gbase, voff) do { _Pragma("unroll") for (int _i = 0; _i < 2; ++_i) \
        __builtin_amdgcn_global_load_lds((const unsigned*)((const char*)(gbase) + (voff)[_i]), (PG8_LAS unsigned*)(lds + (bufoff) + ldsw + _i * 8192), 16, 0, 0); } while (0)
#define PG8_LDA(dst, b, h) do { _Pragma("unroll") for (int m = 0; m < 4; ++m) _Pragma("unroll") for (int k = 0; k < 2; ++k) dst[m][k] = *(const PG8_LAS bf16x8*)(lds + PG8_SA(b, h) + aoff + m * 2048 + k * 1024); } while (0)
#define PG8_LDB(dst, b, h) do { _Pragma("unroll") for (int n = 0; n < 2; ++n) _Pragma("unroll") for (int k = 0; k < 2; ++k) dst[n][k] = *(const PG8_LAS bf16x8*)(lds + PG8_SB(b, h) + boff + n * 2048 + k * 1024); } while (0)
#define PG8_MMA(ai, bj, At, Bt) do { __builtin_amdgcn_s_setprio(1); _Pragma("unroll") for (int m = 0; m < 4; ++m) _Pragma("unroll") for (int n = 0; n < 2; ++n) _Pragma("unroll") for (int k = 0; k < 2; ++k) \
        acc[ai][bj][m][n] = __builtin_amdgcn_mfma_f32_16x16x32_bf16(Bt[n][k], At[m][k], acc[ai][bj][m][n], 0, 0, 0); __builtin_amdgcn_s_setprio(0); } while (0)
#define PG8_WAIT_V(n) asm volatile("s_waitcnt vmcnt(" #n ")" ::: "memory")
#define PG8_WAIT_L(n) asm volatile("s_waitcnt lgkmcnt(" #n ")" ::: "memory")
#define PG8_BAR __builtin_amdgcn_s_barrier()
#define PG8_SCHED __builtin_amdgcn_sched_barrier(0)
    Unit cur, nxt; int ui = 0;
    if (!S.next(0, cur)) return;
    if (g.stagger) { const unsigned long long t0_ = __builtin_amdgcn_s_memrealtime(), d_ = (unsigned long long)(((blockIdx.x >> 3) & 7) * g.stagger);
        while (__builtin_amdgcn_s_memrealtime() - t0_ < d_) __builtin_amdgcn_s_sleep(8); }
    f32x4 acc[2][2][4][2];
#pragma unroll
    for (int a = 0; a < 2; ++a)
#pragma unroll
        for (int b = 0; b < 2; ++b)
#pragma unroll
            for (int m = 0; m < 4; ++m)
#pragma unroll
                for (int n = 0; n < 2; ++n) acc[a][b][m][n] = (f32x4){0.f, 0.f, 0.f, 0.f};
    bf16x8 At[4][2], B0[2][2], B1[2][2];
    const char* cA = PG8_ABASE(cur); const char* cB = PG8_BBASE(cur);
    if constexpr (SP2) {
        PG8_STAGE(PG8_SB(0, 0), cB, voffB); PG8_STAGE(PG8_SB(0, 1), cB + hstepB, voffB); PG8_STAGE(PG8_SA(0, 0), cA, voffA); PG8_STAGE(PG8_SA(0, 1), cA + hstepA, voffA);
        if (wr == 1) PG8_BAR;
        PG8_WAIT_V(2); PG8_BAR;
        PG8_STAGE(PG8_SB(1, 0), cB + kstep, voffB); PG8_STAGE(PG8_SA(1, 0), cA + kstepA, voffA); PG8_STAGE(PG8_SB(1, 1), cB + hstepB + kstep, voffB);
        PG8_WAIT_V(6); PG8_BAR;
    } else {
        PG8_STAGE(PG8_SB(0, 0), cB, voffB); PG8_STAGE(PG8_SA(0, 0), cA, voffA); PG8_STAGE(PG8_SB(0, 1), cB + hstepB, voffB); PG8_STAGE(PG8_SA(0, 1), cA + hstepA, voffA);
        if (wr == 1) PG8_BAR;
        PG8_WAIT_V(4); PG8_BAR;
        PG8_STAGE(PG8_SB(1, 0), cB + kstep, voffB); PG8_STAGE(PG8_SA(1, 0), cA + kstepA, voffA); PG8_STAGE(PG8_SB(1, 1), cB + hstepB + kstep, voffB);
        PG8_WAIT_V(6); PG8_BAR;
    }
    for (;;) {
        const bool has_next = S.next(ui + 1, nxt);
        const char* nA = has_next ? PG8_ABASE(nxt) : cA; const char* nB = has_next ? PG8_BBASE(nxt) : cB;
        for (int t = 0; t < nt; t += 2) {
            const bool last = (t == nt - 2);
            const char* a1 = cA + (size_t)(t + 1) * kstepA;
            const char* a2 = last ? nA : cA + (size_t)(t + 2) * kstepA; const char* b2 = last ? nB : cB + (size_t)(t + 2) * kstep;
            const char* a3 = a2 + kstepA; const char* b3 = b2 + kstep;
            if constexpr (SP2) {
            PG8_LDB(B0, 0, 0); PG8_LDB(B1, 0, 1); PG8_SCHED; PG8_LDA(At, 0, 0); PG8_STAGE(PG8_SA(1, 1), a1 + hstepA, voffA);
            PG8_WAIT_V(8); PG8_WAIT_L(0); PG8_BAR; PG8_MMA(0, 0, At, B0); PG8_MMA(0, 1, At, B1); PG8_BAR; PG8_SCHED;
            PG8_LDA(At, 0, 1); PG8_STAGE(PG8_SB(0, 0), b2, voffB); PG8_STAGE(PG8_SB(0, 1), b2 + hstepB, voffB); PG8_STAGE(PG8_SA(0, 0), a2, voffA);
            PG8_WAIT_V(8); PG8_WAIT_L(0); PG8_BAR; PG8_MMA(1, 0, At, B0); PG8_MMA(1, 1, At, B1); PG8_BAR; PG8_SCHED;
            PG8_LDB(B0, 1, 0); PG8_LDB(B1, 1, 1); PG8_SCHED; PG8_LDA(At, 1, 0); PG8_STAGE(PG8_SA(0, 1), a2 + hstepA, voffA);
            PG8_WAIT_V(8); PG8_WAIT_L(0); PG8_BAR; PG8_MMA(0, 0, At, B0); PG8_MMA(0, 1, At, B1); PG8_BAR; PG8_SCHED;
            PG8_LDA(At, 1, 1); PG8_STAGE(PG8_SB(1, 0), b3, voffB); PG8_STAGE(PG8_SB(1, 1), b3 + hstepB, voffB); PG8_STAGE(PG8_SA(1, 0), a3, voffA);
            PG8_WAIT_V(8); PG8_WAIT_L(0); PG8_BAR; PG8_MMA(1, 0, At, B0); PG8_MMA(1, 1, At, B1); PG8_BAR; PG8_SCHED;
            } else {
            PG8_LDB(B0, 0, 0); PG8_SCHED; PG8_LDA(At, 0, 0); PG8_STAGE(PG8_SA(1, 1), a1 + hstepA, voffA);
            PG8_WAIT_L(8); PG8_BAR; PG8_WAIT_L(0); PG8_MMA(0, 0, At, B0); PG8_BAR; PG8_SCHED;
            PG8_LDB(B1, 0, 1); PG8_STAGE(PG8_SB(0, 0), b2, voffB);
            PG8_BAR; PG8_WAIT_L(0); PG8_MMA(0, 1, At, B1); PG8_BAR;
            PG8_LDA(At, 0, 1); PG8_STAGE(PG8_SA(0, 0), a2, voffA);
            PG8_BAR; PG8_WAIT_L(0); PG8_MMA(1, 0, At, B0); PG8_BAR; PG8_SCHED;
            PG8_STAGE(PG8_SB(0, 1), b2 + hstepB, voffB);
            PG8_WAIT_V(6); PG8_BAR; PG8_MMA(1, 1, At, B1); PG8_BAR;
            PG8_LDB(B0, 1, 0); PG8_SCHED; PG8_LDA(At, 1, 0); PG8_STAGE(PG8_SA(0, 1), a2 + hstepA, voffA);
            PG8_WAIT_L(8); PG8_BAR; PG8_WAIT_L(0); PG8_MMA(0, 0, At, B0); PG8_BAR; PG8_SCHED;
            PG8_LDB(B1, 1, 1); PG8_STAGE(PG8_SB(1, 0), b3, voffB);
            PG8_BAR; PG8_WAIT_L(0); PG8_MMA(0, 1, At, B1); PG8_BAR;
            PG8_LDA(At, 1, 1); PG8_STAGE(PG8_SA(1, 0), a3, voffA);
            PG8_BAR; PG8_WAIT_L(0); PG8_MMA(1, 0, At, B0); PG8_BAR; PG8_SCHED;
            PG8_STAGE(PG8_SB(1, 1), b3 + hstepB, voffB);
            PG8_WAIT_V(6); PG8_BAR; PG8_MMA(1, 1, At, B1); PG8_BAR;
            }
        }
        if constexpr (ALIGN_EPI) { if (wr == 0) PG8_BAR; }
        { E(acc, cur, wr, wc, fr, fq); }
        if (!has_next) break;
#pragma unroll
        for (int a = 0; a < 2; ++a)
#pragma unroll
            for (int b = 0; b < 2; ++b)
#pragma unroll
                for (int m = 0; m < 4; ++m)
#pragma unroll
                    for (int n = 0; n < 2; ++n) acc[a][b][m][n] = (f32x4){0.f, 0.f, 0.f, 0.f};
        cur = nxt; cA = nA; cB = nB; ++ui;
        if constexpr (ALIGN_EPI) { if (wr == 1) PG8_BAR; }
    }
    PG8_WAIT_V(0);
    if constexpr (!ALIGN_EPI) { if (wr == 0) PG8_BAR; }
    PG8_BAR;
#undef PG8_ABASE
#undef PG8_BBASE
#undef PG8_SA
#undef PG8_SB
#undef PG8_STAGE
#undef PG8_LDA
#undef PG8_LDB
#undef PG8_MMA
#undef PG8_WAIT_V
#undef PG8_WAIT_L
#undef PG8_BAR
#undef PG8_SCHED
}
}


constexpr int D_MODEL = 2048, NTOK = 49152, CH_TOK = 16384, N_CHUNK = 3, DEPTH = 2;
constexpr int MIX_IN = 4096, IN_COLS = 12288, D_FF = 5632, PLE_DIM = 256;
constexpr int ZC_UA = 0, ZC_BG = 512, ZC_CG = 1024, ZC_VB = 1536, ZC_Q = 2048, ZC_K = 2560, ZC_VC = 3072, ZC_UD = 3584;
constexpr float EPS = 1e-6f;
constexpr int NWAVES = 8;

constexpr size_t MiB = 1u << 20;
constexpr size_t WS_CTL = 0, CTL_ZERO_BYTES = 1 * MiB;
constexpr size_t WS_TAB = 1 * MiB;
constexpr size_t S5T_BYTES = 12800, S5T_BB = 0, S5T_C = 8192, S5T_AB = 12288;
constexpr size_t TAB_S5 = WS_TAB, TAB_C128 = WS_TAB + 2 * MiB, TAB_S128 = TAB_C128 + 32768, TAB_C32 = TAB_S128 + 32768, TAB_S32 = TAB_C32 + 2048;
constexpr size_t WS_W = 8 * MiB;
constexpr size_t WL_MIX = 0, WL_G = 16 * MiB, WL_GLU = 48 * MiB, WL_BR = WL_GLU + MiB / 2, WL_O = WL_BR + 8 * MiB, WL_FF = WL_O + 8 * MiB, WL_FF2 = WL_FF + 44 * MiB, WL_PG = WL_FF2 + 22 * MiB, WL_PP = WL_PG + 8 * MiB;
constexpr size_t WL_BYTES = WL_PP + 1 * MiB;
static_assert(WL_BYTES == 139 * MiB + MiB / 2, "weight map");
constexpr size_t WS_H = 288 * MiB;
constexpr size_t WS_Z = 352 * MiB;
constexpr size_t WS_YS = 480 * MiB;
constexpr size_t WS_HALL = 352 * MiB;
constexpr size_t WS_MG = 544 * MiB;
constexpr size_t WS_GT = 736 * MiB;
constexpr size_t WS_YF = WS_GT, WS_YB = WS_GT + 32 * MiB, WS_ZF = WS_GT + 64 * MiB, WS_Y1 = WS_GT + 96 * MiB, WS_S5E = WS_GT + 112 * MiB;
constexpr size_t WS_H2ALL = 288 * MiB, WS_MIDALL = 480 * MiB;
constexpr size_t WS_PP = WS_GT;
constexpr size_t WS_P16 = 992 * MiB;
constexpr size_t WS_END = 1016 * MiB;
static_assert(WS_MIDALL + 528 * MiB <= WS_END && WS_H2ALL + 192 * MiB <= WS_MIDALL, "ffn map");
static_assert(WS_W + 2 * WL_BYTES <= WS_H && WS_MG + 192 * MiB <= WS_GT && WS_GT + 256 * MiB <= WS_P16, "ws map");
constexpr int CW_BAR = 4096;

constexpr int LDS_SCRATCH = 151552;
constexpr int LDSCTL_OFF = LDS_SCRATCH;
constexpr int LDS_BYTES = LDS_SCRATCH + 256;

#define GAS __attribute__((address_space(1)))
#define LAS __attribute__((address_space(3)))
typedef unsigned short bf16;
typedef unsigned u32x4 __attribute__((ext_vector_type(4)));
typedef unsigned u32x2 __attribute__((ext_vector_type(2)));
typedef float f32x4 __attribute__((ext_vector_type(4)));
typedef float f32x2 __attribute__((ext_vector_type(2)));
typedef short bf16x8 __attribute__((ext_vector_type(8)));
#define LDS_WAIT() asm volatile("s_waitcnt lgkmcnt(0)" ::: "memory")
using pg8::cvt_pk_bf16; using pg8::bf_lo; using pg8::bf_hi;
__device__ __forceinline__ bf16x8 as_frag(u32x4 v) { return __builtin_bit_cast(bf16x8, v); }
__device__ __forceinline__ void mfma_acc(f32x4& acc, bf16x8 a, bf16x8 b) { asm volatile("s_nop 1\n\tv_mfma_f32_16x16x32_bf16 %0, %1, %2, %0" : "+v"(acc) : "v"(a), "v"(b)); }
__device__ __forceinline__ f32x4 mfma16(bf16x8 a, bf16x8 b, f32x4 c) { mfma_acc(c, a, b); return c; }
#define MFMA_DRAIN() do { __builtin_amdgcn_sched_barrier(0); asm volatile("s_nop 15\n\ts_nop 15" ::: "memory"); __builtin_amdgcn_sched_barrier(0); } while (0)
__device__ __forceinline__ float wave_sum(float v) {
#pragma unroll
    for (int o = 1; o < 64; o <<= 1) v += __shfl_xor(v, o);
    return v;
}
__device__ __forceinline__ unsigned short f2bf(float f) { return (unsigned short)(cvt_pk_bf16(f, 0.f) & 0xffffu); }

#define XB_TMO      128
#define XB_XCNT(j)  (256  + 64 * (j))
#define XB_XSUB(j)  (1280 + 64 * (j))
#define XB_XGEN(j)  (2304 + 64 * (j))
#define XB_TOP      3328
#define XB_TOPGEN   3392
#define XCD_BAR_WORDS 3456
#define XB_SPIN_CAP (1u << 22)
__device__ __forceinline__ unsigned xb_ld(unsigned* p)              { return __hip_atomic_load(p, __ATOMIC_RELAXED, __HIP_MEMORY_SCOPE_AGENT); }
__device__ __forceinline__ unsigned xb_add(unsigned* p, unsigned v) { return __hip_atomic_fetch_add(p, v, __ATOMIC_RELAXED, __HIP_MEMORY_SCOPE_AGENT); }
__device__ __forceinline__ unsigned xb_xcc_id() { return (unsigned)__builtin_amdgcn_s_getreg((3 << 11) | 20) & 0xFu; }
#define XB_SPIN(cond, bar) do { unsigned _sp = 0; while (cond) { __builtin_amdgcn_s_sleep(1); \
    if ((++_sp & 255u) == 0u) { if (xb_ld(&(bar)[XB_TMO])) break; if (_sp > XB_SPIN_CAP) { atomicAdd(&(bar)[XB_TMO], 1u); break; } } } } while (0)
struct XcdBarrier { unsigned* bar; unsigned x; volatile LAS unsigned* st; };
__device__ __forceinline__ XcdBarrier xcd_barrier_post(unsigned* bar, volatile LAS unsigned* st) {
    XcdBarrier b; b.bar = bar; b.x = xb_xcc_id(); b.st = st;
    if (threadIdx.x == 0) (void)xb_add(&bar[XB_XCNT(b.x)], 1u);
    return b;
}
__device__ __forceinline__ void xcd_barrier_complete(unsigned* bar, unsigned x, unsigned& nloc, unsigned& nx) {
    const unsigned G = gridDim.x * gridDim.y * gridDim.z;
    unsigned sum, cnt, mine, sp = 0u;
    for (;;) {
        sum = 0u; cnt = 0u; mine = 0u;
#pragma unroll
        for (unsigned j = 0; j < 16; ++j) { const unsigned c = xb_ld(&bar[XB_XCNT(j)]); sum += c; cnt += (c > 0u) ? 1u : 0u; mine = (j == x) ? c : mine; }
        if (sum == G) break;
        __builtin_amdgcn_s_sleep(1);
        if ((++sp & 255u) == 0u) { if (xb_ld(&bar[XB_TMO])) break; if (sp > XB_SPIN_CAP) { atomicAdd(&bar[XB_TMO], 1u); break; } }
    }
    nloc = mine > 0u ? mine : 1u; nx = cnt > 0u ? cnt : 1u;
}
__device__ __forceinline__ void xcd_barrier(const XcdBarrier& b) {
    asm volatile("s_waitcnt vmcnt(0)" ::: "memory");
    __syncthreads();
    if (threadIdx.x == 0) {
        unsigned* bar = b.bar;
        __builtin_amdgcn_s_waitcnt(0);
        unsigned nloc = b.st[0], nx = b.st[1];
        if (nloc == 0u) { xcd_barrier_complete(bar, b.x, nloc, nx); b.st[0] = nloc; b.st[1] = nx; }
        const unsigned old = xb_add(&bar[XB_XSUB(b.x)], 1u);
        const unsigned gen = old / nloc;
        if (old + 1u == (gen + 1u) * nloc) {
            __builtin_amdgcn_fence(__ATOMIC_RELEASE, "agent");
            asm volatile("s_waitcnt vmcnt(0)" ::: "memory");
            const unsigned og = xb_add(&bar[XB_TOP], 1u);
            const unsigned tg = og / nx;
            if (og + 1u == (tg + 1u) * nx) xb_add(&bar[XB_TOPGEN], 1u);
            else XB_SPIN(xb_ld(&bar[XB_TOPGEN]) == tg, bar);
            __builtin_amdgcn_fence(__ATOMIC_ACQUIRE, "agent");
            xb_add(&bar[XB_XGEN(b.x)], 1u);
            asm volatile("s_waitcnt vmcnt(0)" ::: "memory");
        } else {
            XB_SPIN(xb_ld(&bar[XB_XGEN(b.x)]) == gen, bar);
            __builtin_amdgcn_fence(__ATOMIC_ACQUIRE, "agent");
            asm volatile("s_waitcnt vmcnt(0)" ::: "memory");
        }
    }
    __syncthreads();
}

struct Frame {
    LAS unsigned char* lds;
    int tid, lane, wave;
    int vcu, G;
    unsigned char* ws;
};
struct Args { const float* in[27]; float* out; unsigned char* ws; int ph_lo, ph_hi; };
__device__ __forceinline__ Frame fresh(const Frame& F0) { Frame F = F0; int t = F0.tid; asm volatile("" : "+v"(t)); F.tid = t; F.lane = t & 63; F.wave = __builtin_amdgcn_readfirstlane(t >> 6); return F; }

__device__ __forceinline__ void transpose_item(const float* W, int K, int N, bf16* WT, int k0, int n0, int drow0, LAS float* scr, int lane) {
#pragma unroll 8
    for (int i = 0; i < 32; ++i) { const int kk = 2 * i + (lane >> 5); scr[kk * 33 + (lane & 31)] = W[(size_t)(k0 + kk) * N + n0 + (lane & 31)]; }
    LDS_WAIT(); asm volatile("" ::: "memory");
    const int c = lane & 7;
#pragma unroll
    for (int j = 0; j < 4; ++j) { const int n = (lane >> 3) + 8 * j; const LAS float* s = scr + (8 * c) * 33 + n;
        u32x4 o; o.x = cvt_pk_bf16(s[0 * 33], s[1 * 33]); o.y = cvt_pk_bf16(s[2 * 33], s[3 * 33]); o.z = cvt_pk_bf16(s[4 * 33], s[5 * 33]); o.w = cvt_pk_bf16(s[6 * 33], s[7 * 33]);
        *(u32x4*)(WT + (size_t)(drow0 + n) * K + k0 + 8 * c) = o; }
    LDS_WAIT(); asm volatile("" ::: "memory");
}
__device__ __forceinline__ void conv_plain(const float* W, int K, int N, bf16* WT, int item, LAS float* scr, int lane) {
    const int nblk = N / 32, kb = item / nblk, nb = item % nblk;
    transpose_item(W, K, N, WT, 64 * kb, 32 * nb, 32 * nb, scr, lane);
}
__device__ __forceinline__ void ph_prologue(Frame& F, const Args& A) {
    LAS float* scr = (LAS float*)(F.lds + F.wave * 16384);
    const int gw = F.vcu * NWAVES + F.wave, NGW = F.G * NWAVES;
    constexpr int I_IN = (2048 / 64) * (IN_COLS / 32), I_GLU = (512 / 64) * (512 / 32), I_BR1 = (512 / 64) * (2048 / 32), I_BR = 4 * I_BR1, I_O = (2048 / 64) * (2048 / 32),
                  I_FF = (2048 / 64) * (2 * D_FF / 32), I_FF2 = (D_FF / 64) * (2048 / 32), I_PG = I_O, I_PP = (256 / 64) * (2048 / 32);
    constexpr int I_LAYER = I_IN + I_GLU + I_BR + I_O + I_FF + I_FF2 + I_PG + I_PP;
    for (int it = gw; it < DEPTH * I_LAYER; it += NGW) {
        const int l = it / I_LAYER; int r = it % I_LAYER;
        unsigned char* wl = F.ws + WS_W + (size_t)l * WL_BYTES;
        if (r < I_IN) {
            const float* W = A.in[5] + (size_t)l * 2048 * IN_COLS; const int nblk = IN_COLS / 32, kb = r / nblk, nb = r % nblk, n0 = 32 * nb;
            if (n0 < MIX_IN) transpose_item(W, 2048, IN_COLS, (bf16*)(wl + WL_MIX), 64 * kb, n0, n0, scr, F.lane);
            else transpose_item(W, 2048, IN_COLS, (bf16*)(wl + WL_G), 64 * kb, n0, n0 - MIX_IN, scr, F.lane);
            continue; } r -= I_IN;
        if (r < I_GLU) { conv_plain(A.in[14] + (size_t)l * 512 * 512, 512, 512, (bf16*)(wl + WL_GLU), r, scr, F.lane); continue; } r -= I_GLU;
        if (r < I_BR) { const int kb = r / I_BR1; conv_plain(A.in[19] + ((size_t)l * 4 + kb) * 512 * 2048, 512, 2048, (bf16*)(wl + WL_BR) + (size_t)kb * 2048 * 512, r % I_BR1, scr, F.lane); continue; } r -= I_BR;
        if (r < I_O) { conv_plain(A.in[20] + (size_t)l * 2048 * 2048, 2048, 2048, (bf16*)(wl + WL_O), r, scr, F.lane); continue; } r -= I_O;
        if (r < I_FF) {
            const float* W = A.in[22] + (size_t)l * 2048 * 2 * D_FF; const int nblk = 2 * D_FF / 32, kb = r / nblk, nb = r % nblk, n0 = 32 * nb;
            const int j = n0 / D_FF, rr = n0 % D_FF, pn = rr / 128, cc = rr % 128;
            transpose_item(W, 2048, 2 * D_FF, (bf16*)(wl + WL_FF), 64 * kb, n0, 256 * pn + 128 * j + cc, scr, F.lane);
            continue; } r -= I_FF;
        if (r < I_FF2) { conv_plain(A.in[23] + (size_t)l * D_FF * 2048, D_FF, 2048, (bf16*)(wl + WL_FF2), r, scr, F.lane); continue; } r -= I_FF2;
        if (r < I_PG) { conv_plain(A.in[25] + (size_t)l * 2048 * 2048, 2048, 2048, (bf16*)(wl + WL_PG), r, scr, F.lane); continue; } r -= I_PG;
        conv_plain(A.in[26] + (size_t)l * 256 * 2048, 256, 2048, (bf16*)(wl + WL_PP), r, scr, F.lane);
    }
    {
        const int gt = F.vcu * 512 + F.tid, NT = F.G * 512;
        bf16* c128 = (bf16*)(F.ws + TAB_C128); bf16* s128 = (bf16*)(F.ws + TAB_S128); bf16* c32 = (bf16*)(F.ws + TAB_C32); bf16* s32 = (bf16*)(F.ws + TAB_S32);
        for (int e = gt; e < 128 * 128 + 32 * 32; e += NT) {
            if (e < 128 * 128) { const int i = e >> 7, k = e & 127, m = (i * k) & 127; float sn, cs; sincospif((float)m * (1.0f / 64.0f), &sn, &cs);
                c128[e] = f2bf(cs * 0.08838834764831845f); s128[e] = f2bf(sn * 0.08838834764831845f); }
            else { const int e2 = e - 128 * 128, i = e2 >> 5, k = e2 & 31, m = (i * k) & 31; float sn, cs; sincospif((float)m * (1.0f / 16.0f), &sn, &cs);
                c32[e2] = f2bf(cs * 0.17677669529663687f); s32[e2] = f2bf(sn * 0.17677669529663687f); }
        }
    }
    for (int t = gw; t < DEPTH * 2 * 32; t += NGW) {
        const int g = t & 31, ld = t >> 5;
        unsigned char* tb = F.ws + TAB_S5 + (size_t)t * S5T_BYTES;
        const float* lam_re = A.in[6] + (size_t)t * 64; const float* lam_im = A.in[7] + (size_t)t * 64;
        const float dt = expf(A.in[8][t]);
        const float* b_re = A.in[9] + (size_t)t * 64 * 16; const float* b_im = A.in[10] + (size_t)t * 64 * 16;
        const float* c_re = A.in[11] + (size_t)t * 16 * 64; const float* c_im = A.in[12] + (size_t)t * 16 * 64;
        (void)g; (void)ld;
        const int lane = F.lane, l15 = lane & 15, g4 = lane >> 4;
        {
            const float lr = lam_re[lane], li = lam_im[lane], mag = expf(lr * dt); float sn, cs; sincosf(li * dt, &sn, &cs);
            f32x2 ab; ab.x = mag * cs; ab.y = mag * sn; ((f32x2*)(tb + S5T_AB))[lane] = ab;
        }
#pragma unroll 1
        for (int cb = 0; cb < 8; ++cb) {
            const int col = 16 * cb + l15, p = col >> 1, ri = col & 1;
            const float lr = lam_re[p], li = lam_im[p], mag = expf(lr * dt); float sn, cs; sincosf(li * dt, &sn, &cs);
            const float ar = mag * cs, ai = mag * sn, den = lr * lr + li * li;
            const float fr = ((ar - 1.0f) * lr + ai * li) / den, fi = (ai * lr - (ar - 1.0f) * li) / den;
            float v[8];
#pragma unroll
            for (int j = 0; j < 8; ++j) { const int h = 8 * g4 + j; float x = 0.f;
                if (h < 16) { const float br = b_re[p * 16 + h], bi = b_im[p * 16 + h]; x = ri ? (fr * bi + fi * br) : (fr * br - fi * bi); }
                v[j] = x; }
            u32x4 o; o.x = cvt_pk_bf16(v[0], v[1]); o.y = cvt_pk_bf16(v[2], v[3]); o.z = cvt_pk_bf16(v[4], v[5]); o.w = cvt_pk_bf16(v[6], v[7]);
            ((u32x4*)(tb + S5T_BB))[cb * 64 + lane] = o;
        }
#pragma unroll 1
        for (int ks = 0; ks < 4; ++ks) {
            float v[8];
#pragma unroll
            for (int j = 0; j < 8; ++j) { const int col = 32 * ks + 8 * g4 + j, p = col >> 1, ri = col & 1; v[j] = ri ? -c_im[l15 * 64 + p] : c_re[l15 * 64 + p]; }
            u32x4 o; o.x = cvt_pk_bf16(v[0], v[1]); o.y = cvt_pk_bf16(v[2], v[3]); o.z = cvt_pk_bf16(v[4], v[5]); o.w = cvt_pk_bf16(v[6], v[7]);
            ((u32x4*)(tb + S5T_C))[ks * 64 + lane] = o;
        }
    }
}

__device__ __forceinline__ void ph_norm(Frame& F, const float* xsrc, const float* gain, bf16* H, int nrows) {
    const int gw = F.vcu * NWAVES + F.wave, NGW = F.G * NWAVES;
    f32x4 gv[8];
#pragma unroll
    for (int j = 0; j < 8; ++j) gv[j] = ((const f32x4*)gain)[F.lane + 64 * j];
    for (int m = gw; m < nrows; m += NGW) {
        const f32x4* xr = (const f32x4*)(xsrc + (size_t)m * D_MODEL) + F.lane;
        f32x4 v[8]; float s = 0.f;
#pragma unroll
        for (int j = 0; j < 8; ++j) { v[j] = xr[64 * j]; s += (v[j][0] * v[j][0] + v[j][1] * v[j][1]) + (v[j][2] * v[j][2] + v[j][3] * v[j][3]); }
        const float rstd = rsqrtf(wave_sum(s) * (1.0f / D_MODEL) + EPS);
        u32x2* o = (u32x2*)(H + (size_t)m * D_MODEL) + F.lane;
#pragma unroll
        for (int j = 0; j < 8; ++j) { u32x2 w; w.x = cvt_pk_bf16(v[j][0] * rstd * gv[j][0], v[j][1] * rstd * gv[j][1]); w.y = cvt_pk_bf16(v[j][2] * rstd * gv[j][2], v[j][3] * rstd * gv[j][3]); o[64 * j] = w; }
    }
}
__device__ __forceinline__ void ph_pcvt(Frame& F, const float* pp, const float* ps, bf16* P16) {
    const int gw = F.vcu * NWAVES + F.wave, NGW = F.G * NWAVES;
    for (int m = gw; m < NTOK; m += NGW) {
        const float* src = m < 32768 ? pp + (size_t)m * PLE_DIM : ps + (size_t)(m - 32768) * PLE_DIM;
        const f32x4 v = ((const f32x4*)src)[F.lane];
        u32x2 w; w.x = cvt_pk_bf16(v[0], v[1]); w.y = cvt_pk_bf16(v[2], v[3]);
        ((u32x2*)(P16 + (size_t)m * PLE_DIM))[F.lane] = w;
    }
}
__device__ __forceinline__ void unpack8(u32x4 w, float (&f)[8]) { f[0] = bf_lo(w.x); f[1] = bf_hi(w.x); f[2] = bf_lo(w.y); f[3] = bf_hi(w.y); f[4] = bf_lo(w.z); f[5] = bf_hi(w.z); f[6] = bf_lo(w.w); f[7] = bf_hi(w.w); }
__device__ __forceinline__ u32x4 pack8(const float (&f)[8]) { u32x4 w; w.x = cvt_pk_bf16(f[0], f[1]); w.y = cvt_pk_bf16(f[2], f[3]); w.z = cvt_pk_bf16(f[4], f[5]); w.w = cvt_pk_bf16(f[6], f[7]); return w; }

__device__ __forceinline__ void conv_block(Frame& F, const bf16* Z, bf16* YS, const float* cw  , int blk, int lseq) {
#pragma unroll 1
    for (int i = 0; i < 8; ++i) {
        const int idx = F.tid + 512 * i, r = blk * 64 + (idx >> 6), c = (idx & 63) * 8, lpos = r % lseq;
        const bf16* zr = Z + (size_t)r * MIX_IN;
        float bg[8], z0[8], acc[8], tmp[8], w[8];
        unpack8(*(const u32x4*)(zr + ZC_BG + c), bg);
        {   float cg[8], vv[8]; unpack8(*(const u32x4*)(zr + ZC_CG + c), cg); unpack8(*(const u32x4*)(zr + ZC_VB + c), vv);
            const f32x4 wa = *(const f32x4*)(cw + 512 + c), wb = *(const f32x4*)(cw + 512 + c + 4);
            w[0] = wa[0]; w[1] = wa[1]; w[2] = wa[2]; w[3] = wa[3]; w[4] = wb[0]; w[5] = wb[1]; w[6] = wb[2]; w[7] = wb[3];
#pragma unroll
            for (int j = 0; j < 8; ++j) { z0[j] = cg[j] * vv[j]; acc[j] = w[j] * z0[j]; } }
        if (lpos > 0) { float cg[8], vv[8]; unpack8(*(const u32x4*)(zr - MIX_IN + ZC_CG + c), cg); unpack8(*(const u32x4*)(zr - MIX_IN + ZC_VB + c), vv);
            const f32x4 wa = *(const f32x4*)(cw + c), wb = *(const f32x4*)(cw + c + 4);
            w[0] = wa[0]; w[1] = wa[1]; w[2] = wa[2]; w[3] = wa[3]; w[4] = wb[0]; w[5] = wb[1]; w[6] = wb[2]; w[7] = wb[3];
#pragma unroll
            for (int j = 0; j < 8; ++j) acc[j] += w[j] * (cg[j] * vv[j]); }
        if (lpos < lseq - 1) { float cg[8], vv[8]; unpack8(*(const u32x4*)(zr + MIX_IN + ZC_CG + c), cg); unpack8(*(const u32x4*)(zr + MIX_IN + ZC_VB + c), vv);
            const f32x4 wa = *(const f32x4*)(cw + 1024 + c), wb = *(const f32x4*)(cw + 1024 + c + 4);
            w[0] = wa[0]; w[1] = wa[1]; w[2] = wa[2]; w[3] = wa[3]; w[4] = wb[0]; w[5] = wb[1]; w[6] = wb[2]; w[7] = wb[3];
#pragma unroll
            for (int j = 0; j < 8; ++j) acc[j] += w[j] * (cg[j] * vv[j]); }
#pragma unroll
        for (int j = 0; j < 8; ++j) tmp[j] = bg[j] * acc[j];
        *(u32x4*)(YS + (size_t)r * D_MODEL + 512 + c) = pack8(tmp);
    }
}
__device__ __forceinline__ void s5fin_block(Frame& F, const bf16* Z, const float* YF, const float* YB, const float* dsk  , bf16* Y1, int blk) {
#pragma unroll 1
    for (int i = 0; i < 8; ++i) {
        const int idx = F.tid + 512 * i, r = blk * 64 + (idx >> 6), c = (idx & 63) * 8;
        float u[8], o[8]; unpack8(*(const u32x4*)(Z + (size_t)r * MIX_IN + ZC_UA + c), u);
        const f32x4 f0 = *(const f32x4*)(YF + (size_t)r * 512 + c), f1 = *(const f32x4*)(YF + (size_t)r * 512 + c + 4);
        const f32x4 b0 = *(const f32x4*)(YB + (size_t)r * 512 + c), b1 = *(const f32x4*)(YB + (size_t)r * 512 + c + 4);
        const f32x4 d0 = *(const f32x4*)(dsk + c), d1 = *(const f32x4*)(dsk + c + 4);
#pragma unroll
        for (int j = 0; j < 8; ++j) { const float yy = (j < 4 ? d0[j & 3] : d1[j & 3]) * u[j] + (j < 4 ? f0[j & 3] : f1[j & 3]) + (j < 4 ? b0[j & 3] : b1[j & 3]);
            const float a = 0.7978845608028654f * (yy + 0.044715f * yy * yy * yy);
            const float th = 1.0f - 2.0f * __builtin_amdgcn_rcpf(1.0f + __expf(2.0f * a));
            o[j] = 0.5f * yy * (1.0f + th); }
        *(u32x4*)(Y1 + (size_t)r * 512 + c) = pack8(o);
    }
}

constexpr int S5_SEG = 512, S5_TPS = S5_SEG / 16;
template <bool FULL>
__device__ __forceinline__ void s5_seg_task(Frame& F, const unsigned char* tb, const bf16* Zs, float* Yout, f32x2* Ev, int nseg, int seg, int dir, int g) {
    LAS float* BU = (LAS float*)(F.lds + F.wave * 12288);
    LAS unsigned* XD = (LAS unsigned*)(F.lds + F.wave * 12288 + 8192);
    const int lane = F.lane, l15 = lane & 15, g4 = lane >> 4;
    const f32x2 ab = ((const f32x2*)(tb + S5T_AB))[lane];
    const float ar = ab.x, ai = ab.y;
    bf16x8 bbf[8];
#pragma unroll
    for (int cb = 0; cb < 8; ++cb) bbf[cb] = as_frag(((const u32x4*)(tb + S5T_BB))[cb * 64 + lane]);
    float xr = 0.f, xi = 0.f;
    float pwr[4], pwi[4];
    pwr[0] = ar; pwi[0] = ai;
#pragma unroll
    for (int j = 1; j < 4; ++j) { pwr[j] = pwr[j - 1] * ar - pwi[j - 1] * ai; pwi[j] = pwr[j - 1] * ai + pwi[j - 1] * ar; }
    if (FULL) {
        float pr = ar, pi = ai;
#pragma unroll
        for (int i = 0; i < 9; ++i) { const float nr = pr * pr - pi * pi, ni = 2.f * pr * pi; pr = nr; pi = ni; }
        if (dir == 0) { for (int j = 0; j < seg; ++j) { const f32x2 e = Ev[j * 64 + lane]; const float nr = pr * xr - pi * xi + e.x, ni = pr * xi + pi * xr + e.y; xr = nr; xi = ni; } }
        else { for (int j = nseg - 1; j > seg; --j) { const f32x2 e = Ev[j * 64 + lane]; const float nr = pr * xr - pi * xi + e.x, ni = pr * xi + pi * xr + e.y; xr = nr; xi = ni; } }
    }
    bf16x8 cf[4];
    if (FULL) {
#pragma unroll
        for (int ks = 0; ks < 4; ++ks) cf[ks] = as_frag(((const u32x4*)(tb + S5T_C))[ks * 64 + lane]);
    }
    const int tile0 = seg * S5_TPS;
    const bf16* zcol = Zs + ZC_UA + g * 16 + 8 * (g4 & 1);
    u32x4 ring[4];
#pragma unroll
    for (int j = 0; j < 4; ++j) { const int tile = tile0 + (dir ? S5_TPS - 1 - j : j); ring[j] = (u32x4){0u, 0u, 0u, 0u}; if (g4 < 2) ring[j] = *(const u32x4*)(zcol + (size_t)(tile * 16 + l15) * MIX_IN); }
#pragma unroll 1
    for (int it = 0; it < S5_TPS; it += 4) {
#pragma unroll
        for (int j = 0; j < 4; ++j) {
            const int tile = tile0 + (dir ? S5_TPS - 1 - (it + j) : it + j);
            const bf16x8 uf = as_frag(ring[j]);
            if (it + j + 4 < S5_TPS) { const int tn = dir ? tile - 4 : tile + 4; u32x4 nx = (u32x4){0u, 0u, 0u, 0u}; if (g4 < 2) nx = *(const u32x4*)(zcol + (size_t)(tn * 16 + l15) * MIX_IN); ring[j] = nx; }
            f32x4 a8[8];
#pragma unroll
            for (int cb = 0; cb < 8; ++cb) a8[cb] = mfma16(uf, bbf[cb], (f32x4){0.f, 0.f, 0.f, 0.f});
            MFMA_DRAIN();
#pragma unroll
            for (int cb = 0; cb < 8; ++cb)
#pragma unroll
                for (int q = 0; q < 4; ++q) BU[(4 * g4 + q) * 128 + 16 * cb + l15] = a8[cb][q];
            LDS_WAIT();
#pragma unroll
            for (int k = 0; k < 4; ++k) {
                float cr[4], ci[4], yr[4], yi[4];
                f32x2 bv[4];
#pragma unroll
                for (int j = 0; j < 4; ++j) { const int t = dir ? 15 - (4 * k + j) : 4 * k + j; bv[j] = *(const LAS f32x2*)(BU + t * 128 + 2 * lane); }
                cr[0] = bv[0].x; ci[0] = bv[0].y;
#pragma unroll
                for (int j = 1; j < 4; ++j) {
                    cr[j] = __builtin_fmaf(ar, cr[j - 1], __builtin_fmaf(-ai, ci[j - 1], bv[j].x));
                    ci[j] = __builtin_fmaf(ar, ci[j - 1], __builtin_fmaf(ai, cr[j - 1], bv[j].y));
                }
#pragma unroll
                for (int j = 0; j < 4; ++j) {
                    yr[j] = __builtin_fmaf(pwr[j], xr, __builtin_fmaf(-pwi[j], xi, cr[j]));
                    yi[j] = __builtin_fmaf(pwr[j], xi, __builtin_fmaf(pwi[j], xr, ci[j]));
                    if (FULL) { const int t = dir ? 15 - (4 * k + j) : 4 * k + j; XD[t * 64 + lane] = cvt_pk_bf16(yr[j], yi[j]); }
                }
                xr = yr[3]; xi = yi[3];
            }
            if (FULL) {
                LDS_WAIT();
                f32x4 y = (f32x4){0.f, 0.f, 0.f, 0.f};
#pragma unroll
                for (int ks = 0; ks < 4; ++ks) y = mfma16(as_frag(*(const LAS u32x4*)(XD + l15 * 64 + 16 * ks + 4 * g4)), cf[ks], y);
                MFMA_DRAIN();
                float* yo = Yout + (size_t)(tile * 16 + 4 * g4) * 512 + g * 16 + l15;
#pragma unroll
                for (int q = 0; q < 4; ++q) yo[(size_t)q * 512] = y[q];
            }
            LDS_WAIT();
        }
    }
    if (!FULL) { f32x2 e; e.x = xr; e.y = xi; Ev[seg * 64 + lane] = e; }
}

constexpr int NA_KL = 0, NA_VT = 73728, NA_BIAS = 147456;
constexpr int NA_RR = 8;
__device__ __forceinline__ void na_task(Frame& F, const bf16* Zs  , bf16* YSs  , int rows, int h, int r0,
                                        const float* qg, const float* kg, const float* relb  ) {
    LAS unsigned* KL = (LAS unsigned*)(F.lds + NA_KL); LAS unsigned* VT = (LAS unsigned*)(F.lds + NA_VT); LAS unsigned short* VT16 = (LAS unsigned short*)(F.lds + NA_VT);
    LAS float* BIAS = (LAS float*)(F.lds + NA_BIAS);
    const int tid = F.tid, lane = F.lane, l15 = lane & 15, g4 = lane >> 4;
    __syncthreads();
    for (int i = tid; i < 15 * 31; i += 512) BIAS[i] = relb[i];
    const int scol = tid >> 3, schunk = tid & 7;
    float kgv[8];
    { const f32x4 a = *(const f32x4*)(kg + 8 * schunk), b = *(const f32x4*)(kg + 8 * schunk + 4); kgv[0] = a[0]; kgv[1] = a[1]; kgv[2] = a[2]; kgv[3] = a[3]; kgv[4] = b[0]; kgv[5] = b[1]; kgv[6] = b[2]; kgv[7] = b[3]; }
    int rs0 = r0 - 4; rs0 = rs0 < 0 ? 0 : (rs0 > rows - 8 ? rows - 8 : rs0);
    const bf16* zst = Zs + (size_t)scol * MIX_IN + h * 64 + 8 * schunk;
#define NA_LOAD(rho, kr, vr) do { const bf16* zt_ = zst + (size_t)(rho) * 64 * MIX_IN; kr = *(const u32x4*)(zt_ + ZC_K); vr = *(const u32x4*)(zt_ + ZC_VC); } while (0)
#define NA_STORE(rho, kr, vr) do { float kf_[8]; unpack8(kr, kf_); float ss_ = 0.f; \
        _Pragma("unroll") for (int j_ = 0; j_ < 8; ++j_) ss_ += kf_[j_] * kf_[j_]; \
        ss_ += __shfl_xor(ss_, 1); ss_ += __shfl_xor(ss_, 2); ss_ += __shfl_xor(ss_, 4); \
        const float rk_ = rsqrtf(ss_ * (1.0f / 64.0f) + EPS); \
        _Pragma("unroll") for (int j_ = 0; j_ < 8; ++j_) kf_[j_] = kf_[j_] * rk_ * kgv[j_]; \
        const int slot_ = (rho) & 7; \
        *(LAS u32x4*)(KL + (slot_ * 64 + scol) * 36 + schunk * 4) = pack8(kf_); \
        const unsigned vw_[4] = {vr.x, vr.y, vr.z, vr.w}; \
        _Pragma("unroll") for (int j_ = 0; j_ < 8; ++j_) VT16[(slot_ * 64 + 8 * schunk + j_) * 72 + scol] = (unsigned short)((j_ & 1) ? (vw_[j_ >> 1] >> 16) : (vw_[j_ >> 1] & 0xffffu)); } while (0)
    {
        __syncthreads();
#pragma unroll 1
        for (int b = 0; b < 2; ++b) {
            u32x4 kr[4], vr[4];
#pragma unroll
            for (int i = 0; i < 4; ++i) NA_LOAD(rs0 + 4 * b + i, kr[i], vr[i]);
#pragma unroll
            for (int i = 0; i < 4; ++i) NA_STORE(rs0 + 4 * b + i, kr[i], vr[i]);
        }
    }
    int nextrow = rs0 + 8;
#pragma unroll 1
    for (int r = r0; r < r0 + NA_RR; ++r) {
        int rs = r - 4; rs = rs < 0 ? 0 : (rs > rows - 8 ? rows - 8 : rs);
        int rsn = r + 1 - 4; rsn = rsn < 0 ? 0 : (rsn > rows - 8 ? rows - 8 : rsn);
        const bool pre = (r + 1 < r0 + NA_RR) && (rsn + 7 >= nextrow);
        u32x4 pk = (u32x4){0u, 0u, 0u, 0u}, pv = (u32x4){0u, 0u, 0u, 0u};
        if (pre) NA_LOAD(nextrow, pk, pv);
        __syncthreads();
        if (F.wave < 4) {
            const int jb = F.wave, qc = 16 * jb + l15;
            int kc0 = 16 * jb - 8; kc0 = kc0 < 0 ? 0 : (kc0 > 32 ? 32 : kc0);
            int cs = qc - 8; cs = cs < 0 ? 0 : (cs > 48 ? 48 : cs);
            bf16x8 qf[2];
            {
                const bf16* zq = Zs + (size_t)(r * 64 + qc) * MIX_IN + ZC_Q + h * 64 + 8 * g4;
                float q0[8], q1[8]; unpack8(*(const u32x4*)zq, q0); unpack8(*(const u32x4*)(zq + 32), q1);
                float ss = 0.f;
#pragma unroll
                for (int j = 0; j < 8; ++j) ss += q0[j] * q0[j] + q1[j] * q1[j];
                ss += __shfl_xor(ss, 16); ss += __shfl_xor(ss, 32);
                const float rq = rsqrtf(ss * (1.0f / 64.0f) + EPS) * 0.125f;
                const f32x4 ga = *(const f32x4*)(qg + 8 * g4), gb = *(const f32x4*)(qg + 8 * g4 + 4), gc = *(const f32x4*)(qg + 32 + 8 * g4), gd = *(const f32x4*)(qg + 32 + 8 * g4 + 4);
#pragma unroll
                for (int j = 0; j < 4; ++j) { q0[j] *= rq * ga[j]; q0[4 + j] *= rq * gb[j]; q1[j] *= rq * gc[j]; q1[4 + j] *= rq * gd[j]; }
                qf[0] = as_frag(pack8(q0)); qf[1] = as_frag(pack8(q1));
            }
            f32x4 S[8][2];
#pragma unroll
            for (int a = 0; a < 8; ++a) {
                const int slot = (rs + a) & 7;
#pragma unroll
                for (int kb2 = 0; kb2 < 2; ++kb2) {
                    const LAS unsigned* kp = KL + (slot * 64 + kc0 + 16 * kb2 + l15) * 36 + 4 * g4;
                    S[a][kb2] = mfma16(as_frag(*(const LAS u32x4*)kp), qf[0], (f32x4){0.f, 0.f, 0.f, 0.f});
                    S[a][kb2] = mfma16(as_frag(*(const LAS u32x4*)(kp + 16)), qf[1], S[a][kb2]);
                }
            }
            MFMA_DRAIN();
            float mx = -3.0e38f;
#pragma unroll
            for (int a = 0; a < 8; ++a) {
                const int dr = rs + a - r + 7;
#pragma unroll
                for (int kb2 = 0; kb2 < 2; ++kb2)
#pragma unroll
                    for (int q = 0; q < 4; ++q) {
                        const int kc = kc0 + 16 * kb2 + 4 * g4 + q; const bool valid = (kc >= cs) && (kc < cs + 16);
                        int dc = kc - qc + 15; dc = dc < 0 ? 0 : (dc > 30 ? 30 : dc);
                        const float s = valid ? S[a][kb2][q] + BIAS[dr * 31 + dc] : -1.0e30f;
                        S[a][kb2][q] = s; mx = fmaxf(mx, s);
                    }
            }
            mx = fmaxf(mx, __shfl_xor(mx, 16)); mx = fmaxf(mx, __shfl_xor(mx, 32));
            float sum = 0.f;
#pragma unroll
            for (int a = 0; a < 8; ++a)
#pragma unroll
                for (int kb2 = 0; kb2 < 2; ++kb2)
#pragma unroll
                    for (int q = 0; q < 4; ++q) { const float p = __expf(S[a][kb2][q] - mx); S[a][kb2][q] = p; sum += p; }
            sum += __shfl_xor(sum, 16); sum += __shfl_xor(sum, 32);
            const float rinv = 1.0f / sum;
            f32x4 O[4];
#pragma unroll
            for (int dt = 0; dt < 4; ++dt) O[dt] = (f32x4){0.f, 0.f, 0.f, 0.f};
#pragma unroll
            for (int a = 0; a < 8; ++a) {
                const int slot = (rs + a) & 7;
                u32x4 pw; pw.x = cvt_pk_bf16(S[a][0][0], S[a][0][1]); pw.y = cvt_pk_bf16(S[a][0][2], S[a][0][3]); pw.z = cvt_pk_bf16(S[a][1][0], S[a][1][1]); pw.w = cvt_pk_bf16(S[a][1][2], S[a][1][3]);
                const bf16x8 pf = as_frag(pw);
#pragma unroll
                for (int dt = 0; dt < 4; ++dt) {
                    const LAS unsigned* vp = VT + (slot * 64 + 16 * dt + l15) * 36 + (kc0 >> 1) + 2 * g4;
                    const u32x2 v0 = *(const LAS u32x2*)vp, v1 = *(const LAS u32x2*)(vp + 8);
                    u32x4 vw; vw.x = v0.x; vw.y = v0.y; vw.z = v1.x; vw.w = v1.y;
                    O[dt] = mfma16(as_frag(vw), pf, O[dt]);
                }
            }
            MFMA_DRAIN();
            bf16* yo = YSs + (size_t)(r * 64 + qc) * D_MODEL + 1024 + h * 64 + 4 * g4;
#pragma unroll
            for (int dt = 0; dt < 4; ++dt) { u32x2 w; w.x = cvt_pk_bf16(O[dt][0] * rinv, O[dt][1] * rinv); w.y = cvt_pk_bf16(O[dt][2] * rinv, O[dt][3] * rinv); *(u32x2*)(yo + 16 * dt) = w; }
        }
        __syncthreads();
        if (pre) { NA_STORE(nextrow, pk, pv); nextrow += 1; }
    }
#undef NA_LOAD
#undef NA_STORE
}


#define TR2(o0, o1, off0, off1) "ds_read_b64_tr_b16 %" #o0 ", %16 offset:" #off0 "\n\tds_read_b64_tr_b16 %" #o1 ", %16 offset:" #off1 "\n\t"
constexpr int FN_XT = 0, FN_YR = 34816, FN_YI = 34816 + 34816;
template <int N1>
__device__ __forceinline__ void fnet1_tile(Frame& F, const bf16* Zs, bf16* ZFsg  , int g, int l2, const bf16* CT1, const bf16* ST1  , const bf16* C128, const bf16* S128) {
    constexpr int JT = N1 / 16, KS1 = N1 / 32;
    LAS unsigned short* YR = (LAS unsigned short*)(F.lds + FN_YR); LAS unsigned short* YI = (LAS unsigned short*)(F.lds + FN_YI);
    const int tid = F.tid, lane = F.lane, l15 = lane & 15, g4 = lane >> 4, w = F.wave;
    __syncthreads();
    {
        constexpr int NI = (N1 * 16) / 512;
        u32x4 raw[NI];
#pragma unroll
        for (int i = 0; i < NI; ++i) { const int idx = tid + 512 * i, l1 = idx >> 4, ch = idx & 15; raw[i] = *(const u32x4*)(Zs + (size_t)(128 * l1 + l2) * MIX_IN + ZC_UD + g * 128 + 8 * ch); }
#pragma unroll
        for (int i = 0; i < NI; ++i) { const int idx = tid + 512 * i, l1 = idx >> 4, ch = idx & 15; *(LAS u32x4*)(F.lds + FN_XT + l1 * 272 + ch * 16) = raw[i]; }
    }
    __syncthreads();
    {
        bf16x8 af[KS1];
        {
            const unsigned base = (unsigned)(size_t)F.lds + (unsigned)(FN_XT + (8 * g4 + (l15 >> 2)) * 272 + (16 * w + 4 * (lane & 3)) * 2);
            if constexpr (KS1 == 4) {
                u32x2 t_[8];
                asm volatile("ds_read_b64_tr_b16 %0, %8\n\tds_read_b64_tr_b16 %1, %8 offset:1088\n\tds_read_b64_tr_b16 %2, %8 offset:8704\n\tds_read_b64_tr_b16 %3, %8 offset:9792\n\t"
                             "ds_read_b64_tr_b16 %4, %8 offset:17408\n\tds_read_b64_tr_b16 %5, %8 offset:18496\n\tds_read_b64_tr_b16 %6, %8 offset:26112\n\tds_read_b64_tr_b16 %7, %8 offset:27200\n\ts_waitcnt lgkmcnt(0)"
                             : "=&v"(t_[0]), "=&v"(t_[1]), "=&v"(t_[2]), "=&v"(t_[3]), "=&v"(t_[4]), "=&v"(t_[5]), "=&v"(t_[6]), "=&v"(t_[7]) : "v"(base) : "memory");
#pragma unroll
                for (int ks = 0; ks < 4; ++ks) { u32x4 a; a.x = t_[2 * ks].x; a.y = t_[2 * ks].y; a.z = t_[2 * ks + 1].x; a.w = t_[2 * ks + 1].y; af[ks] = as_frag(a); }
            } else {
                u32x2 t0_, t1_;
                asm volatile("ds_read_b64_tr_b16 %0, %2\n\tds_read_b64_tr_b16 %1, %2 offset:1088\n\ts_waitcnt lgkmcnt(0)" : "=&v"(t0_), "=&v"(t1_) : "v"(base) : "memory");
                u32x4 a; a.x = t0_.x; a.y = t0_.y; a.z = t1_.x; a.w = t1_.y; af[0] = as_frag(a);
            }
        }
#pragma unroll 1
        for (int tj = 0; tj < JT; ++tj) {
            const int k1 = 16 * tj + l15;
            f32x4 ar = (f32x4){0.f, 0.f, 0.f, 0.f}, as = (f32x4){0.f, 0.f, 0.f, 0.f};
#pragma unroll
            for (int ks = 0; ks < KS1; ++ks) {
                ar = mfma16(af[ks], as_frag(*(const u32x4*)(CT1 + k1 * N1 + 32 * ks + 8 * g4)), ar);
                as = mfma16(af[ks], as_frag(*(const u32x4*)(ST1 + k1 * N1 + 32 * ks + 8 * g4)), as);
            }
            MFMA_DRAIN();
            float tsn, tcs; sincospif((float)(k1 * l2) * (2.0f / (float)(N1 * 128)), &tsn, &tcs);
            float zr[4], zi[4];
#pragma unroll
            for (int q = 0; q < 4; ++q) { const float yr = ar[q], yi = -as[q]; zr[q] = yr * tcs + yi * tsn; zi[q] = yi * tcs - yr * tsn; }
            u32x2 wr2, wi2; wr2.x = cvt_pk_bf16(zr[0], zr[1]); wr2.y = cvt_pk_bf16(zr[2], zr[3]); wi2.x = cvt_pk_bf16(zi[0], zi[1]); wi2.y = cvt_pk_bf16(zi[2], zi[3]);
            *(LAS u32x2*)(YR + k1 * 136 + 16 * w + 4 * g4) = wr2; *(LAS u32x2*)(YI + k1 * 136 + 16 * w + 4 * g4) = wi2;
        }
    }
    __syncthreads();
    {
        bf16x8 cfr[4], sfr[4];
#pragma unroll
        for (int ks = 0; ks < 4; ++ks) { cfr[ks] = as_frag(*(const u32x4*)(C128 + (16 * w + l15) * 128 + 32 * ks + 8 * g4)); sfr[ks] = as_frag(*(const u32x4*)(S128 + (16 * w + l15) * 128 + 32 * ks + 8 * g4)); }
#pragma unroll 1
        for (int tj = 0; tj < JT; ++tj) {
            const int k1 = 16 * tj + l15;
            f32x4 zr = (f32x4){0.f, 0.f, 0.f, 0.f}, zi = (f32x4){0.f, 0.f, 0.f, 0.f};
#pragma unroll
            for (int ks = 0; ks < 4; ++ks) {
                const u32x4 yr = *(const LAS u32x4*)(YR + k1 * 136 + 32 * ks + 8 * g4), yi = *(const LAS u32x4*)(YI + k1 * 136 + 32 * ks + 8 * g4);
                u32x4 ny; ny.x = yr.x ^ 0x80008000u; ny.y = yr.y ^ 0x80008000u; ny.z = yr.z ^ 0x80008000u; ny.w = yr.w ^ 0x80008000u;
                zr = mfma16(cfr[ks], as_frag(yr), zr); zr = mfma16(sfr[ks], as_frag(yi), zr);
                zi = mfma16(cfr[ks], as_frag(yi), zi); zi = mfma16(sfr[ks], as_frag(ny), zi);
            }
            MFMA_DRAIN();
            bf16* zo = ZFsg + ((size_t)k1 * 128 + l2) * 256 + 16 * w + 4 * g4;
            u32x2 a, b; a.x = cvt_pk_bf16(zr[0], zr[1]); a.y = cvt_pk_bf16(zr[2], zr[3]); b.x = cvt_pk_bf16(zi[0], zi[1]); b.y = cvt_pk_bf16(zi[2], zi[3]);
            *(u32x2*)zo = a; *(u32x2*)(zo + 128) = b;
        }
    }
}
__device__ __forceinline__ void fnet2_tile(Frame& F, const bf16* ZFsg, bf16* YSs  , int g, int k1, int N1, const bf16* C128, const bf16* S128) {
    constexpr int RS = 528;
    const int tid = F.tid, lane = F.lane, l15 = lane & 15, g4 = lane >> 4, w = F.wave;
    __syncthreads();
    const bf16* src = ZFsg + (size_t)k1 * 128 * 256;
    {
        u32x4 raw[8];
#pragma unroll
        for (int i = 0; i < 8; ++i) { const int idx = tid + 512 * i; raw[i] = *(const u32x4*)(src + (size_t)idx * 8); }
#pragma unroll
        for (int i = 0; i < 8; ++i) { const int idx = tid + 512 * i, l2 = idx >> 5, ch = idx & 31; *(LAS u32x4*)(F.lds + l2 * RS + ch * 16) = raw[i]; }
    }
    __syncthreads();
    const unsigned base = (unsigned)(size_t)F.lds + (unsigned)((8 * g4 + (l15 >> 2)) * RS + (16 * w + 4 * (lane & 3)) * 2);
    u32x2 t_[16];
    asm volatile(
        TR2(0, 1, 0, 2112) TR2(2, 3, 16896, 19008) TR2(4, 5, 33792, 35904) TR2(6, 7, 50688, 52800)
        TR2(8, 9, 256, 2368) TR2(10, 11, 17152, 19264) TR2(12, 13, 34048, 36160) TR2(14, 15, 50944, 53056)
        "s_waitcnt lgkmcnt(0)"
        : "=&v"(t_[0]), "=&v"(t_[1]), "=&v"(t_[2]), "=&v"(t_[3]), "=&v"(t_[4]), "=&v"(t_[5]), "=&v"(t_[6]), "=&v"(t_[7]),
          "=&v"(t_[8]), "=&v"(t_[9]), "=&v"(t_[10]), "=&v"(t_[11]), "=&v"(t_[12]), "=&v"(t_[13]), "=&v"(t_[14]), "=&v"(t_[15])
        : "v"(base) : "memory");
    bf16x8 zrf[4], zif[4];
#pragma unroll
    for (int ks = 0; ks < 4; ++ks) { u32x4 a; a.x = t_[2 * ks].x; a.y = t_[2 * ks].y; a.z = t_[2 * ks + 1].x; a.w = t_[2 * ks + 1].y; zrf[ks] = as_frag(a);
        u32x4 b; b.x = t_[8 + 2 * ks].x; b.y = t_[8 + 2 * ks].y; b.z = t_[8 + 2 * ks + 1].x; b.w = t_[8 + 2 * ks + 1].y; zif[ks] = as_frag(b); }
#pragma unroll 1
    for (int tj = 0; tj < 8; ++tj) {
        const int k2 = 16 * tj + l15;
        f32x4 y = (f32x4){0.f, 0.f, 0.f, 0.f};
#pragma unroll
        for (int ks = 0; ks < 4; ++ks) {
            y = mfma16(zrf[ks], as_frag(*(const u32x4*)(C128 + k2 * 128 + 32 * ks + 8 * g4)), y);
            y = mfma16(zif[ks], as_frag(*(const u32x4*)(S128 + k2 * 128 + 32 * ks + 8 * g4)), y);
        }
        MFMA_DRAIN();
        u32x2 o; o.x = cvt_pk_bf16(y[0], y[1]); o.y = cvt_pk_bf16(y[2], y[3]);
        *(u32x2*)(YSs + (size_t)(k1 + N1 * k2) * D_MODEL + 1536 + g * 128 + 16 * w + 4 * g4) = o;
    }
}

struct ChunkGeo { int nseq, lseq, rows, n1; };
__device__ __forceinline__ ChunkGeo chunk_geo(int ch) { ChunkGeo g; if (ch < 2) { g.nseq = 1; g.lseq = 16384; g.rows = 256; g.n1 = 128; } else { g.nseq = 4; g.lseq = 4096; g.rows = 64; g.n1 = 32; } return g; }

__device__ __forceinline__ void ph_s5a(Frame& F, const Args& A, int layer, int ch) {
    const ChunkGeo cg = chunk_geo(ch);
    const bf16* Z = (const bf16*)(F.ws + WS_Z); f32x2* EV = (f32x2*)(F.ws + WS_S5E);
    const int nseg = cg.lseq / S5_SEG, ntask = cg.nseq * nseg * 64;
#pragma unroll 1
    for (int tt = F.vcu * 8 + F.wave; tt < ntask; tt += F.G * 8) {
        const int dg = tt & 63, sg = tt >> 6, seg = sg % nseg, seq = sg / nseg, dir = dg >> 5, g = dg & 31;
        const unsigned char* tb = F.ws + TAB_S5 + (size_t)(((layer * 2 + dir) * 32) + g) * S5T_BYTES;
        s5_seg_task<false>(F, tb, Z + (size_t)seq * cg.lseq * MIX_IN, nullptr, EV + (size_t)(seq * 64 + dg) * nseg * 64, nseg, seg, dir, g);
    }
    int t0 = F.vcu; asm volatile("" : "+s"(t0));
    bf16* YS = (bf16*)(F.ws + WS_YS); bf16* ZF = (bf16*)(F.ws + WS_ZF);
    const int n_f1 = 512, n_cv = CH_TOK / 64;
#pragma unroll 1
    for (; t0 < n_f1 + n_cv; t0 += F.G) {
        if (t0 < n_f1) {
            const int u = t0;
            const bf16* C128 = (const bf16*)(F.ws + TAB_C128); const bf16* S128 = (const bf16*)(F.ws + TAB_S128);
            if (ch < 2) { const int g = u >> 7, l2 = u & 127;
                fnet1_tile<128>(F, Z, ZF + (size_t)g * 16384 * 256, g, l2, C128, S128, C128, S128);
            } else {
                const bf16* C32 = (const bf16*)(F.ws + TAB_C32); const bf16* S32 = (const bf16*)(F.ws + TAB_S32);
#pragma unroll 1
                for (int s = 0; s < 4; ++s) { const int uu = u * 4 + s, l2 = uu & 127, g = (uu >> 7) & 3, seq = uu >> 9;
                    fnet1_tile<32>(F, Z + (size_t)seq * 4096 * MIX_IN, ZF + (size_t)(seq * 4 + g) * 4096 * 256, g, l2, C32, S32, C128, S128); }
            }
        } else {
            conv_block(F, Z, YS, A.in[15] + (size_t)layer * 3 * 512, t0 - n_f1, cg.lseq);
        }
    }
}
__device__ __forceinline__ void ph_mix1(Frame& F, const Args& A, int layer, int ch) {
    const ChunkGeo cg = chunk_geo(ch);
    const bf16* Z = (const bf16*)(F.ws + WS_Z); bf16* YS = (bf16*)(F.ws + WS_YS); const bf16* ZF = (const bf16*)(F.ws + WS_ZF);
    float* YF = (float*)(F.ws + WS_YF); float* YB = (float*)(F.ws + WS_YB); f32x2* EV = (f32x2*)(F.ws + WS_S5E);
    const int nseg = cg.lseq / S5_SEG;
    const int n_s5 = cg.nseq * nseg * 8;
    const int n_na = cg.nseq * 8 * (cg.rows / NA_RR);
    const int n_f2 = 512;
    int t0 = F.vcu;
#pragma unroll 1
    for (; t0 < n_s5; t0 += F.G) {
        const int tt = t0 * 8 + F.wave, dg = tt & 63, sg = tt >> 6, seg = sg % nseg, seq = sg / nseg, dir = dg >> 5, g = dg & 31;
        const unsigned char* tb = F.ws + TAB_S5 + (size_t)(((layer * 2 + dir) * 32) + g) * S5T_BYTES;
        const size_t row0 = (size_t)seq * cg.lseq;
        s5_seg_task<true>(F, tb, Z + row0 * MIX_IN, (dir ? YB : YF) + row0 * 512, EV + (size_t)(seq * 64 + dg) * nseg * 64, nseg, seg, dir, g);
    }
    asm volatile("" : "+s"(t0));
#pragma unroll 1
    for (; t0 < n_s5 + n_na + n_f2; t0 += F.G) {
        const int t = t0 - n_s5;
        if (t < n_na) {
            const int runs = cg.rows / NA_RR, run = t % runs, h = (t / runs) & 7, seq = t / (runs * 8);
            const size_t row0 = (size_t)seq * cg.lseq;
            na_task(F, Z + row0 * MIX_IN, YS + row0 * D_MODEL, cg.rows, h, run * NA_RR, A.in[16] + layer * 64, A.in[17] + layer * 64, A.in[18] + ((size_t)layer * 8 + h) * 15 * 31);
        } else {
            const int u = t - n_na;
            const bf16* C128 = (const bf16*)(F.ws + TAB_C128); const bf16* S128 = (const bf16*)(F.ws + TAB_S128);
            int seq, g, k1; if (ch < 2) { seq = 0; g = u >> 7; k1 = u & 127; } else { k1 = u & 31; g = (u >> 5) & 3; seq = u >> 7; }
            fnet2_tile(F, ZF + (size_t)(seq * 4 + g) * cg.lseq * 256, YS + (size_t)seq * cg.lseq * D_MODEL, g, k1, cg.n1, C128, S128);
        }
    }
}
__device__ __forceinline__ void ph_mix2(Frame& F, const Args& A, int layer, int ch) {
    const bf16* Z = (const bf16*)(F.ws + WS_Z);
    const float* YF = (const float*)(F.ws + WS_YF); const float* YB = (const float*)(F.ws + WS_YB); bf16* Y1 = (bf16*)(F.ws + WS_Y1);
    (void)ch;
#pragma unroll 1
    for (int t = F.vcu; t < CH_TOK / 64; t += F.G) s5fin_block(F, Z, YF, YB, A.in[13] + (size_t)layer * 512, Y1, t);
}

constexpr int MK_STAG = 0, MK_STAG_MERGE = 0;
constexpr int PH_A = 8, PH_PER_LAYER = 3 * PH_A + 1 + 3 + 3, N_PHASES = 1 + DEPTH * PH_PER_LAYER;
__global__ void __launch_bounds__(NWAVES * 64, 2) fwd_kernel(const Args A) {
    extern __shared__ __attribute__((aligned(16))) unsigned char lds_raw[];
    Frame F;
    F.lds = (LAS unsigned char*)lds_raw;
    F.tid = threadIdx.x; F.lane = F.tid & 63; F.wave = __builtin_amdgcn_readfirstlane(F.tid >> 6);
    F.G = gridDim.x; { const int bx = blockIdx.x; F.vcu = (F.G % 8 == 0) ? (bx % 8) * (F.G / 8) + bx / 8 : bx; }
    F.ws = A.ws;
    volatile LAS unsigned* LCTL = (volatile LAS unsigned*)(F.lds + LDSCTL_OFF);
    if (F.tid < 64) LCTL[F.tid] = 0u;
    __syncthreads();
    const int lo = A.ph_lo, hi = A.ph_hi;
    const bool multi = (hi - lo) > 1;
    XcdBarrier bar; bar.bar = (unsigned*)(F.ws + WS_CTL) + CW_BAR; bar.x = 0; bar.st = LCTL;
    if (multi) bar = xcd_barrier_post((unsigned*)(F.ws + WS_CTL) + CW_BAR, LCTL);
#define IN(k) (lo <= (k) && (k) < hi)
#define SEAM(k) do { if ((k) + 1 < hi) xcd_barrier(bar); } while (0)

    if (IN(0)) { Frame Fp = fresh(F); ph_prologue(Fp, A); SEAM(0); }

#pragma unroll 1
    for (int layer = 0; layer < DEPTH; ++layer) {
        const int pl = 1 + layer * PH_PER_LAYER;
        if (pl + PH_PER_LAYER <= lo || pl >= hi) continue;
        const unsigned char* wl = F.ws + WS_W + (size_t)layer * WL_BYTES;
        bf16* H = (bf16*)(F.ws + WS_H); bf16* Z = (bf16*)(F.ws + WS_Z); bf16* YS = (bf16*)(F.ws + WS_YS); bf16* MGA = (bf16*)(F.ws + WS_MG); bf16* GT = (bf16*)(F.ws + WS_GT);
        bf16* Y1 = (bf16*)(F.ws + WS_Y1); bf16* P16 = (bf16*)(F.ws + WS_P16); bf16* PP = (bf16*)(F.ws + WS_PP); bf16* HALL = (bf16*)(F.ws + WS_HALL);
#pragma unroll 1
        for (int ch = 0; ch < N_CHUNK; ++ch) {
            const int pb = pl + ch * PH_A;
            const float* x_cur = layer == 0 ? ((ch < 2) ? A.in[0] + (size_t)ch * CH_TOK * D_MODEL : A.in[1]) : A.out + (size_t)ch * CH_TOK * D_MODEL;
            bf16* MG = MGA + (size_t)ch * CH_TOK * D_MODEL;
            if (IN(pb + 0)) { Frame Fp = fresh(F); ph_norm(Fp, x_cur, A.in[4] + (size_t)layer * D_MODEL, H, CH_TOK); SEAM(pb + 0); }
            if (IN(pb + 1)) {
                pg8::Gemm g{H, (const bf16*)(wl + WL_MIX), D_MODEL, D_MODEL, D_MODEL, 0, 0, 0, 0}; pg8::StaticOrder S; S.init(CH_TOK, MIX_IN, F.G, (int)blockIdx.x);
                pg8::EpiStoreBf16 E{Z, MIX_IN};

                pg8::gemm_phase<pg8::EpiStoreBf16, pg8::StaticOrder, true, true>(F.lds, g, S, E);
                SEAM(pb + 1); }
            if (IN(pb + 2)) { Frame Fp = fresh(F); ph_s5a(Fp, A, layer, ch); SEAM(pb + 2); }
            if (IN(pb + 3)) { Frame Fp = fresh(F); ph_mix1(Fp, A, layer, ch); SEAM(pb + 3); }
            if (IN(pb + 4)) { Frame Fp = fresh(F); ph_mix2(Fp, A, layer, ch); SEAM(pb + 4); }
            if (IN(pb + 5)) {
                pg8::Gemm g{Y1, (const bf16*)(wl + WL_GLU), 512, 512, 512, 0, 0, 0, 0}; pg8::StaticOrder S; S.init(CH_TOK, 512, F.G, (int)blockIdx.x);
                pg8::EpiGlu E{Y1, 512, YS, D_MODEL};
                pg8::gemm_phase<pg8::EpiGlu, pg8::StaticOrder, true, true>(F.lds, g, S, E);
                SEAM(pb + 5); }
            if (IN(pb + 6)) {
                pg8::Gemm g{YS, (const bf16*)(wl + WL_BR), D_MODEL, 512, 512, 3, 512, 0, 0}; pg8::StaticOrder S; S.init(CH_TOK, 8192, F.G, (int)blockIdx.x);
                pg8::EpiStoreBlk E{GT};

                pg8::gemm_phase<pg8::EpiStoreBlk, pg8::StaticOrder, false, true>(F.lds, g, S, E);
                SEAM(pb + 6); }
            if (IN(pb + 7)) {
                pg8::Gemm g{H, (const bf16*)(wl + WL_G), D_MODEL, D_MODEL, D_MODEL, 0, 0, 2, MK_STAG_MERGE}; pg8::StaticOrder S; S.init(CH_TOK, 32 * 256, F.G, (int)blockIdx.x);
                pg8::EpiMerge E{GT, MG};

                pg8::gemm_phase<pg8::EpiMerge, pg8::StaticOrder, true, true>(F.lds, g, S, E);
                SEAM(pb + 7); }
        }
        {
            const int pb = pl + 3 * PH_A;
            if (IN(pb)) {
                pg8::Gemm g{MGA, (const bf16*)(wl + WL_O), D_MODEL, D_MODEL, D_MODEL, 0, 0, 0, MK_STAG, MK_BLK_MG ? 4 : 0}; pg8::StaticOrder S; S.init(NTOK, D_MODEL, F.G, (int)blockIdx.x);
                pg8::EpiResF32 E{layer == 0 ? A.in[0] : A.out, layer == 0 ? A.in[1] : A.out + (size_t)32768 * D_MODEL, 32768, A.out, D_MODEL};
                pg8::gemm_phase<pg8::EpiResF32, pg8::StaticOrder, true, true>(F.lds, g, S, E);
                SEAM(pb); }
        }
        {
            const int pb = pl + 3 * PH_A + 1;
            bf16* H2 = (bf16*)(F.ws + WS_H2ALL); bf16* MIDA = (bf16*)(F.ws + WS_MIDALL);
            if (IN(pb + 0)) { Frame Fp = fresh(F); ph_norm(Fp, A.out, A.in[21] + (size_t)layer * D_MODEL, H2, NTOK); SEAM(pb + 0); }
            if (IN(pb + 1)) {
                pg8::Gemm g{H2, (const bf16*)(wl + WL_FF), D_MODEL, D_MODEL, D_MODEL, 0, 0, 0, 0}; pg8::StaticOrder S; S.init(NTOK, 2 * D_FF, F.G, (int)blockIdx.x);
                pg8::EpiSwiglu E{MIDA, D_FF};

                pg8::gemm_phase<pg8::EpiSwiglu, pg8::StaticOrder, true, true>(F.lds, g, S, E);
                SEAM(pb + 1); }
            if (IN(pb + 2)) {
                pg8::Gemm g{MIDA, (const bf16*)(wl + WL_FF2), D_FF, D_FF, D_FF, 0, 0, 0, MK_STAG, MK_BLK_MID ? 5 : 0}; pg8::StaticOrder S; S.init(NTOK, D_MODEL, F.G, (int)blockIdx.x);
                pg8::EpiResF32 E{A.out, A.out, 1 << 30, A.out, D_MODEL};
                pg8::gemm_phase<pg8::EpiResF32, pg8::StaticOrder, true, true>(F.lds, g, S, E);
                SEAM(pb + 2); }
        }
        {
            const int pb = pl + 3 * PH_A + 1 + 3;
            if (IN(pb + 0)) { Frame Fp = fresh(F); ph_norm(Fp, A.out, A.in[24] + (size_t)layer * D_MODEL, HALL, NTOK);
                ph_pcvt(Fp, A.in[2] + (size_t)layer * 32768 * PLE_DIM, A.in[3] + (size_t)layer * CH_TOK * PLE_DIM, P16); SEAM(pb + 0); }
            if (IN(pb + 1)) {
                int kpp = PLE_DIM; asm volatile("" : "+s"(kpp));
                pg8::Gemm g{P16, (const bf16*)(wl + WL_PP), kpp, kpp, kpp, 0, 0, 0, 0}; pg8::StaticOrder S; S.init(NTOK, D_MODEL, F.G, (int)blockIdx.x);
#if MK_BLK_PP
                pg8::EpiStoreBlk32 E{PP, D_MODEL / 32};
                pg8::gemm_phase<pg8::EpiStoreBlk32, pg8::StaticOrder, true, true>(F.lds, g, S, E);
#else
                pg8::EpiStoreBf16 E{PP, D_MODEL};
                pg8::gemm_phase<pg8::EpiStoreBf16, pg8::StaticOrder, true, true>(F.lds, g, S, E);
#endif
                SEAM(pb + 1); }
            if (IN(pb + 2)) {
                pg8::Gemm g{HALL, (const bf16*)(wl + WL_PG), D_MODEL, D_MODEL, D_MODEL, 0, 0, 0, MK_STAG}; pg8::StaticOrder S; S.init(NTOK, D_MODEL, F.G, (int)blockIdx.x);
                pg8::EpiPle E{A.out, A.out, D_MODEL, PP, D_MODEL};
                pg8::gemm_phase<pg8::EpiPle, pg8::StaticOrder, true, true>(F.lds, g, S, E);
                SEAM(pb + 2); }
        }
    }
#undef IN
#undef SEAM
}

#ifndef MK_PER_PHASE
#define MK_PER_PHASE 0
#endif
extern "C" void kernel_launch(void* const* d_in, const int* in_sizes, int n_in, void* d_out, int out_size, void* d_ws, size_t ws_size, hipStream_t stream) {
    static int grid = 0;
    if (grid == 0) {
        if (n_in != 27 || out_size != NTOK * D_MODEL || ws_size < WS_END) { fprintf(stderr, "kernel_launch: unexpected shapes (n_in %d, out %d, ws %zu); nothing launched\n", n_in, out_size, ws_size); grid = -1; return; }
        int dev = 0, cus = 0, per_cu = 0;
        if (hipGetDevice(&dev) != hipSuccess || hipDeviceGetAttribute(&cus, hipDeviceAttributeMultiprocessorCount, dev) != hipSuccess) { grid = -1; return; }
        if (hipFuncSetAttribute((const void*)fwd_kernel, hipFuncAttributeMaxDynamicSharedMemorySize, LDS_BYTES) != hipSuccess) { fprintf(stderr, "kernel_launch: hipFuncSetAttribute failed\n"); grid = -1; return; }
        if (hipOccupancyMaxActiveBlocksPerMultiprocessor(&per_cu, (const void*)fwd_kernel, NWAVES * 64, LDS_BYTES) != hipSuccess || per_cu < 1)
            fprintf(stderr, "kernel_launch: occupancy query reports %d workgroups per CU\n", per_cu);
        (void)hipGetLastError();
        grid = cus;
    }
    if (grid < 0) return;
    (void)in_sizes;
    if (hipMemsetAsync((char*)d_ws + WS_CTL, 0, CTL_ZERO_BYTES, stream) != hipSuccess) return;
    Args a{};
    for (int i = 0; i < 27; ++i) a.in[i] = (const float*)d_in[i];
    a.out = (float*)d_out; a.ws = (unsigned char*)d_ws;
#if MK_PER_PHASE
    for (int p = 0; p < N_PHASES; ++p) { a.ph_lo = p; a.ph_hi = p + 1; hipLaunchKernelGGL(fwd_kernel, dim3(grid), dim3(NWAVES * 64), LDS_BYTES, stream, a); }
#else
    a.ph_lo = 0; a.ph_hi = N_PHASES;
    hipLaunchKernelGGL(fwd_kernel, dim3(grid), dim3(NWAVES * 64), LDS_BYTES, stream, a);
#endif
}
```

```cpp
#include <hip/hip_runtime.h>
#include <cstdio>
#include <cstdint>

namespace pg8 {
#define PG8_LAS __attribute__((address_space(3)))
typedef unsigned short bf16_t;
typedef short bf16x8 __attribute__((ext_vector_type(8)));
typedef float f32x4 __attribute__((ext_vector_type(4)));
typedef float f32x2 __attribute__((ext_vector_type(2)));
typedef unsigned u32x4 __attribute__((ext_vector_type(4)));
typedef unsigned u32x2 __attribute__((ext_vector_type(2)));
constexpr int BM = 256, BK = 64, HALF = 128, HTB = HALF * BK * 2  , STAGE_BYTES = 8 * HTB, NXCD = 8, WGM = 8;

__host__ __device__ __forceinline__ int lds_byte(int r, int c) { const int st = (r >> 4) * 2 + (c >> 5), rr = r & 15, cc = c & 31, ob = rr * 64 + cc * 2; return st * 1024 + (ob ^ (((ob >> 9) & 1) << 5)); }
__host__ __device__ __forceinline__ void stage_rc(int b, int& R, int& C) { const int st = b / 1024, sb = b % 1024, swz = sb ^ (((sb >> 9) & 1) << 5); R = (st >> 1) * 16 + swz / 64; C = (st & 1) * 32 + (swz % 64) / 2; }
__host__ __device__ __forceinline__ int perm32(int rho) { const int n = rho >> 4, i = rho & 15; return 8 * (i >> 2) + 4 * n + (i & 3); }

struct Unit { int pm, pn; };
struct Gemm { const bf16_t* A; const bf16_t* Bt; int lda, ldb, K, agrp_shift, agrp_stride, bmode, stagger, ablk; };
#ifndef MK_PF
#define MK_PF 0
#endif
#ifndef MK_BLK_W
#define MK_BLK_W 0
#endif
#ifndef MK_BLK_PP
#define MK_BLK_PP 1
#endif
#ifndef MK_BLK_MG
#define MK_BLK_MG 1
#endif
#ifndef MK_BLK_MID
#define MK_BLK_MID 1
#endif

__device__ __forceinline__ void tile_of(int wgid, int nwg, int nM, int nN, int& pm, int& pn) {
    { const int q = nwg / NXCD, r = nwg % NXCD, xcd = wgid % NXCD, off = wgid / NXCD; wgid = (xcd < r ? xcd * (q + 1) : r * (q + 1) + (xcd - r) * q) + off; }
    const int nig = WGM * nN, gid = wgid / nig, fm = gid * WGM, gsz = (nM - fm) < WGM ? (nM - fm) : WGM;
    pm = fm + ((wgid % nig) % gsz); pn = (wgid % nig) / gsz;
}
struct StaticOrder {
    int nM, nN, nwg, G, c;
    __device__ __forceinline__ void init(int M, int N, int G_, int c_) { nM = M / BM; nN = N / BM; nwg = nM * nN; G = G_; c = c_; }
    __device__ __forceinline__ bool next(int i, Unit& u) const {
        const long L = (long)i * G + c; if (L >= nwg) return false;
        tile_of((int)L, nwg, nM, nN, u.pm, u.pn); return true;
    }
};
struct MergeOrder {
    int nM, ntile, G, c;
    __device__ __forceinline__ void init(int M, int G_, int c_) { nM = M / BM; ntile = nM * 16; G = G_; c = c_; }
    __device__ __forceinline__ bool next(int i, Unit& u) const {
        const long L = (long)(i >> 1) * G + c; if (L >= ntile) return false;
        int pm, ct; tile_of((int)L, ntile, nM, 16, pm, ct); u.pm = pm; u.pn = (i & 1) * 16 + ct; return true;
    }
};

typedef __bf16 bf16x2_t __attribute__((ext_vector_type(2)));
__device__ __forceinline__ unsigned cvt_pk_bf16(float lo, float hi) { const f32x2 v = {lo, hi}; return __builtin_bit_cast(unsigned, __builtin_convertvector(v, bf16x2_t)); }
__device__ __forceinline__ float bf_lo(unsigned w) { return __uint_as_float(w << 16); }
__device__ __forceinline__ float bf_hi(unsigned w) { return __uint_as_float(w & 0xffff0000u); }
__device__ __forceinline__ float sigmoidf_fast(float x) { return __builtin_amdgcn_rcpf(1.0f + __expf(-x)); }

__device__ __forceinline__ void st16(void* p, u32x4 v) { *(u32x4*)p = v; }
struct EpiStoreBf16 {
    static constexpr bool PERM = true; static constexpr int PF = 0;
    bf16_t* O; int ldc;
    __device__ __forceinline__ void operator()(const f32x4 (&acc)[2][2][4][2], const Unit& u, int wr, int wc, int fr, int fq) const {
        const int row0 = u.pm * BM + wr * 64 + fr, col0 = u.pn * BM + wc * 32 + 8 * fq;
#pragma unroll
        for (int ai = 0; ai < 2; ++ai)
#pragma unroll
            for (int m = 0; m < 4; ++m) { bf16_t* rowp = O + (size_t)(row0 + ai * HALF + m * 16) * ldc + col0;
#pragma unroll
                for (int bj = 0; bj < 2; ++bj) { const f32x4 v0 = acc[ai][bj][m][0], v1 = acc[ai][bj][m][1];
                    u32x4 w; w.x = cvt_pk_bf16(v0[0], v0[1]); w.y = cvt_pk_bf16(v0[2], v0[3]); w.z = cvt_pk_bf16(v1[0], v1[1]); w.w = cvt_pk_bf16(v1[2], v1[3]);
                    st16(rowp + bj * HALF, w); } }
    }
};
struct EpiStoreBlk {
    static constexpr bool PERM = true; static constexpr int PF = 0;
    bf16_t* O;
    __device__ __forceinline__ void operator()(const f32x4 (&acc)[2][2][4][2], const Unit& u, int wr, int wc, int fr, int fq) const {
        bf16_t* base = O + ((size_t)(u.pm * 16 + wr * 4) * 512 + (u.pn * 16 + wc * 2 + (fq >> 1))) * 256 + fr * 16 + (fq & 1) * 8;
#pragma unroll
        for (int ai = 0; ai < 2; ++ai)
#pragma unroll
            for (int m = 0; m < 4; ++m) { bf16_t* rowp = base + (size_t)(ai * 8 + m) * 512 * 256;
#pragma unroll
                for (int bj = 0; bj < 2; ++bj) { const f32x4 v0 = acc[ai][bj][m][0], v1 = acc[ai][bj][m][1];
                    u32x4 w; w.x = cvt_pk_bf16(v0[0], v0[1]); w.y = cvt_pk_bf16(v0[2], v0[3]); w.z = cvt_pk_bf16(v1[0], v1[1]); w.w = cvt_pk_bf16(v1[2], v1[3]);
                    st16(rowp + bj * 8 * 256, w); } }
    }
};
struct EpiStoreBlk32 {
    static constexpr bool PERM = true; static constexpr int PF = 0;
    bf16_t* O; int nbc;
    __device__ __forceinline__ void operator()(const f32x4 (&acc)[2][2][4][2], const Unit& u, int wr, int wc, int fr, int fq) const {
        bf16_t* base = O + ((size_t)(u.pm * 16 + wr * 4) * nbc + (u.pn * 8 + wc)) * 512 + fr * 32 + fq * 8;
#pragma unroll
        for (int ai = 0; ai < 2; ++ai)
#pragma unroll
            for (int m = 0; m < 4; ++m) { bf16_t* rowp = base + (size_t)(ai * 8 + m) * nbc * 512;
#pragma unroll
                for (int bj = 0; bj < 2; ++bj) { const f32x4 v0 = acc[ai][bj][m][0], v1 = acc[ai][bj][m][1];
                    u32x4 w; w.x = cvt_pk_bf16(v0[0], v0[1]); w.y = cvt_pk_bf16(v0[2], v0[3]); w.z = cvt_pk_bf16(v1[0], v1[1]); w.w = cvt_pk_bf16(v1[2], v1[3]);
                    st16(rowp + bj * 4 * 512, w); } }
    }
};
struct EpiGlu {
    static constexpr bool PERM = true; static constexpr int PF = 0;
    const bf16_t* Y1; int ld1; bf16_t* O; int ldc;
    __device__ __forceinline__ void operator()(const f32x4 (&acc)[2][2][4][2], const Unit& u, int wr, int wc, int fr, int fq) const {
        const int row0 = u.pm * BM + wr * 64 + fr, col0 = u.pn * BM + wc * 32 + 8 * fq;
        u32x4 y[2][4][2];
#pragma unroll
        for (int ai = 0; ai < 2; ++ai)
#pragma unroll
            for (int m = 0; m < 4; ++m)
#pragma unroll
                for (int bj = 0; bj < 2; ++bj) y[ai][m][bj] = *(const u32x4*)(Y1 + (size_t)(row0 + ai * HALF + m * 16) * ld1 + col0 + bj * HALF);
#pragma unroll
        for (int ai = 0; ai < 2; ++ai)
#pragma unroll
            for (int m = 0; m < 4; ++m) { const size_t r = (size_t)(row0 + ai * HALF + m * 16);
#pragma unroll
                for (int bj = 0; bj < 2; ++bj) { const f32x4 v0 = acc[ai][bj][m][0], v1 = acc[ai][bj][m][1]; const u32x4 yy = y[ai][m][bj];
                    u32x4 w;
                    w.x = cvt_pk_bf16(bf_lo(yy.x) * sigmoidf_fast(v0[0]), bf_hi(yy.x) * sigmoidf_fast(v0[1]));
                    w.y = cvt_pk_bf16(bf_lo(yy.y) * sigmoidf_fast(v0[2]), bf_hi(yy.y) * sigmoidf_fast(v0[3]));
                    w.z = cvt_pk_bf16(bf_lo(yy.z) * sigmoidf_fast(v1[0]), bf_hi(yy.z) * sigmoidf_fast(v1[1]));
                    w.w = cvt_pk_bf16(bf_lo(yy.w) * sigmoidf_fast(v1[2]), bf_hi(yy.w) * sigmoidf_fast(v1[3]));
                    *(u32x4*)(O + r * ldc + col0 + bj * HALF) = w; } }
    }
};
struct EpiMerge {
    static constexpr bool PERM = true; static constexpr int PF = 0;
    const bf16_t* P; bf16_t* MG;
    __device__ __forceinline__ void operator()(const f32x4 (&acc)[2][2][4][2], const Unit& u, int wr, int wc, int fr, int fq) const {
        const int row0 = u.pm * BM + wr * 64 + fr, c = u.pn * 64 + wc * 16 + 4 * fq;
        const bf16_t* Pb = P + ((size_t)(u.pm * 16 + wr * 4) * 512 + (u.pn * 4 + wc)) * 256 + fr * 16 + 4 * fq;
        u32x2 p[2][4][4];
#pragma unroll
        for (int ai = 0; ai < 2; ++ai)
#pragma unroll
            for (int m = 0; m < 4; ++m)
#pragma unroll
                for (int kb = 0; kb < 4; ++kb) p[ai][m][kb] = *(const u32x2*)(Pb + ((size_t)(ai * 8 + m) * 512 + kb * 128) * 256);
#pragma unroll
        for (int ai = 0; ai < 2; ++ai) {
#pragma unroll
            for (int m = 0; m < 4; ++m) { const size_t r = (size_t)(row0 + ai * HALF + m * 16);
                f32x4 t = (f32x4){0.f, 0.f, 0.f, 0.f};
#pragma unroll
                for (int kb = 0; kb < 4; ++kb) { const f32x4 a = acc[ai][kb >> 1][m][kb & 1]; const u32x2 q = p[ai][m][kb];
                    t[0] += bf_lo(q.x) * sigmoidf_fast(a[0]); t[1] += bf_hi(q.x) * sigmoidf_fast(a[1]); t[2] += bf_lo(q.y) * sigmoidf_fast(a[2]); t[3] += bf_hi(q.y) * sigmoidf_fast(a[3]); }
                u32x2 w; w.x = cvt_pk_bf16(t[0], t[1]); w.y = cvt_pk_bf16(t[2], t[3]);
                if (MK_BLK_MG) *(u32x2*)(MG + ((size_t)(u.pm * 16 + wr * 4 + ai * 8 + m) * 128 + (u.pn * 4 + wc)) * 256 + fr * 16 + 4 * fq) = w;
                else *(u32x2*)(MG + r * 2048 + c) = w; }
        }
    }
};
struct EpiResF32 {
    static constexpr bool PERM = true;
    static constexpr int PF = MK_PF;
    const float* base; const float* base2; int split_row; float* out; int ldc;
    __device__ __forceinline__ void prefetch(const Unit& u, int tid, int q, PG8_LAS unsigned* dummy) const {
        const float* bp = (u.pm * BM >= split_row) ? base2 - (size_t)split_row * ldc : base;
        __builtin_amdgcn_global_load_lds((const unsigned*)(bp + (size_t)(u.pm * BM + q * 64 + (tid >> 3)) * ldc + u.pn * BM + (tid & 7) * 32), dummy, 4, 0, 0);
    }
    __device__ __forceinline__ void operator()(const f32x4 (&acc)[2][2][4][2], const Unit& u, int wr, int wc, int fr, int fq) const {
        const int row0 = u.pm * BM + wr * 64 + fr, col0 = u.pn * BM + wc * 32 + 8 * fq;
        const float* bp = (u.pm * BM >= split_row) ? base2 - (size_t)split_row * ldc : base;
        f32x4 bs[4][2][2][2];
#define PG8_RES_PTR(p_, k_, mm_, bj_, n_) ((p_) + (size_t)(row0 + ((k_) >> 1) * HALF + (2 * ((k_) & 1) + (mm_)) * 16) * ldc + col0 + (bj_) * HALF + (n_) * 4)
#define PG8_RES_LD(k_) do { _Pragma("unroll") for (int mm = 0; mm < 2; ++mm) _Pragma("unroll") for (int bj = 0; bj < 2; ++bj) _Pragma("unroll") for (int n = 0; n < 2; ++n) \
            bs[k_][mm][bj][n] = *(const f32x4*)PG8_RES_PTR(bp, k_, mm, bj, n); } while (0)
        PG8_RES_LD(0); PG8_RES_LD(1);
#pragma unroll
        for (int k = 0; k < 4; ++k) {
#pragma unroll
            for (int mm = 0; mm < 2; ++mm)
#pragma unroll
                for (int bj = 0; bj < 2; ++bj)
#pragma unroll
                    for (int n = 0; n < 2; ++n) *(f32x4*)PG8_RES_PTR(out, k, mm, bj, n) = bs[k][mm][bj][n] + acc[k >> 1][bj][2 * (k & 1) + mm][n];
            if (k == 0) PG8_RES_LD(2);
            if (k == 1) PG8_RES_LD(3);
        }
#undef PG8_RES_LD
#undef PG8_RES_PTR
    }
};
struct EpiSwiglu {
    static constexpr bool PERM = true; static constexpr int PF = 0;
    bf16_t* O; int ldc;
    __device__ __forceinline__ void operator()(const f32x4 (&acc)[2][2][4][2], const Unit& u, int wr, int wc, int fr, int fq) const {
        const int row0 = u.pm * BM + wr * 64 + fr, col0 = u.pn * HALF + wc * 32 + 8 * fq;
#pragma unroll
        for (int ai = 0; ai < 2; ++ai)
#pragma unroll
            for (int m = 0; m < 4; ++m) {
                f32x4 t[2];
#pragma unroll
                for (int n = 0; n < 2; ++n)
#pragma unroll
                    for (int j = 0; j < 4; ++j) { const float a = acc[ai][0][m][n][j], b = acc[ai][1][m][n][j]; t[n][j] = a * sigmoidf_fast(a) * b; }
                u32x4 w; w.x = cvt_pk_bf16(t[0][0], t[0][1]); w.y = cvt_pk_bf16(t[0][2], t[0][3]); w.z = cvt_pk_bf16(t[1][0], t[1][1]); w.w = cvt_pk_bf16(t[1][2], t[1][3]);
                if (MK_BLK_MID) st16(O + ((size_t)(u.pm * 16 + wr * 4 + ai * 8 + m) * (ldc >> 5) + (u.pn * 4 + wc)) * 512 + fr * 32 + fq * 8, w);
                else st16(O + (size_t)(row0 + ai * HALF + m * 16) * ldc + col0, w); }
    }
};
struct EpiPle {
    static constexpr bool PERM = true; static constexpr int PF = MK_PF;
    const float* base; float* out; int ldc; const bf16_t* PP; int ldp;
    __device__ __forceinline__ void prefetch(const Unit& u, int tid, int q, PG8_LAS unsigned* dummy) const {
        __builtin_amdgcn_global_load_lds((const unsigned*)(base + (size_t)(u.pm * BM + q * 64 + (tid >> 3)) * ldc + u.pn * BM + (tid & 7) * 32), dummy, 4, 0, 0);
        if (MK_BLK_PP && q < 2) { const int L = q * 512 + tid;
            __builtin_amdgcn_global_load_lds((const unsigned*)(PP + ((size_t)(u.pm * 16 + (L >> 6)) * (ldp >> 5) + u.pn * 8) * 512 + (L & 63) * 64), dummy, 4, 0, 0); }
    }
    __device__ __forceinline__ void operator()(const f32x4 (&acc)[2][2][4][2], const Unit& u, int wr, int wc, int fr, int fq) const {
        const int row0 = u.pm * BM + wr * 64 + fr, col0 = u.pn * BM + wc * 32 + 8 * fq;
#pragma unroll
        for (int ai = 0; ai < 2; ++ai)
#pragma unroll
            for (int mh = 0; mh < 2; ++mh) {
                f32x4 b0[2][2], b1[2][2]; u32x4 pp[2][2];
#pragma unroll
                for (int mm = 0; mm < 2; ++mm)
#pragma unroll
                    for (int bj = 0; bj < 2; ++bj) { const size_t r = (size_t)(row0 + ai * HALF + (2 * mh + mm) * 16); const int c = col0 + bj * HALF;
                        b0[mm][bj] = *(const f32x4*)(base + r * ldc + c); b1[mm][bj] = *(const f32x4*)(base + r * ldc + c + 4); pp[mm][bj] = MK_BLK_PP ? *(const u32x4*)(PP + ((size_t)(u.pm * 16 + wr * 4 + ai * 8 + 2 * mh + mm) * (ldp >> 5) + (u.pn * 8 + bj * 4 + wc)) * 512 + fr * 32 + fq * 8) : *(const u32x4*)(PP + r * ldp + c); }
#pragma unroll
                for (int mm = 0; mm < 2; ++mm)
#pragma unroll
                    for (int bj = 0; bj < 2; ++bj) { const int m = 2 * mh + mm; const size_t r = (size_t)(row0 + ai * HALF + m * 16); const int c = col0 + bj * HALF;
                        const f32x4 a0 = acc[ai][bj][m][0], a1 = acc[ai][bj][m][1]; const u32x4 p = pp[mm][bj];
                        f32x4 o0 = b0[mm][bj], o1 = b1[mm][bj];
                        o0[0] += sigmoidf_fast(a0[0]) * bf_lo(p.x); o0[1] += sigmoidf_fast(a0[1]) * bf_hi(p.x); o0[2] += sigmoidf_fast(a0[2]) * bf_lo(p.y); o0[3] += sigmoidf_fast(a0[3]) * bf_hi(p.y);
                        o1[0] += sigmoidf_fast(a1[0]) * bf_lo(p.z); o1[1] += sigmoidf_fast(a1[1]) * bf_hi(p.z); o1[2] += sigmoidf_fast(a1[2]) * bf_lo(p.w); o1[3] += sigmoidf_fast(a1[3]) * bf_hi(p.w);
                        *(f32x4*)(out + r * ldc + c) = o0; *(f32x4*)(out + r * ldc + c + 4) = o1; }
            }
    }
};
template <class Epi, class Sched, bool ALIGN_EPI = false, bool SP2 = false>
__device__ __forceinline__ void gemm_phase(PG8_LAS unsigned char* lds, const Gemm g, const Sched& S, const Epi& E) {
    int tid_ = threadIdx.x; asm volatile("" : "+v"(tid_));
    const int tid = tid_, wid = __builtin_amdgcn_readfirstlane(tid >> 6), lane = tid & 63, wr = wid >> 2, wc = wid & 3, fr = lane & 15, fq = lane >> 4;
    const int K = g.K, nt = K / BK, lda = g.lda, ldb = g.ldb;
    unsigned voffA[2], voffB[2];
#pragma unroll
    for (int i = 0; i < 2; ++i) { int R, C; stage_rc(tid * 16 + i * 8192, R, C); const int Rb = Epi::PERM ? ((R & ~31) + perm32(R & 31)) : R;
        const int Rg = (g.bmode == 2) ? (((Rb >> 2) & 1) * 2048 + 16 * (Rb >> 5) + 4 * ((Rb >> 3) & 3) + (Rb & 3)) : Rb;
        voffA[i] = g.ablk ? (unsigned)(((((R >> 4) * (K >> g.ablk) + (C >> g.ablk)) * 16 + (R & 15)) << g.ablk) + (C & ((1 << g.ablk) - 1))) * 2u : (unsigned)(R * lda + C) * 2u; voffB[i] = MK_BLK_W ? (unsigned)((((((Rg >> 4) * (K >> 5) + (C >> 5)) * 16 + (Rg & 15)) << 5) + (C & 31)) * 2) : (unsigned)(Rg * ldb + C) * 2u; }
    const size_t kstep = (size_t)(BK * 2);
    const size_t kstepB = MK_BLK_W ? (size_t)(BK * 32) : kstep;
    const size_t kstepA = g.ablk ? (size_t)(BK * 32) : kstep;
    const size_t hstepA = (size_t)HALF * lda * 2, hstepB = (size_t)(g.bmode == 2 ? 4096 : (g.bmode ? 2048 : HALF)) * ldb * 2;
    const size_t tstepA = 2 * hstepA, tstepB = (size_t)BM * ldb * 2;
#define PG8_ABASE(u) ((const char*)g.A + (size_t)(u).pm * tstepA + (size_t)((u).pn >> g.agrp_shift) * (size_t)g.agrp_stride * 2)
#define PG8_BBASE(u) ((const char*)g.Bt + (g.bmode == 2 ? (size_t)((u).pn * 64) * ldb * 2 : (g.bmode ? (size_t)(((u).pn >> 4) * 4096 + ((u).pn & 15) * HALF) * ldb * 2 : (size_t)(u).pn * tstepB)))
    const unsigned ldsw = (unsigned)wid * 1024u;
    const int aoff = lds_byte(wr * 64 + fr, fq * 8), boff = lds_byte(wc * 32 + fr, fq * 8);
#define PG8_SA(b, h) (((b) * 2 + (h)) * HTB)
#define PG8_SB(b, h) ((4 + (b) * 2 + (h)) * HTB)
#define PG8_STAGE(bufoff, gbase, voff) do { _Pragma("unroll") for (int _i = 0; _i < 2; ++_i) \
        __builtin_amdgcn_global_load_lds((const unsigned*)((const char*)(gbase) + (voff)[_i]), (PG8_LAS unsigned*)(lds + (bufoff) + ldsw + _i * 8192), 16, 0, 0); } while (0)
#define PG8_LDA(dst, b, h) do { _Pragma("unroll") for (int m = 0; m < 4; ++m) _Pragma("unroll") for (int k = 0; k < 2; ++k) dst[m][k] = *(const PG8_LAS bf16x8*)(lds + PG8_SA(b, h) + aoff + m * 2048 + k * 1024); } while (0)
#define PG8_LDB(dst, b, h) do { _Pragma("unroll") for (int n = 0; n < 2; ++n) _Pragma("unroll") for (int k = 0; k < 2; ++k) dst[n][k] = *(const PG8_LAS bf16x8*)(lds + PG8_SB(b, h) + boff + n * 2048 + k * 1024); } while (0)
#define PG8_MMA(ai, bj, At, Bt) do { __builtin_amdgcn_s_setprio(1); _Pragma("unroll") for (int m = 0; m < 4; ++m) _Pragma("unroll") for (int n = 0; n < 2; ++n) _Pragma("unroll") for (int k = 0; k < 2; ++k) \
        acc[ai][bj][m][n] = __builtin_amdgcn_mfma_f32_16x16x32_bf16(Bt[n][k], At[m][k], acc[ai][bj][m][n], 0, 0, 0); __builtin_amdgcn_s_setprio(0); } while (0)
#define PG8_WAIT_V(n) asm volatile("s_waitcnt vmcnt(" #n ")" ::: "memory")
#define PG8_WAIT_L(n) asm volatile("s_waitcnt lgkmcnt(" #n ")" ::: "memory")
#define PG8_BAR __builtin_amdgcn_s_barrier()
#define PG8_SCHED __builtin_amdgcn_sched_barrier(0)
    Unit cur, nxt; int ui = 0;
    if (!S.next(0, cur)) return;
    if (g.stagger) { const unsigned long long t0_ = __builtin_amdgcn_s_memrealtime(), d_ = (unsigned long long)(((blockIdx.x >> 3) & 7) * g.stagger);
        while (__builtin_amdgcn_s_memrealtime() - t0_ < d_) __builtin_amdgcn_s_sleep(8); }
    f32x4 acc[2][2][4][2];
#pragma unroll
    for (int a = 0; a < 2; ++a)
#pragma unroll
        for (int b = 0; b < 2; ++b)
#pragma unroll
            for (int m = 0; m < 4; ++m)
#pragma unroll
                for (int n = 0; n < 2; ++n) acc[a][b][m][n] = (f32x4){0.f, 0.f, 0.f, 0.f};
    bf16x8 At[4][2], B0[2][2], B1[2][2];
    const char* cA = PG8_ABASE(cur); const char* cB = PG8_BBASE(cur);
    if constexpr (SP2) {
        PG8_STAGE(PG8_SB(0, 0), cB, voffB); PG8_STAGE(PG8_SB(0, 1), cB + hstepB, voffB); PG8_STAGE(PG8_SA(0, 0), cA, voffA); PG8_STAGE(PG8_SA(0, 1), cA + hstepA, voffA);
        if (wr == 1) PG8_BAR;
        PG8_WAIT_V(2); PG8_BAR;
        PG8_STAGE(PG8_SB(1, 0), cB + kstepB, voffB); PG8_STAGE(PG8_SA(1, 0), cA + kstepA, voffA); PG8_STAGE(PG8_SB(1, 1), cB + hstepB + kstepB, voffB);
        PG8_WAIT_V(6); PG8_BAR;
    } else {
        PG8_STAGE(PG8_SB(0, 0), cB, voffB); PG8_STAGE(PG8_SA(0, 0), cA, voffA); PG8_STAGE(PG8_SB(0, 1), cB + hstepB, voffB); PG8_STAGE(PG8_SA(0, 1), cA + hstepA, voffA);
        if (wr == 1) PG8_BAR;
        PG8_WAIT_V(4); PG8_BAR;
        PG8_STAGE(PG8_SB(1, 0), cB + kstepB, voffB); PG8_STAGE(PG8_SA(1, 0), cA + kstepA, voffA); PG8_STAGE(PG8_SB(1, 1), cB + hstepB + kstepB, voffB);
        PG8_WAIT_V(6); PG8_BAR;
    }
    for (;;) {
        const bool has_next = S.next(ui + 1, nxt);
        const char* nA = has_next ? PG8_ABASE(nxt) : cA; const char* nB = has_next ? PG8_BBASE(nxt) : cB;
        for (int t = 0; t < nt; t += 2) {
            const bool last = (t == nt - 2);
            if constexpr (Epi::PF != 0) { if ((t & 7) == 4 && t < 32) E.prefetch(cur, tid, t >> 3, (PG8_LAS unsigned*)(lds + 8 * HTB + wid * 256)); }
            const char* a1 = cA + (size_t)(t + 1) * kstepA;
            const char* a2 = last ? nA : cA + (size_t)(t + 2) * kstepA; const char* b2 = last ? nB : cB + (size_t)(t + 2) * kstepB;
            const char* a3 = a2 + kstepA; const char* b3 = b2 + kstepB;
            if constexpr (SP2) {
            PG8_LDB(B0, 0, 0); PG8_LDB(B1, 0, 1); PG8_SCHED; PG8_LDA(At, 0, 0); PG8_STAGE(PG8_SA(1, 1), a1 + hstepA, voffA);
            PG8_WAIT_V(8); PG8_WAIT_L(0); PG8_BAR; PG8_MMA(0, 0, At, B0); PG8_MMA(0, 1, At, B1); PG8_BAR; PG8_SCHED;
            PG8_LDA(At, 0, 1); PG8_STAGE(PG8_SB(0, 0), b2, voffB); PG8_STAGE(PG8_SB(0, 1), b2 + hstepB, voffB); PG8_STAGE(PG8_SA(0, 0), a2, voffA);
            PG8_WAIT_V(8); PG8_WAIT_L(0); PG8_BAR; PG8_MMA(1, 0, At, B0); PG8_MMA(1, 1, At, B1); PG8_BAR; PG8_SCHED;
            PG8_LDB(B0, 1, 0); PG8_LDB(B1, 1, 1); PG8_SCHED; PG8_LDA(At, 1, 0); PG8_STAGE(PG8_SA(0, 1), a2 + hstepA, voffA);
            PG8_WAIT_V(8); PG8_WAIT_L(0); PG8_BAR; PG8_MMA(0, 0, At, B0); PG8_MMA(0, 1, At, B1); PG8_BAR; PG8_SCHED;
            PG8_LDA(At, 1, 1); PG8_STAGE(PG8_SB(1, 0), b3, voffB); PG8_STAGE(PG8_SB(1, 1), b3 + hstepB, voffB); PG8_STAGE(PG8_SA(1, 0), a3, voffA);
            PG8_WAIT_V(8); PG8_WAIT_L(0); PG8_BAR; PG8_MMA(1, 0, At, B0); PG8_MMA(1, 1, At, B1); PG8_BAR; PG8_SCHED;
            } else {
            PG8_LDB(B0, 0, 0); PG8_SCHED; PG8_LDA(At, 0, 0); PG8_STAGE(PG8_SA(1, 1), a1 + hstepA, voffA);
            PG8_WAIT_L(8); PG8_BAR; PG8_WAIT_L(0); PG8_MMA(0, 0, At, B0); PG8_BAR; PG8_SCHED;
            PG8_LDB(B1, 0, 1); PG8_STAGE(PG8_SB(0, 0), b2, voffB);
            PG8_BAR; PG8_WAIT_L(0); PG8_MMA(0, 1, At, B1); PG8_BAR;
            PG8_LDA(At, 0, 1); PG8_STAGE(PG8_SA(0, 0), a2, voffA);
            PG8_BAR; PG8_WAIT_L(0); PG8_MMA(1, 0, At, B0); PG8_BAR; PG8_SCHED;
            PG8_STAGE(PG8_SB(0, 1), b2 + hstepB, voffB);
            PG8_WAIT_V(6); PG8_BAR; PG8_MMA(1, 1, At, B1); PG8_BAR;
            PG8_LDB(B0, 1, 0); PG8_SCHED; PG8_LDA(At, 1, 0); PG8_STAGE(PG8_SA(0, 1), a2 + hstepA, voffA);
            PG8_WAIT_L(8); PG8_BAR; PG8_WAIT_L(0); PG8_MMA(0, 0, At, B0); PG8_BAR; PG8_SCHED;
            PG8_LDB(B1, 1, 1); PG8_STAGE(PG8_SB(1, 0), b3, voffB);
            PG8_BAR; PG8_WAIT_L(0); PG8_MMA(0, 1, At, B1); PG8_BAR;
            PG8_LDA(At, 1, 1); PG8_STAGE(PG8_SA(1, 0), a3, voffA);
            PG8_BAR; PG8_WAIT_L(0); PG8_MMA(1, 0, At, B0); PG8_BAR; PG8_SCHED;
            PG8_STAGE(PG8_SB(1, 1), b3 + hstepB, voffB);
            PG8_WAIT_V(6); PG8_BAR; PG8_MMA(1, 1, At, B1); PG8_BAR;
            }
        }
        if constexpr (ALIGN_EPI) { if (wr == 0) PG8_BAR; }
        { E(acc, cur, wr, wc, fr, fq); }
        if (!has_next) break;
#pragma unroll
        for (int a = 0; a < 2; ++a)
#pragma unroll
            for (int b = 0; b < 2; ++b)
#pragma unroll
                for (int m = 0; m < 4; ++m)
#pragma unroll
                    for (int n = 0; n < 2; ++n) acc[a][b][m][n] = (f32x4){0.f, 0.f, 0.f, 0.f};
        cur = nxt; cA = nA; cB = nB; ++ui;
        if constexpr (ALIGN_EPI) { if (wr == 1) PG8_BAR; }
    }
    PG8_WAIT_V(0);
    if constexpr (!ALIGN_EPI) { if (wr == 0) PG8_BAR; }
    PG8_BAR;
#undef PG8_ABASE
#undef PG8_BBASE
#undef PG8_SA
#undef PG8_SB
#undef PG8_STAGE
#undef PG8_LDA
#undef PG8_LDB
#undef PG8_MMA
#undef PG8_WAIT_V
#undef PG8_WAIT_L
#undef PG8_BAR
#undef PG8_SCHED
}
}


constexpr int D_MODEL = 2048, NTOK = 49152, CH_TOK = 16384, N_CHUNK = 3, DEPTH = 2;
constexpr int MIX_IN = 4096, IN_COLS = 12288, D_FF = 5632, PLE_DIM = 256;
constexpr int ZC_UA = 0, ZC_BG = 512, ZC_CG = 1024, ZC_VB = 1536, ZC_Q = 2048, ZC_K = 2560, ZC_VC = 3072, ZC_UD = 3584;
constexpr float EPS = 1e-6f;
constexpr int NWAVES = 8;

constexpr size_t MiB = 1u << 20;
constexpr size_t WS_CTL = 0, CTL_ZERO_BYTES = 1 * MiB;
constexpr size_t WS_TAB = 1 * MiB;
constexpr size_t S5T_BYTES = 12800, S5T_BB = 0, S5T_C = 8192, S5T_AB = 12288;
constexpr size_t TAB_S5 = WS_TAB, TAB_C128 = WS_TAB + 2 * MiB, TAB_S128 = TAB_C128 + 32768, TAB_C32 = TAB_S128 + 32768, TAB_S32 = TAB_C32 + 2048;
constexpr size_t WS_W = 8 * MiB;
constexpr size_t WL_MIX = 0, WL_G = 16 * MiB, WL_GLU = 48 * MiB, WL_BR = WL_GLU + MiB / 2, WL_O = WL_BR + 8 * MiB, WL_FF = WL_O + 8 * MiB, WL_FF2 = WL_FF + 44 * MiB, WL_PG = WL_FF2 + 22 * MiB, WL_PP = WL_PG + 8 * MiB;
constexpr size_t WL_BYTES = WL_PP + 1 * MiB;
static_assert(WL_BYTES == 139 * MiB + MiB / 2, "weight map");
constexpr size_t WS_H = 288 * MiB;
constexpr size_t WS_Z = 352 * MiB;
constexpr size_t WS_YS = 480 * MiB;
constexpr size_t WS_HALL = 352 * MiB;
constexpr size_t WS_MG = 544 * MiB;
constexpr size_t WS_GT = 736 * MiB;
constexpr size_t WS_YF = WS_GT, WS_YB = WS_GT + 32 * MiB, WS_ZF = WS_GT + 64 * MiB, WS_Y1 = WS_GT + 96 * MiB, WS_S5E = WS_GT + 112 * MiB;
constexpr size_t WS_H2ALL = 288 * MiB, WS_MIDALL = 480 * MiB;
constexpr size_t WS_PP = WS_GT;
constexpr size_t WS_P16 = 992 * MiB;
constexpr size_t WS_END = 1016 * MiB;
static_assert(WS_MIDALL + 528 * MiB <= WS_END && WS_H2ALL + 192 * MiB <= WS_MIDALL, "ffn map");
static_assert(WS_W + 2 * WL_BYTES <= WS_H && WS_MG + 192 * MiB <= WS_GT && WS_GT + 256 * MiB <= WS_P16, "ws map");
constexpr int CW_BAR = 4096;

constexpr int LDS_SCRATCH = 151552;
constexpr int LDSCTL_OFF = LDS_SCRATCH;
constexpr int LDS_BYTES = LDS_SCRATCH + 256;

#define GAS __attribute__((address_space(1)))
#define LAS __attribute__((address_space(3)))
typedef unsigned short bf16;
typedef unsigned u32x4 __attribute__((ext_vector_type(4)));
typedef unsigned u32x2 __attribute__((ext_vector_type(2)));
typedef float f32x4 __attribute__((ext_vector_type(4)));
typedef float f32x2 __attribute__((ext_vector_type(2)));
typedef short bf16x8 __attribute__((ext_vector_type(8)));
#define LDS_WAIT() asm volatile("s_waitcnt lgkmcnt(0)" ::: "memory")
using pg8::cvt_pk_bf16; using pg8::bf_lo; using pg8::bf_hi;
__device__ __forceinline__ bf16x8 as_frag(u32x4 v) { return __builtin_bit_cast(bf16x8, v); }
__device__ __forceinline__ void mfma_acc(f32x4& acc, bf16x8 a, bf16x8 b) { asm volatile("s_nop 1\n\tv_mfma_f32_16x16x32_bf16 %0, %1, %2, %0" : "+v"(acc) : "v"(a), "v"(b)); }
__device__ __forceinline__ f32x4 mfma16(bf16x8 a, bf16x8 b, f32x4 c) { mfma_acc(c, a, b); return c; }
#define MFMA_DRAIN() do { __builtin_amdgcn_sched_barrier(0); asm volatile("s_nop 15\n\ts_nop 15" ::: "memory"); __builtin_amdgcn_sched_barrier(0); } while (0)
__device__ __forceinline__ float wave_sum(float v) {
#pragma unroll
    for (int o = 1; o < 64; o <<= 1) v += __shfl_xor(v, o);
    return v;
}
__device__ __forceinline__ unsigned short f2bf(float f) { return (unsigned short)(cvt_pk_bf16(f, 0.f) & 0xffffu); }

#define XB_TMO      128
#define XB_XCNT(j)  (256  + 64 * (j))
#define XB_XSUB(j)  (1280 + 64 * (j))
#define XB_XGEN(j)  (2304 + 64 * (j))
#define XB_TOP      3328
#define XB_TOPGEN   3392
#define XCD_BAR_WORDS 3456
#define XB_SPIN_CAP (1u << 22)
__device__ __forceinline__ unsigned xb_ld(unsigned* p)              { return __hip_atomic_load(p, __ATOMIC_RELAXED, __HIP_MEMORY_SCOPE_AGENT); }
__device__ __forceinline__ unsigned xb_add(unsigned* p, unsigned v) { return __hip_atomic_fetch_add(p, v, __ATOMIC_RELAXED, __HIP_MEMORY_SCOPE_AGENT); }
__device__ __forceinline__ unsigned xb_xcc_id() { return (unsigned)__builtin_amdgcn_s_getreg((3 << 11) | 20) & 0xFu; }
#define XB_SPIN(cond, bar) do { unsigned _sp = 0; while (cond) { __builtin_amdgcn_s_sleep(1); \
    if ((++_sp & 255u) == 0u) { if (xb_ld(&(bar)[XB_TMO])) break; if (_sp > XB_SPIN_CAP) { atomicAdd(&(bar)[XB_TMO], 1u); break; } } } } while (0)
struct XcdBarrier { unsigned* bar; unsigned x; volatile LAS unsigned* st; };
__device__ __forceinline__ XcdBarrier xcd_barrier_post(unsigned* bar, volatile LAS unsigned* st) {
    XcdBarrier b; b.bar = bar; b.x = xb_xcc_id(); b.st = st;
    if (threadIdx.x == 0) (void)xb_add(&bar[XB_XCNT(b.x)], 1u);
    return b;
}
__device__ __forceinline__ void xcd_barrier_complete(unsigned* bar, unsigned x, unsigned& nloc, unsigned& nx) {
    const unsigned G = gridDim.x * gridDim.y * gridDim.z;
    unsigned sum, cnt, mine, sp = 0u;
    for (;;) {
        sum = 0u; cnt = 0u; mine = 0u;
#pragma unroll
        for (unsigned j = 0; j < 16; ++j) { const unsigned c = xb_ld(&bar[XB_XCNT(j)]); sum += c; cnt += (c > 0u) ? 1u : 0u; mine = (j == x) ? c : mine; }
        if (sum == G) break;
        __builtin_amdgcn_s_sleep(1);
        if ((++sp & 255u) == 0u) { if (xb_ld(&bar[XB_TMO])) break; if (sp > XB_SPIN_CAP) { atomicAdd(&bar[XB_TMO], 1u); break; } }
    }
    nloc = mine > 0u ? mine : 1u; nx = cnt > 0u ? cnt : 1u;
}
__device__ __forceinline__ void xcd_barrier(const XcdBarrier& b) {
    asm volatile("s_waitcnt vmcnt(0)" ::: "memory");
    __syncthreads();
    if (threadIdx.x == 0) {
        unsigned* bar = b.bar;
        __builtin_amdgcn_s_waitcnt(0);
        unsigned nloc = b.st[0], nx = b.st[1];
        if (nloc == 0u) { xcd_barrier_complete(bar, b.x, nloc, nx); b.st[0] = nloc; b.st[1] = nx; }
        const unsigned old = xb_add(&bar[XB_XSUB(b.x)], 1u);
        const unsigned gen = old / nloc;
        if (old + 1u == (gen + 1u) * nloc) {
            __builtin_amdgcn_fence(__ATOMIC_RELEASE, "agent");
            asm volatile("s_waitcnt vmcnt(0)" ::: "memory");
            const unsigned og = xb_add(&bar[XB_TOP], 1u);
            const unsigned tg = og / nx;
            if (og + 1u == (tg + 1u) * nx) xb_add(&bar[XB_TOPGEN], 1u);
            else XB_SPIN(xb_ld(&bar[XB_TOPGEN]) == tg, bar);
            __builtin_amdgcn_fence(__ATOMIC_ACQUIRE, "agent");
            xb_add(&bar[XB_XGEN(b.x)], 1u);
            asm volatile("s_waitcnt vmcnt(0)" ::: "memory");
        } else {
            XB_SPIN(xb_ld(&bar[XB_XGEN(b.x)]) == gen, bar);
            __builtin_amdgcn_fence(__ATOMIC_ACQUIRE, "agent");
            asm volatile("s_waitcnt vmcnt(0)" ::: "memory");
        }
    }
    __syncthreads();
}

struct Frame {
    LAS unsigned char* lds;
    int tid, lane, wave;
    int vcu, G;
    unsigned char* ws;
};
struct Args { const float* in[27]; float* out; unsigned char* ws; int ph_lo, ph_hi; };
__device__ __forceinline__ Frame fresh(const Frame& F0) { Frame F = F0; int t = F0.tid; asm volatile("" : "+v"(t)); F.tid = t; F.lane = t & 63; F.wave = __builtin_amdgcn_readfirstlane(t >> 6); return F; }

__device__ __forceinline__ void transpose_item(const float* W, int K, int N, bf16* WT, int k0, int n0, int drow0, LAS float* scr, int lane) {
#pragma unroll 8
    for (int i = 0; i < 32; ++i) { const int kk = 2 * i + (lane >> 5); scr[kk * 33 + (lane & 31)] = W[(size_t)(k0 + kk) * N + n0 + (lane & 31)]; }
    LDS_WAIT(); asm volatile("" ::: "memory");
    const int c = lane & 7;
#pragma unroll
    for (int j = 0; j < 4; ++j) { const int n = (lane >> 3) + 8 * j; const LAS float* s = scr + (8 * c) * 33 + n;
        u32x4 o; o.x = cvt_pk_bf16(s[0 * 33], s[1 * 33]); o.y = cvt_pk_bf16(s[2 * 33], s[3 * 33]); o.z = cvt_pk_bf16(s[4 * 33], s[5 * 33]); o.w = cvt_pk_bf16(s[6 * 33], s[7 * 33]);
        if (MK_BLK_W) { const int dr = drow0 + n, kc = k0 + 8 * c; *(u32x4*)(WT + ((size_t)(dr >> 4) * (K >> 5) + (kc >> 5)) * 512 + (dr & 15) * 32 + (kc & 31)) = o; }
        else *(u32x4*)(WT + (size_t)(drow0 + n) * K + k0 + 8 * c) = o; }
    LDS_WAIT(); asm volatile("" ::: "memory");
}
__device__ __forceinline__ void conv_plain(const float* W, int K, int N, bf16* WT, int item, LAS float* scr, int lane) {
    const int nblk = N / 32, kb = item / nblk, nb = item % nblk;
    transpose_item(W, K, N, WT, 64 * kb, 32 * nb, 32 * nb, scr, lane);
}
__device__ __forceinline__ void ph_prologue(Frame& F, const Args& A) {
    LAS float* scr = (LAS float*)(F.lds + F.wave * 16384);
    const int gw = F.vcu * NWAVES + F.wave, NGW = F.G * NWAVES;
    constexpr int I_IN = (2048 / 64) * (IN_COLS / 32), I_GLU = (512 / 64) * (512 / 32), I_BR1 = (512 / 64) * (2048 / 32), I_BR = 4 * I_BR1, I_O = (2048 / 64) * (2048 / 32),
                  I_FF = (2048 / 64) * (2 * D_FF / 32), I_FF2 = (D_FF / 64) * (2048 / 32), I_PG = I_O, I_PP = (256 / 64) * (2048 / 32);
    constexpr int I_LAYER = I_IN + I_GLU + I_BR + I_O + I_FF + I_FF2 + I_PG + I_PP;
    for (int it = gw; it < DEPTH * I_LAYER; it += NGW) {
        const int l = it / I_LAYER; int r = it % I_LAYER;
        unsigned char* wl = F.ws + WS_W + (size_t)l * WL_BYTES;
        if (r < I_IN) {
            const float* W = A.in[5] + (size_t)l * 2048 * IN_COLS; const int nblk = IN_COLS / 32, kb = r / nblk, nb = r % nblk, n0 = 32 * nb;
            if (n0 < MIX_IN) transpose_item(W, 2048, IN_COLS, (bf16*)(wl + WL_MIX), 64 * kb, n0, n0, scr, F.lane);
            else transpose_item(W, 2048, IN_COLS, (bf16*)(wl + WL_G), 64 * kb, n0, n0 - MIX_IN, scr, F.lane);
            continue; } r -= I_IN;
        if (r < I_GLU) { conv_plain(A.in[14] + (size_t)l * 512 * 512, 512, 512, (bf16*)(wl + WL_GLU), r, scr, F.lane); continue; } r -= I_GLU;
        if (r < I_BR) { const int kb = r / I_BR1; conv_plain(A.in[19] + ((size_t)l * 4 + kb) * 512 * 2048, 512, 2048, (bf16*)(wl + WL_BR) + (size_t)kb * 2048 * 512, r % I_BR1, scr, F.lane); continue; } r -= I_BR;
        if (r < I_O) { conv_plain(A.in[20] + (size_t)l * 2048 * 2048, 2048, 2048, (bf16*)(wl + WL_O), r, scr, F.lane); continue; } r -= I_O;
        if (r < I_FF) {
            const float* W = A.in[22] + (size_t)l * 2048 * 2 * D_FF; const int nblk = 2 * D_FF / 32, kb = r / nblk, nb = r % nblk, n0 = 32 * nb;
            const int j = n0 / D_FF, rr = n0 % D_FF, pn = rr / 128, cc = rr % 128;
            transpose_item(W, 2048, 2 * D_FF, (bf16*)(wl + WL_FF), 64 * kb, n0, 256 * pn + 128 * j + cc, scr, F.lane);
            continue; } r -= I_FF;
        if (r < I_FF2) { conv_plain(A.in[23] + (size_t)l * D_FF * 2048, D_FF, 2048, (bf16*)(wl + WL_FF2), r, scr, F.lane); continue; } r -= I_FF2;
        if (r < I_PG) { conv_plain(A.in[25] + (size_t)l * 2048 * 2048, 2048, 2048, (bf16*)(wl + WL_PG), r, scr, F.lane); continue; } r -= I_PG;
        conv_plain(A.in[26] + (size_t)l * 256 * 2048, 256, 2048, (bf16*)(wl + WL_PP), r, scr, F.lane);
    }
    {
        const int gt = F.vcu * 512 + F.tid, NT = F.G * 512;
        bf16* c128 = (bf16*)(F.ws + TAB_C128); bf16* s128 = (bf16*)(F.ws + TAB_S128); bf16* c32 = (bf16*)(F.ws + TAB_C32); bf16* s32 = (bf16*)(F.ws + TAB_S32);
        for (int e = gt; e < 128 * 128 + 32 * 32; e += NT) {
            if (e < 128 * 128) { const int i = e >> 7, k = e & 127, m = (i * k) & 127; float sn, cs; sincospif((float)m * (1.0f / 64.0f), &sn, &cs);
                c128[e] = f2bf(cs * 0.08838834764831845f); s128[e] = f2bf(sn * 0.08838834764831845f); }
            else { const int e2 = e - 128 * 128, i = e2 >> 5, k = e2 & 31, m = (i * k) & 31; float sn, cs; sincospif((float)m * (1.0f / 16.0f), &sn, &cs);
                c32[e2] = f2bf(cs * 0.17677669529663687f); s32[e2] = f2bf(sn * 0.17677669529663687f); }
        }
    }
    for (int t = gw; t < DEPTH * 2 * 32; t += NGW) {
        const int g = t & 31, ld = t >> 5;
        unsigned char* tb = F.ws + TAB_S5 + (size_t)t * S5T_BYTES;
        const float* lam_re = A.in[6] + (size_t)t * 64; const float* lam_im = A.in[7] + (size_t)t * 64;
        const float dt = expf(A.in[8][t]);
        const float* b_re = A.in[9] + (size_t)t * 64 * 16; const float* b_im = A.in[10] + (size_t)t * 64 * 16;
        const float* c_re = A.in[11] + (size_t)t * 16 * 64; const float* c_im = A.in[12] + (size_t)t * 16 * 64;
        (void)g; (void)ld;
        const int lane = F.lane, l15 = lane & 15, g4 = lane >> 4;
        {
            const float lr = lam_re[lane], li = lam_im[lane], mag = expf(lr * dt); float sn, cs; sincosf(li * dt, &sn, &cs);
            f32x2 ab; ab.x = mag * cs; ab.y = mag * sn; ((f32x2*)(tb + S5T_AB))[lane] = ab;
        }
#pragma unroll 1
        for (int cb = 0; cb < 8; ++cb) {
            const int col = 16 * cb + l15, p = col >> 1, ri = col & 1;
            const float lr = lam_re[p], li = lam_im[p], mag = expf(lr * dt); float sn, cs; sincosf(li * dt, &sn, &cs);
            const float ar = mag * cs, ai = mag * sn, den = lr * lr + li * li;
            const float fr = ((ar - 1.0f) * lr + ai * li) / den, fi = (ai * lr - (ar - 1.0f) * li) / den;
            float v[8];
#pragma unroll
            for (int j = 0; j < 8; ++j) { const int h = 8 * g4 + j; float x = 0.f;
                if (h < 16) { const float br = b_re[p * 16 + h], bi = b_im[p * 16 + h]; x = ri ? (fr * bi + fi * br) : (fr * br - fi * bi); }
                v[j] = x; }
            u32x4 o; o.x = cvt_pk_bf16(v[0], v[1]); o.y = cvt_pk_bf16(v[2], v[3]); o.z = cvt_pk_bf16(v[4], v[5]); o.w = cvt_pk_bf16(v[6], v[7]);
            ((u32x4*)(tb + S5T_BB))[cb * 64 + lane] = o;
        }
#pragma unroll 1
        for (int ks = 0; ks < 4; ++ks) {
            float v[8];
#pragma unroll
            for (int j = 0; j < 8; ++j) { const int col = 32 * ks + 8 * g4 + j, p = col >> 1, ri = col & 1; v[j] = ri ? -c_im[l15 * 64 + p] : c_re[l15 * 64 + p]; }
            u32x4 o; o.x = cvt_pk_bf16(v[0], v[1]); o.y = cvt_pk_bf16(v[2], v[3]); o.z = cvt_pk_bf16(v[4], v[5]); o.w = cvt_pk_bf16(v[6], v[7]);
            ((u32x4*)(tb + S5T_C))[ks * 64 + lane] = o;
        }
    }
}

__device__ __forceinline__ void ph_norm(Frame& F, const float* xsrc, const float* gain, bf16* H, int nrows) {
    const int gw = F.vcu * NWAVES + F.wave, NGW = F.G * NWAVES;
    f32x4 gv[8];
#pragma unroll
    for (int j = 0; j < 8; ++j) gv[j] = ((const f32x4*)gain)[F.lane + 64 * j];
    for (int m = gw; m < nrows; m += NGW) {
        const f32x4* xr = (const f32x4*)(xsrc + (size_t)m * D_MODEL) + F.lane;
        f32x4 v[8]; float s = 0.f;
#pragma unroll
        for (int j = 0; j < 8; ++j) { v[j] = xr[64 * j]; s += (v[j][0] * v[j][0] + v[j][1] * v[j][1]) + (v[j][2] * v[j][2] + v[j][3] * v[j][3]); }
        const float rstd = rsqrtf(wave_sum(s) * (1.0f / D_MODEL) + EPS);
        u32x2* o = (u32x2*)(H + (size_t)m * D_MODEL) + F.lane;
#pragma unroll
        for (int j = 0; j < 8; ++j) { u32x2 w; w.x = cvt_pk_bf16(v[j][0] * rstd * gv[j][0], v[j][1] * rstd * gv[j][1]); w.y = cvt_pk_bf16(v[j][2] * rstd * gv[j][2], v[j][3] * rstd * gv[j][3]); o[64 * j] = w; }
    }
}
__device__ __forceinline__ void ph_pcvt(Frame& F, const float* pp, const float* ps, bf16* P16) {
    const int gw = F.vcu * NWAVES + F.wave, NGW = F.G * NWAVES;
    for (int m = gw; m < NTOK; m += NGW) {
        const float* src = m < 32768 ? pp + (size_t)m * PLE_DIM : ps + (size_t)(m - 32768) * PLE_DIM;
        const f32x4 v = ((const f32x4*)src)[F.lane];
        u32x2 w; w.x = cvt_pk_bf16(v[0], v[1]); w.y = cvt_pk_bf16(v[2], v[3]);
        ((u32x2*)(P16 + (size_t)m * PLE_DIM))[F.lane] = w;
    }
}
__device__ __forceinline__ void unpack8(u32x4 w, float (&f)[8]) { f[0] = bf_lo(w.x); f[1] = bf_hi(w.x); f[2] = bf_lo(w.y); f[3] = bf_hi(w.y); f[4] = bf_lo(w.z); f[5] = bf_hi(w.z); f[6] = bf_lo(w.w); f[7] = bf_hi(w.w); }
__device__ __forceinline__ u32x4 pack8(const float (&f)[8]) { u32x4 w; w.x = cvt_pk_bf16(f[0], f[1]); w.y = cvt_pk_bf16(f[2], f[3]); w.z = cvt_pk_bf16(f[4], f[5]); w.w = cvt_pk_bf16(f[6], f[7]); return w; }

__device__ __forceinline__ void conv_block(Frame& F, const bf16* Z, bf16* YS, const float* cw  , int blk, int lseq) {
#pragma unroll 1
    for (int i = 0; i < 8; ++i) {
        const int idx = F.tid + 512 * i, r = blk * 64 + (idx >> 6), c = (idx & 63) * 8, lpos = r % lseq;
        const bf16* zr = Z + (size_t)r * MIX_IN;
        float bg[8], z0[8], acc[8], tmp[8], w[8];
        unpack8(*(const u32x4*)(zr + ZC_BG + c), bg);
        {   float cg[8], vv[8]; unpack8(*(const u32x4*)(zr + ZC_CG + c), cg); unpack8(*(const u32x4*)(zr + ZC_VB + c), vv);
            const f32x4 wa = *(const f32x4*)(cw + 512 + c), wb = *(const f32x4*)(cw + 512 + c + 4);
            w[0] = wa[0]; w[1] = wa[1]; w[2] = wa[2]; w[3] = wa[3]; w[4] = wb[0]; w[5] = wb[1]; w[6] = wb[2]; w[7] = wb[3];
#pragma unroll
            for (int j = 0; j < 8; ++j) { z0[j] = cg[j] * vv[j]; acc[j] = w[j] * z0[j]; } }
        if (lpos > 0) { float cg[8], vv[8]; unpack8(*(const u32x4*)(zr - MIX_IN + ZC_CG + c), cg); unpack8(*(const u32x4*)(zr - MIX_IN + ZC_VB + c), vv);
            const f32x4 wa = *(const f32x4*)(cw + c), wb = *(const f32x4*)(cw + c + 4);
            w[0] = wa[0]; w[1] = wa[1]; w[2] = wa[2]; w[3] = wa[3]; w[4] = wb[0]; w[5] = wb[1]; w[6] = wb[2]; w[7] = wb[3];
#pragma unroll
            for (int j = 0; j < 8; ++j) acc[j] += w[j] * (cg[j] * vv[j]); }
        if (lpos < lseq - 1) { float cg[8], vv[8]; unpack8(*(const u32x4*)(zr + MIX_IN + ZC_CG + c), cg); unpack8(*(const u32x4*)(zr + MIX_IN + ZC_VB + c), vv);
            const f32x4 wa = *(const f32x4*)(cw + 1024 + c), wb = *(const f32x4*)(cw + 1024 + c + 4);
            w[0] = wa[0]; w[1] = wa[1]; w[2] = wa[2]; w[3] = wa[3]; w[4] = wb[0]; w[5] = wb[1]; w[6] = wb[2]; w[7] = wb[3];
#pragma unroll
            for (int j = 0; j < 8; ++j) acc[j] += w[j] * (cg[j] * vv[j]); }
#pragma unroll
        for (int j = 0; j < 8; ++j) tmp[j] = bg[j] * acc[j];
        *(u32x4*)(YS + (size_t)r * D_MODEL + 512 + c) = pack8(tmp);
    }
}
__device__ __forceinline__ void s5fin_block(Frame& F, const bf16* Z, const float* YF, const float* YB, const float* dsk  , bf16* Y1, int blk) {
#pragma unroll 1
    for (int i = 0; i < 8; ++i) {
        const int idx = F.tid + 512 * i, r = blk * 64 + (idx >> 6), c = (idx & 63) * 8;
        float u[8], o[8]; unpack8(*(const u32x4*)(Z + (size_t)r * MIX_IN + ZC_UA + c), u);
        const f32x4 f0 = *(const f32x4*)(YF + (size_t)r * 512 + c), f1 = *(const f32x4*)(YF + (size_t)r * 512 + c + 4);
        const f32x4 b0 = *(const f32x4*)(YB + (size_t)r * 512 + c), b1 = *(const f32x4*)(YB + (size_t)r * 512 + c + 4);
        const f32x4 d0 = *(const f32x4*)(dsk + c), d1 = *(const f32x4*)(dsk + c + 4);
#pragma unroll
        for (int j = 0; j < 8; ++j) { const float yy = (j < 4 ? d0[j & 3] : d1[j & 3]) * u[j] + (j < 4 ? f0[j & 3] : f1[j & 3]) + (j < 4 ? b0[j & 3] : b1[j & 3]);
            const float a = 0.7978845608028654f * (yy + 0.044715f * yy * yy * yy);
            const float th = 1.0f - 2.0f * __builtin_amdgcn_rcpf(1.0f + __expf(2.0f * a));
            o[j] = 0.5f * yy * (1.0f + th); }
        *(u32x4*)(Y1 + (size_t)r * 512 + c) = pack8(o);
    }
}

constexpr int S5_SEG = 512, S5_TPS = S5_SEG / 16;
template <bool FULL>
__device__ __forceinline__ void s5_seg_task(Frame& F, const unsigned char* tb, const bf16* Zs, float* Yout, f32x2* Ev, int nseg, int seg, int dir, int g) {
    LAS float* BU = (LAS float*)(F.lds + F.wave * 12288);
    LAS unsigned* XD = (LAS unsigned*)(F.lds + F.wave * 12288 + 8192);
    const int lane = F.lane, l15 = lane & 15, g4 = lane >> 4;
    const f32x2 ab = ((const f32x2*)(tb + S5T_AB))[lane];
    const float ar = ab.x, ai = ab.y;
    bf16x8 bbf[8];
#pragma unroll
    for (int cb = 0; cb < 8; ++cb) bbf[cb] = as_frag(((const u32x4*)(tb + S5T_BB))[cb * 64 + lane]);
    float xr = 0.f, xi = 0.f;
    float pwr[4], pwi[4];
    pwr[0] = ar; pwi[0] = ai;
#pragma unroll
    for (int j = 1; j < 4; ++j) { pwr[j] = pwr[j - 1] * ar - pwi[j - 1] * ai; pwi[j] = pwr[j - 1] * ai + pwi[j - 1] * ar; }
    if (FULL) {
        float pr = ar, pi = ai;
#pragma unroll
        for (int i = 0; i < 9; ++i) { const float nr = pr * pr - pi * pi, ni = 2.f * pr * pi; pr = nr; pi = ni; }
        if (dir == 0) { for (int j = 0; j < seg; ++j) { const f32x2 e = Ev[j * 64 + lane]; const float nr = pr * xr - pi * xi + e.x, ni = pr * xi + pi * xr + e.y; xr = nr; xi = ni; } }
        else { for (int j = nseg - 1; j > seg; --j) { const f32x2 e = Ev[j * 64 + lane]; const float nr = pr * xr - pi * xi + e.x, ni = pr * xi + pi * xr + e.y; xr = nr; xi = ni; } }
    }
    bf16x8 cf[4];
    if (FULL) {
#pragma unroll
        for (int ks = 0; ks < 4; ++ks) cf[ks] = as_frag(((const u32x4*)(tb + S5T_C))[ks * 64 + lane]);
    }
    const int tile0 = seg * S5_TPS;
    const bf16* zcol = Zs + ZC_UA + g * 16 + 8 * (g4 & 1);
    u32x4 ring[4];
#pragma unroll
    for (int j = 0; j < 4; ++j) { const int tile = tile0 + (dir ? S5_TPS - 1 - j : j); ring[j] = (u32x4){0u, 0u, 0u, 0u}; if (g4 < 2) ring[j] = *(const u32x4*)(zcol + (size_t)(tile * 16 + l15) * MIX_IN); }
#pragma unroll 1
    for (int it = 0; it < S5_TPS; it += 4) {
#pragma unroll
        for (int j = 0; j < 4; ++j) {
            const int tile = tile0 + (dir ? S5_TPS - 1 - (it + j) : it + j);
            const bf16x8 uf = as_frag(ring[j]);
            if (it + j + 4 < S5_TPS) { const int tn = dir ? tile - 4 : tile + 4; u32x4 nx = (u32x4){0u, 0u, 0u, 0u}; if (g4 < 2) nx = *(const u32x4*)(zcol + (size_t)(tn * 16 + l15) * MIX_IN); ring[j] = nx; }
            f32x4 a8[8];
#pragma unroll
            for (int cb = 0; cb < 8; ++cb) a8[cb] = mfma16(uf, bbf[cb], (f32x4){0.f, 0.f, 0.f, 0.f});
            MFMA_DRAIN();
#pragma unroll
            for (int cb = 0; cb < 8; ++cb)
#pragma unroll
                for (int q = 0; q < 4; ++q) BU[(4 * g4 + q) * 128 + 16 * cb + l15] = a8[cb][q];
            LDS_WAIT();
#pragma unroll
            for (int k = 0; k < 4; ++k) {
                float cr[4], ci[4], yr[4], yi[4];
                f32x2 bv[4];
#pragma unroll
                for (int j = 0; j < 4; ++j) { const int t = dir ? 15 - (4 * k + j) : 4 * k + j; bv[j] = *(const LAS f32x2*)(BU + t * 128 + 2 * lane); }
                cr[0] = bv[0].x; ci[0] = bv[0].y;
#pragma unroll
                for (int j = 1; j < 4; ++j) {
                    cr[j] = __builtin_fmaf(ar, cr[j - 1], __builtin_fmaf(-ai, ci[j - 1], bv[j].x));
                    ci[j] = __builtin_fmaf(ar, ci[j - 1], __builtin_fmaf(ai, cr[j - 1], bv[j].y));
                }
#pragma unroll
                for (int j = 0; j < 4; ++j) {
                    yr[j] = __builtin_fmaf(pwr[j], xr, __builtin_fmaf(-pwi[j], xi, cr[j]));
                    yi[j] = __builtin_fmaf(pwr[j], xi, __builtin_fmaf(pwi[j], xr, ci[j]));
                    if (FULL) { const int t = dir ? 15 - (4 * k + j) : 4 * k + j; XD[t * 64 + lane] = cvt_pk_bf16(yr[j], yi[j]); }
                }
                xr = yr[3]; xi = yi[3];
            }
            if (FULL) {
                LDS_WAIT();
                f32x4 y = (f32x4){0.f, 0.f, 0.f, 0.f};
#pragma unroll
                for (int ks = 0; ks < 4; ++ks) y = mfma16(as_frag(*(const LAS u32x4*)(XD + l15 * 64 + 16 * ks + 4 * g4)), cf[ks], y);
                MFMA_DRAIN();
                float* yo = Yout + (size_t)(tile * 16 + 4 * g4) * 512 + g * 16 + l15;
#pragma unroll
                for (int q = 0; q < 4; ++q) yo[(size_t)q * 512] = y[q];
            }
            LDS_WAIT();
        }
    }
    if (!FULL) { f32x2 e; e.x = xr; e.y = xi; Ev[seg * 64 + lane] = e; }
}

constexpr int NA_KL = 0, NA_VT = 73728, NA_BIAS = 147456;
constexpr int NA_RR = 8;
__device__ __forceinline__ void na_task(Frame& F, const bf16* Zs  , bf16* YSs  , int rows, int h, int r0,
                                        const float* qg, const float* kg, const float* relb  ) {
    LAS unsigned* KL = (LAS unsigned*)(F.lds + NA_KL); LAS unsigned* VT = (LAS unsigned*)(F.lds + NA_VT); LAS unsigned short* VT16 = (LAS unsigned short*)(F.lds + NA_VT);
    LAS float* BIAS = (LAS float*)(F.lds + NA_BIAS);
    const int tid = F.tid, lane = F.lane, l15 = lane & 15, g4 = lane >> 4;
    __syncthreads();
    for (int i = tid; i < 15 * 31; i += 512) BIAS[i] = relb[i];
    const int scol = tid >> 3, schunk = tid & 7;
    float kgv[8];
    { const f32x4 a = *(const f32x4*)(kg + 8 * schunk), b = *(const f32x4*)(kg + 8 * schunk + 4); kgv[0] = a[0]; kgv[1] = a[1]; kgv[2] = a[2]; kgv[3] = a[3]; kgv[4] = b[0]; kgv[5] = b[1]; kgv[6] = b[2]; kgv[7] = b[3]; }
    int rs0 = r0 - 4; rs0 = rs0 < 0 ? 0 : (rs0 > rows - 8 ? rows - 8 : rs0);
    const bf16* zst = Zs + (size_t)scol * MIX_IN + h * 64 + 8 * schunk;
#define NA_LOAD(rho, kr, vr) do { const bf16* zt_ = zst + (size_t)(rho) * 64 * MIX_IN; kr = *(const u32x4*)(zt_ + ZC_K); vr = *(const u32x4*)(zt_ + ZC_VC); } while (0)
#define NA_STORE(rho, kr, vr) do { float kf_[8]; unpack8(kr, kf_); float ss_ = 0.f; \
        _Pragma("unroll") for (int j_ = 0; j_ < 8; ++j_) ss_ += kf_[j_] * kf_[j_]; \
        ss_ += __shfl_xor(ss_, 1); ss_ += __shfl_xor(ss_, 2); ss_ += __shfl_xor(ss_, 4); \
        const float rk_ = rsqrtf(ss_ * (1.0f / 64.0f) + EPS); \
        _Pragma("unroll") for (int j_ = 0; j_ < 8; ++j_) kf_[j_] = kf_[j_] * rk_ * kgv[j_]; \
        const int slot_ = (rho) & 7; \
        *(LAS u32x4*)(KL + (slot_ * 64 + scol) * 36 + schunk * 4) = pack8(kf_); \
        const unsigned vw_[4] = {vr.x, vr.y, vr.z, vr.w}; \
        _Pragma("unroll") for (int j_ = 0; j_ < 8; ++j_) VT16[(slot_ * 64 + 8 * schunk + j_) * 72 + scol] = (unsigned short)((j_ & 1) ? (vw_[j_ >> 1] >> 16) : (vw_[j_ >> 1] & 0xffffu)); } while (0)
    {
        __syncthreads();
#pragma unroll 1
        for (int b = 0; b < 2; ++b) {
            u32x4 kr[4], vr[4];
#pragma unroll
            for (int i = 0; i < 4; ++i) NA_LOAD(rs0 + 4 * b + i, kr[i], vr[i]);
#pragma unroll
            for (int i = 0; i < 4; ++i) NA_STORE(rs0 + 4 * b + i, kr[i], vr[i]);
        }
    }
    int nextrow = rs0 + 8;
#pragma unroll 1
    for (int r = r0; r < r0 + NA_RR; ++r) {
        int rs = r - 4; rs = rs < 0 ? 0 : (rs > rows - 8 ? rows - 8 : rs);
        int rsn = r + 1 - 4; rsn = rsn < 0 ? 0 : (rsn > rows - 8 ? rows - 8 : rsn);
        const bool pre = (r + 1 < r0 + NA_RR) && (rsn + 7 >= nextrow);
        u32x4 pk = (u32x4){0u, 0u, 0u, 0u}, pv = (u32x4){0u, 0u, 0u, 0u};
        if (pre) NA_LOAD(nextrow, pk, pv);
        __syncthreads();
        if (F.wave < 4) {
            const int jb = F.wave, qc = 16 * jb + l15;
            int kc0 = 16 * jb - 8; kc0 = kc0 < 0 ? 0 : (kc0 > 32 ? 32 : kc0);
            int cs = qc - 8; cs = cs < 0 ? 0 : (cs > 48 ? 48 : cs);
            bf16x8 qf[2];
            {
                const bf16* zq = Zs + (size_t)(r * 64 + qc) * MIX_IN + ZC_Q + h * 64 + 8 * g4;
                float q0[8], q1[8]; unpack8(*(const u32x4*)zq, q0); unpack8(*(const u32x4*)(zq + 32), q1);
                float ss = 0.f;
#pragma unroll
                for (int j = 0; j < 8; ++j) ss += q0[j] * q0[j] + q1[j] * q1[j];
                ss += __shfl_xor(ss, 16); ss += __shfl_xor(ss, 32);
                const float rq = rsqrtf(ss * (1.0f / 64.0f) + EPS) * 0.125f;
                const f32x4 ga = *(const f32x4*)(qg + 8 * g4), gb = *(const f32x4*)(qg + 8 * g4 + 4), gc = *(const f32x4*)(qg + 32 + 8 * g4), gd = *(const f32x4*)(qg + 32 + 8 * g4 + 4);
#pragma unroll
                for (int j = 0; j < 4; ++j) { q0[j] *= rq * ga[j]; q0[4 + j] *= rq * gb[j]; q1[j] *= rq * gc[j]; q1[4 + j] *= rq * gd[j]; }
                qf[0] = as_frag(pack8(q0)); qf[1] = as_frag(pack8(q1));
            }
            f32x4 S[8][2];
#pragma unroll
            for (int a = 0; a < 8; ++a) {
                const int slot = (rs + a) & 7;
#pragma unroll
                for (int kb2 = 0; kb2 < 2; ++kb2) {
                    const LAS unsigned* kp = KL + (slot * 64 + kc0 + 16 * kb2 + l15) * 36 + 4 * g4;
                    S[a][kb2] = mfma16(as_frag(*(const LAS u32x4*)kp), qf[0], (f32x4){0.f, 0.f, 0.f, 0.f});
                    S[a][kb2] = mfma16(as_frag(*(const LAS u32x4*)(kp + 16)), qf[1], S[a][kb2]);
                }
            }
            MFMA_DRAIN();
            float mx = -3.0e38f;
#pragma unroll
            for (int a = 0; a < 8; ++a) {
                const int dr = rs + a - r + 7;
#pragma unroll
                for (int kb2 = 0; kb2 < 2; ++kb2)
#pragma unroll
                    for (int q = 0; q < 4; ++q) {
                        const int kc = kc0 + 16 * kb2 + 4 * g4 + q; const bool valid = (kc >= cs) && (kc < cs + 16);
                        int dc = kc - qc + 15; dc = dc < 0 ? 0 : (dc > 30 ? 30 : dc);
                        const float s = valid ? S[a][kb2][q] + BIAS[dr * 31 + dc] : -1.0e30f;
                        S[a][kb2][q] = s; mx = fmaxf(mx, s);
                    }
            }
            mx = fmaxf(mx, __shfl_xor(mx, 16)); mx = fmaxf(mx, __shfl_xor(mx, 32));
            float sum = 0.f;
#pragma unroll
            for (int a = 0; a < 8; ++a)
#pragma unroll
                for (int kb2 = 0; kb2 < 2; ++kb2)
#pragma unroll
                    for (int q = 0; q < 4; ++q) { const float p = __expf(S[a][kb2][q] - mx); S[a][kb2][q] = p; sum += p; }
            sum += __shfl_xor(sum, 16); sum += __shfl_xor(sum, 32);
            const float rinv = 1.0f / sum;
            f32x4 O[4];
#pragma unroll
            for (int dt = 0; dt < 4; ++dt) O[dt] = (f32x4){0.f, 0.f, 0.f, 0.f};
#pragma unroll
            for (int a = 0; a < 8; ++a) {
                const int slot = (rs + a) & 7;
                u32x4 pw; pw.x = cvt_pk_bf16(S[a][0][0], S[a][0][1]); pw.y = cvt_pk_bf16(S[a][0][2], S[a][0][3]); pw.z = cvt_pk_bf16(S[a][1][0], S[a][1][1]); pw.w = cvt_pk_bf16(S[a][1][2], S[a][1][3]);
                const bf16x8 pf = as_frag(pw);
#pragma unroll
                for (int dt = 0; dt < 4; ++dt) {
                    const LAS unsigned* vp = VT + (slot * 64 + 16 * dt + l15) * 36 + (kc0 >> 1) + 2 * g4;
                    const u32x2 v0 = *(const LAS u32x2*)vp, v1 = *(const LAS u32x2*)(vp + 8);
                    u32x4 vw; vw.x = v0.x; vw.y = v0.y; vw.z = v1.x; vw.w = v1.y;
                    O[dt] = mfma16(as_frag(vw), pf, O[dt]);
                }
            }
            MFMA_DRAIN();
            bf16* yo = YSs + (size_t)(r * 64 + qc) * D_MODEL + 1024 + h * 64 + 4 * g4;
#pragma unroll
            for (int dt = 0; dt < 4; ++dt) { u32x2 w; w.x = cvt_pk_bf16(O[dt][0] * rinv, O[dt][1] * rinv); w.y = cvt_pk_bf16(O[dt][2] * rinv, O[dt][3] * rinv); *(u32x2*)(yo + 16 * dt) = w; }
        }
        __syncthreads();
        if (pre) { NA_STORE(nextrow, pk, pv); nextrow += 1; }
    }
#undef NA_LOAD
#undef NA_STORE
}


#define TR2(o0, o1, off0, off1) "ds_read_b64_tr_b16 %" #o0 ", %16 offset:" #off0 "\n\tds_read_b64_tr_b16 %" #o1 ", %16 offset:" #off1 "\n\t"
constexpr int FN_XT = 0, FN_YR = 34816, FN_YI = 34816 + 34816;
template <int N1>
__device__ __forceinline__ void fnet1_tile(Frame& F, const bf16* Zs, bf16* ZFsg  , int g, int l2, const bf16* CT1, const bf16* ST1  , const bf16* C128, const bf16* S128) {
    constexpr int JT = N1 / 16, KS1 = N1 / 32;
    LAS unsigned short* YR = (LAS unsigned short*)(F.lds + FN_YR); LAS unsigned short* YI = (LAS unsigned short*)(F.lds + FN_YI);
    const int tid = F.tid, lane = F.lane, l15 = lane & 15, g4 = lane >> 4, w = F.wave;
    __syncthreads();
    {
        constexpr int NI = (N1 * 16) / 512;
        u32x4 raw[NI];
#pragma unroll
        for (int i = 0; i < NI; ++i) { const int idx = tid + 512 * i, l1 = idx >> 4, ch = idx & 15; raw[i] = *(const u32x4*)(Zs + (size_t)(128 * l1 + l2) * MIX_IN + ZC_UD + g * 128 + 8 * ch); }
#pragma unroll
        for (int i = 0; i < NI; ++i) { const int idx = tid + 512 * i, l1 = idx >> 4, ch = idx & 15; *(LAS u32x4*)(F.lds + FN_XT + l1 * 272 + ch * 16) = raw[i]; }
    }
    __syncthreads();
    {
        bf16x8 af[KS1];
        {
            const unsigned base = (unsigned)(size_t)F.lds + (unsigned)(FN_XT + (8 * g4 + (l15 >> 2)) * 272 + (16 * w + 4 * (lane & 3)) * 2);
            if constexpr (KS1 == 4) {
                u32x2 t_[8];
                asm volatile("ds_read_b64_tr_b16 %0, %8\n\tds_read_b64_tr_b16 %1, %8 offset:1088\n\tds_read_b64_tr_b16 %2, %8 offset:8704\n\tds_read_b64_tr_b16 %3, %8 offset:9792\n\t"
                             "ds_read_b64_tr_b16 %4, %8 offset:17408\n\tds_read_b64_tr_b16 %5, %8 offset:18496\n\tds_read_b64_tr_b16 %6, %8 offset:26112\n\tds_read_b64_tr_b16 %7, %8 offset:27200\n\ts_waitcnt lgkmcnt(0)"
                             : "=&v"(t_[0]), "=&v"(t_[1]), "=&v"(t_[2]), "=&v"(t_[3]), "=&v"(t_[4]), "=&v"(t_[5]), "=&v"(t_[6]), "=&v"(t_[7]) : "v"(base) : "memory");
#pragma unroll
                for (int ks = 0; ks < 4; ++ks) { u32x4 a; a.x = t_[2 * ks].x; a.y = t_[2 * ks].y; a.z = t_[2 * ks + 1].x; a.w = t_[2 * ks + 1].y; af[ks] = as_frag(a); }
            } else {
                u32x2 t0_, t1_;
                asm volatile("ds_read_b64_tr_b16 %0, %2\n\tds_read_b64_tr_b16 %1, %2 offset:1088\n\ts_waitcnt lgkmcnt(0)" : "=&v"(t0_), "=&v"(t1_) : "v"(base) : "memory");
                u32x4 a; a.x = t0_.x; a.y = t0_.y; a.z = t1_.x; a.w = t1_.y; af[0] = as_frag(a);
            }
        }
#pragma unroll 1
        for (int tj = 0; tj < JT; ++tj) {
            const int k1 = 16 * tj + l15;
            f32x4 ar = (f32x4){0.f, 0.f, 0.f, 0.f}, as = (f32x4){0.f, 0.f, 0.f, 0.f};
#pragma unroll
            for (int ks = 0; ks < KS1; ++ks) {
                ar = mfma16(af[ks], as_frag(*(const u32x4*)(CT1 + k1 * N1 + 32 * ks + 8 * g4)), ar);
                as = mfma16(af[ks], as_frag(*(const u32x4*)(ST1 + k1 * N1 + 32 * ks + 8 * g4)), as);
            }
            MFMA_DRAIN();
            float tsn, tcs; sincospif((float)(k1 * l2) * (2.0f / (float)(N1 * 128)), &tsn, &tcs);
            float zr[4], zi[4];
#pragma unroll
            for (int q = 0; q < 4; ++q) { const float yr = ar[q], yi = -as[q]; zr[q] = yr * tcs + yi * tsn; zi[q] = yi * tcs - yr * tsn; }
            u32x2 wr2, wi2; wr2.x = cvt_pk_bf16(zr[0], zr[1]); wr2.y = cvt_pk_bf16(zr[2], zr[3]); wi2.x = cvt_pk_bf16(zi[0], zi[1]); wi2.y = cvt_pk_bf16(zi[2], zi[3]);
            *(LAS u32x2*)(YR + k1 * 136 + 16 * w + 4 * g4) = wr2; *(LAS u32x2*)(YI + k1 * 136 + 16 * w + 4 * g4) = wi2;
        }
    }
    __syncthreads();
    {
        bf16x8 cfr[4], sfr[4];
#pragma unroll
        for (int ks = 0; ks < 4; ++ks) { cfr[ks] = as_frag(*(const u32x4*)(C128 + (16 * w + l15) * 128 + 32 * ks + 8 * g4)); sfr[ks] = as_frag(*(const u32x4*)(S128 + (16 * w + l15) * 128 + 32 * ks + 8 * g4)); }
#pragma unroll 1
        for (int tj = 0; tj < JT; ++tj) {
            const int k1 = 16 * tj + l15;
            f32x4 zr = (f32x4){0.f, 0.f, 0.f, 0.f}, zi = (f32x4){0.f, 0.f, 0.f, 0.f};
#pragma unroll
            for (int ks = 0; ks < 4; ++ks) {
                const u32x4 yr = *(const LAS u32x4*)(YR + k1 * 136 + 32 * ks + 8 * g4), yi = *(const LAS u32x4*)(YI + k1 * 136 + 32 * ks + 8 * g4);
                u32x4 ny; ny.x = yr.x ^ 0x80008000u; ny.y = yr.y ^ 0x80008000u; ny.z = yr.z ^ 0x80008000u; ny.w = yr.w ^ 0x80008000u;
                zr = mfma16(cfr[ks], as_frag(yr), zr); zr = mfma16(sfr[ks], as_frag(yi), zr);
                zi = mfma16(cfr[ks], as_frag(yi), zi); zi = mfma16(sfr[ks], as_frag(ny), zi);
            }
            MFMA_DRAIN();
            bf16* zo = ZFsg + ((size_t)k1 * 128 + l2) * 256 + 16 * w + 4 * g4;
            u32x2 a, b; a.x = cvt_pk_bf16(zr[0], zr[1]); a.y = cvt_pk_bf16(zr[2], zr[3]); b.x = cvt_pk_bf16(zi[0], zi[1]); b.y = cvt_pk_bf16(zi[2], zi[3]);
            *(u32x2*)zo = a; *(u32x2*)(zo + 128) = b;
        }
    }
}
__device__ __forceinline__ void fnet2_tile(Frame& F, const bf16* ZFsg, bf16* YSs  , int g, int k1, int N1, const bf16* C128, const bf16* S128) {
    constexpr int RS = 528;
    const int tid = F.tid, lane = F.lane, l15 = lane & 15, g4 = lane >> 4, w = F.wave;
    __syncthreads();
    const bf16* src = ZFsg + (size_t)k1 * 128 * 256;
    {
        u32x4 raw[8];
#pragma unroll
        for (int i = 0; i < 8; ++i) { const int idx = tid + 512 * i; raw[i] = *(const u32x4*)(src + (size_t)idx * 8); }
#pragma unroll
        for (int i = 0; i < 8; ++i) { const int idx = tid + 512 * i, l2 = idx >> 5, ch = idx & 31; *(LAS u32x4*)(F.lds + l2 * RS + ch * 16) = raw[i]; }
    }
    __syncthreads();
    const unsigned base = (unsigned)(size_t)F.lds + (unsigned)((8 * g4 + (l15 >> 2)) * RS + (16 * w + 4 * (lane & 3)) * 2);
    u32x2 t_[16];
    asm volatile(
        TR2(0, 1, 0, 2112) TR2(2, 3, 16896, 19008) TR2(4, 5, 33792, 35904) TR2(6, 7, 50688, 52800)
        TR2(8, 9, 256, 2368) TR2(10, 11, 17152, 19264) TR2(12, 13, 34048, 36160) TR2(14, 15, 50944, 53056)
        "s_waitcnt lgkmcnt(0)"
        : "=&v"(t_[0]), "=&v"(t_[1]), "=&v"(t_[2]), "=&v"(t_[3]), "=&v"(t_[4]), "=&v"(t_[5]), "=&v"(t_[6]), "=&v"(t_[7]),
          "=&v"(t_[8]), "=&v"(t_[9]), "=&v"(t_[10]), "=&v"(t_[11]), "=&v"(t_[12]), "=&v"(t_[13]), "=&v"(t_[14]), "=&v"(t_[15])
        : "v"(base) : "memory");
    bf16x8 zrf[4], zif[4];
#pragma unroll
    for (int ks = 0; ks < 4; ++ks) { u32x4 a; a.x = t_[2 * ks].x; a.y = t_[2 * ks].y; a.z = t_[2 * ks + 1].x; a.w = t_[2 * ks + 1].y; zrf[ks] = as_frag(a);
        u32x4 b; b.x = t_[8 + 2 * ks].x; b.y = t_[8 + 2 * ks].y; b.z = t_[8 + 2 * ks + 1].x; b.w = t_[8 + 2 * ks + 1].y; zif[ks] = as_frag(b); }
#pragma unroll 1
    for (int tj = 0; tj < 8; ++tj) {
        const int k2 = 16 * tj + l15;
        f32x4 y = (f32x4){0.f, 0.f, 0.f, 0.f};
#pragma unroll
        for (int ks = 0; ks < 4; ++ks) {
            y = mfma16(zrf[ks], as_frag(*(const u32x4*)(C128 + k2 * 128 + 32 * ks + 8 * g4)), y);
            y = mfma16(zif[ks], as_frag(*(const u32x4*)(S128 + k2 * 128 + 32 * ks + 8 * g4)), y);
        }
        MFMA_DRAIN();
        u32x2 o; o.x = cvt_pk_bf16(y[0], y[1]); o.y = cvt_pk_bf16(y[2], y[3]);
        *(u32x2*)(YSs + (size_t)(k1 + N1 * k2) * D_MODEL + 1536 + g * 128 + 16 * w + 4 * g4) = o;
    }
}

struct ChunkGeo { int nseq, lseq, rows, n1; };
__device__ __forceinline__ ChunkGeo chunk_geo(int ch) { ChunkGeo g; if (ch < 2) { g.nseq = 1; g.lseq = 16384; g.rows = 256; g.n1 = 128; } else { g.nseq = 4; g.lseq = 4096; g.rows = 64; g.n1 = 32; } return g; }

__device__ __forceinline__ void ph_s5a(Frame& F, const Args& A, int layer, int ch) {
    const ChunkGeo cg = chunk_geo(ch);
    const bf16* Z = (const bf16*)(F.ws + WS_Z); f32x2* EV = (f32x2*)(F.ws + WS_S5E);
    const int nseg = cg.lseq / S5_SEG, ntask = cg.nseq * nseg * 64;
#pragma unroll 1
    for (int tt = F.vcu * 8 + F.wave; tt < ntask; tt += F.G * 8) {
        const int dg = tt & 63, sg = tt >> 6, seg = sg % nseg, seq = sg / nseg, dir = dg >> 5, g = dg & 31;
        const unsigned char* tb = F.ws + TAB_S5 + (size_t)(((layer * 2 + dir) * 32) + g) * S5T_BYTES;
        s5_seg_task<false>(F, tb, Z + (size_t)seq * cg.lseq * MIX_IN, nullptr, EV + (size_t)(seq * 64 + dg) * nseg * 64, nseg, seg, dir, g);
    }
    int t0 = F.vcu; asm volatile("" : "+s"(t0));
    bf16* YS = (bf16*)(F.ws + WS_YS); bf16* ZF = (bf16*)(F.ws + WS_ZF);
    const int n_f1 = 512, n_cv = CH_TOK / 64;
#pragma unroll 1
    for (; t0 < n_f1 + n_cv; t0 += F.G) {
        if (t0 < n_f1) {
            const int u = t0;
            const bf16* C128 = (const bf16*)(F.ws + TAB_C128); const bf16* S128 = (const bf16*)(F.ws + TAB_S128);
            if (ch < 2) { const int g = u >> 7, l2 = u & 127;
                fnet1_tile<128>(F, Z, ZF + (size_t)g * 16384 * 256, g, l2, C128, S128, C128, S128);
            } else {
                const bf16* C32 = (const bf16*)(F.ws + TAB_C32); const bf16* S32 = (const bf16*)(F.ws + TAB_S32);
#pragma unroll 1
                for (int s = 0; s < 4; ++s) { const int uu = u * 4 + s, l2 = uu & 127, g = (uu >> 7) & 3, seq = uu >> 9;
                    fnet1_tile<32>(F, Z + (size_t)seq * 4096 * MIX_IN, ZF + (size_t)(seq * 4 + g) * 4096 * 256, g, l2, C32, S32, C128, S128); }
            }
        } else {
            conv_block(F, Z, YS, A.in[15] + (size_t)layer * 3 * 512, t0 - n_f1, cg.lseq);
        }
    }
}
__device__ __forceinline__ void ph_mix1(Frame& F, const Args& A, int layer, int ch) {
    const ChunkGeo cg = chunk_geo(ch);
    const bf16* Z = (const bf16*)(F.ws + WS_Z); bf16* YS = (bf16*)(F.ws + WS_YS); const bf16* ZF = (const bf16*)(F.ws + WS_ZF);
    float* YF = (float*)(F.ws + WS_YF); float* YB = (float*)(F.ws + WS_YB); f32x2* EV = (f32x2*)(F.ws + WS_S5E);
    const int nseg = cg.lseq / S5_SEG;
    const int n_s5 = cg.nseq * nseg * 8;
    const int n_na = cg.nseq * 8 * (cg.rows / NA_RR);
    const int n_f2 = 512;
    int t0 = F.vcu;
#pragma unroll 1
    for (; t0 < n_s5; t0 += F.G) {
        const int tt = t0 * 8 + F.wave, dg = tt & 63, sg = tt >> 6, seg = sg % nseg, seq = sg / nseg, dir = dg >> 5, g = dg & 31;
        const unsigned char* tb = F.ws + TAB_S5 + (size_t)(((layer * 2 + dir) * 32) + g) * S5T_BYTES;
        const size_t row0 = (size_t)seq * cg.lseq;
        s5_seg_task<true>(F, tb, Z + row0 * MIX_IN, (dir ? YB : YF) + row0 * 512, EV + (size_t)(seq * 64 + dg) * nseg * 64, nseg, seg, dir, g);
    }
    asm volatile("" : "+s"(t0));
#pragma unroll 1
    for (; t0 < n_s5 + n_na + n_f2; t0 += F.G) {
        const int t = t0 - n_s5;
        if (t < n_na) {
            const int runs = cg.rows / NA_RR, run = t % runs, h = (t / runs) & 7, seq = t / (runs * 8);
            const size_t row0 = (size_t)seq * cg.lseq;
            na_task(F, Z + row0 * MIX_IN, YS + row0 * D_MODEL, cg.rows, h, run * NA_RR, A.in[16] + layer * 64, A.in[17] + layer * 64, A.in[18] + ((size_t)layer * 8 + h) * 15 * 31);
        } else {
            const int u = t - n_na;
            const bf16* C128 = (const bf16*)(F.ws + TAB_C128); const bf16* S128 = (const bf16*)(F.ws + TAB_S128);
            int seq, g, k1; if (ch < 2) { seq = 0; g = u >> 7; k1 = u & 127; } else { k1 = u & 31; g = (u >> 5) & 3; seq = u >> 7; }
            fnet2_tile(F, ZF + (size_t)(seq * 4 + g) * cg.lseq * 256, YS + (size_t)seq * cg.lseq * D_MODEL, g, k1, cg.n1, C128, S128);
        }
    }
}
__device__ __forceinline__ void ph_mix2(Frame& F, const Args& A, int layer, int ch) {
    const bf16* Z = (const bf16*)(F.ws + WS_Z);
    const float* YF = (const float*)(F.ws + WS_YF); const float* YB = (const float*)(F.ws + WS_YB); bf16* Y1 = (bf16*)(F.ws + WS_Y1);
    (void)ch;
#pragma unroll 1
    for (int t = F.vcu; t < CH_TOK / 64; t += F.G) s5fin_block(F, Z, YF, YB, A.in[13] + (size_t)layer * 512, Y1, t);
}

constexpr int MK_STAG = 0, MK_STAG_MERGE = 0;
constexpr int PH_A = 8, PH_PER_LAYER = 3 * PH_A + 1 + 3 + 3, N_PHASES = 1 + DEPTH * PH_PER_LAYER;
__global__ void __launch_bounds__(NWAVES * 64, 2) fwd_kernel(const Args A) {
    extern __shared__ __attribute__((aligned(16))) unsigned char lds_raw[];
    Frame F;
    F.lds = (LAS unsigned char*)lds_raw;
    F.tid = threadIdx.x; F.lane = F.tid & 63; F.wave = __builtin_amdgcn_readfirstlane(F.tid >> 6);
    F.G = gridDim.x; { const int bx = blockIdx.x; F.vcu = (F.G % 8 == 0) ? (bx % 8) * (F.G / 8) + bx / 8 : bx; }
    F.ws = A.ws;
    volatile LAS unsigned* LCTL = (volatile LAS unsigned*)(F.lds + LDSCTL_OFF);
    if (F.tid < 64) LCTL[F.tid] = 0u;
    __syncthreads();
    const int lo = A.ph_lo, hi = A.ph_hi;
    const bool multi = (hi - lo) > 1;
    XcdBarrier bar; bar.bar = (unsigned*)(F.ws + WS_CTL) + CW_BAR; bar.x = 0; bar.st = LCTL;
    if (multi) bar = xcd_barrier_post((unsigned*)(F.ws + WS_CTL) + CW_BAR, LCTL);
#define IN(k) (lo <= (k) && (k) < hi)
#define SEAM(k) do { if ((k) + 1 < hi) xcd_barrier(bar); } while (0)

    if (IN(0)) { Frame Fp = fresh(F); ph_prologue(Fp, A); SEAM(0); }

#pragma unroll 1
    for (int layer = 0; layer < DEPTH; ++layer) {
        const int pl = 1 + layer * PH_PER_LAYER;
        if (pl + PH_PER_LAYER <= lo || pl >= hi) continue;
        const unsigned char* wl = F.ws + WS_W + (size_t)layer * WL_BYTES;
        bf16* H = (bf16*)(F.ws + WS_H); bf16* Z = (bf16*)(F.ws + WS_Z); bf16* YS = (bf16*)(F.ws + WS_YS); bf16* MGA = (bf16*)(F.ws + WS_MG); bf16* GT = (bf16*)(F.ws + WS_GT);
        bf16* Y1 = (bf16*)(F.ws + WS_Y1); bf16* P16 = (bf16*)(F.ws + WS_P16); bf16* PP = (bf16*)(F.ws + WS_PP); bf16* HALL = (bf16*)(F.ws + WS_HALL);
#pragma unroll 1
        for (int ch = 0; ch < N_CHUNK; ++ch) {
            const int pb = pl + ch * PH_A;
            const float* x_cur = layer == 0 ? ((ch < 2) ? A.in[0] + (size_t)ch * CH_TOK * D_MODEL : A.in[1]) : A.out + (size_t)ch * CH_TOK * D_MODEL;
            bf16* MG = MGA + (size_t)ch * CH_TOK * D_MODEL;
            if (IN(pb + 0)) { Frame Fp = fresh(F); ph_norm(Fp, x_cur, A.in[4] + (size_t)layer * D_MODEL, H, CH_TOK); SEAM(pb + 0); }
            if (IN(pb + 1)) {
                pg8::Gemm g{H, (const bf16*)(wl + WL_MIX), D_MODEL, D_MODEL, D_MODEL, 0, 0, 0, 0}; pg8::StaticOrder S; S.init(CH_TOK, MIX_IN, F.G, (int)blockIdx.x);
                pg8::EpiStoreBf16 E{Z, MIX_IN};

                pg8::gemm_phase<pg8::EpiStoreBf16, pg8::StaticOrder, true, true>(F.lds, g, S, E);
                SEAM(pb + 1); }
            if (IN(pb + 2)) { Frame Fp = fresh(F); ph_s5a(Fp, A, layer, ch); SEAM(pb + 2); }
            if (IN(pb + 3)) { Frame Fp = fresh(F); ph_mix1(Fp, A, layer, ch); SEAM(pb + 3); }
            if (IN(pb + 4)) { Frame Fp = fresh(F); ph_mix2(Fp, A, layer, ch); SEAM(pb + 4); }
            if (IN(pb + 5)) {
                pg8::Gemm g{Y1, (const bf16*)(wl + WL_GLU), 512, 512, 512, 0, 0, 0, 0}; pg8::StaticOrder S; S.init(CH_TOK, 512, F.G, (int)blockIdx.x);
                pg8::EpiGlu E{Y1, 512, YS, D_MODEL};
                pg8::gemm_phase<pg8::EpiGlu, pg8::StaticOrder, true, true>(F.lds, g, S, E);
                SEAM(pb + 5); }
            if (IN(pb + 6)) {
                pg8::Gemm g{YS, (const bf16*)(wl + WL_BR), D_MODEL, 512, 512, 3, 512, 0, 0}; pg8::StaticOrder S; S.init(CH_TOK, 8192, F.G, (int)blockIdx.x);
                pg8::EpiStoreBlk E{GT};

                pg8::gemm_phase<pg8::EpiStoreBlk, pg8::StaticOrder, false, true>(F.lds, g, S, E);
                SEAM(pb + 6); }
            if (IN(pb + 7)) {
                pg8::Gemm g{H, (const bf16*)(wl + WL_G), D_MODEL, D_MODEL, D_MODEL, 0, 0, 2, MK_STAG_MERGE}; pg8::StaticOrder S; S.init(CH_TOK, 32 * 256, F.G, (int)blockIdx.x);
                pg8::EpiMerge E{GT, MG};

                pg8::gemm_phase<pg8::EpiMerge, pg8::StaticOrder, true, true>(F.lds, g, S, E);
                SEAM(pb + 7); }
        }
        {
            const int pb = pl + 3 * PH_A;
            if (IN(pb)) {
                pg8::Gemm g{MGA, (const bf16*)(wl + WL_O), D_MODEL, D_MODEL, D_MODEL, 0, 0, 0, MK_STAG, MK_BLK_MG ? 4 : 0}; pg8::StaticOrder S; S.init(NTOK, D_MODEL, F.G, (int)blockIdx.x);
                pg8::EpiResF32 E{layer == 0 ? A.in[0] : A.out, layer == 0 ? A.in[1] : A.out + (size_t)32768 * D_MODEL, 32768, A.out, D_MODEL};
                pg8::gemm_phase<pg8::EpiResF32, pg8::StaticOrder, true, true>(F.lds, g, S, E);
                SEAM(pb); }
        }
        {
            const int pb = pl + 3 * PH_A + 1;
            bf16* H2 = (bf16*)(F.ws + WS_H2ALL); bf16* MIDA = (bf16*)(F.ws + WS_MIDALL);
            if (IN(pb + 0)) { Frame Fp = fresh(F); ph_norm(Fp, A.out, A.in[21] + (size_t)layer * D_MODEL, H2, NTOK); SEAM(pb + 0); }
            if (IN(pb + 1)) {
                pg8::Gemm g{H2, (const bf16*)(wl + WL_FF), D_MODEL, D_MODEL, D_MODEL, 0, 0, 0, 0}; pg8::StaticOrder S; S.init(NTOK, 2 * D_FF, F.G, (int)blockIdx.x);
                pg8::EpiSwiglu E{MIDA, D_FF};

                pg8::gemm_phase<pg8::EpiSwiglu, pg8::StaticOrder, true, true>(F.lds, g, S, E);
                SEAM(pb + 1); }
            if (IN(pb + 2)) {
                pg8::Gemm g{MIDA, (const bf16*)(wl + WL_FF2), D_FF, D_FF, D_FF, 0, 0, 0, MK_STAG, MK_BLK_MID ? 5 : 0}; pg8::StaticOrder S; S.init(NTOK, D_MODEL, F.G, (int)blockIdx.x);
                pg8::EpiResF32 E{A.out, A.out, 1 << 30, A.out, D_MODEL};
                pg8::gemm_phase<pg8::EpiResF32, pg8::StaticOrder, true, true>(F.lds, g, S, E);
                SEAM(pb + 2); }
        }
        {
            const int pb = pl + 3 * PH_A + 1 + 3;
            if (IN(pb + 0)) { Frame Fp = fresh(F); ph_norm(Fp, A.out, A.in[24] + (size_t)layer * D_MODEL, HALL, NTOK);
                ph_pcvt(Fp, A.in[2] + (size_t)layer * 32768 * PLE_DIM, A.in[3] + (size_t)layer * CH_TOK * PLE_DIM, P16); SEAM(pb + 0); }
            if (IN(pb + 1)) {
                int kpp = PLE_DIM; asm volatile("" : "+s"(kpp));
                pg8::Gemm g{P16, (const bf16*)(wl + WL_PP), kpp, kpp, kpp, 0, 0, 0, 0}; pg8::StaticOrder S; S.init(NTOK, D_MODEL, F.G, (int)blockIdx.x);
#if MK_BLK_PP
                pg8::EpiStoreBlk32 E{PP, D_MODEL / 32};
                pg8::gemm_phase<pg8::EpiStoreBlk32, pg8::StaticOrder, true, true>(F.lds, g, S, E);
#else
                pg8::EpiStoreBf16 E{PP, D_MODEL};
                pg8::gemm_phase<pg8::EpiStoreBf16, pg8::StaticOrder, true, true>(F.lds, g, S, E);
#endif
                SEAM(pb + 1); }
            if (IN(pb + 2)) {
                pg8::Gemm g{HALL, (const bf16*)(wl + WL_PG), D_MODEL, D_MODEL, D_MODEL, 0, 0, 0, MK_STAG}; pg8::StaticOrder S; S.init(NTOK, D_MODEL, F.G, (int)blockIdx.x);
                pg8::EpiPle E{A.out, A.out, D_MODEL, PP, D_MODEL};
                pg8::gemm_phase<pg8::EpiPle, pg8::StaticOrder, true, true>(F.lds, g, S, E);
                SEAM(pb + 2); }
        }
    }
#undef IN
#undef SEAM
}

#ifndef MK_PER_PHASE
#define MK_PER_PHASE 0
#endif
extern "C" void kernel_launch(void* const* d_in, const int* in_sizes, int n_in, void* d_out, int out_size, void* d_ws, size_t ws_size, hipStream_t stream) {
    static int grid = 0;
    if (grid == 0) {
        if (n_in != 27 || out_size != NTOK * D_MODEL || ws_size < WS_END) { fprintf(stderr, "kernel_launch: unexpected shapes (n_in %d, out %d, ws %zu); nothing launched\n", n_in, out_size, ws_size); grid = -1; return; }
        int dev = 0, cus = 0, per_cu = 0;
        if (hipGetDevice(&dev) != hipSuccess || hipDeviceGetAttribute(&cus, hipDeviceAttributeMultiprocessorCount, dev) != hipSuccess) { grid = -1; return; }
        if (hipFuncSetAttribute((const void*)fwd_kernel, hipFuncAttributeMaxDynamicSharedMemorySize, LDS_BYTES) != hipSuccess) { fprintf(stderr, "kernel_launch: hipFuncSetAttribute failed\n"); grid = -1; return; }
        if (hipOccupancyMaxActiveBlocksPerMultiprocessor(&per_cu, (const void*)fwd_kernel, NWAVES * 64, LDS_BYTES) != hipSuccess || per_cu < 1)
            fprintf(stderr, "kernel_launch: occupancy query reports %d workgroups per CU\n", per_cu);
        (void)hipGetLastError();
        grid = cus;
    }
    if (grid < 0) return;
    (void)in_sizes;
    if (hipMemsetAsync((char*)d_ws + WS_CTL, 0, CTL_ZERO_BYTES, stream) != hipSuccess) return;
    Args a{};
    for (int i = 0; i < 27; ++i) a.in[i] = (const float*)d_in[i];
    a.out = (float*)d_out; a.ws = (unsigned char*)d_ws;
#if MK_PER_PHASE
    for (int p = 0; p < N_PHASES; ++p) { a.ph_lo = p; a.ph_hi = p + 1; hipLaunchKernelGGL(fwd_kernel, dim3(grid), dim3(NWAVES * 64), LDS_BYTES, stream, a); }
#else
    a.ph_lo = 0; a.ph_hi = N_PHASES;
    hipLaunchKernelGGL(fwd_kernel, dim3(grid), dim3(NWAVES * 64), LDS_BYTES, stream, a);
#endif
}
```
